# Optimizing an MI355X kernel written in HIP

```python
import math
import jax
import jax.numpy as jnp
from jax import lax
import numpy as np

D_MODEL = 1024
BATCH = 4
SEQ = 4096
DEPTH = 1

CHUNK = 64
QBLOCK = 128
SB_HEADS = 8
HEAD_DIM = 64
SB_WIDTH = SB_HEADS * HEAD_DIM
POOL_WINDOWS = (2, 4, 8, 16)
N_POOL_GROUPS = len(POOL_WINDOWS)
POOL_WIDTH = 512
POOL_GROUP_DIM = POOL_WIDTH // N_POOL_GROUPS
MAX_WIN = max(POOL_WINDOWS)
IN_WIDTH = 3 * SB_WIDTH + POOL_WIDTH + 2 * D_MODEL
N_EXPERTS = 64
EXPERT_DIM = 128
TOP_K = 8
N_EXPERT_GROUPS = 8
TOPK_GROUPS = 4
SHARED_DIM = 256
ROUTED_SCALE = 2.5
NORM_EPS = 1e-6

kernel_name = "hybrid_stickbreak_pool_moe_block"


def _rmsnorm(x, g):
    xf = x.astype(jnp.float32)
    r = lax.rsqrt(jnp.mean(xf * xf, axis=-1, keepdims=True) + NORM_EPS)
    return (xf * r).astype(x.dtype) * g


def _stick_breaking(q, k, v):
    S = q.shape[2]
    scale = 1.0 / math.sqrt(HEAD_DIM)
    outs = []
    for i0 in range(0, S, QBLOCK):
        kn = i0 + QBLOCK
        qb = q[:, :, i0:kn]
        kb = k[:, :, :kn]
        vb = v[:, :, :kn]
        z = jnp.einsum('bhqd,bhkd->bhqk', qb, kb).astype(jnp.float32) * scale
        qpos = i0 + jnp.arange(QBLOCK)[:, None]
        kpos = jnp.arange(kn)[None, :]
        mask = kpos < qpos
        log_fail = jnp.where(mask, jax.nn.log_sigmoid(-z), 0.0)
        between = lax.cumsum(log_fail, axis=3, reverse=True) - log_fail
        a = jnp.where(mask, jnp.exp(jax.nn.log_sigmoid(z) + between), 0.0)
        outs.append(jnp.einsum('bhqk,bhkd->bhqd', a.astype(vb.dtype), vb))
    return jnp.concatenate(outs, axis=2)


def _multiscale_pool(u, w_pool_group, pool_scale):
    B, S, _ = u.shape
    uf = u.astype(jnp.float32).reshape(B, S, N_POOL_GROUPS, POOL_GROUP_DIM)
    cs = jnp.pad(jnp.cumsum(uf, axis=1), ((0, 0), (MAX_WIN, 0), (0, 0), (0, 0)))
    cur = cs[:, MAX_WIN:]
    prev = jnp.stack([cs[:, MAX_WIN - w:MAX_WIN - w + S, gi]
                      for gi, w in enumerate(POOL_WINDOWS)], axis=2)
    count = jnp.minimum(jnp.arange(S)[:, None] + 1,
                        jnp.array(POOL_WINDOWS)[None, :]).astype(jnp.float32)
    mixed = (cur - prev) / count[None, :, :, None] - uf
    mixed = jnp.einsum('bsgc,gcd->bsgd', mixed.astype(u.dtype), w_pool_group)
    return mixed.reshape(B, S, POOL_WIDTH) * pool_scale


def _moe(h, w_router, router_bias, w_exp_gate, w_exp_up, w_exp_down,
         w_sh_gate, w_sh_up, w_sh_down):
    T = h.shape[0]
    per_group = N_EXPERTS // N_EXPERT_GROUPS
    scores = jax.nn.sigmoid((h @ w_router).astype(jnp.float32))
    sel = scores + router_bias.astype(jnp.float32)
    grp_score = jnp.sum(lax.top_k(sel.reshape(T, N_EXPERT_GROUPS, per_group), 2)[0], axis=-1)
    _, gidx = lax.top_k(grp_score, TOPK_GROUPS)
    gmask = jnp.any(gidx[:, :, None] == jnp.arange(N_EXPERT_GROUPS)[None, None, :], axis=1)
    emask = jnp.repeat(gmask, per_group, axis=1)
    _, eidx = lax.top_k(jnp.where(emask, sel, -jnp.inf), TOP_K)
    w = jnp.take_along_axis(scores, eidx, axis=1)
    w = w / jnp.sum(w, axis=-1, keepdims=True) * ROUTED_SCALE
    gates = jnp.zeros((T, N_EXPERTS), jnp.float32).at[jnp.arange(T)[:, None], eidx].set(w)
    a = jnp.einsum('td,edf->tef', h, w_exp_gate)
    b = jnp.einsum('td,edf->tef', h, w_exp_up)
    hmid = (jax.nn.silu(a) * b * gates[:, :, None]).astype(h.dtype)
    routed = jnp.einsum('tef,efd->td', hmid, w_exp_down)
    shared = (jax.nn.silu(h @ w_sh_gate) * (h @ w_sh_up)) @ w_sh_down
    return routed + shared


def _layer(x, c, w_ada, b_ada, g_norm1, w_in, g_q, g_k, w_sb_out, w_pool_group,
           pool_scale, w_pool_out, w_out, g_norm2, w_router, router_bias,
           w_exp_gate, w_exp_up, w_exp_down, w_sh_gate, w_sh_up, w_sh_down):
    B, S, D = x.shape
    mod = (jax.nn.silu(c) @ w_ada + b_ada)[:, None, :]
    shift1, scale1, gate1, shift2, scale2, gate2 = jnp.split(mod, 6, axis=-1)

    h = _rmsnorm(x, g_norm1) * (1 + scale1) + shift1
    proj = h @ w_in
    cuts = [SB_WIDTH, 2 * SB_WIDTH, 3 * SB_WIDTH, 3 * SB_WIDTH + POOL_WIDTH,
            3 * SB_WIDTH + POOL_WIDTH + D_MODEL]
    q, k, v, u, g_a, g_b = jnp.split(proj, cuts, axis=-1)

    def heads(t):
        return t.reshape(B, S, SB_HEADS, HEAD_DIM).transpose(0, 2, 1, 3)

    q = _rmsnorm(heads(q), g_q)
    k = _rmsnorm(heads(k), g_k)
    o_sb = _stick_breaking(q, k, heads(v)).transpose(0, 2, 1, 3).reshape(B, S, SB_WIDTH)
    y_sb = o_sb @ w_sb_out
    y_pool = _multiscale_pool(u, w_pool_group, pool_scale) @ w_pool_out
    merged = jax.nn.sigmoid(g_a) * y_sb + jax.nn.sigmoid(g_b) * y_pool
    x = x + gate1 * (merged @ w_out)

    h2 = _rmsnorm(x, g_norm2) * (1 + scale2) + shift2
    y = _moe(h2.reshape(B * S, D), w_router, router_bias, w_exp_gate, w_exp_up,
             w_exp_down, w_sh_gate, w_sh_up, w_sh_down).reshape(B, S, D)
    return x + gate2 * y


def setup_inputs(seed: int = 0) -> dict:
    key = jax.random.key(seed)
    ks = jax.random.split(key, 24)
    D, L = D_MODEL, DEPTH

    def nrm(k, shape, fan_in, mult=1.0):
        return jax.random.normal(k, shape, jnp.float32) * (mult * fan_in ** -0.5)

    def gain(k, shape):
        return 1.0 + 0.02 * jax.random.normal(k, shape, jnp.float32)

    return {
        "x": jax.random.normal(ks[0], (BATCH, SEQ, D), jnp.float32),
        "c": jax.random.normal(ks[1], (BATCH, D), jnp.float32),
        "w_ada": nrm(ks[2], (L, D, 6 * D), D, 0.5),
        "b_ada": 0.02 * jax.random.normal(ks[3], (L, 6 * D), jnp.float32),
        "g_norm1": gain(ks[4], (L, D)),
        "w_in": nrm(ks[5], (L, D, IN_WIDTH), D),
        "g_q": gain(ks[6], (L, HEAD_DIM)),
        "g_k": gain(ks[7], (L, HEAD_DIM)),
        "w_sb_out": nrm(ks[8], (L, SB_WIDTH, D), SB_WIDTH),
        "w_pool_group": nrm(ks[9], (L, N_POOL_GROUPS, POOL_GROUP_DIM, POOL_GROUP_DIM), POOL_GROUP_DIM),
        "pool_scale": gain(ks[10], (L, POOL_WIDTH)),
        "w_pool_out": nrm(ks[11], (L, POOL_WIDTH, D), POOL_WIDTH),
        "w_out": nrm(ks[12], (L, D, D), D),
        "g_norm2": gain(ks[13], (L, D)),
        "w_router": nrm(ks[14], (L, D, N_EXPERTS), D),
        "router_bias": 0.01 * jax.random.normal(ks[15], (L, N_EXPERTS), jnp.float32),
        "w_exp_gate": nrm(ks[16], (L, N_EXPERTS, D, EXPERT_DIM), D),
        "w_exp_up": nrm(ks[17], (L, N_EXPERTS, D, EXPERT_DIM), D),
        "w_exp_down": nrm(ks[18], (L, N_EXPERTS, EXPERT_DIM, D), EXPERT_DIM),
        "w_sh_gate": nrm(ks[19], (L, D, SHARED_DIM), D),
        "w_sh_up": nrm(ks[20], (L, D, SHARED_DIM), D),
        "w_sh_down": nrm(ks[21], (L, SHARED_DIM, D), SHARED_DIM),
    }


def reference(x, c, w_ada, b_ada, g_norm1, w_in, g_q, g_k, w_sb_out, w_pool_group,
              pool_scale, w_pool_out, w_out, g_norm2, w_router, router_bias,
              w_exp_gate, w_exp_up, w_exp_down, w_sh_gate, w_sh_up, w_sh_down):
    for l in range(DEPTH):
        x = _layer(x, c, w_ada[l], b_ada[l], g_norm1[l], w_in[l], g_q[l], g_k[l],
                   w_sb_out[l], w_pool_group[l], pool_scale[l], w_pool_out[l],
                   w_out[l], g_norm2[l], w_router[l], router_bias[l],
                   w_exp_gate[l], w_exp_up[l], w_exp_down[l],
                   w_sh_gate[l], w_sh_up[l], w_sh_down[l])
    return x
```

```cpp
#include <hip/hip_runtime.h>
#include <cstdint>
#include <cstdio>

typedef unsigned short bf16_t;
constexpr int D = 1024, BATCH = 4, SEQ = 4096, M = BATCH * SEQ, NH = 8, HD = 64, SBW = 512, PW = 512, INW = 4096;
constexpr int NE = 64, ED = 128, TOPK = 8, SHD = 256;
constexpr float EPS = 1e-6f, RSCALE = 2.5f;

constexpr size_t MiB = 1u << 20;
constexpr size_t WS_CTL = 0, WS_MOD = 1 * MiB, WS_PE = 2 * MiB, WS_PW = 3 * MiB, WS_LIST = 4 * MiB;
constexpr size_t WS_XN = 74 * MiB, WS_OSB = 74 * MiB, WS_MIX = 90 * MiB, WS_H2 = 74 * MiB;
constexpr size_t WS_Q = 106 * MiB, WS_K = 122 * MiB, WS_V = 138 * MiB, WS_MERGED = 106 * MiB, WS_HM = 106 * MiB, WS_SH = 138 * MiB;
constexpr size_t WS_U = 154 * MiB, WS_GA = 170 * MiB, WS_GB = 202 * MiB, WS_PMB = 234 * MiB, WS_END = 256 * MiB;

__device__ __forceinline__ unsigned f2bf(float f) { unsigned u = __builtin_bit_cast(unsigned, f); return (u + 0x7fffu + ((u >> 16) & 1u)) >> 16; }
__device__ __forceinline__ float bf2f(unsigned h) { return __builtin_bit_cast(float, h << 16); }
__device__ __forceinline__ float wave_sum(float v) {
#pragma unroll
    for (int o = 1; o < 64; o <<= 1) v += __shfl_xor(v, o);
    return v;
}
__device__ __forceinline__ float sigmoidf_(float v) { return 1.f / (1.f + __expf(-v)); }
__device__ __forceinline__ float siluf_(float v) { return v / (1.f + __expf(-v)); }

namespace nv {
__global__ void __launch_bounds__(256) k_mod(const float* c, const float* w_ada, const float* b_ada, float* mod) {
    const int j = blockIdx.x * 256 + threadIdx.x, b = blockIdx.y;
    float acc = 0.f;
    for (int k = 0; k < D; ++k) acc += siluf_(c[b * D + k]) * w_ada[(size_t)k * 6 * D + j];
    mod[b * 6 * D + j] = acc + b_ada[j];
}
__global__ void __launch_bounds__(256) k_rownorm(const float* x, const float* g, const float* mod, int shift_off, int scale_off, bf16_t* out) {
    __shared__ float red[4];
    const int t = blockIdx.x, b = t / SEQ, tid = threadIdx.x;
    const float4 v = ((const float4*)(x + (size_t)t * D))[tid];
    float s = v.x * v.x + v.y * v.y + v.z * v.z + v.w * v.w;
    s = wave_sum(s);
    if ((tid & 63) == 0) red[tid >> 6] = s;
    __syncthreads();
    s = red[0] + red[1] + red[2] + red[3];
    const float r = rsqrtf(s * (1.f / D) + EPS);
    const int k = tid * 4;
    const float* sh = mod + b * 6 * D + shift_off; const float* sc = mod + b * 6 * D + scale_off;
    const float vv[4] = {v.x, v.y, v.z, v.w};
#pragma unroll
    for (int i = 0; i < 4; ++i) out[(size_t)t * D + k + i] = (bf16_t)f2bf(vv[i] * r * g[k + i] * (1.f + sc[k + i]) + sh[k + i]);
}
__device__ __forceinline__ float bfel(const uint4& a, int kk) {
    const unsigned w = kk < 2 ? a.x : kk < 4 ? a.y : kk < 6 ? a.z : a.w;
    return (kk & 1) ? __builtin_bit_cast(float, w & 0xffff0000u) : __builtin_bit_cast(float, w << 16);
}
template <class Epi, bool DUAL>
__global__ void __launch_bounds__(256) k_gemm(const bf16_t* A, int lda, const float* B, const float* B2, int ldb, int K, Epi epi) {
    const int tid = threadIdx.x, tx = tid & 63, ty = __builtin_amdgcn_readfirstlane(tid >> 6);
    const int n0 = blockIdx.x * 64, m0 = blockIdx.y * 32 + ty * 8;
    float acc[8], acc2[8];
#pragma unroll
    for (int i = 0; i < 8; ++i) { acc[i] = 0.f; acc2[i] = 0.f; }
    for (int k8 = 0; k8 < K; k8 += 8) {
        uint4 a[8];
#pragma unroll
        for (int i = 0; i < 8; ++i) a[i] = *(const uint4*)(A + (size_t)(m0 + i) * lda + k8);
#pragma unroll
        for (int kk = 0; kk < 8; ++kk) {
            const float b = B[(size_t)(k8 + kk) * ldb + n0 + tx];
            float b2 = 0.f; if (DUAL) b2 = B2[(size_t)(k8 + kk) * ldb + n0 + tx];
#pragma unroll
            for (int i = 0; i < 8; ++i) { const float av = bfel(a[i], kk); acc[i] += av * b; if (DUAL) acc2[i] += av * b2; }
        }
    }
    epi(m0, n0, tx, acc, acc2);
}
struct EpiProj {
    const float* gq; const float* gk; bf16_t *Q, *K, *V, *U, *GA, *GB; unsigned* dbg;
    __device__ void put(bf16_t* p, float v, int sec) const {
        if (dbg) { const float o = bf2f(*p); if (!(fabsf(o - v) <= 0.02f + 0.02f * fabsf(v))) atomicAdd(dbg + sec, 1u); }
        *p = (bf16_t)f2bf(v);
    }
    __device__ void operator()(int m0, int n0, int tx, const float (&acc)[8], const float (&)[8]) const {
#pragma unroll
        for (int i = 0; i < 8; ++i) {
            const size_t row = m0 + i; const float v = acc[i];
            if (n0 < 1024) {
                const float ss = wave_sum(v * v); const float r = rsqrtf(ss * (1.f / 64.f) + EPS);
                if (n0 < 512) put(Q + row * 512 + n0 + tx, v * r * gq[tx] * (0.125f * 1.4426950408889634f), 0);
                else put(K + row * 512 + (n0 - 512) + tx, v * r * gk[tx], 1);
            } else if (n0 < 1536) put(V + row * 512 + (n0 - 1024) + tx, v, 2);
            else if (n0 < 2048) put(U + row * 512 + (n0 - 1536) + tx, v, 3);
            else if (n0 < 3072) put(GA + row * 1024 + (n0 - 2048) + tx, sigmoidf_(v), 4);
            else put(GB + row * 1024 + (n0 - 3072) + tx, sigmoidf_(v), 5);
        }
    }
};
__global__ void k_poison(const unsigned* dbg, unsigned mask, float* out) {
    unsigned bad = 0; for (int i = 0; i < 8; ++i) if ((mask >> i) & 1u) bad |= dbg[i];
    if (bad) out[blockIdx.x * 256 + threadIdx.x] = __builtin_nanf("");
}
struct EpiPool { const float* ps; bf16_t* PMB; int g; int pad;
    __device__ void operator()(int m0, int n0, int tx, const float (&acc)[8], const float (&)[8]) const {
#pragma unroll
        for (int i = 0; i < 8; ++i) PMB[(size_t)(m0 + i) * 512 + g * 128 + n0 + tx] = (bf16_t)f2bf(acc[i] * ps[g * 128 + n0 + tx]);
    }
};
struct EpiMerge { const bf16_t* G; bf16_t* MG; int add; int pad;
    __device__ void operator()(int m0, int n0, int tx, const float (&acc)[8], const float (&)[8]) const {
#pragma unroll
        for (int i = 0; i < 8; ++i) { const size_t o = (size_t)(m0 + i) * 1024 + n0 + tx; float v = bf2f(G[o]) * acc[i]; if (add) v += bf2f(MG[o]); MG[o] = (bf16_t)f2bf(v); }
    }
};
struct EpiX1 { const float* x; const float* mod; float* X1;
    __device__ void operator()(int m0, int n0, int tx, const float (&acc)[8], const float (&)[8]) const {
#pragma unroll
        for (int i = 0; i < 8; ++i) { const size_t row = m0 + i; const int b = (int)(row / SEQ); const size_t o = row * 1024 + n0 + tx;
            X1[o] = x[o] + mod[b * 6 * D + 2 * D + n0 + tx] * acc[i]; }
    }
};
struct EpiShared { bf16_t* SH;
    __device__ void operator()(int m0, int n0, int tx, const float (&acc)[8], const float (&acc2)[8]) const {
#pragma unroll
        for (int i = 0; i < 8; ++i) SH[(size_t)(m0 + i) * SHD + n0 + tx] = (bf16_t)f2bf(siluf_(acc[i]) * acc2[i]);
    }
};
__global__ void __launch_bounds__(256) k_attn(const bf16_t* Q, const bf16_t* K, const bf16_t* V, bf16_t* O) {
    const int lane = threadIdx.x & 63; const int gw = blockIdx.x * 4 + (threadIdx.x >> 6);
    const int t = gw % SEQ, h = (gw / SEQ) % NH, b = gw / (SEQ * NH);
    const size_t base = (size_t)b * SEQ * 512 + h * 64 + lane;
    const float q = bf2f(Q[base + (size_t)t * 512]);
    float carry = 0.f, o = 0.f;
    for (int s = t - 1; s >= 0; --s) {
        const float z = wave_sum(q * bf2f(K[base + (size_t)s * 512]));
        const float sp = fmaxf(z, 0.f) + log2f(1.f + exp2f(-fabsf(z)));
        const float a = exp2f((z - sp) + carry);
        o += a * bf2f(V[base + (size_t)s * 512]);
        carry -= sp;
    }
    O[base + (size_t)t * 512] = (bf16_t)f2bf(o);
}
__global__ void __launch_bounds__(256) k_pool(const bf16_t* U, bf16_t* MIX) {
    const int idx = blockIdx.x * 256 + threadIdx.x; const int c = idx % 512; const int row = idx / 512; const int tl = row % SEQ;
    const int w = 2 << (c >> 7);
    const int cnt = (tl + 1) < w ? (tl + 1) : w;
    float s = 0.f;
    for (int i = 0; i < cnt; ++i) s += bf2f(U[(size_t)(row - i) * 512 + c]);
    MIX[(size_t)row * 512 + c] = (bf16_t)f2bf(s / (float)cnt - bf2f(U[(size_t)row * 512 + c]));
}
__global__ void __launch_bounds__(64) k_route(const float* X1, const float* g2, const float* mod, const float* Wr, const float* rbias, bf16_t* H2, int* PE, float* PWt) {
    __shared__ float hrow[D];
    const int t = blockIdx.x, b = t / SEQ, lane = threadIdx.x;
    float v[16]; float ss = 0.f;
#pragma unroll
    for (int j = 0; j < 4; ++j) { const float4 f = ((const float4*)(X1 + (size_t)t * D))[lane + 64 * j]; v[4 * j] = f.x; v[4 * j + 1] = f.y; v[4 * j + 2] = f.z; v[4 * j + 3] = f.w; ss += f.x * f.x + f.y * f.y + f.z * f.z + f.w * f.w; }
    ss = wave_sum(ss); const float r = rsqrtf(ss * (1.f / D) + EPS);
    const float* sh = mod + b * 6 * D + 3 * D; const float* sc = mod + b * 6 * D + 4 * D;
#pragma unroll
    for (int j = 0; j < 4; ++j)
#pragma unroll
        for (int i = 0; i < 4; ++i) { const int k = (lane + 64 * j) * 4 + i; const float h = v[4 * j + i] * r * g2[k] * (1.f + sc[k]) + sh[k]; hrow[k] = h; H2[(size_t)t * D + k] = (bf16_t)f2bf(h); }
    __syncthreads();
    float logit = 0.f;
    for (int k = 0; k < D; ++k) logit += hrow[k] * Wr[k * NE + lane];
    const float score = 1.f / (1.f + expf(-logit)); const float sel = score + rbias[lane];
    float m1 = sel; m1 = fmaxf(m1, __shfl_xor(m1, 1)); m1 = fmaxf(m1, __shfl_xor(m1, 2)); m1 = fmaxf(m1, __shfl_xor(m1, 4));
    const unsigned long long bal = __ballot(sel == m1); const int g = lane >> 3; const unsigned gm = (unsigned)(bal >> (g * 8)) & 0xffu;
    const int first = g * 8 + __ffs(gm) - 1;
    float m2 = (lane == first) ? -INFINITY : sel; m2 = fmaxf(m2, __shfl_xor(m2, 1)); m2 = fmaxf(m2, __shfl_xor(m2, 2)); m2 = fmaxf(m2, __shfl_xor(m2, 4));
    const float gs = m1 + m2;
    int grank = 0;
    for (int gg = 0; gg < 8; ++gg) { const float o = __shfl(gs, gg * 8); grank += (o > gs || (o == gs && gg < g)) ? 1 : 0; }
    const float ms = grank < 4 ? sel : -INFINITY;
    int rank = 0;
    for (int e = 0; e < 64; ++e) { const float o = __shfl(ms, e); rank += (o > ms || (o == ms && e < lane)) ? 1 : 0; }
    const bool chosen = rank < TOPK;
    const float wsum = wave_sum(chosen ? score : 0.f);
    if (chosen) { PE[t * 8 + rank] = lane; PWt[t * 8 + rank] = score / wsum * RSCALE; }
}
__global__ void __launch_bounds__(256) k_hmid(const bf16_t* H2, const int* PE, const float* PWt, const float* Wg, const float* Wu, bf16_t* HM) {
    const int lane = threadIdx.x & 63; const int p = blockIdx.x * 4 + (threadIdx.x >> 6); const int t = p >> 3;
    const int e = PE[p]; const float w = PWt[p];
    const float* wg = Wg + (size_t)e * D * ED; const float* wu = Wu + (size_t)e * D * ED;
    float a0 = 0.f, a1 = 0.f, b0 = 0.f, b1 = 0.f;
    for (int k = 0; k < D; ++k) { const float h = bf2f(H2[(size_t)t * D + k]); a0 += h * wg[k * ED + lane]; a1 += h * wg[k * ED + 64 + lane]; b0 += h * wu[k * ED + lane]; b1 += h * wu[k * ED + 64 + lane]; }
    HM[(size_t)p * ED + lane] = (bf16_t)f2bf(siluf_(a0) * b0 * w); HM[(size_t)p * ED + 64 + lane] = (bf16_t)f2bf(siluf_(a1) * b1 * w);
}
__global__ void __launch_bounds__(256) k_out(const bf16_t* HM, const bf16_t* SH, const int* PE, const float* Wd, const float* Wsd, const float* mod, float* OUT) {
    const int t = blockIdx.x, b = t / SEQ, tid = threadIdx.x;
    float acc[4] = {0.f, 0.f, 0.f, 0.f};
    for (int k = 0; k < 8; ++k) { const int e = PE[t * 8 + k]; const float* wd = Wd + (size_t)e * ED * D;
        for (int j = 0; j < ED; ++j) { const float h = bf2f(HM[(size_t)(t * 8 + k) * ED + j]);
#pragma unroll
            for (int i = 0; i < 4; ++i) acc[i] += h * wd[(size_t)j * D + tid + 256 * i]; } }
    for (int j = 0; j < SHD; ++j) { const float h = bf2f(SH[(size_t)t * SHD + j]);
#pragma unroll
        for (int i = 0; i < 4; ++i) acc[i] += h * Wsd[(size_t)j * D + tid + 256 * i]; }
#pragma unroll
    for (int i = 0; i < 4; ++i) { const int n = tid + 256 * i; const size_t o = (size_t)t * D + n; OUT[o] = OUT[o] + mod[b * 6 * D + 5 * D + n] * acc[i]; }
}
}

namespace pg8 {
#define PG8_LAS __attribute__((address_space(3)))
typedef short bf16x8 __attribute__((ext_vector_type(8)));
typedef float f32x4 __attribute__((ext_vector_type(4)));
typedef unsigned u32x4 __attribute__((ext_vector_type(4)));
constexpr int BM = 256, BK = 64, HALF = 128, HTB = HALF * BK * 2  , STAGE_BYTES = 8 * HTB, NXCD = 8, WGM = 8;

__host__ __device__ __forceinline__ int lds_byte(int r, int c) { const int st = (r >> 4) * 2 + (c >> 5), rr = r & 15, cc = c & 31, ob = rr * 64 + cc * 2; return st * 1024 + (ob ^ (((ob >> 9) & 1) << 5)); }
__host__ __device__ __forceinline__ void stage_rc(int b, int& R, int& C) { const int st = b / 1024, sb = b % 1024, swz = sb ^ (((sb >> 9) & 1) << 5); R = (st >> 1) * 16 + swz / 64; C = (st & 1) * 32 + (swz % 64) / 2; }
__host__ __device__ __forceinline__ int perm32(int rho) { const int n = rho >> 4, i = rho & 15; return 8 * (i >> 2) + 4 * n + (i & 3); }

struct Unit { int pm, pn; };
struct Gemm { const bf16_t* A; const bf16_t* Bt; int M, N, K; };

struct StaticOrder {
    int nM, nN, nwg, G, c;
    __host__ __device__ void init(int M_, int N_, int G_, int c_) { nM = M_ / BM; nN = N_ / BM; nwg = nM * nN; G = G_; c = c_; }
    __host__ __device__ bool next(int i, Unit& u) const {
        const long L = (long)i * G + c; if (L >= nwg) return false;
        int wgid = (int)L; { const int q = nwg / NXCD, r = nwg % NXCD, xcd = wgid % NXCD, off = wgid / NXCD; wgid = (xcd < r ? xcd * (q + 1) : r * (q + 1) + (xcd - r) * q) + off; }
        const int nig = WGM * nN, gid = wgid / nig, fm = gid * WGM, gsz = (nM - fm) < WGM ? (nM - fm) : WGM;
        u.pm = fm + ((wgid % nig) % gsz); u.pn = (wgid % nig) / gsz; return true;
    }
    __device__ __forceinline__ void a_ready(const Unit&) const {}
    __device__ __forceinline__ void done(const Unit&) const {}
};
typedef float f32x2_t __attribute__((ext_vector_type(2))); typedef __bf16 bf16x2_t __attribute__((ext_vector_type(2)));
__device__ __forceinline__ unsigned cvt_pk_bf16(float lo, float hi) { f32x2_t v = {lo, hi}; bf16x2_t b = __builtin_convertvector(v, bf16x2_t); return __builtin_bit_cast(unsigned, b); }
__device__ __forceinline__ float fsigmoid(float v) { return __builtin_amdgcn_rcpf(1.f + __builtin_amdgcn_exp2f(-1.4426950408889634f * v)); }
constexpr float QSCALE = 0.125f * 1.4426950408889634f;

struct EpiProj {
    static constexpr bool PERM = true, AFTER_DRAIN = false;
    bf16_t *Q, *K, *V, *U, *GA, *GB; const float* gq; const float* gk;
    __device__ __forceinline__ void operator()(const f32x4 (&acc)[2][2][4][2], const Unit& u, int wr, int wc, int fr, int fq) const {
        const int row0 = u.pm * BM + wr * 64 + fr; const int sec = u.pn;
        if (sec < 4) {
            const bool isq = sec < 2; const float* g = isq ? gq : gk; bf16_t* base = (isq ? Q : K) + ((sec & 1) * 4 + wc) * 64 + 8 * fq;
            const float qs = isq ? QSCALE : 1.f;
            f32x4 gv[2][2];
#pragma unroll
            for (int bj = 0; bj < 2; ++bj)
#pragma unroll
                for (int n = 0; n < 2; ++n) gv[bj][n] = *(const f32x4*)(g + 32 * bj + 8 * fq + 4 * n);
#pragma unroll
            for (int ai = 0; ai < 2; ++ai)
#pragma unroll
                for (int m = 0; m < 4; ++m) {
                    float ss = 0.f;
#pragma unroll
                    for (int bj = 0; bj < 2; ++bj)
#pragma unroll
                        for (int n = 0; n < 2; ++n) { const f32x4 x = acc[ai][bj][m][n]; ss += (x[0] * x[0] + x[1] * x[1]) + (x[2] * x[2] + x[3] * x[3]); }
                    ss += __shfl_xor(ss, 16); ss += __shfl_xor(ss, 32);
                    const float r = rsqrtf(ss * (1.f / 64.f) + EPS) * qs;
                    bf16_t* rowp = base + (size_t)(row0 + ai * HALF + m * 16) * 512;
#pragma unroll
                    for (int bj = 0; bj < 2; ++bj) { const f32x4 v0 = acc[ai][bj][m][0] * gv[bj][0] * r, v1 = acc[ai][bj][m][1] * gv[bj][1] * r;
                        u32x4 w; w.x = cvt_pk_bf16(v0[0], v0[1]); w.y = cvt_pk_bf16(v0[2], v0[3]); w.z = cvt_pk_bf16(v1[0], v1[1]); w.w = cvt_pk_bf16(v1[2], v1[3]);
                        *(u32x4*)(rowp + 32 * bj) = w; }
                }
        } else if (sec < 8) {
            bf16_t* base = (sec < 6 ? V : U) + (sec & 1) * 256 + wc * 32 + 8 * fq;
#pragma unroll
            for (int ai = 0; ai < 2; ++ai)
#pragma unroll
                for (int m = 0; m < 4; ++m) { bf16_t* rowp = base + (size_t)(row0 + ai * HALF + m * 16) * 512;
#pragma unroll
                    for (int bj = 0; bj < 2; ++bj) { const f32x4 v0 = acc[ai][bj][m][0], v1 = acc[ai][bj][m][1];
                        u32x4 w; w.x = cvt_pk_bf16(v0[0], v0[1]); w.y = cvt_pk_bf16(v0[2], v0[3]); w.z = cvt_pk_bf16(v1[0], v1[1]); w.w = cvt_pk_bf16(v1[2], v1[3]);
                        *(u32x4*)(rowp + bj * HALF) = w; } }
        } else {
            bf16_t* base = (sec < 12 ? GA : GB) + ((sec - 8) & 3) * 256 + wc * 32 + 8 * fq;
#pragma unroll
            for (int ai = 0; ai < 2; ++ai)
#pragma unroll
                for (int m = 0; m < 4; ++m) { bf16_t* rowp = base + (size_t)(row0 + ai * HALF + m * 16) * 1024;
#pragma unroll
                    for (int bj = 0; bj < 2; ++bj) { const f32x4 v0 = acc[ai][bj][m][0], v1 = acc[ai][bj][m][1];
                        u32x4 w; w.x = cvt_pk_bf16(fsigmoid(v0[0]), fsigmoid(v0[1])); w.y = cvt_pk_bf16(fsigmoid(v0[2]), fsigmoid(v0[3])); w.z = cvt_pk_bf16(fsigmoid(v1[0]), fsigmoid(v1[1])); w.w = cvt_pk_bf16(fsigmoid(v1[2]), fsigmoid(v1[3]));
                        *(u32x4*)(rowp + bj * HALF) = w; } }
        }
    }
};

struct EpiMerge {
    static constexpr bool PERM = true, AFTER_DRAIN = false;
    const bf16_t* G; bf16_t* MG; int add;
    __device__ __forceinline__ void operator()(const f32x4 (&acc)[2][2][4][2], const Unit& u, int wr, int wc, int fr, int fq) const {
        const int row0 = u.pm * BM + wr * 64 + fr, col0 = u.pn * BM + wc * 32 + 8 * fq;
#pragma unroll
        for (int ai = 0; ai < 2; ++ai)
#pragma unroll
            for (int m = 0; m < 4; ++m) { const size_t off = (size_t)(row0 + ai * HALF + m * 16) * 1024 + col0;
#pragma unroll
                for (int bj = 0; bj < 2; ++bj) { const u32x4 g = *(const u32x4*)(G + off + bj * HALF); const f32x4 a0 = acc[ai][bj][m][0], a1 = acc[ai][bj][m][1];
                    float v[8] = {bf2f(g.x & 0xffffu) * a0[0], bf2f(g.x >> 16) * a0[1], bf2f(g.y & 0xffffu) * a0[2], bf2f(g.y >> 16) * a0[3], bf2f(g.z & 0xffffu) * a1[0], bf2f(g.z >> 16) * a1[1], bf2f(g.w & 0xffffu) * a1[2], bf2f(g.w >> 16) * a1[3]};
                    if (add) { const u32x4 o = *(const u32x4*)(MG + off + bj * HALF);
                        v[0] += bf2f(o.x & 0xffffu); v[1] += bf2f(o.x >> 16); v[2] += bf2f(o.y & 0xffffu); v[3] += bf2f(o.y >> 16); v[4] += bf2f(o.z & 0xffffu); v[5] += bf2f(o.z >> 16); v[6] += bf2f(o.w & 0xffffu); v[7] += bf2f(o.w >> 16); }
                    u32x4 w; w.x = cvt_pk_bf16(v[0], v[1]); w.y = cvt_pk_bf16(v[2], v[3]); w.z = cvt_pk_bf16(v[4], v[5]); w.w = cvt_pk_bf16(v[6], v[7]);
                    *(u32x4*)(MG + off + bj * HALF) = w; } }
    }
};
struct EpiX1 {
    static constexpr bool PERM = false, AFTER_DRAIN = false;
    const float* x; const float* gate; float* X1;
    __device__ __forceinline__ void operator()(const f32x4 (&acc)[2][2][4][2], const Unit& u, int wr, int wc, int fr, int fq) const {
        const int row0 = u.pm * BM + wr * 64 + fr, col0 = u.pn * BM + wc * 32 + 4 * fq; const int b = (u.pm * BM) / SEQ;
        f32x4 gv[2][2];
#pragma unroll
        for (int bj = 0; bj < 2; ++bj)
#pragma unroll
            for (int n = 0; n < 2; ++n) gv[bj][n] = *(const f32x4*)(gate + (size_t)b * 6 * D + col0 + bj * HALF + n * 16);
#pragma unroll
        for (int ai = 0; ai < 2; ++ai)
#pragma unroll
            for (int m = 0; m < 4; ++m) { const size_t off = (size_t)(row0 + ai * HALF + m * 16) * D + col0;
#pragma unroll
                for (int bj = 0; bj < 2; ++bj)
#pragma unroll
                    for (int n = 0; n < 2; ++n) *(f32x4*)(X1 + off + bj * HALF + n * 16) = *(const f32x4*)(x + off + bj * HALF + n * 16) + gv[bj][n] * acc[ai][bj][m][n]; }
    }
};

template <class Epi, class Sched, bool ALIGN_EPI = false, bool SP2 = false>
__device__ __forceinline__ void gemm_phase(PG8_LAS unsigned char* lds, const Gemm g, const Sched& S, const Epi& E) {
    const int tid = threadIdx.x, wid = __builtin_amdgcn_readfirstlane(tid >> 6), lane = tid & 63, wr = wid >> 2, wc = wid & 3, fr = lane & 15, fq = lane >> 4;
    const int K = g.K, nt = K / BK;
    unsigned voffA[2], voffB[2];
#pragma unroll
    for (int i = 0; i < 2; ++i) { int R, C; stage_rc(tid * 16 + i * 8192, R, C); const int Rb = Epi::PERM ? ((R & ~31) + perm32(R & 31)) : R;
        voffA[i] = (unsigned)(R * K + C) * 2u; voffB[i] = (unsigned)(Rb * K + C) * 2u; }
    const size_t kstep = (size_t)(BK * 2);
    const size_t hstep = (size_t)HALF * K * 2;
    const size_t tstep = 2 * hstep;
    const unsigned ldsw = (unsigned)wid * 1024u;
    const int aoff = lds_byte(wr * 64 + fr, fq * 8), boff = lds_byte(wc * 32 + fr, fq * 8);
#define PG8_SA(b, h) (((b) * 2 + (h)) * HTB)
#define PG8_SB(b, h) ((4 + (b) * 2 + (h)) * HTB)
#define PG8_STAGE(bufoff, gbase, voff) do { _Pragma("unroll") for (int _i = 0; _i < 2; ++_i) \
        __builtin_amdgcn_global_load_lds((const unsigned*)((const char*)(gbase) + (voff)[_i]), (PG8_LAS unsigned*)(lds + (bufoff) + ldsw + _i * 8192), 16, 0, 0); } while (0)
#define PG8_LDA(dst, b, h) do { _Pragma("unroll") for (int m = 0; m < 4; ++m) _Pragma("unroll") for (int k = 0; k < 2; ++k) dst[m][k] = *(const PG8_LAS bf16x8*)(lds + PG8_SA(b, h) + aoff + m * 2048 + k * 1024); } while (0)
#define PG8_LDB(dst, b, h) do { _Pragma("unroll") for (int n = 0; n < 2; ++n) _Pragma("unroll") for (int k = 0; k < 2; ++k) dst[n][k] = *(const PG8_LAS bf16x8*)(lds + PG8_SB(b, h) + boff + n * 2048 + k * 1024); } while (0)
#define PG8_MMA(ai, bj, At, Bt) do { __builtin_amdgcn_s_setprio(1); _Pragma("unroll") for (int m = 0; m < 4; ++m) _Pragma("unroll") for (int n = 0; n < 2; ++n) _Pragma("unroll") for (int k = 0; k < 2; ++k) \
        acc[ai][bj][m][n] = __builtin_amdgcn_mfma_f32_16x16x32_bf16(Bt[n][k], At[m][k], acc[ai][bj][m][n], 0, 0, 0); __builtin_amdgcn_s_setprio(0); } while (0)
#define PG8_WAIT_V(n) asm volatile("s_waitcnt vmcnt(" #n ")" ::: "memory")
#define PG8_WAIT_L(n) asm volatile("s_waitcnt lgkmcnt(" #n ")" ::: "memory")
#define PG8_BAR __builtin_amdgcn_s_barrier()
#define PG8_SCHED __builtin_amdgcn_sched_barrier(0)
    Unit cur, nxt; int ui = 0;
    if (!S.next(0, cur)) return;
    f32x4 acc[2][2][4][2];
#pragma unroll
    for (int a = 0; a < 2; ++a)
#pragma unroll
        for (int b = 0; b < 2; ++b)
#pragma unroll
            for (int m = 0; m < 4; ++m)
#pragma unroll
                for (int n = 0; n < 2; ++n) acc[a][b][m][n] = (f32x4){0.f, 0.f, 0.f, 0.f};
    bf16x8 At[4][2], B0[2][2], B1[2][2];
    const char* cA = (const char*)g.A + (size_t)cur.pm * tstep; const char* cB = (const char*)g.Bt + (size_t)cur.pn * tstep;
    S.a_ready(cur);
    if constexpr (SP2) {
        PG8_STAGE(PG8_SB(0, 0), cB, voffB); PG8_STAGE(PG8_SB(0, 1), cB + hstep, voffB); PG8_STAGE(PG8_SA(0, 0), cA, voffA); PG8_STAGE(PG8_SA(0, 1), cA + hstep, voffA);
        if (wr == 1) PG8_BAR;
        PG8_WAIT_V(2); PG8_BAR;
        PG8_STAGE(PG8_SB(1, 0), cB + kstep, voffB); PG8_STAGE(PG8_SA(1, 0), cA + kstep, voffA); PG8_STAGE(PG8_SB(1, 1), cB + hstep + kstep, voffB);
        PG8_WAIT_V(6); PG8_BAR;
    } else {
        PG8_STAGE(PG8_SB(0, 0), cB, voffB); PG8_STAGE(PG8_SA(0, 0), cA, voffA); PG8_STAGE(PG8_SB(0, 1), cB + hstep, voffB); PG8_STAGE(PG8_SA(0, 1), cA + hstep, voffA);
        if (wr == 1) PG8_BAR;
        PG8_WAIT_V(4); PG8_BAR;
        PG8_STAGE(PG8_SB(1, 0), cB + kstep, voffB); PG8_STAGE(PG8_SA(1, 0), cA + kstep, voffA); PG8_STAGE(PG8_SB(1, 1), cB + hstep + kstep, voffB);
        PG8_WAIT_V(6); PG8_BAR;
    }
    for (;;) {
        const bool has_next = S.next(ui + 1, nxt);
        const char* nA = has_next ? (const char*)g.A + (size_t)nxt.pm * tstep : cA; const char* nB = has_next ? (const char*)g.Bt + (size_t)nxt.pn * tstep : cB;
        for (int t = 0; t < nt; t += 2) {
            const bool last = (t == nt - 2);
            const char* a1 = cA + (size_t)(t + 1) * kstep;
            const char* a2 = last ? nA : cA + (size_t)(t + 2) * kstep; const char* b2 = last ? nB : cB + (size_t)(t + 2) * kstep;
            const char* a3 = a2 + kstep; const char* b3 = b2 + kstep;
            if (last && has_next) S.a_ready(nxt);
            if constexpr (SP2) {
            PG8_LDB(B0, 0, 0); PG8_LDB(B1, 0, 1); PG8_SCHED; PG8_LDA(At, 0, 0); PG8_STAGE(PG8_SA(1, 1), a1 + hstep, voffA);
            PG8_WAIT_V(8); PG8_WAIT_L(0); PG8_BAR; PG8_MMA(0, 0, At, B0); PG8_MMA(0, 1, At, B1); PG8_BAR; PG8_SCHED;
            PG8_LDA(At, 0, 1); PG8_STAGE(PG8_SB(0, 0), b2, voffB); PG8_STAGE(PG8_SB(0, 1), b2 + hstep, voffB); PG8_STAGE(PG8_SA(0, 0), a2, voffA);
            PG8_WAIT_V(8); PG8_WAIT_L(0); PG8_BAR; PG8_MMA(1, 0, At, B0); PG8_MMA(1, 1, At, B1); PG8_BAR; PG8_SCHED;
            PG8_LDB(B0, 1, 0); PG8_LDB(B1, 1, 1); PG8_SCHED; PG8_LDA(At, 1, 0); PG8_STAGE(PG8_SA(0, 1), a2 + hstep, voffA);
            PG8_WAIT_V(8); PG8_WAIT_L(0); PG8_BAR; PG8_MMA(0, 0, At, B0); PG8_MMA(0, 1, At, B1); PG8_BAR; PG8_SCHED;
            PG8_LDA(At, 1, 1); PG8_STAGE(PG8_SB(1, 0), b3, voffB); PG8_STAGE(PG8_SB(1, 1), b3 + hstep, voffB); PG8_STAGE(PG8_SA(1, 0), a3, voffA);
            PG8_WAIT_V(8); PG8_WAIT_L(0); PG8_BAR; PG8_MMA(1, 0, At, B0); PG8_MMA(1, 1, At, B1); PG8_BAR; PG8_SCHED;
            } else {
            PG8_LDB(B0, 0, 0); PG8_SCHED; PG8_LDA(At, 0, 0); PG8_STAGE(PG8_SA(1, 1), a1 + hstep, voffA);
            PG8_WAIT_L(8); PG8_BAR; PG8_WAIT_L(0); PG8_MMA(0, 0, At, B0); PG8_BAR; PG8_SCHED;
            PG8_LDB(B1, 0, 1); PG8_STAGE(PG8_SB(0, 0), b2, voffB);
            PG8_BAR; PG8_WAIT_L(0); PG8_MMA(0, 1, At, B1); PG8_BAR;
            PG8_LDA(At, 0, 1); PG8_STAGE(PG8_SA(0, 0), a2, voffA);
            PG8_BAR; PG8_WAIT_L(0); PG8_MMA(1, 0, At, B0); PG8_BAR; PG8_SCHED;
            PG8_STAGE(PG8_SB(0, 1), b2 + hstep, voffB);
            PG8_WAIT_V(6); PG8_BAR; PG8_MMA(1, 1, At, B1); PG8_BAR;
            PG8_LDB(B0, 1, 0); PG8_SCHED; PG8_LDA(At, 1, 0); PG8_STAGE(PG8_SA(0, 1), a2 + hstep, voffA);
            PG8_WAIT_L(8); PG8_BAR; PG8_WAIT_L(0); PG8_MMA(0, 0, At, B0); PG8_BAR; PG8_SCHED;
            PG8_LDB(B1, 1, 1); PG8_STAGE(PG8_SB(1, 0), b3, voffB);
            PG8_BAR; PG8_WAIT_L(0); PG8_MMA(0, 1, At, B1); PG8_BAR;
            PG8_LDA(At, 1, 1); PG8_STAGE(PG8_SA(1, 0), a3, voffA);
            PG8_BAR; PG8_WAIT_L(0); PG8_MMA(1, 0, At, B0); PG8_BAR; PG8_SCHED;
            PG8_STAGE(PG8_SB(1, 1), b3 + hstep, voffB);
            PG8_WAIT_V(6); PG8_BAR; PG8_MMA(1, 1, At, B1); PG8_BAR;
            }
        }
        if constexpr (ALIGN_EPI) { if (wr == 0) PG8_BAR; }
        if constexpr (!Epi::AFTER_DRAIN) { E(acc, cur, wr, wc, fr, fq); S.done(cur); }
        if (!has_next) break;
#pragma unroll
        for (int a = 0; a < 2; ++a)
#pragma unroll
            for (int b = 0; b < 2; ++b)
#pragma unroll
                for (int m = 0; m < 4; ++m)
#pragma unroll
                    for (int n = 0; n < 2; ++n) acc[a][b][m][n] = (f32x4){0.f, 0.f, 0.f, 0.f};
        cur = nxt; cA = nA; cB = nB; ++ui;
        if constexpr (ALIGN_EPI) { if (wr == 1) PG8_BAR; }
    }
    PG8_WAIT_V(0);
    if constexpr (!ALIGN_EPI) { if (wr == 0) PG8_BAR; }
    PG8_BAR;
    if constexpr (Epi::AFTER_DRAIN) { E.fused(acc, cur, wr, wc, fr, fq, lds, wid, lane); S.done(cur); }
#undef PG8_SA
#undef PG8_SB
#undef PG8_STAGE
#undef PG8_LDA
#undef PG8_LDB
#undef PG8_MMA
#undef PG8_WAIT_V
#undef PG8_WAIT_L
#undef PG8_BAR
#undef PG8_SCHED
}
}
using pg8::f32x4; using pg8::bf16x8;
#define GAS __attribute__((address_space(1)))
#define LAS __attribute__((address_space(3)))
typedef unsigned v4u __attribute__((ext_vector_type(4)));
typedef GAS unsigned gu32;
typedef GAS unsigned long long gu64;
#define RLX_AGENT __ATOMIC_RELAXED, __HIP_MEMORY_SCOPE_AGENT
#define LDS_WAIT() asm volatile("s_waitcnt lgkmcnt(0)" ::: "memory")
#define VM_WAIT() asm volatile("s_waitcnt vmcnt(0)" ::: "memory")
__device__ __forceinline__ unsigned long long rt() { return __builtin_amdgcn_s_memrealtime(); }
__device__ __forceinline__ unsigned pk2(float lo, float hi) { return f2bf(lo) | (f2bf(hi) << 16); }

#define XB_TMO      128
#define XB_XCNT(j)  (256  + 64 * (j))
#define XB_XSUB(j)  (1280 + 64 * (j))
#define XB_XGEN(j)  (2304 + 64 * (j))
#define XB_TOP      3328
#define XB_TOPGEN   3392
#define XCD_BAR_WORDS 3456
#define XB_SPIN_CAP (1u << 18)

__device__ __forceinline__ unsigned xb_ld(unsigned* p)              { return __hip_atomic_load(p, __ATOMIC_RELAXED, __HIP_MEMORY_SCOPE_AGENT); }
__device__ __forceinline__ unsigned xb_add(unsigned* p, unsigned v) { return __hip_atomic_fetch_add(p, v, __ATOMIC_RELAXED, __HIP_MEMORY_SCOPE_AGENT); }
__device__ __forceinline__ unsigned xb_xcc_id() { return (unsigned)__builtin_amdgcn_s_getreg((3 << 11) | 20) & 0xFu; }
#define XB_SPIN(cond, bar) do { unsigned _sp = 0; while (cond) { __builtin_amdgcn_s_sleep(1); \
    if ((++_sp & 255u) == 0u) { if (xb_ld(&(bar)[XB_TMO])) break; if (_sp > XB_SPIN_CAP) { atomicAdd(&(bar)[XB_TMO], 1u); break; } } } } while (0)

struct XcdBarrier {
    unsigned* bar; unsigned x;
    volatile LAS unsigned* st;
};

__device__ __forceinline__ XcdBarrier xcd_barrier_post(unsigned* bar, volatile LAS unsigned* st) {
    XcdBarrier b; b.bar = bar; b.x = xb_xcc_id(); b.st = st;
    if (threadIdx.x == 0) (void)xb_add(&bar[XB_XCNT(b.x)], 1u);
    return b;
}
__device__ __forceinline__ void xcd_barrier_complete(unsigned* bar, unsigned x, unsigned& nloc, unsigned& nx) {
    const unsigned G = gridDim.x * gridDim.y * gridDim.z;
    unsigned sum, cnt, mine, sp = 0u;
    for (;;) {
        sum = 0u; cnt = 0u; mine = 0u;
#pragma unroll
        for (unsigned j = 0; j < 16; ++j) { const unsigned c = xb_ld(&bar[XB_XCNT(j)]); sum += c; cnt += (c > 0u) ? 1u : 0u; mine = (j == x) ? c : mine; }
        if (sum == G) break;
        __builtin_amdgcn_s_sleep(1);
        if ((++sp & 255u) == 0u) { if (xb_ld(&bar[XB_TMO])) break; if (sp > XB_SPIN_CAP) { atomicAdd(&bar[XB_TMO], 1u); break; } }
    }
    nloc = mine > 0u ? mine : 1u; nx = cnt > 0u ? cnt : 1u;
}

__device__ __forceinline__ void xcd_barrier(const XcdBarrier& b) {
    asm volatile("s_waitcnt vmcnt(0)" ::: "memory");
    __syncthreads();
    if (threadIdx.x == 0) {
        unsigned* bar = b.bar;
        __builtin_amdgcn_s_waitcnt(0);
        unsigned nloc = b.st[0], nx = b.st[1];
        if (nloc == 0u) { xcd_barrier_complete(bar, b.x, nloc, nx); b.st[0] = nloc; b.st[1] = nx; }
        const unsigned old = xb_add(&bar[XB_XSUB(b.x)], 1u);
        const unsigned gen = old / nloc;
        if (old + 1u == (gen + 1u) * nloc) {
            __builtin_amdgcn_fence(__ATOMIC_RELEASE, "agent");
            asm volatile("s_waitcnt vmcnt(0)" ::: "memory");
            const unsigned og = xb_add(&bar[XB_TOP], 1u);
            const unsigned tg = og / nx;
            if (og + 1u == (tg + 1u) * nx) xb_add(&bar[XB_TOPGEN], 1u);
            else XB_SPIN(xb_ld(&bar[XB_TOPGEN]) == tg, bar);
            __builtin_amdgcn_fence(__ATOMIC_ACQUIRE, "agent");
            xb_add(&bar[XB_XGEN(b.x)], 1u);
            asm volatile("s_waitcnt vmcnt(0)" ::: "memory");
        } else {
            XB_SPIN(xb_ld(&bar[XB_XGEN(b.x)]) == gen, bar);
            __builtin_amdgcn_fence(__ATOMIC_ACQUIRE, "agent");
            asm volatile("s_waitcnt vmcnt(0)" ::: "memory");
        }
    }
    __syncthreads();
}

constexpr int NWAVES = 8;
constexpr size_t WS_MODP = 1 * MiB + 128 * 1024;
constexpr size_t WS_WIN = 12 * MiB, WS_WSB = 20 * MiB, WS_WEFF = 21 * MiB, WS_WOUT = 22 * MiB, WS_WGU = 24 * MiB, WS_WD = 56 * MiB, WS_WSHGU = 72 * MiB, WS_WSHD = 73 * MiB;
constexpr size_t WS_WRH = 73 * MiB + 512 * 1024, WS_WRL = WS_WRH + 128 * 1024;
constexpr size_t CTL_ZERO_BYTES = 256 * 1024;
constexpr int CW_TMO = 0, CW_CODE = 1, CW_BAR = 4096, CW_CNT = 16384;
constexpr int RING_OFF = 0, RING_BYTES = 131072, LDSCTL_OFF = RING_BYTES, MISC_OFF = LDSCTL_OFF + 320, LDS_BYTES = 147456;

struct Frame {
    LAS unsigned char* lds; volatile LAS unsigned* MISC; gu32* ctl;
    int tid, lane, wave, vcu, G;
};
struct Args { const float* in[22]; float* out; unsigned char* ws; int ph_lo, ph_hi, use_bar, pad; };

__device__ __forceinline__ void transpose_item(const float* W, int ldw, int k0, int n0, bf16_t* dst, int ldk, LAS float* scr, int lane) {
#pragma unroll 8
    for (int i = 0; i < 32; ++i) { const int kk = 2 * i + (lane >> 5); scr[kk * 33 + (lane & 31)] = W[(size_t)(k0 + kk) * ldw + n0 + (lane & 31)]; }
    LDS_WAIT(); asm volatile("" ::: "memory");
    const int c = lane & 7;
#pragma unroll
    for (int j = 0; j < 4; ++j) { const int n = (lane >> 3) + 8 * j; const LAS float* s = scr + (8 * c) * 33 + n;
        v4u o; o.x = pk2(s[0 * 33], s[1 * 33]); o.y = pk2(s[2 * 33], s[3 * 33]); o.z = pk2(s[4 * 33], s[5 * 33]); o.w = pk2(s[6 * 33], s[7 * 33]);
        *(GAS v4u*)(dst + (size_t)n * ldk + k0 + 8 * c) = o; }
    LDS_WAIT(); asm volatile("" ::: "memory");
}

__device__ __forceinline__ void p0a(Frame& F, const Args& a) {
    unsigned char* ws = a.ws;
    const int gw = F.vcu * NWAVES + F.wave, NGW = F.G * NWAVES, lane = F.lane;
    { const float* c = a.in[1]; const float* w_ada = a.in[2]; float* MODP = (float*)(ws + WS_MODP);
      for (int it = gw; it < 96 * 8; it += NGW) { const int cg = it % 96, ks = it / 96;
          const float* w = w_ada + (size_t)(ks * 128) * (6 * D) + cg * 64 + lane;
          float a0 = 0.f, a1 = 0.f, a2 = 0.f, a3 = 0.f;
          for (int k = 0; k < 128; ++k) { const float wv = w[(size_t)k * (6 * D)]; const int kk = ks * 128 + k;
              a0 += siluf_(c[kk]) * wv; a1 += siluf_(c[D + kk]) * wv; a2 += siluf_(c[2 * D + kk]) * wv; a3 += siluf_(c[3 * D + kk]) * wv; }
          float* o = MODP + (size_t)ks * 4 * 6 * D + cg * 64 + lane;
          o[0] = a0; o[6 * D] = a1; o[12 * D] = a2; o[18 * D] = a3; } }
    LAS float* scr = (LAS float*)(F.lds + RING_OFF + F.wave * 16384);
    constexpr int I_IN = 16 * 128, I_SB = 8 * 32, I_OUT = 16 * 32, I_EG = 64 * 64, I_EU = 64 * 64, I_ED = 64 * 64, I_SG = 16 * 8, I_SU = 16 * 8, I_SD = 4 * 32;
    constexpr int NITEMS = I_IN + I_SB + I_OUT + I_EG + I_EU + I_ED + I_SG + I_SU + I_SD;
    for (int it = gw; it < NITEMS; it += NGW) {
        int r = it;
        if (r < I_IN) { const int kb = r >> 7, nb = r & 127, n0 = nb * 32; int d0 = n0;
            if (n0 < 1024) d0 = (n0 & ~255) + 128 * ((n0 >> 5) & 1) + 32 * ((n0 >> 6) & 3);
            transpose_item(a.in[5], INW, kb * 64, n0, (bf16_t*)(ws + WS_WIN) + (size_t)d0 * D, D, scr, lane); continue; } r -= I_IN;
        if (r < I_SB) { const int kb = r >> 5, nb = r & 31; transpose_item(a.in[8], D, kb * 64, nb * 32, (bf16_t*)(ws + WS_WSB) + (size_t)(nb * 32) * SBW, SBW, scr, lane); continue; } r -= I_SB;
        if (r < I_OUT) { const int kb = r >> 5, nb = r & 31; transpose_item(a.in[12], D, kb * 64, nb * 32, (bf16_t*)(ws + WS_WOUT) + (size_t)(nb * 32) * D, D, scr, lane); continue; } r -= I_OUT;
        if (r < I_EG) { const int e = r >> 6, q = r & 63, kb = q >> 2, nb = q & 3; transpose_item(a.in[16] + (size_t)e * D * ED, ED, kb * 64, nb * 32, (bf16_t*)(ws + WS_WGU) + ((size_t)e * 256 + nb * 32) * D, D, scr, lane); continue; } r -= I_EG;
        if (r < I_EU) { const int e = r >> 6, q = r & 63, kb = q >> 2, nb = q & 3; transpose_item(a.in[17] + (size_t)e * D * ED, ED, kb * 64, nb * 32, (bf16_t*)(ws + WS_WGU) + ((size_t)e * 256 + 128 + nb * 32) * D, D, scr, lane); continue; } r -= I_EU;
        if (r < I_ED) { const int e = r >> 6, q = r & 63, kb = q >> 5, nb = q & 31; transpose_item(a.in[18] + (size_t)e * ED * D, D, kb * 64, nb * 32, (bf16_t*)(ws + WS_WD) + ((size_t)e * D + nb * 32) * ED, ED, scr, lane); continue; } r -= I_ED;
        if (r < I_SG) { const int kb = r >> 3, nb = r & 7, n0 = nb * 32; transpose_item(a.in[19], SHD, kb * 64, n0, (bf16_t*)(ws + WS_WSHGU) + (size_t)((n0 >> 7) * 256 + (n0 & 127)) * D, D, scr, lane); continue; } r -= I_SG;
        if (r < I_SU) { const int kb = r >> 3, nb = r & 7, n0 = nb * 32; transpose_item(a.in[20], SHD, kb * 64, n0, (bf16_t*)(ws + WS_WSHGU) + (size_t)((n0 >> 7) * 256 + 128 + (n0 & 127)) * D, D, scr, lane); continue; } r -= I_SU;
        { const int kb = r >> 5, nb = r & 31; transpose_item(a.in[21], D, kb * 64, nb * 32, (bf16_t*)(ws + WS_WSHD) + (size_t)(nb * 32) * SHD, SHD, scr, lane); }
    }
    { const float* wg = a.in[9]; const float* ps = a.in[10]; const float* wpo = a.in[11]; bf16_t* WE = (bf16_t*)(ws + WS_WEFF);
      for (int it = gw; it < 512; it += NGW) { const int g = it >> 7, nb = (it >> 3) & 15, cb = it & 7; const int n = nb * 64 + lane;
          float acc[16];
#pragma unroll
          for (int i = 0; i < 16; ++i) acc[i] = 0.f;
          for (int d = 0; d < 128; ++d) { const float wv = wpo[(size_t)(g * 128 + d) * D + n] * ps[g * 128 + d];
#pragma unroll
              for (int i = 0; i < 16; ++i) acc[i] += wg[(size_t)(g * 128 + cb * 16 + i) * 128 + d] * wv; }
          v4u o0, o1; o0.x = pk2(acc[0], acc[1]); o0.y = pk2(acc[2], acc[3]); o0.z = pk2(acc[4], acc[5]); o0.w = pk2(acc[6], acc[7]);
          o1.x = pk2(acc[8], acc[9]); o1.y = pk2(acc[10], acc[11]); o1.z = pk2(acc[12], acc[13]); o1.w = pk2(acc[14], acc[15]);
          GAS v4u* op = (GAS v4u*)(WE + (size_t)n * PW + g * 128 + cb * 16); op[0] = o0; op[1] = o1; } }
    { const float* wr = a.in[14]; bf16_t* WH = (bf16_t*)(ws + WS_WRH); bf16_t* WL = (bf16_t*)(ws + WS_WRL);
      for (int i = (F.vcu * NWAVES * 64 + F.tid); i < D * NE; i += F.G * NWAVES * 64) { const int e = i >> 10, k = i & 1023; const float v = wr[k * NE + e];
          const unsigned h = f2bf(v); WH[i] = (bf16_t)h; WL[i] = (bf16_t)f2bf(v - bf2f(h)); } }
}
__device__ __forceinline__ void p0b(Frame& F, const Args& a) {
    unsigned char* ws = a.ws; const float* MODP = (const float*)(ws + WS_MODP); const float* b_ada = a.in[3];
    if (F.tid < 96) { const int idx = 96 * F.vcu + F.tid, b = idx / (6 * D), j = idx % (6 * D); float v = b_ada[j];
#pragma unroll
        for (int ks = 0; ks < 8; ++ks) v += MODP[(size_t)(ks * 4 + b) * 6 * D + j];
        ((float*)(ws + WS_MOD))[idx] = v; }
    const int rows_per = M / F.G, r0 = F.vcu * rows_per, b = r0 / SEQ;
    LAS float* gsv = (LAS float*)(F.lds + RING_OFF); LAS float* shv = gsv + D;
    for (int k = F.tid; k < D; k += NWAVES * 64) { float sh = b_ada[k], sc = b_ada[D + k];
#pragma unroll
        for (int ks = 0; ks < 8; ++ks) { sh += MODP[(size_t)(ks * 4 + b) * 6 * D + k]; sc += MODP[(size_t)(ks * 4 + b) * 6 * D + D + k]; }
        gsv[k] = a.in[4][k] * (1.f + sc); shv[k] = sh; }
    __syncthreads();
    const float* x = a.in[0]; bf16_t* XN = (bf16_t*)(ws + WS_XN);
    for (int i = F.wave; i < rows_per; i += NWAVES) { const int row = r0 + i;
        const GAS f32x4* xr = (const GAS f32x4*)(x + (size_t)row * D) + F.lane;
        f32x4 v[4]; float s = 0.f;
#pragma unroll
        for (int j = 0; j < 4; ++j) { v[j] = xr[64 * j]; s += (v[j].x * v[j].x + v[j].y * v[j].y) + (v[j].z * v[j].z + v[j].w * v[j].w); }
        const float r = rsqrtf(wave_sum(s) * (1.f / D) + EPS);
        GAS unsigned long long* o8 = (GAS unsigned long long*)(XN + (size_t)row * D) + F.lane;
#pragma unroll
        for (int j = 0; j < 4; ++j) { const f32x4 gg = *(const LAS f32x4*)(gsv + 4 * F.lane + 256 * j), ss = *(const LAS f32x4*)(shv + 4 * F.lane + 256 * j);
            const f32x4 h = v[j] * r * gg + ss;
            o8[64 * j] = (unsigned long long)pk2(h.x, h.y) | ((unsigned long long)pk2(h.z, h.w) << 32); } }
    __syncthreads();
}

namespace sb {
using pg8::bf16x8; using pg8::f32x4; typedef float f32x16 __attribute__((ext_vector_type(16))); typedef short v4i16_t __attribute__((ext_vector_type(4)));
typedef short s16x4 __attribute__((ext_vector_type(4)));
constexpr int VPITCH = 128, VBYTES = 64 * VPITCH, WAVE_LDS = 2 * VBYTES;
constexpr float EXIT_THR = -152.f;
__device__ __forceinline__ int crow(int r, int hi) { return (r & 3) + 8 * (r >> 2) + 4 * hi; }
__device__ __forceinline__ s16x4 vtr(LAS const unsigned char* p) { return __builtin_bit_cast(s16x4, __builtin_amdgcn_ds_read_tr16_b64_v4i16((LAS v4i16_t*)p)); }
__device__ __forceinline__ unsigned pkbf(float lo, float hi) { return pg8::cvt_pk_bf16(lo, hi); }

__device__ __forceinline__ void attn_unit(int b, int h, int qb, const bf16_t* Q, const bf16_t* K, const bf16_t* V, bf16_t* O, LAS unsigned char* vlds, int wid, int lane) {
    const int r32 = lane & 31, hi = lane >> 5;
    const int t0 = qb * 256 + wid * 32;
    const size_t rowbase = (size_t)b * SEQ;
    const bf16_t* Kh = K + rowbase * 512 + h * 64; const bf16_t* Vh = V + rowbase * 512 + h * 64;
    bf16x8 qr[4];
#pragma unroll
    for (int d0 = 0; d0 < 4; ++d0) qr[d0] = *(const bf16x8*)(Q + (rowbase + t0 + r32) * 512 + h * 64 + d0 * 16 + hi * 8);
    f32x16 o0 = {}, o1 = {};
    float carry = 0.f;
    int kt = t0 >> 6;
    bf16x8 kf[8];
#define SB_LOADK(KT) do { const int kb_ = (KT) * 64; \
        _Pragma("unroll") for (int d0 = 0; d0 < 4; ++d0) { kf[2 * d0] = *(const bf16x8*)(Kh + (size_t)(kb_ + r32) * 512 + d0 * 16 + hi * 8); kf[2 * d0 + 1] = *(const bf16x8*)(Kh + (size_t)(kb_ + 32 + r32) * 512 + d0 * 16 + hi * 8); } } while (0)
#define SB_DMAV(KT, BUF) do { const int kb_ = (KT) * 64; \
        _Pragma("unroll") for (int i = 0; i < 8; ++i) __builtin_amdgcn_global_load_lds((const unsigned*)(Vh + (size_t)(kb_ + 8 * i + (lane >> 3)) * 512 + (lane & 7) * 8), (LAS unsigned*)(vlds + (BUF) * VBYTES + i * 1024), 16, 0, 0); } while (0)
    int cur = 0;
    SB_DMAV(kt, 0);
    SB_LOADK(kt);
    const int trbase = (4 * hi + ((lane & 15) >> 2)) * VPITCH + (16 * ((lane >> 4) & 1) + 4 * (lane & 3)) * 2;
    bool diag = true;
    for (;; --kt) {
        const int kbase = kt * 64;
        f32x16 p0 = {}, p1 = {};
#pragma unroll
        for (int d0 = 0; d0 < 4; ++d0) { p0 = __builtin_amdgcn_mfma_f32_32x32x16_bf16(kf[2 * d0], qr[d0], p0, 0, 0, 0); p1 = __builtin_amdgcn_mfma_f32_32x32x16_bf16(kf[2 * d0 + 1], qr[d0], p1, 0, 0, 0); }
        asm volatile("" ::: "memory");
        if (kt > 0) { SB_DMAV(kt - 1, cur ^ 1); SB_LOADK(kt - 1); }
        asm volatile("" ::: "memory");
        bf16x8 pa[4]; float suf = 0.f;
        const int qrel = t0 + r32 - kbase;
#define SB_HALF(P, KOFF, PA0, PA1) do { f32x16 sp_; \
        _Pragma("unroll") for (int r = 0; r < 16; ++r) sp_[r] = __builtin_amdgcn_logf(1.f + __builtin_amdgcn_exp2f(P[r])); \
        if (diag) { _Pragma("unroll") for (int r = 0; r < 16; ++r) if (crow(r, hi) + (KOFF) >= qrel) sp_[r] = 0.f; } \
        float e_[4], og_[4], R_[4]; \
        _Pragma("unroll") for (int c = 0; c < 4; ++c) { sp_[4 * c + 2] += sp_[4 * c + 3]; sp_[4 * c + 1] += sp_[4 * c + 2]; sp_[4 * c] += sp_[4 * c + 1]; e_[c] = sp_[4 * c]; } \
        _Pragma("unroll") for (int c = 0; c < 4; ++c) og_[c] = __shfl_xor(e_[c], 32); \
        _Pragma("unroll") for (int c = 3; c >= 0; --c) { R_[c] = carry - (suf + (hi == 0 ? og_[c] : 0.f)); suf += e_[c] + og_[c]; } \
        _Pragma("unroll") for (int r = 0; r < 16; ++r) P[r] = __builtin_amdgcn_exp2f(P[r] - sp_[r] + R_[r >> 2]); \
        if (diag) { _Pragma("unroll") for (int r = 0; r < 16; ++r) if (crow(r, hi) + (KOFF) >= qrel) P[r] = 0.f; } \
        pg8::u32x4 w_; w_.x = pkbf(P[0], P[1]); w_.y = pkbf(P[2], P[3]); w_.z = pkbf(P[4], P[5]); w_.w = pkbf(P[6], P[7]); PA0 = __builtin_bit_cast(bf16x8, w_); \
        w_.x = pkbf(P[8], P[9]); w_.y = pkbf(P[10], P[11]); w_.z = pkbf(P[12], P[13]); w_.w = pkbf(P[14], P[15]); PA1 = __builtin_bit_cast(bf16x8, w_); } while (0)
        SB_HALF(p1, 32, pa[2], pa[3]);
        SB_HALF(p0, 0, pa[0], pa[1]);
#undef SB_HALF
        carry -= suf;
        diag = false;
        if (kt > 0) asm volatile("s_waitcnt vmcnt(16)" ::: "memory"); else asm volatile("s_waitcnt vmcnt(0)" ::: "memory");
        LAS const unsigned char* vb = vlds + cur * VBYTES + trbase;
#pragma unroll
        for (int s = 0; s < 4; ++s) {
            LAS const unsigned char* vp = vb + (16 * s) * VPITCH;
            const s16x4 a0 = vtr(vp), a1 = vtr(vp + 8 * VPITCH), b0 = vtr(vp + 64), b1 = vtr(vp + 8 * VPITCH + 64);
            const bf16x8 v0 = {a0[0], a0[1], a0[2], a0[3], a1[0], a1[1], a1[2], a1[3]}, v1 = {b0[0], b0[1], b0[2], b0[3], b1[0], b1[1], b1[2], b1[3]};
            o0 = __builtin_amdgcn_mfma_f32_32x32x16_bf16(pa[s], v0, o0, 0, 0, 0);
            o1 = __builtin_amdgcn_mfma_f32_32x32x16_bf16(pa[s], v1, o1, 0, 0, 0);
        }
        asm volatile("s_waitcnt lgkmcnt(0)" ::: "memory");
        cur ^= 1;
        if (kt == 0 || __all(carry < EXIT_THR)) break;
    }
    asm volatile("s_waitcnt vmcnt(0)" ::: "memory");
#undef SB_LOADK
#undef SB_DMAV
    bf16_t* Ow = O + (rowbase + t0) * 512 + h * 64 + r32;
#pragma unroll
    for (int r = 0; r < 16; ++r) { const int q = crow(r, hi); Ow[(size_t)q * 512] = (bf16_t)f2bf(o0[r]); Ow[(size_t)q * 512 + 32] = (bf16_t)f2bf(o1[r]); }
}
}

__device__ __forceinline__ void p2_pool(Frame& F, const bf16_t* U, bf16_t* MIX) {
    const int rows_per = M / F.G; const int col8 = F.tid & 63, w = 2 << (col8 >> 4);
    for (int rr = F.wave; rr < rows_per; rr += NWAVES) { const int t = F.vcu * rows_per + rr, tl = t % SEQ; const int cnt = (tl + 1) < w ? (tl + 1) : w;
        float acc[8];
#pragma unroll
        for (int j = 0; j < 8; ++j) acc[j] = 0.f;
        v4u self = {0u, 0u, 0u, 0u};
        for (int i = 0; i < cnt; ++i) { const v4u u = *(const GAS v4u*)(U + (size_t)(t - i) * PW + col8 * 8); if (i == 0) self = u;
            acc[0] += bf2f(u.x & 0xffffu); acc[1] += bf2f(u.x >> 16); acc[2] += bf2f(u.y & 0xffffu); acc[3] += bf2f(u.y >> 16);
            acc[4] += bf2f(u.z & 0xffffu); acc[5] += bf2f(u.z >> 16); acc[6] += bf2f(u.w & 0xffffu); acc[7] += bf2f(u.w >> 16); }
        const float inv = 1.f / (float)cnt;
        v4u o; o.x = pk2(acc[0] * inv - bf2f(self.x & 0xffffu), acc[1] * inv - bf2f(self.x >> 16)); o.y = pk2(acc[2] * inv - bf2f(self.y & 0xffffu), acc[3] * inv - bf2f(self.y >> 16));
        o.z = pk2(acc[4] * inv - bf2f(self.z & 0xffffu), acc[5] * inv - bf2f(self.z >> 16)); o.w = pk2(acc[6] * inv - bf2f(self.w & 0xffffu), acc[7] * inv - bf2f(self.w >> 16));
        *(GAS v4u*)(MIX + (size_t)t * PW + col8 * 8) = o; }
}

namespace slow {
__device__ __forceinline__ void route(Frame& F, const Args& a) {
    unsigned char* ws = a.ws; const float* X1 = a.out; const float* g2 = a.in[13]; const float* mod = (const float*)(ws + WS_MOD); const float* Wr = a.in[14]; const float* rbias = a.in[15];
    bf16_t* H2 = (bf16_t*)(ws + WS_H2); int* PE = (int*)(ws + WS_PE); float* PWt = (float*)(ws + WS_PW);
    LAS float* hrow = (LAS float*)(F.lds + RING_OFF + F.wave * 4096); const int lane = F.lane;
    for (int t = F.vcu * NWAVES + F.wave; t < M; t += F.G * NWAVES) { const int b = t / SEQ;
        float v[16]; float ss = 0.f;
#pragma unroll
        for (int j = 0; j < 4; ++j) { const f32x4 f = ((const GAS f32x4*)(X1 + (size_t)t * D))[lane + 64 * j]; v[4 * j] = f.x; v[4 * j + 1] = f.y; v[4 * j + 2] = f.z; v[4 * j + 3] = f.w; ss += f.x * f.x + f.y * f.y + f.z * f.z + f.w * f.w; }
        ss = wave_sum(ss); const float r = rsqrtf(ss * (1.f / D) + EPS);
        const float* sh = mod + b * 6 * D + 3 * D; const float* sc = mod + b * 6 * D + 4 * D;
#pragma unroll
        for (int j = 0; j < 4; ++j)
#pragma unroll
            for (int i = 0; i < 4; ++i) { const int k = (lane + 64 * j) * 4 + i; const float h = v[4 * j + i] * r * g2[k] * (1.f + sc[k]) + sh[k]; hrow[k] = h; H2[(size_t)t * D + k] = (bf16_t)f2bf(h); }
        LDS_WAIT(); asm volatile("" ::: "memory");
        float logit = 0.f;
        for (int k = 0; k < D; ++k) logit += hrow[k] * Wr[k * NE + lane];
        LDS_WAIT(); asm volatile("" ::: "memory");
        const float score = 1.f / (1.f + expf(-logit)); const float sel = score + rbias[lane];
        float m1 = sel; m1 = fmaxf(m1, __shfl_xor(m1, 1)); m1 = fmaxf(m1, __shfl_xor(m1, 2)); m1 = fmaxf(m1, __shfl_xor(m1, 4));
        const unsigned long long bal = __ballot(sel == m1); const int g = lane >> 3; const unsigned gm = (unsigned)(bal >> (g * 8)) & 0xffu;
        const int first = g * 8 + __ffs(gm) - 1;
        float m2 = (lane == first) ? -INFINITY : sel; m2 = fmaxf(m2, __shfl_xor(m2, 1)); m2 = fmaxf(m2, __shfl_xor(m2, 2)); m2 = fmaxf(m2, __shfl_xor(m2, 4));
        const float gs = m1 + m2;
        int grank = 0;
        for (int gg = 0; gg < 8; ++gg) { const float o = __shfl(gs, gg * 8); grank += (o > gs || (o == gs && gg < g)) ? 1 : 0; }
        const float ms = grank < 4 ? sel : -INFINITY;
        int rank = 0;
        for (int e = 0; e < 64; ++e) { const float o = __shfl(ms, e); rank += (o > ms || (o == ms && e < lane)) ? 1 : 0; }
        const bool chosen = rank < TOPK;
        const float wsum = wave_sum(chosen ? score : 0.f);
        if (chosen) { PE[t * 8 + rank] = lane; PWt[t * 8 + rank] = score / wsum * RSCALE; }
    }
}
__device__ __forceinline__ void hmid(Frame& F, const Args& a) {
    unsigned char* ws = a.ws; const bf16_t* H2 = (const bf16_t*)(ws + WS_H2); const int* PE = (const int*)(ws + WS_PE); const float* PWt = (const float*)(ws + WS_PW);
    const float* Wg = a.in[16]; const float* Wu = a.in[17]; bf16_t* HM = (bf16_t*)(ws + WS_HM); const int lane = F.lane;
    for (int p = F.vcu * NWAVES + F.wave; p < M * 8; p += F.G * NWAVES) { const int t = p >> 3; const int e = PE[p]; const float w = PWt[p];
        const float* wg = Wg + (size_t)e * D * ED; const float* wu = Wu + (size_t)e * D * ED;
        float a0 = 0.f, a1 = 0.f, b0 = 0.f, b1 = 0.f;
        for (int k = 0; k < D; ++k) { const float h = bf2f(H2[(size_t)t * D + k]); a0 += h * wg[k * ED + lane]; a1 += h * wg[k * ED + 64 + lane]; b0 += h * wu[k * ED + lane]; b1 += h * wu[k * ED + 64 + lane]; }
        HM[(size_t)p * ED + lane] = (bf16_t)f2bf(siluf_(a0) * b0 * w); HM[(size_t)p * ED + 64 + lane] = (bf16_t)f2bf(siluf_(a1) * b1 * w); }
    const float* Wsg = a.in[19]; const float* Wsu = a.in[20]; bf16_t* SH = (bf16_t*)(ws + WS_SH);
    for (int it = F.vcu * NWAVES + F.wave; it < (M / 8) * (SHD / 64); it += F.G * NWAVES) { const int m0 = (it >> 2) * 8, n0 = (it & 3) * 64;
        float ag[8], au[8];
#pragma unroll
        for (int i = 0; i < 8; ++i) { ag[i] = 0.f; au[i] = 0.f; }
        for (int k = 0; k < D; ++k) { const float bg = Wsg[(size_t)k * SHD + n0 + lane], bu = Wsu[(size_t)k * SHD + n0 + lane];
#pragma unroll
            for (int i = 0; i < 8; ++i) { const float h = bf2f(H2[(size_t)(m0 + i) * D + k]); ag[i] += h * bg; au[i] += h * bu; } }
#pragma unroll
        for (int i = 0; i < 8; ++i) SH[(size_t)(m0 + i) * SHD + n0 + lane] = (bf16_t)f2bf(siluf_(ag[i]) * au[i]); }
}
__device__ __forceinline__ void outp(Frame& F, const Args& a) {
    unsigned char* ws = a.ws; const bf16_t* HM = (const bf16_t*)(ws + WS_HM); const bf16_t* SH = (const bf16_t*)(ws + WS_SH); const int* PE = (const int*)(ws + WS_PE);
    const float* Wd = a.in[18]; const float* Wsd = a.in[21]; const float* mod = (const float*)(ws + WS_MOD); float* OUT = a.out; const int lane = F.lane;
    for (int t = F.vcu * NWAVES + F.wave; t < M; t += F.G * NWAVES) { const int b = t / SEQ;
        float acc[16];
#pragma unroll
        for (int i = 0; i < 16; ++i) acc[i] = 0.f;
        for (int k = 0; k < 8; ++k) { const int e = PE[t * 8 + k]; const float* wd = Wd + (size_t)e * ED * D;
            for (int j = 0; j < ED; ++j) { const float h = bf2f(HM[(size_t)(t * 8 + k) * ED + j]);
#pragma unroll
                for (int i = 0; i < 16; ++i) acc[i] += h * wd[(size_t)j * D + lane + 64 * i]; } }
        for (int j = 0; j < SHD; ++j) { const float h = bf2f(SH[(size_t)t * SHD + j]);
#pragma unroll
            for (int i = 0; i < 16; ++i) acc[i] += h * Wsd[(size_t)j * D + lane + 64 * i]; }
#pragma unroll
        for (int i = 0; i < 16; ++i) { const int n = lane + 64 * i; const size_t o = (size_t)t * D + n; OUT[o] = OUT[o] + mod[b * 6 * D + 5 * D + n] * acc[i]; } }
}
}

__global__ void __launch_bounds__(NWAVES * 64, 2) mk_fwd(Args args) {
    extern __shared__ __attribute__((aligned(16))) unsigned char lds[];
    Frame F;
    F.lds = (LAS unsigned char*)lds; F.MISC = (volatile LAS unsigned*)(F.lds + MISC_OFF);
    F.tid = threadIdx.x; F.lane = F.tid & 63; F.wave = __builtin_amdgcn_readfirstlane(F.tid >> 6);
    F.G = gridDim.x; { const int bx = blockIdx.x; F.vcu = (F.G % 8 == 0) ? (bx % 8) * (F.G / 8) + bx / 8 : bx; }
    unsigned char* ws = args.ws; F.ctl = (gu32*)(ws + WS_CTL);
    for (int u = F.tid; u < (LDS_BYTES - LDSCTL_OFF) / 4; u += NWAVES * 64) ((LAS unsigned*)(F.lds + LDSCTL_OFF))[u] = 0u;
    __syncthreads();
    XcdBarrier bar; bar.bar = (unsigned*)(F.ctl + CW_BAR); bar.x = 0; bar.st = nullptr;
    if (args.use_bar) bar = xcd_barrier_post((unsigned*)(F.ctl + CW_BAR), F.MISC + 8);
    const int lo = args.ph_lo, hi = args.ph_hi;
#define IN(k) (lo <= (k) && (k) < hi)
#define SEAM(k) do { if (IN(k) && IN((k) + 1)) xcd_barrier(bar); } while (0)
    if (IN(0)) { p0a(F, args); } SEAM(0);
    if (IN(1)) { p0b(F, args); } SEAM(1);
    if (IN(2)) {
        pg8::Gemm g{(const bf16_t*)(ws + WS_XN), (const bf16_t*)(ws + WS_WIN), M, INW, D}; pg8::StaticOrder S; S.init(M, INW, F.G, (int)blockIdx.x);
        pg8::EpiProj E{(bf16_t*)(ws + WS_Q), (bf16_t*)(ws + WS_K), (bf16_t*)(ws + WS_V), (bf16_t*)(ws + WS_U), (bf16_t*)(ws + WS_GA), (bf16_t*)(ws + WS_GB), args.in[6], args.in[7]};
        pg8::gemm_phase<pg8::EpiProj, pg8::StaticOrder, true, true>(F.lds + RING_OFF, g, S, E);
    } SEAM(2);
    if (IN(3)) {
        const bf16_t* Q = (const bf16_t*)(ws + WS_Q); const bf16_t* K = (const bf16_t*)(ws + WS_K); const bf16_t* V = (const bf16_t*)(ws + WS_V);
        for (int u = blockIdx.x; u < BATCH * NH * (SEQ / 256); u += F.G) { const int qb = u & 15, bh = u >> 4;
            sb::attn_unit(bh >> 3, bh & 7, qb, Q, K, V, (bf16_t*)(ws + WS_OSB), F.lds + RING_OFF + F.wave * sb::WAVE_LDS, F.wave, F.lane); }
        p2_pool(F, (const bf16_t*)(ws + WS_U), (bf16_t*)(ws + WS_MIX));
    } SEAM(3);
    if (IN(4)) {
        pg8::StaticOrder S; S.init(M, D, F.G, (int)blockIdx.x);
        { pg8::Gemm g{(const bf16_t*)(ws + WS_OSB), (const bf16_t*)(ws + WS_WSB), M, D, SBW}; pg8::EpiMerge E{(const bf16_t*)(ws + WS_GA), (bf16_t*)(ws + WS_MERGED), 0};
          pg8::gemm_phase<pg8::EpiMerge, pg8::StaticOrder, true, true>(F.lds + RING_OFF, g, S, E); }
        { pg8::Gemm g{(const bf16_t*)(ws + WS_MIX), (const bf16_t*)(ws + WS_WEFF), M, D, PW}; pg8::EpiMerge E{(const bf16_t*)(ws + WS_GB), (bf16_t*)(ws + WS_MERGED), 1};
          pg8::gemm_phase<pg8::EpiMerge, pg8::StaticOrder, true, true>(F.lds + RING_OFF, g, S, E); }
    } SEAM(4);
    if (IN(5)) {
        pg8::Gemm g{(const bf16_t*)(ws + WS_MERGED), (const bf16_t*)(ws + WS_WOUT), M, D, D}; pg8::StaticOrder S; S.init(M, D, F.G, (int)blockIdx.x);
        pg8::EpiX1 E{args.in[0], (const float*)(ws + WS_MOD) + 2 * D, args.out};
        pg8::gemm_phase<pg8::EpiX1, pg8::StaticOrder, true, true>(F.lds + RING_OFF, g, S, E);
    } SEAM(5);
    if (IN(6)) { slow::route(F, args); } SEAM(6);
    if (IN(7)) { slow::hmid(F, args); } SEAM(7);
    if (IN(8)) { slow::outp(F, args); }
#undef IN
#undef SEAM
}
#ifndef FAST_HI
#define FAST_HI 9
#endif
#ifndef ONE_LAUNCH
#define ONE_LAUNCH 1
#endif
extern "C" void kernel_launch(void* const* d_in, const int* in_sizes, int n_in, void* d_out, int out_size, void* d_ws, size_t ws_size, hipStream_t stream) {
    static int grid = 0;
    if (grid == 0) {
        if (n_in != 22 || out_size != M * D || ws_size < WS_END) { fprintf(stderr, "kernel_launch: unexpected shapes n_in %d out %d ws %zu\n", n_in, out_size, ws_size); grid = -1; return; }
        int dev = 0, cus = 0, per_cu = 0;
        if (hipGetDevice(&dev) != hipSuccess || hipDeviceGetAttribute(&cus, hipDeviceAttributeMultiprocessorCount, dev) != hipSuccess) { grid = -1; return; }
        if (hipFuncSetAttribute((const void*)mk_fwd, hipFuncAttributeMaxDynamicSharedMemorySize, LDS_BYTES) != hipSuccess) { fprintf(stderr, "kernel_launch: hipFuncSetAttribute failed\n"); grid = -1; return; }
        if (hipOccupancyMaxActiveBlocksPerMultiprocessor(&per_cu, (const void*)mk_fwd, NWAVES * 64, LDS_BYTES) != hipSuccess || per_cu < 1) fprintf(stderr, "kernel_launch: occupancy query says %d per CU\n", per_cu);
        (void)hipGetLastError();
        grid = cus;
    }
    if (grid < 0) return;
    const float* x = (const float*)d_in[0]; const float* c = (const float*)d_in[1]; const float* w_ada = (const float*)d_in[2]; const float* b_ada = (const float*)d_in[3];
    const float* g1 = (const float*)d_in[4]; const float* w_in = (const float*)d_in[5]; const float* gq = (const float*)d_in[6]; const float* gk = (const float*)d_in[7];
    const float* w_sb = (const float*)d_in[8]; const float* w_pg = (const float*)d_in[9]; const float* ps = (const float*)d_in[10]; const float* w_po = (const float*)d_in[11];
    const float* w_out = (const float*)d_in[12]; const float* g2 = (const float*)d_in[13]; const float* w_r = (const float*)d_in[14]; const float* rb = (const float*)d_in[15];
    const float* w_eg = (const float*)d_in[16]; const float* w_eu = (const float*)d_in[17]; const float* w_ed = (const float*)d_in[18];
    const float* w_sg = (const float*)d_in[19]; const float* w_su = (const float*)d_in[20]; const float* w_sd = (const float*)d_in[21];
    unsigned char* ws = (unsigned char*)d_ws; float* out = (float*)d_out;
    float* MOD = (float*)(ws + WS_MOD); int* PE = (int*)(ws + WS_PE); float* PWt = (float*)(ws + WS_PW);
    bf16_t* XN = (bf16_t*)(ws + WS_XN); bf16_t* OSB = (bf16_t*)(ws + WS_OSB); bf16_t* MIX = (bf16_t*)(ws + WS_MIX); bf16_t* H2 = (bf16_t*)(ws + WS_H2);
    bf16_t* Q = (bf16_t*)(ws + WS_Q); bf16_t* K = (bf16_t*)(ws + WS_K); bf16_t* V = (bf16_t*)(ws + WS_V); bf16_t* MERGED = (bf16_t*)(ws + WS_MERGED);
    bf16_t* HM = (bf16_t*)(ws + WS_HM); bf16_t* SH = (bf16_t*)(ws + WS_SH); bf16_t* U = (bf16_t*)(ws + WS_U); bf16_t* GA = (bf16_t*)(ws + WS_GA); bf16_t* GB = (bf16_t*)(ws + WS_GB);
    bf16_t* PMB = (bf16_t*)(ws + WS_PMB);

    if (hipMemsetAsync(ws + WS_CTL, 0, CTL_ZERO_BYTES, stream) != hipSuccess) { fprintf(stderr, "kernel_launch: memset failed\n"); return; }
    Args a{};
    for (int i = 0; i < 22; ++i) a.in[i] = (const float*)d_in[i];
    a.out = out; a.ws = ws;
    if (FAST_HI > 0) {
        if (ONE_LAUNCH) { a.ph_lo = 0; a.ph_hi = FAST_HI; a.use_bar = 1; hipLaunchKernelGGL(mk_fwd, dim3(grid), dim3(NWAVES * 64), LDS_BYTES, stream, a); }
        else for (int p = 0; p < FAST_HI; ++p) { a.ph_lo = p; a.ph_hi = p + 1; a.use_bar = 0; hipLaunchKernelGGL(mk_fwd, dim3(grid), dim3(NWAVES * 64), LDS_BYTES, stream, a); }
    }
    if (FAST_HI <= 0) nv::k_mod<<<dim3(24, 4), 256, 0, stream>>>(c, w_ada, b_ada, MOD);
    if (FAST_HI <= 1) nv::k_rownorm<<<M, 256, 0, stream>>>(x, g1, MOD, 0, D, XN);
    if (FAST_HI <= 2) nv::k_gemm<nv::EpiProj, false><<<dim3(INW / 64, M / 32), 256, 0, stream>>>(XN, D, w_in, nullptr, INW, D, nv::EpiProj{gq, gk, Q, K, V, U, GA, GB, nullptr});
#if defined(DBG_P1)
    nv::k_gemm<nv::EpiProj, false><<<dim3(INW / 64, M / 32), 256, 0, stream>>>(XN, D, w_in, nullptr, INW, D, nv::EpiProj{gq, gk, Q, K, V, U, GA, GB, (unsigned*)(ws + WS_CTL) + 2});
#endif
    if (FAST_HI <= 3) { nv::k_attn<<<M * NH / 4, 256, 0, stream>>>(Q, K, V, OSB); nv::k_pool<<<M * 512 / 256, 256, 0, stream>>>(U, MIX); }
    if (FAST_HI <= 4) {
        for (int g = 0; g < 4; ++g)
            nv::k_gemm<nv::EpiPool, false><<<dim3(2, M / 32), 256, 0, stream>>>(MIX + g * 128, 512, w_pg + (size_t)g * 128 * 128, nullptr, 128, 128, nv::EpiPool{ps, PMB, g, 0});
        nv::k_gemm<nv::EpiMerge, false><<<dim3(D / 64, M / 32), 256, 0, stream>>>(OSB, 512, w_sb, nullptr, D, 512, nv::EpiMerge{GA, MERGED, 0, 0});
        nv::k_gemm<nv::EpiMerge, false><<<dim3(D / 64, M / 32), 256, 0, stream>>>(PMB, 512, w_po, nullptr, D, 512, nv::EpiMerge{GB, MERGED, 1, 0});
    }
    if (FAST_HI <= 5) nv::k_gemm<nv::EpiX1, false><<<dim3(D / 64, M / 32), 256, 0, stream>>>(MERGED, D, w_out, nullptr, D, D, nv::EpiX1{x, MOD, out});
    if (FAST_HI <= 6) nv::k_route<<<M, 64, 0, stream>>>(out, g2, MOD, w_r, rb, H2, PE, PWt);
    if (FAST_HI <= 7) { nv::k_gemm<nv::EpiShared, true><<<dim3(SHD / 64, M / 32), 256, 0, stream>>>(H2, D, w_sg, w_su, SHD, D, nv::EpiShared{SH}); nv::k_hmid<<<M * 8 / 4, 256, 0, stream>>>(H2, PE, PWt, w_eg, w_eu, HM); }
    if (FAST_HI <= 8) nv::k_out<<<M, 256, 0, stream>>>(HM, SH, PE, w_ed, w_sd, MOD, out);
#if defined(DBG_P1)
    nv::k_poison<<<1024, 256, 0, stream>>>((const unsigned*)(ws + WS_CTL) + 2, DBG_P1, out);
#endif
}
```

```cpp
#include <hip/hip_runtime.h>
#include <cstdint>
#include <cstdio>

typedef unsigned short bf16_t;
constexpr int D = 1024, BATCH = 4, SEQ = 4096, M = BATCH * SEQ, NH = 8, HD = 64, SBW = 512, PW = 512, INW = 4096;
constexpr int NE = 64, ED = 128, TOPK = 8, SHD = 256;
constexpr float EPS = 1e-6f, RSCALE = 2.5f;

constexpr size_t MiB = 1u << 20;
constexpr size_t WS_CTL = 0, WS_MOD = 1 * MiB, WS_PE = 2 * MiB, WS_PW = 3 * MiB, WS_LIST = 4 * MiB;
constexpr size_t WS_XN = 74 * MiB, WS_OSB = 74 * MiB, WS_MIX = 90 * MiB, WS_H2 = 74 * MiB;
constexpr size_t WS_Q = 106 * MiB, WS_K = 122 * MiB, WS_V = 138 * MiB, WS_MERGED = 106 * MiB;
constexpr size_t WS_SLOT = 190 * MiB, WS_SH = 192 * MiB, WS_HM = 200 * MiB;
constexpr size_t WS_YH = 12 * MiB, WS_YSH = 156 * MiB;
constexpr size_t WS_U = 154 * MiB, WS_GA = 170 * MiB, WS_GB = 202 * MiB, WS_END = 256 * MiB;

__device__ __forceinline__ unsigned f2bf(float f) { unsigned u = __builtin_bit_cast(unsigned, f); return (u + 0x7fffu + ((u >> 16) & 1u)) >> 16; }
__device__ __forceinline__ float bf2f(unsigned h) { return __builtin_bit_cast(float, h << 16); }
__device__ __forceinline__ float wave_sum(float v) {
#pragma unroll
    for (int o = 1; o < 64; o <<= 1) v += __shfl_xor(v, o);
    return v;
}
__device__ __forceinline__ float sigmoidf_(float v) { return 1.f / (1.f + __expf(-v)); }
__device__ __forceinline__ float siluf_(float v) { return v / (1.f + __expf(-v)); }

namespace pg8 {
#define PG8_LAS __attribute__((address_space(3)))
typedef short bf16x8 __attribute__((ext_vector_type(8)));
typedef float f32x4 __attribute__((ext_vector_type(4)));
typedef unsigned u32x4 __attribute__((ext_vector_type(4)));
constexpr int BM = 256, BK = 64, HALF = 128, HTB = HALF * BK * 2  , STAGE_BYTES = 8 * HTB, NXCD = 8, WGM = 8;

__host__ __device__ __forceinline__ int lds_byte(int r, int c) { const int st = (r >> 4) * 2 + (c >> 5), rr = r & 15, cc = c & 31, ob = rr * 64 + cc * 2; return st * 1024 + (ob ^ (((ob >> 9) & 1) << 5)); }
__host__ __device__ __forceinline__ void stage_rc(int b, int& R, int& C) { const int st = b / 1024, sb = b % 1024, swz = sb ^ (((sb >> 9) & 1) << 5); R = (st >> 1) * 16 + swz / 64; C = (st & 1) * 32 + (swz % 64) / 2; }
__host__ __device__ __forceinline__ int perm32(int rho) { const int n = rho >> 4, i = rho & 15; return 8 * (i >> 2) + 4 * n + (i & 3); }

struct Unit { int pm, pn; };
struct Gemm { const bf16_t* A; const bf16_t* Bt; int M, N, K; };

struct StaticOrder {
    int nM, nN, nwg, G, c;
    __host__ __device__ void init(int M_, int N_, int G_, int c_) { nM = M_ / BM; nN = N_ / BM; nwg = nM * nN; G = G_; c = c_; }
    __host__ __device__ bool next(int i, Unit& u) const {
        const long L = (long)i * G + c; if (L >= nwg) return false;
        int wgid = (int)L; { const int q = nwg / NXCD, r = nwg % NXCD, xcd = wgid % NXCD, off = wgid / NXCD; wgid = (xcd < r ? xcd * (q + 1) : r * (q + 1) + (xcd - r) * q) + off; }
        const int nig = WGM * nN, gid = wgid / nig, fm = gid * WGM, gsz = (nM - fm) < WGM ? (nM - fm) : WGM;
        u.pm = fm + ((wgid % nig) % gsz); u.pn = (wgid % nig) / gsz; return true;
    }
    __device__ __forceinline__ void a_ready(const Unit&) const {}
    __device__ __forceinline__ void done(const Unit&) const {}
};
typedef float f32x2_t __attribute__((ext_vector_type(2))); typedef __bf16 bf16x2_t __attribute__((ext_vector_type(2)));
__device__ __forceinline__ unsigned cvt_pk_bf16(float lo, float hi) { f32x2_t v = {lo, hi}; bf16x2_t b = __builtin_convertvector(v, bf16x2_t); return __builtin_bit_cast(unsigned, b); }
__device__ __forceinline__ float fsigmoid(float v) { return __builtin_amdgcn_rcpf(1.f + __builtin_amdgcn_exp2f(-1.4426950408889634f * v)); }
constexpr float QSCALE = 0.125f * 1.4426950408889634f;

struct EpiProj {
    static constexpr bool PERM = true, AFTER_DRAIN = false;
    bf16_t *Q, *K, *V, *U, *GA, *GB; const float* gq; const float* gk;
    __device__ __forceinline__ void operator()(const f32x4 (&acc)[2][2][4][2], const Unit& u, int wr, int wc, int fr, int fq) const {
        const int row0 = u.pm * BM + wr * 64 + fr; const int sec = u.pn;
        if (sec < 4) {
            const bool isq = sec < 2; const float* g = isq ? gq : gk; bf16_t* base = (isq ? Q : K) + ((sec & 1) * 4 + wc) * 64 + 8 * fq;
            const float qs = isq ? QSCALE : 1.f;
            f32x4 gv[2][2];
#pragma unroll
            for (int bj = 0; bj < 2; ++bj)
#pragma unroll
                for (int n = 0; n < 2; ++n) gv[bj][n] = *(const f32x4*)(g + 32 * bj + 8 * fq + 4 * n);
#pragma unroll
            for (int ai = 0; ai < 2; ++ai)
#pragma unroll
                for (int m = 0; m < 4; ++m) {
                    float ss = 0.f;
#pragma unroll
                    for (int bj = 0; bj < 2; ++bj)
#pragma unroll
                        for (int n = 0; n < 2; ++n) { const f32x4 x = acc[ai][bj][m][n]; ss += (x[0] * x[0] + x[1] * x[1]) + (x[2] * x[2] + x[3] * x[3]); }
                    ss += __shfl_xor(ss, 16); ss += __shfl_xor(ss, 32);
                    const float r = rsqrtf(ss * (1.f / 64.f) + EPS) * qs;
                    bf16_t* rowp = base + (size_t)(row0 + ai * HALF + m * 16) * 512;
#pragma unroll
                    for (int bj = 0; bj < 2; ++bj) { const f32x4 v0 = acc[ai][bj][m][0] * gv[bj][0] * r, v1 = acc[ai][bj][m][1] * gv[bj][1] * r;
                        u32x4 w; w.x = cvt_pk_bf16(v0[0], v0[1]); w.y = cvt_pk_bf16(v0[2], v0[3]); w.z = cvt_pk_bf16(v1[0], v1[1]); w.w = cvt_pk_bf16(v1[2], v1[3]);
                        *(u32x4*)(rowp + 32 * bj) = w; }
                }
        } else if (sec < 8) {
            bf16_t* base = (sec < 6 ? V : U) + (sec & 1) * 256 + wc * 32 + 8 * fq;
#pragma unroll
            for (int ai = 0; ai < 2; ++ai)
#pragma unroll
                for (int m = 0; m < 4; ++m) { bf16_t* rowp = base + (size_t)(row0 + ai * HALF + m * 16) * 512;
#pragma unroll
                    for (int bj = 0; bj < 2; ++bj) { const f32x4 v0 = acc[ai][bj][m][0], v1 = acc[ai][bj][m][1];
                        u32x4 w; w.x = cvt_pk_bf16(v0[0], v0[1]); w.y = cvt_pk_bf16(v0[2], v0[3]); w.z = cvt_pk_bf16(v1[0], v1[1]); w.w = cvt_pk_bf16(v1[2], v1[3]);
                        *(u32x4*)(rowp + bj * HALF) = w; } }
        } else {
            bf16_t* base = (sec < 12 ? GA : GB) + ((sec - 8) & 3) * 256 + wc * 32 + 8 * fq;
#pragma unroll
            for (int ai = 0; ai < 2; ++ai)
#pragma unroll
                for (int m = 0; m < 4; ++m) { bf16_t* rowp = base + (size_t)(row0 + ai * HALF + m * 16) * 1024;
#pragma unroll
                    for (int bj = 0; bj < 2; ++bj) { const f32x4 v0 = acc[ai][bj][m][0], v1 = acc[ai][bj][m][1];
                        u32x4 w; w.x = cvt_pk_bf16(fsigmoid(v0[0]), fsigmoid(v0[1])); w.y = cvt_pk_bf16(fsigmoid(v0[2]), fsigmoid(v0[3])); w.z = cvt_pk_bf16(fsigmoid(v1[0]), fsigmoid(v1[1])); w.w = cvt_pk_bf16(fsigmoid(v1[2]), fsigmoid(v1[3]));
                        *(u32x4*)(rowp + bj * HALF) = w; } }
        }
    }
};

struct EpiMerge {
    static constexpr bool PERM = true, AFTER_DRAIN = false;
    const bf16_t* G; bf16_t* MG; int add;
    __device__ __forceinline__ void operator()(const f32x4 (&acc)[2][2][4][2], const Unit& u, int wr, int wc, int fr, int fq) const {
        const int row0 = u.pm * BM + wr * 64 + fr, col0 = u.pn * BM + wc * 32 + 8 * fq;
#pragma unroll
        for (int ai = 0; ai < 2; ++ai)
#pragma unroll
            for (int m = 0; m < 4; ++m) { const size_t off = (size_t)(row0 + ai * HALF + m * 16) * 1024 + col0;
#pragma unroll
                for (int bj = 0; bj < 2; ++bj) { const u32x4 g = *(const u32x4*)(G + off + bj * HALF); const f32x4 a0 = acc[ai][bj][m][0], a1 = acc[ai][bj][m][1];
                    float v[8] = {bf2f(g.x & 0xffffu) * a0[0], bf2f(g.x >> 16) * a0[1], bf2f(g.y & 0xffffu) * a0[2], bf2f(g.y >> 16) * a0[3], bf2f(g.z & 0xffffu) * a1[0], bf2f(g.z >> 16) * a1[1], bf2f(g.w & 0xffffu) * a1[2], bf2f(g.w >> 16) * a1[3]};
                    if (add) { const u32x4 o = *(const u32x4*)(MG + off + bj * HALF);
                        v[0] += bf2f(o.x & 0xffffu); v[1] += bf2f(o.x >> 16); v[2] += bf2f(o.y & 0xffffu); v[3] += bf2f(o.y >> 16); v[4] += bf2f(o.z & 0xffffu); v[5] += bf2f(o.z >> 16); v[6] += bf2f(o.w & 0xffffu); v[7] += bf2f(o.w >> 16); }
                    u32x4 w; w.x = cvt_pk_bf16(v[0], v[1]); w.y = cvt_pk_bf16(v[2], v[3]); w.z = cvt_pk_bf16(v[4], v[5]); w.w = cvt_pk_bf16(v[6], v[7]);
                    *(u32x4*)(MG + off + bj * HALF) = w; } }
    }
};
struct EpiX1 {
    static constexpr bool PERM = false, AFTER_DRAIN = false;
    const float* x; const float* gate; float* X1;
    __device__ __forceinline__ void operator()(const f32x4 (&acc)[2][2][4][2], const Unit& u, int wr, int wc, int fr, int fq) const {
        const int row0 = u.pm * BM + wr * 64 + fr, col0 = u.pn * BM + wc * 32 + 4 * fq; const int b = (u.pm * BM) / SEQ;
        f32x4 gv[2][2];
#pragma unroll
        for (int bj = 0; bj < 2; ++bj)
#pragma unroll
            for (int n = 0; n < 2; ++n) gv[bj][n] = *(const f32x4*)(gate + (size_t)b * 6 * D + col0 + bj * HALF + n * 16);
#pragma unroll
        for (int ai = 0; ai < 2; ++ai)
#pragma unroll
            for (int m = 0; m < 4; ++m) { const size_t off = (size_t)(row0 + ai * HALF + m * 16) * D + col0;
#pragma unroll
                for (int bj = 0; bj < 2; ++bj)
#pragma unroll
                    for (int n = 0; n < 2; ++n) *(f32x4*)(X1 + off + bj * HALF + n * 16) = *(const f32x4*)(x + off + bj * HALF + n * 16) + gv[bj][n] * acc[ai][bj][m][n]; }
    }
};

template <class Epi, class Sched, bool ALIGN_EPI = false, bool SP2 = false>
__device__ __forceinline__ void gemm_phase(PG8_LAS unsigned char* lds, const Gemm g, const Sched& S, const Epi& E) {
    int tid_ = threadIdx.x; asm volatile("" : "+v"(tid_));
    const int tid = tid_, wid = __builtin_amdgcn_readfirstlane(tid >> 6), lane = tid & 63, wr = wid >> 2, wc = wid & 3, fr = lane & 15, fq = lane >> 4;
    const int K = g.K, nt = K / BK;
    unsigned voffA[2], voffB[2];
#pragma unroll
    for (int i = 0; i < 2; ++i) { int R, C; stage_rc(tid * 16 + i * 8192, R, C); const int Rb = Epi::PERM ? ((R & ~31) + perm32(R & 31)) : R;
        voffA[i] = (unsigned)(R * K + C) * 2u; voffB[i] = (unsigned)(Rb * K + C) * 2u; }
    const size_t kstep = (size_t)(BK * 2);
    const size_t hstep = (size_t)HALF * K * 2;
    const size_t tstep = 2 * hstep;
    const unsigned ldsw = (unsigned)wid * 1024u;
    const int aoff = lds_byte(wr * 64 + fr, fq * 8), boff = lds_byte(wc * 32 + fr, fq * 8);
#define PG8_SA(b, h) (((b) * 2 + (h)) * HTB)
#define PG8_SB(b, h) ((4 + (b) * 2 + (h)) * HTB)
#define PG8_STAGE(bufoff, gbase, voff) do { _Pragma("unroll") for (int _i = 0; _i < 2; ++_i) \
        __builtin_amdgcn_global_load_lds((const unsigned*)((const char*)(gbase) + (voff)[_i]), (PG8_LAS unsigned*)(lds + (bufoff) + ldsw + _i * 8192), 16, 0, 0); } while (0)
#define PG8_LDA(dst, b, h) do { _Pragma("unroll") for (int m = 0; m < 4; ++m) _Pragma("unroll") for (int k = 0; k < 2; ++k) dst[m][k] = *(const PG8_LAS bf16x8*)(lds + PG8_SA(b, h) + aoff + m * 2048 + k * 1024); } while (0)
#define PG8_LDB(dst, b, h) do { _Pragma("unroll") for (int n = 0; n < 2; ++n) _Pragma("unroll") for (int k = 0; k < 2; ++k) dst[n][k] = *(const PG8_LAS bf16x8*)(lds + PG8_SB(b, h) + boff + n * 2048 + k * 1024); } while (0)
#define PG8_MMA(ai, bj, At, Bt) do { __builtin_amdgcn_s_setprio(1); _Pragma("unroll") for (int m = 0; m < 4; ++m) _Pragma("unroll") for (int n = 0; n < 2; ++n) _Pragma("unroll") for (int k = 0; k < 2; ++k) \
        acc[ai][bj][m][n] = __builtin_amdgcn_mfma_f32_16x16x32_bf16(Bt[n][k], At[m][k], acc[ai][bj][m][n], 0, 0, 0); __builtin_amdgcn_s_setprio(0); } while (0)
#define PG8_WAIT_V(n) asm volatile("s_waitcnt vmcnt(" #n ")" ::: "memory")
#define PG8_WAIT_L(n) asm volatile("s_waitcnt lgkmcnt(" #n ")" ::: "memory")
#define PG8_BAR __builtin_amdgcn_s_barrier()
#define PG8_SCHED __builtin_amdgcn_sched_barrier(0)
    Unit cur, nxt; int ui = 0;
    if (!S.next(0, cur)) return;
    f32x4 acc[2][2][4][2];
#pragma unroll
    for (int a = 0; a < 2; ++a)
#pragma unroll
        for (int b = 0; b < 2; ++b)
#pragma unroll
            for (int m = 0; m < 4; ++m)
#pragma unroll
                for (int n = 0; n < 2; ++n) acc[a][b][m][n] = (f32x4){0.f, 0.f, 0.f, 0.f};
    bf16x8 At[4][2], B0[2][2], B1[2][2];
    const char* cA = (const char*)g.A + (size_t)cur.pm * tstep; const char* cB = (const char*)g.Bt + (size_t)cur.pn * tstep;
    S.a_ready(cur);
    if constexpr (SP2) {
        PG8_STAGE(PG8_SB(0, 0), cB, voffB); PG8_STAGE(PG8_SB(0, 1), cB + hstep, voffB); PG8_STAGE(PG8_SA(0, 0), cA, voffA); PG8_STAGE(PG8_SA(0, 1), cA + hstep, voffA);
        if (wr == 1) PG8_BAR;
        PG8_WAIT_V(2); PG8_BAR;
        PG8_STAGE(PG8_SB(1, 0), cB + kstep, voffB); PG8_STAGE(PG8_SA(1, 0), cA + kstep, voffA); PG8_STAGE(PG8_SB(1, 1), cB + hstep + kstep, voffB);
        PG8_WAIT_V(6); PG8_BAR;
    } else {
        PG8_STAGE(PG8_SB(0, 0), cB, voffB); PG8_STAGE(PG8_SA(0, 0), cA, voffA); PG8_STAGE(PG8_SB(0, 1), cB + hstep, voffB); PG8_STAGE(PG8_SA(0, 1), cA + hstep, voffA);
        if (wr == 1) PG8_BAR;
        PG8_WAIT_V(4); PG8_BAR;
        PG8_STAGE(PG8_SB(1, 0), cB + kstep, voffB); PG8_STAGE(PG8_SA(1, 0), cA + kstep, voffA); PG8_STAGE(PG8_SB(1, 1), cB + hstep + kstep, voffB);
        PG8_WAIT_V(6); PG8_BAR;
    }
    for (;;) {
        const bool has_next = S.next(ui + 1, nxt);
        const char* nA = has_next ? (const char*)g.A + (size_t)nxt.pm * tstep : cA; const char* nB = has_next ? (const char*)g.Bt + (size_t)nxt.pn * tstep : cB;
#pragma nounroll
        for (int t = 0; t < nt; t += 2) {
            const bool last = (t == nt - 2);
            const char* a1 = cA + (size_t)(t + 1) * kstep;
            const char* a2 = last ? nA : cA + (size_t)(t + 2) * kstep; const char* b2 = last ? nB : cB + (size_t)(t + 2) * kstep;
            const char* a3 = a2 + kstep; const char* b3 = b2 + kstep;
            if (last && has_next) S.a_ready(nxt);
            if constexpr (SP2) {
            PG8_LDB(B0, 0, 0); PG8_LDB(B1, 0, 1); PG8_SCHED; PG8_LDA(At, 0, 0); PG8_STAGE(PG8_SA(1, 1), a1 + hstep, voffA);
            PG8_WAIT_V(8); PG8_WAIT_L(0); PG8_BAR; PG8_MMA(0, 0, At, B0); PG8_MMA(0, 1, At, B1); PG8_BAR; PG8_SCHED;
            PG8_LDA(At, 0, 1); PG8_STAGE(PG8_SB(0, 0), b2, voffB); PG8_STAGE(PG8_SB(0, 1), b2 + hstep, voffB); PG8_STAGE(PG8_SA(0, 0), a2, voffA);
            PG8_WAIT_V(8); PG8_WAIT_L(0); PG8_BAR; PG8_MMA(1, 0, At, B0); PG8_MMA(1, 1, At, B1); PG8_BAR; PG8_SCHED;
            PG8_LDB(B0, 1, 0); PG8_LDB(B1, 1, 1); PG8_SCHED; PG8_LDA(At, 1, 0); PG8_STAGE(PG8_SA(0, 1), a2 + hstep, voffA);
            PG8_WAIT_V(8); PG8_WAIT_L(0); PG8_BAR; PG8_MMA(0, 0, At, B0); PG8_MMA(0, 1, At, B1); PG8_BAR; PG8_SCHED;
            PG8_LDA(At, 1, 1); PG8_STAGE(PG8_SB(1, 0), b3, voffB); PG8_STAGE(PG8_SB(1, 1), b3 + hstep, voffB); PG8_STAGE(PG8_SA(1, 0), a3, voffA);
            PG8_WAIT_V(8); PG8_WAIT_L(0); PG8_BAR; PG8_MMA(1, 0, At, B0); PG8_MMA(1, 1, At, B1); PG8_BAR; PG8_SCHED;
            } else {
            PG8_LDB(B0, 0, 0); PG8_SCHED; PG8_LDA(At, 0, 0); PG8_STAGE(PG8_SA(1, 1), a1 + hstep, voffA);
            PG8_WAIT_L(8); PG8_BAR; PG8_WAIT_L(0); PG8_MMA(0, 0, At, B0); PG8_BAR; PG8_SCHED;
            PG8_LDB(B1, 0, 1); PG8_STAGE(PG8_SB(0, 0), b2, voffB);
            PG8_BAR; PG8_WAIT_L(0); PG8_MMA(0, 1, At, B1); PG8_BAR;
            PG8_LDA(At, 0, 1); PG8_STAGE(PG8_SA(0, 0), a2, voffA);
            PG8_BAR; PG8_WAIT_L(0); PG8_MMA(1, 0, At, B0); PG8_BAR; PG8_SCHED;
            PG8_STAGE(PG8_SB(0, 1), b2 + hstep, voffB);
            PG8_WAIT_V(6); PG8_BAR; PG8_MMA(1, 1, At, B1); PG8_BAR;
            PG8_LDB(B0, 1, 0); PG8_SCHED; PG8_LDA(At, 1, 0); PG8_STAGE(PG8_SA(0, 1), a2 + hstep, voffA);
            PG8_WAIT_L(8); PG8_BAR; PG8_WAIT_L(0); PG8_MMA(0, 0, At, B0); PG8_BAR; PG8_SCHED;
            PG8_LDB(B1, 1, 1); PG8_STAGE(PG8_SB(1, 0), b3, voffB);
            PG8_BAR; PG8_WAIT_L(0); PG8_MMA(0, 1, At, B1); PG8_BAR;
            PG8_LDA(At, 1, 1); PG8_STAGE(PG8_SA(1, 0), a3, voffA);
            PG8_BAR; PG8_WAIT_L(0); PG8_MMA(1, 0, At, B0); PG8_BAR; PG8_SCHED;
            PG8_STAGE(PG8_SB(1, 1), b3 + hstep, voffB);
            PG8_WAIT_V(6); PG8_BAR; PG8_MMA(1, 1, At, B1); PG8_BAR;
            }
        }
        if constexpr (ALIGN_EPI) { if (wr == 0) PG8_BAR; }
        if constexpr (!Epi::AFTER_DRAIN) { E(acc, cur, wr, wc, fr, fq); S.done(cur); }
        if (!has_next) break;
#pragma unroll
        for (int a = 0; a < 2; ++a)
#pragma unroll
            for (int b = 0; b < 2; ++b)
#pragma unroll
                for (int m = 0; m < 4; ++m)
#pragma unroll
                    for (int n = 0; n < 2; ++n) acc[a][b][m][n] = (f32x4){0.f, 0.f, 0.f, 0.f};
        cur = nxt; cA = nA; cB = nB; ++ui;
        if constexpr (ALIGN_EPI) { if (wr == 1) PG8_BAR; }
    }
    PG8_WAIT_V(0);
    if constexpr (!ALIGN_EPI) { if (wr == 0) PG8_BAR; }
    PG8_BAR;
    if constexpr (Epi::AFTER_DRAIN) { E.fused(acc, cur, wr, wc, fr, fq, lds, wid, lane); S.done(cur); }
#undef PG8_SA
#undef PG8_SB
#undef PG8_STAGE
#undef PG8_LDA
#undef PG8_LDB
#undef PG8_MMA
#undef PG8_WAIT_V
#undef PG8_WAIT_L
#undef PG8_BAR
#undef PG8_SCHED
}
}
using pg8::f32x4; using pg8::bf16x8;
#define GAS __attribute__((address_space(1)))
#define LAS __attribute__((address_space(3)))
typedef unsigned v4u __attribute__((ext_vector_type(4)));
typedef GAS unsigned gu32;
typedef GAS unsigned long long gu64;
#define RLX_AGENT __ATOMIC_RELAXED, __HIP_MEMORY_SCOPE_AGENT
#define LDS_WAIT() asm volatile("s_waitcnt lgkmcnt(0)" ::: "memory")
#define VM_WAIT() asm volatile("s_waitcnt vmcnt(0)" ::: "memory")
__device__ __forceinline__ unsigned long long rt() { return __builtin_amdgcn_s_memrealtime(); }
__device__ __forceinline__ unsigned pk2(float lo, float hi) { return f2bf(lo) | (f2bf(hi) << 16); }

#define XB_TMO      128
#define XB_XCNT(j)  (256  + 64 * (j))
#define XB_XSUB(j)  (1280 + 64 * (j))
#define XB_XGEN(j)  (2304 + 64 * (j))
#define XB_TOP      3328
#define XB_TOPGEN   3392
#define XCD_BAR_WORDS 3456
#define XB_SPIN_CAP (1u << 18)

__device__ __forceinline__ unsigned xb_ld(unsigned* p)              { return __hip_atomic_load(p, __ATOMIC_RELAXED, __HIP_MEMORY_SCOPE_AGENT); }
__device__ __forceinline__ unsigned xb_add(unsigned* p, unsigned v) { return __hip_atomic_fetch_add(p, v, __ATOMIC_RELAXED, __HIP_MEMORY_SCOPE_AGENT); }
__device__ __forceinline__ unsigned xb_xcc_id() { return (unsigned)__builtin_amdgcn_s_getreg((3 << 11) | 20) & 0xFu; }
#define XB_SPIN(cond, bar) do { unsigned _sp = 0; while (cond) { __builtin_amdgcn_s_sleep(1); \
    if ((++_sp & 255u) == 0u) { if (xb_ld(&(bar)[XB_TMO])) break; if (_sp > XB_SPIN_CAP) { atomicAdd(&(bar)[XB_TMO], 1u); break; } } } } while (0)

struct XcdBarrier {
    unsigned* bar; unsigned x;
    volatile LAS unsigned* st;
};

__device__ __forceinline__ XcdBarrier xcd_barrier_post(unsigned* bar, volatile LAS unsigned* st) {
    XcdBarrier b; b.bar = bar; b.x = xb_xcc_id(); b.st = st;
    if (threadIdx.x == 0) (void)xb_add(&bar[XB_XCNT(b.x)], 1u);
    return b;
}
__device__ __forceinline__ void xcd_barrier_complete(unsigned* bar, unsigned x, unsigned& nloc, unsigned& nx) {
    const unsigned G = gridDim.x * gridDim.y * gridDim.z;
    unsigned sum, cnt, mine, sp = 0u;
    for (;;) {
        sum = 0u; cnt = 0u; mine = 0u;
#pragma unroll
        for (unsigned j = 0; j < 16; ++j) { const unsigned c = xb_ld(&bar[XB_XCNT(j)]); sum += c; cnt += (c > 0u) ? 1u : 0u; mine = (j == x) ? c : mine; }
        if (sum == G) break;
        __builtin_amdgcn_s_sleep(1);
        if ((++sp & 255u) == 0u) { if (xb_ld(&bar[XB_TMO])) break; if (sp > XB_SPIN_CAP) { atomicAdd(&bar[XB_TMO], 1u); break; } }
    }
    nloc = mine > 0u ? mine : 1u; nx = cnt > 0u ? cnt : 1u;
}

__device__ __forceinline__ void xcd_barrier(const XcdBarrier& b) {
    asm volatile("s_waitcnt vmcnt(0)" ::: "memory");
    __syncthreads();
    if (threadIdx.x == 0) {
        unsigned* bar = b.bar;
        __builtin_amdgcn_s_waitcnt(0);
        unsigned nloc = b.st[0], nx = b.st[1];
        if (nloc == 0u) { xcd_barrier_complete(bar, b.x, nloc, nx); b.st[0] = nloc; b.st[1] = nx; }
        const unsigned old = xb_add(&bar[XB_XSUB(b.x)], 1u);
        const unsigned gen = old / nloc;
        if (old + 1u == (gen + 1u) * nloc) {
            __builtin_amdgcn_fence(__ATOMIC_RELEASE, "agent");
            asm volatile("s_waitcnt vmcnt(0)" ::: "memory");
            const unsigned og = xb_add(&bar[XB_TOP], 1u);
            const unsigned tg = og / nx;
            if (og + 1u == (tg + 1u) * nx) xb_add(&bar[XB_TOPGEN], 1u);
            else XB_SPIN(xb_ld(&bar[XB_TOPGEN]) == tg, bar);
            __builtin_amdgcn_fence(__ATOMIC_ACQUIRE, "agent");
            xb_add(&bar[XB_XGEN(b.x)], 1u);
            asm volatile("s_waitcnt vmcnt(0)" ::: "memory");
        } else {
            XB_SPIN(xb_ld(&bar[XB_XGEN(b.x)]) == gen, bar);
            __builtin_amdgcn_fence(__ATOMIC_ACQUIRE, "agent");
            asm volatile("s_waitcnt vmcnt(0)" ::: "memory");
        }
    }
    __syncthreads();
}

constexpr int NWAVES = 8;
#ifndef DBL_PHASE
#define DBL_PHASE -1
#endif
constexpr size_t WS_MODP = 1 * MiB + 128 * 1024;
constexpr size_t WS_WIN = 12 * MiB, WS_WSB = 20 * MiB, WS_WEFF = 21 * MiB, WS_WOUT = 22 * MiB, WS_WGU = 24 * MiB;
constexpr size_t WS_WSHGU = 237 * MiB, WS_WD = 238 * MiB, WS_WSHD = 254 * MiB, WS_WRH = 254 * MiB + 512 * 1024, WS_WRL = WS_WRH + 128 * 1024;
constexpr size_t CTL_ZERO_BYTES = 256 * 1024;
constexpr int CW_TMO = 0, CW_CODE = 1, CW_BAR = 4096, CW_CNT = 16384;
constexpr int RING_OFF = 0, RING_BYTES = 131072, AUX_OFF = RING_BYTES, LDS_BYTES = 163840, LDSCTL_OFF = LDS_BYTES - 1024, MISC_OFF = LDSCTL_OFF + 320;

struct Frame {
    LAS unsigned char* lds; volatile LAS unsigned* MISC; gu32* ctl;
    int tid, lane, wave, vcu, G;
};
struct Args { const float* in[22]; float* out; unsigned char* ws; int ph_lo, ph_hi, use_bar, pad; };

struct TItem { const float* W; bf16_t* dst; int ldw, ldk, k0, n0; };
__device__ __forceinline__ void titem_load(const TItem& t, f32x4 (&v)[8], int lane) {
    const int kr = lane >> 3, n4 = (lane & 7) * 4;
#pragma unroll
    for (int i = 0; i < 8; ++i) v[i] = *(const GAS f32x4*)(t.W + (size_t)(t.k0 + kr + 8 * i) * t.ldw + t.n0 + n4);
}
__device__ __forceinline__ void titem_store(const TItem& t, const f32x4 (&v)[8], LAS float* scr, int lane) {
    { const int kr = lane >> 3, n4 = (lane & 7) * 4;
#pragma unroll
      for (int i = 0; i < 8; ++i) { LAS float* d = scr + (kr + 8 * i) * 33 + n4; d[0] = v[i].x; d[1] = v[i].y; d[2] = v[i].z; d[3] = v[i].w; } }
    LDS_WAIT(); asm volatile("" ::: "memory");
    const int c = lane & 7;
#pragma unroll
    for (int j = 0; j < 4; ++j) { const int n = (lane >> 3) + 8 * j; const LAS float* sp = scr + (8 * c) * 33 + n;
        v4u o; o.x = pk2(sp[0 * 33], sp[1 * 33]); o.y = pk2(sp[2 * 33], sp[3 * 33]); o.z = pk2(sp[4 * 33], sp[5 * 33]); o.w = pk2(sp[6 * 33], sp[7 * 33]);
        *(GAS v4u*)(t.dst + (size_t)n * t.ldk + t.k0 + 8 * c) = o; }
    LDS_WAIT(); asm volatile("" ::: "memory");
}
__device__ __forceinline__ TItem titem_decode(int it, const Args& a, bool late) {
    unsigned char* ws = a.ws; TItem t;
    constexpr int I_IN = 16 * 128, I_SB = 8 * 32, I_OUT = 16 * 32, I_EG = 64 * 64, I_EU = 64 * 64, I_ED = 64 * 64, I_SG = 16 * 8, I_SU = 16 * 8;
    int r = it;
    if (late) {
        if (r < I_ED) { const int e = r >> 6, q = r & 63, kb = q >> 5, nb = q & 31; t.W = a.in[18] + (size_t)e * ED * D; t.ldw = D; t.k0 = kb * 64; t.n0 = nb * 32; t.dst = (bf16_t*)(ws + WS_WD) + ((size_t)e * D + nb * 32) * ED; t.ldk = ED; return t; } r -= I_ED;
        { const int kb = r >> 5, nb = r & 31; t.W = a.in[21]; t.ldw = D; t.k0 = kb * 64; t.n0 = nb * 32; t.dst = (bf16_t*)(ws + WS_WSHD) + (size_t)(nb * 32) * SHD; t.ldk = SHD; return t; } }
    if (r < I_IN) { const int kb = r >> 7, nb = r & 127, n0 = nb * 32; int d0 = n0;
        if (n0 < 1024) d0 = (n0 & ~255) + 128 * ((n0 >> 5) & 1) + 32 * ((n0 >> 6) & 3);
        t.W = a.in[5]; t.ldw = INW; t.k0 = kb * 64; t.n0 = n0; t.dst = (bf16_t*)(ws + WS_WIN) + (size_t)d0 * D; t.ldk = D; return t; } r -= I_IN;
    if (r < I_SB) { const int kb = r >> 5, nb = r & 31; t.W = a.in[8]; t.ldw = D; t.k0 = kb * 64; t.n0 = nb * 32; t.dst = (bf16_t*)(ws + WS_WSB) + (size_t)(nb * 32) * SBW; t.ldk = SBW; return t; } r -= I_SB;
    if (r < I_OUT) { const int kb = r >> 5, nb = r & 31; t.W = a.in[12]; t.ldw = D; t.k0 = kb * 64; t.n0 = nb * 32; t.dst = (bf16_t*)(ws + WS_WOUT) + (size_t)(nb * 32) * D; t.ldk = D; return t; } r -= I_OUT;
    if (r < I_EG) { const int e = r >> 6, q = r & 63, kb = q >> 2, nb = q & 3; t.W = a.in[16] + (size_t)e * D * ED; t.ldw = ED; t.k0 = kb * 64; t.n0 = nb * 32; t.dst = (bf16_t*)(ws + WS_WGU) + ((size_t)e * 256 + nb * 32) * D; t.ldk = D; return t; } r -= I_EG;
    if (r < I_EU) { const int e = r >> 6, q = r & 63, kb = q >> 2, nb = q & 3; t.W = a.in[17] + (size_t)e * D * ED; t.ldw = ED; t.k0 = kb * 64; t.n0 = nb * 32; t.dst = (bf16_t*)(ws + WS_WGU) + ((size_t)e * 256 + 128 + nb * 32) * D; t.ldk = D; return t; } r -= I_EU;
    if (r < I_SG) { const int kb = r >> 3, nb = r & 7, n0 = nb * 32; t.W = a.in[19]; t.ldw = SHD; t.k0 = kb * 64; t.n0 = n0; t.dst = (bf16_t*)(ws + WS_WSHGU) + (size_t)((n0 >> 7) * 256 + (n0 & 127)) * D; t.ldk = D; return t; } r -= I_SG;
    { const int kb = r >> 3, nb = r & 7, n0 = nb * 32; t.W = a.in[20]; t.ldw = SHD; t.k0 = kb * 64; t.n0 = n0; t.dst = (bf16_t*)(ws + WS_WSHGU) + (size_t)((n0 >> 7) * 256 + 128 + (n0 & 127)) * D; t.ldk = D; return t; }
}

__device__ __forceinline__ void titem_run(Frame& F, const Args& a, bool late, int nitems, int first, int stride) {
    LAS float* scr = (LAS float*)(F.lds + RING_OFF + F.wave * 16384); const int lane = F.lane;
    f32x4 va[8], vb[8]; TItem cur, nxt; int it = first;
    if (it < nitems) { cur = titem_decode(it, a, late); titem_load(cur, va, lane); }
    for (; it < nitems; it += 2 * stride) {
        const bool h1 = it + stride < nitems, h2 = it + 2 * stride < nitems;
        if (h1) { nxt = titem_decode(it + stride, a, late); titem_load(nxt, vb, lane); }
        titem_store(cur, va, scr, lane);
        if (h2) { cur = titem_decode(it + 2 * stride, a, late); titem_load(cur, va, lane); }
        if (h1) titem_store(nxt, vb, scr, lane);
    }
}

__device__ __forceinline__ void p0a(Frame& F, const Args& a) {
    unsigned char* ws = a.ws;
    const int gw = F.vcu * NWAVES + F.wave, NGW = F.G * NWAVES, lane = F.lane;
    LAS float* silu_t = (LAS float*)(F.lds + AUX_OFF + 1024);
    { const float* c = a.in[1]; for (int i = F.tid; i < 4 * D; i += NWAVES * 64) ((LAS float*)(F.lds + RING_OFF + 65536))[i] = siluf_(c[i]); }
    LAS float* silu = (LAS float*)(F.lds + RING_OFF + 65536);
    (void)silu_t;
    if (F.G == 256) { const float* wg = a.in[9]; const float* ps = a.in[10]; const float* wpo = a.in[11]; bf16_t* WE = (bf16_t*)(ws + WS_WEFF);
        const int g = F.vcu >> 6, nb = (F.vcu & 63) * 16; LAS float* wgt = (LAS float*)(F.lds + RING_OFF);
        for (int i = F.tid; i < 128 * 128; i += NWAVES * 64) { const int cc = i >> 7, d = i & 127; wgt[d * 128 + cc] = wg[(size_t)g * 16384 + i]; }
        __syncthreads();
        const int cc = F.tid & 127, nq = (F.tid >> 7) * 4; float acc4[4] = {0.f, 0.f, 0.f, 0.f};
        for (int d = 0; d < 128; ++d) { const float wv = wgt[d * 128 + cc] * ps[g * 128 + d]; const float* wr = wpo + (size_t)(g * 128 + d) * D + nb + nq;
#pragma unroll
            for (int j = 0; j < 4; ++j) acc4[j] += wv * wr[j]; }
#pragma unroll
        for (int j = 0; j < 4; ++j) WE[(size_t)(nb + nq + j) * PW + g * 128 + cc] = (bf16_t)f2bf(acc4[j]);
    }
    __syncthreads();
    { const float* w_ada = a.in[2]; float* MODP = (float*)(ws + WS_MODP);
      for (int it = gw; it < 96 * 8; it += NGW) { const int cg = it % 96, ks = it / 96;
          const float* w = w_ada + (size_t)(ks * 128) * (6 * D) + cg * 64 + lane;
          float a0 = 0.f, a1 = 0.f, a2 = 0.f, a3 = 0.f;
#pragma unroll 8
          for (int k = 0; k < 128; ++k) { const float wv = w[(size_t)k * (6 * D)]; const int kk = ks * 128 + k;
              a0 += silu[kk] * wv; a1 += silu[D + kk] * wv; a2 += silu[2 * D + kk] * wv; a3 += silu[3 * D + kk] * wv; }
          float* o = MODP + (size_t)ks * 4 * 6 * D + cg * 64 + lane;
          o[0] = a0; o[6 * D] = a1; o[12 * D] = a2; o[18 * D] = a3; } }
    __syncthreads();
    titem_run(F, a, false, 16 * 128 + 8 * 32 + 16 * 32 + 2 * 64 * 64 + 2 * 16 * 8, gw, NGW);
    { const float* wr = a.in[14]; bf16_t* WH = (bf16_t*)(ws + WS_WRH); bf16_t* WL = (bf16_t*)(ws + WS_WRL);
      for (int i = (F.vcu * NWAVES * 64 + F.tid); i < D * NE; i += F.G * NWAVES * 64) { const int e = i >> 10, k = i & 1023; const float v = wr[k * NE + e];
          const unsigned h = f2bf(v); WH[i] = (bf16_t)h; WL[i] = (bf16_t)f2bf(v - bf2f(h)); } }
}
__device__ __forceinline__ void p0b(Frame& F, const Args& a) {
    unsigned char* ws = a.ws; const float* MODP = (const float*)(ws + WS_MODP); const float* b_ada = a.in[3];
    if (F.tid < 96) { const int idx = 96 * F.vcu + F.tid, b = idx / (6 * D), j = idx % (6 * D); float v = b_ada[j];
#pragma unroll
        for (int ks = 0; ks < 8; ++ks) v += MODP[(size_t)(ks * 4 + b) * 6 * D + j];
        ((float*)(ws + WS_MOD))[idx] = v; }
    const int rows_per = M / F.G, r0 = F.vcu * rows_per, b = r0 / SEQ;
    LAS float* gsv = (LAS float*)(F.lds + RING_OFF); LAS float* shv = gsv + D;
    for (int k = F.tid; k < D; k += NWAVES * 64) { float sh = b_ada[k], sc = b_ada[D + k];
#pragma unroll
        for (int ks = 0; ks < 8; ++ks) { sh += MODP[(size_t)(ks * 4 + b) * 6 * D + k]; sc += MODP[(size_t)(ks * 4 + b) * 6 * D + D + k]; }
        gsv[k] = a.in[4][k] * (1.f + sc); shv[k] = sh; }
    __syncthreads();
    const float* x = a.in[0]; bf16_t* XN = (bf16_t*)(ws + WS_XN);
    for (int i = F.wave; i < rows_per; i += NWAVES) { const int row = r0 + i;
        const GAS f32x4* xr = (const GAS f32x4*)(x + (size_t)row * D) + F.lane;
        f32x4 v[4]; float s = 0.f;
#pragma unroll
        for (int j = 0; j < 4; ++j) { v[j] = xr[64 * j]; s += (v[j].x * v[j].x + v[j].y * v[j].y) + (v[j].z * v[j].z + v[j].w * v[j].w); }
        const float r = rsqrtf(wave_sum(s) * (1.f / D) + EPS);
        GAS unsigned long long* o8 = (GAS unsigned long long*)(XN + (size_t)row * D) + F.lane;
#pragma unroll
        for (int j = 0; j < 4; ++j) { const f32x4 gg = *(const LAS f32x4*)(gsv + 4 * F.lane + 256 * j), ss = *(const LAS f32x4*)(shv + 4 * F.lane + 256 * j);
            const f32x4 h = v[j] * r * gg + ss;
            o8[64 * j] = (unsigned long long)pk2(h.x, h.y) | ((unsigned long long)pk2(h.z, h.w) << 32); } }
    __syncthreads();
}

namespace sb {
using pg8::bf16x8; using pg8::f32x4; typedef float f32x16 __attribute__((ext_vector_type(16))); typedef short v4i16_t __attribute__((ext_vector_type(4)));
typedef short s16x4 __attribute__((ext_vector_type(4)));
constexpr int VPITCH = 128, VBYTES = 64 * VPITCH, WAVE_LDS = 2 * VBYTES;
constexpr float EXIT_THR = -152.f;
__device__ __forceinline__ int crow(int r, int hi) { return (r & 3) + 8 * (r >> 2) + 4 * hi; }
__device__ __forceinline__ s16x4 vtr(LAS const unsigned char* p) { return __builtin_bit_cast(s16x4, __builtin_amdgcn_ds_read_tr16_b64_v4i16((LAS v4i16_t*)p)); }
__device__ __forceinline__ unsigned pkbf(float lo, float hi) { return pg8::cvt_pk_bf16(lo, hi); }

__device__ __forceinline__ void attn_unit(int b, int h, int qb, const bf16_t* Q, const bf16_t* K, const bf16_t* V, bf16_t* O, LAS unsigned char* vlds, int wid, int lane) {
    const int r32 = lane & 31, hi = lane >> 5;
    const int t0 = qb * 256 + wid * 32;
    const size_t rowbase = (size_t)b * SEQ;
    const bf16_t* Kh = K + rowbase * 512 + h * 64; const bf16_t* Vh = V + rowbase * 512 + h * 64;
    bf16x8 qr[4];
#pragma unroll
    for (int d0 = 0; d0 < 4; ++d0) qr[d0] = *(const bf16x8*)(Q + (rowbase + t0 + r32) * 512 + h * 64 + d0 * 16 + hi * 8);
    f32x16 o0 = {}, o1 = {};
    float carry = 0.f;
    int kt = t0 >> 6;
    bf16x8 kf[8];
#define SB_LOADK(KT) do { const int kb_ = (KT) * 64; \
        _Pragma("unroll") for (int d0 = 0; d0 < 4; ++d0) { kf[2 * d0] = *(const bf16x8*)(Kh + (size_t)(kb_ + r32) * 512 + d0 * 16 + hi * 8); kf[2 * d0 + 1] = *(const bf16x8*)(Kh + (size_t)(kb_ + 32 + r32) * 512 + d0 * 16 + hi * 8); } } while (0)
#define SB_DMAV(KT, BUF) do { const int kb_ = (KT) * 64; \
        _Pragma("unroll") for (int i = 0; i < 8; ++i) __builtin_amdgcn_global_load_lds((const unsigned*)(Vh + (size_t)(kb_ + 8 * i + (lane >> 3)) * 512 + (lane & 7) * 8), (LAS unsigned*)(vlds + (BUF) * VBYTES + i * 1024), 16, 0, 0); } while (0)
    int cur = 0;
    SB_DMAV(kt, 0);
    SB_LOADK(kt);
    const int trbase = (4 * hi + ((lane & 15) >> 2)) * VPITCH + (16 * ((lane >> 4) & 1) + 4 * (lane & 3)) * 2;
    bool diag = true;
    for (;; --kt) {
        const int kbase = kt * 64;
        f32x16 p0 = {}, p1 = {};
#pragma unroll
        for (int d0 = 0; d0 < 4; ++d0) { p0 = __builtin_amdgcn_mfma_f32_32x32x16_bf16(kf[2 * d0], qr[d0], p0, 0, 0, 0); p1 = __builtin_amdgcn_mfma_f32_32x32x16_bf16(kf[2 * d0 + 1], qr[d0], p1, 0, 0, 0); }
        asm volatile("" ::: "memory");
        if (kt > 0) { SB_DMAV(kt - 1, cur ^ 1); SB_LOADK(kt - 1); }
        asm volatile("" ::: "memory");
        bf16x8 pa[4]; float suf = 0.f;
        const int qrel = t0 + r32 - kbase;
#define SB_HALF(P, KOFF, PA0, PA1) do { f32x16 sp_; \
        _Pragma("unroll") for (int r = 0; r < 16; ++r) sp_[r] = __builtin_amdgcn_logf(1.f + __builtin_amdgcn_exp2f(P[r])); \
        if (diag) { _Pragma("unroll") for (int r = 0; r < 16; ++r) if (crow(r, hi) + (KOFF) >= qrel) sp_[r] = 0.f; } \
        float e_[4], og_[4], R_[4]; \
        _Pragma("unroll") for (int c = 0; c < 4; ++c) { sp_[4 * c + 2] += sp_[4 * c + 3]; sp_[4 * c + 1] += sp_[4 * c + 2]; sp_[4 * c] += sp_[4 * c + 1]; e_[c] = sp_[4 * c]; } \
        _Pragma("unroll") for (int c = 0; c < 4; ++c) og_[c] = __shfl_xor(e_[c], 32); \
        _Pragma("unroll") for (int c = 3; c >= 0; --c) { R_[c] = carry - (suf + (hi == 0 ? og_[c] : 0.f)); suf += e_[c] + og_[c]; } \
        _Pragma("unroll") for (int r = 0; r < 16; ++r) P[r] = __builtin_amdgcn_exp2f(P[r] - sp_[r] + R_[r >> 2]); \
        if (diag) { _Pragma("unroll") for (int r = 0; r < 16; ++r) if (crow(r, hi) + (KOFF) >= qrel) P[r] = 0.f; } \
        pg8::u32x4 w_; w_.x = pkbf(P[0], P[1]); w_.y = pkbf(P[2], P[3]); w_.z = pkbf(P[4], P[5]); w_.w = pkbf(P[6], P[7]); PA0 = __builtin_bit_cast(bf16x8, w_); \
        w_.x = pkbf(P[8], P[9]); w_.y = pkbf(P[10], P[11]); w_.z = pkbf(P[12], P[13]); w_.w = pkbf(P[14], P[15]); PA1 = __builtin_bit_cast(bf16x8, w_); } while (0)
        SB_HALF(p1, 32, pa[2], pa[3]);
        SB_HALF(p0, 0, pa[0], pa[1]);
#undef SB_HALF
        carry -= suf;
        diag = false;
        if (kt > 0) asm volatile("s_waitcnt vmcnt(16)" ::: "memory"); else asm volatile("s_waitcnt vmcnt(0)" ::: "memory");
        LAS const unsigned char* vb = vlds + cur * VBYTES + trbase;
#pragma unroll
        for (int s = 0; s < 4; ++s) {
            LAS const unsigned char* vp = vb + (16 * s) * VPITCH;
            const s16x4 a0 = vtr(vp), a1 = vtr(vp + 8 * VPITCH), b0 = vtr(vp + 64), b1 = vtr(vp + 8 * VPITCH + 64);
            const bf16x8 v0 = {a0[0], a0[1], a0[2], a0[3], a1[0], a1[1], a1[2], a1[3]}, v1 = {b0[0], b0[1], b0[2], b0[3], b1[0], b1[1], b1[2], b1[3]};
            o0 = __builtin_amdgcn_mfma_f32_32x32x16_bf16(pa[s], v0, o0, 0, 0, 0);
            o1 = __builtin_amdgcn_mfma_f32_32x32x16_bf16(pa[s], v1, o1, 0, 0, 0);
        }
        asm volatile("s_waitcnt lgkmcnt(0)" ::: "memory");
        cur ^= 1;
        if (kt == 0 || __all(carry < EXIT_THR)) break;
    }
    asm volatile("s_waitcnt vmcnt(0)" ::: "memory");
#undef SB_LOADK
#undef SB_DMAV
    bf16_t* Ow = O + (rowbase + t0) * 512 + h * 64 + r32;
#pragma unroll
    for (int r = 0; r < 16; ++r) { const int q = crow(r, hi); Ow[(size_t)q * 512] = (bf16_t)f2bf(o0[r]); Ow[(size_t)q * 512 + 32] = (bf16_t)f2bf(o1[r]); }
}
}

__device__ __forceinline__ void p2_pool(Frame& F, const bf16_t* U, bf16_t* MIX) {
    const int rows_per = M / F.G; const int col8 = F.lane, w = 2 << (col8 >> 4);
    for (int rb = F.wave * 8; rb < rows_per; rb += NWAVES * 8) { const int t0 = F.vcu * rows_per + rb;
        v4u ld[23];
#pragma unroll
        for (int i = 0; i < 23; ++i) ld[i] = *(const GAS v4u*)(U + ((long)(t0 - 15 + i)) * PW + col8 * 8);
#pragma unroll
        for (int r = 0; r < 8; ++r) { const int tl = (t0 + r) % SEQ; const int cnt = (tl + 1) < w ? (tl + 1) : w;
            float acc[8];
#pragma unroll
            for (int j = 0; j < 8; ++j) acc[j] = 0.f;
#pragma unroll
            for (int i = 0; i < 16; ++i) { const v4u u = ld[15 + r - i]; const float m = (i < cnt) ? 1.f : 0.f;
                acc[0] += m * bf2f(u.x & 0xffffu); acc[1] += m * bf2f(u.x >> 16); acc[2] += m * bf2f(u.y & 0xffffu); acc[3] += m * bf2f(u.y >> 16);
                acc[4] += m * bf2f(u.z & 0xffffu); acc[5] += m * bf2f(u.z >> 16); acc[6] += m * bf2f(u.w & 0xffffu); acc[7] += m * bf2f(u.w >> 16); }
            const float inv = 1.f / (float)cnt; const v4u self = ld[15 + r];
            v4u o; o.x = pk2(acc[0] * inv - bf2f(self.x & 0xffffu), acc[1] * inv - bf2f(self.x >> 16)); o.y = pk2(acc[2] * inv - bf2f(self.y & 0xffffu), acc[3] * inv - bf2f(self.y >> 16));
            o.z = pk2(acc[4] * inv - bf2f(self.z & 0xffffu), acc[5] * inv - bf2f(self.z >> 16)); o.w = pk2(acc[6] * inv - bf2f(self.w & 0xffffu), acc[7] * inv - bf2f(self.w >> 16));
            *(GAS v4u*)(MIX + (size_t)(t0 + r) * PW + col8 * 8) = o; } }
}

constexpr int P5_TAB = AUX_OFF + 2048;
constexpr int P5_CNT = AUX_OFF + 1024;
constexpr int LIST_CAP = 16384;
typedef float f32x16 __attribute__((ext_vector_type(16)));
__device__ __forceinline__ void p5_route(Frame& F, const Args& a) {
    unsigned char* ws = a.ws; const float* X1 = a.out; const float* g2 = a.in[13]; const float* mod = (const float*)(ws + WS_MOD); const float* rbias = a.in[15];
    bf16_t* H2 = (bf16_t*)(ws + WS_H2); int* PE = (int*)(ws + WS_PE); float* PWt = (float*)(ws + WS_PW);
    const bf16_t* WH = (const bf16_t*)(ws + WS_WRH); const bf16_t* WL = (const bf16_t*)(ws + WS_WRL);
    unsigned long long* LIST = (unsigned long long*)(ws + WS_LIST); gu32* gcnt = F.ctl + CW_CNT;
    LAS unsigned char* Ahi = F.lds + RING_OFF; LAS unsigned char* Alo = Ahi + 65536; LAS float* part = (LAS float*)Ahi;
    LAS float* gsv = (LAS float*)(F.lds + P5_TAB); LAS float* shv = gsv + D; LAS unsigned* cnt_l = (LAS unsigned*)(F.lds + P5_CNT); LAS unsigned* base_l = cnt_l + 64;
    const int lane = F.lane, wave = F.wave, r32 = lane & 31, hi = lane >> 5;
    const int upc = (M / 32) / F.G;
    { const int b = (F.vcu * upc * 32) / SEQ;
      for (int k = F.tid; k < D; k += NWAVES * 64) { gsv[k] = g2[k] * (1.f + mod[b * 6 * D + 4 * D + k]); shv[k] = mod[b * 6 * D + 3 * D + k]; } }
    for (int u = F.vcu * upc; u < (F.vcu + 1) * upc; ++u) {
        const int row0 = u * 32;
        if (F.tid < 64) cnt_l[F.tid] = 0u;
        __syncthreads();
#pragma unroll
        for (int i = 0; i < 4; ++i) { const int rl = 4 * wave + i, row = row0 + rl;
            const GAS f32x4* xr = (const GAS f32x4*)(X1 + (size_t)row * D) + lane;
            f32x4 v[4]; float s = 0.f;
#pragma unroll
            for (int j = 0; j < 4; ++j) { v[j] = xr[64 * j]; s += (v[j].x * v[j].x + v[j].y * v[j].y) + (v[j].z * v[j].z + v[j].w * v[j].w); }
            const float r = rsqrtf(wave_sum(s) * (1.f / D) + EPS);
            GAS unsigned long long* o8 = (GAS unsigned long long*)(H2 + (size_t)row * D) + lane;
#pragma unroll
            for (int j = 0; j < 4; ++j) { const f32x4 gg = *(const LAS f32x4*)(gsv + 4 * lane + 256 * j), ss = *(const LAS f32x4*)(shv + 4 * lane + 256 * j);
                const f32x4 h = v[j] * r * gg + ss;
                const unsigned h0 = f2bf(h.x), h1 = f2bf(h.y), h2_ = f2bf(h.z), h3 = f2bf(h.w);
                const unsigned long long hh = (unsigned long long)(h0 | (h1 << 16)) | ((unsigned long long)(h2_ | (h3 << 16)) << 32);
                o8[64 * j] = hh;
                const unsigned long long ll = (unsigned long long)pk2(h.x - bf2f(h0), h.y - bf2f(h1)) | ((unsigned long long)pk2(h.z - bf2f(h2_), h.w - bf2f(h3)) << 32);
                const int chunk = (lane >> 1) + 32 * j, off = rl * 2048 + ((chunk ^ (rl & 15)) << 4) + ((lane & 1) << 3);
                *(LAS unsigned long long*)(Ahi + off) = hh; *(LAS unsigned long long*)(Alo + off) = ll; } }
        __syncthreads();
        f32x16 acc0 = {}, acc1 = {};
#pragma unroll
        for (int s8 = 0; s8 < 8; ++s8) { const int s = 8 * wave + s8, chunk = 2 * s + hi, off = r32 * 2048 + ((chunk ^ (r32 & 15)) << 4);
            const bf16x8 ah = *(const LAS bf16x8*)(Ahi + off), al = *(const LAS bf16x8*)(Alo + off);
            const bf16x8 bh0 = *(const bf16x8*)(WH + (size_t)r32 * D + 16 * s + 8 * hi), bh1 = *(const bf16x8*)(WH + (size_t)(32 + r32) * D + 16 * s + 8 * hi);
            const bf16x8 bl0 = *(const bf16x8*)(WL + (size_t)r32 * D + 16 * s + 8 * hi), bl1 = *(const bf16x8*)(WL + (size_t)(32 + r32) * D + 16 * s + 8 * hi);
            acc0 = __builtin_amdgcn_mfma_f32_32x32x16_bf16(ah, bh0, acc0, 0, 0, 0); acc1 = __builtin_amdgcn_mfma_f32_32x32x16_bf16(ah, bh1, acc1, 0, 0, 0);
            acc0 = __builtin_amdgcn_mfma_f32_32x32x16_bf16(al, bh0, acc0, 0, 0, 0); acc1 = __builtin_amdgcn_mfma_f32_32x32x16_bf16(al, bh1, acc1, 0, 0, 0);
            acc0 = __builtin_amdgcn_mfma_f32_32x32x16_bf16(ah, bl0, acc0, 0, 0, 0); acc1 = __builtin_amdgcn_mfma_f32_32x32x16_bf16(ah, bl1, acc1, 0, 0, 0); }
        __syncthreads();
#pragma unroll
        for (int r = 0; r < 16; ++r) { const int rw = (r & 3) + 8 * (r >> 2) + 4 * hi; part[wave * 2048 + rw * 64 + r32] = acc0[r]; part[wave * 2048 + rw * 64 + 32 + r32] = acc1[r]; }
        __syncthreads();
        unsigned posv[4]; int rankv[4]; float wv[4]; bool chv[4];
#pragma unroll
        for (int i = 0; i < 4; ++i) { const int rl = 4 * wave + i;
            float logit = 0.f;
#pragma unroll
            for (int w = 0; w < 8; ++w) logit += part[w * 2048 + rl * 64 + lane];
            const float score = 1.f / (1.f + expf(-logit)); const float sel = score + rbias[lane];
            float m1 = sel; m1 = fmaxf(m1, __shfl_xor(m1, 1)); m1 = fmaxf(m1, __shfl_xor(m1, 2)); m1 = fmaxf(m1, __shfl_xor(m1, 4));
            const unsigned long long bal = __ballot(sel == m1); const int g = lane >> 3; const unsigned gm = (unsigned)(bal >> (g * 8)) & 0xffu;
            const int first = g * 8 + __ffs(gm) - 1;
            float m2 = (lane == first) ? -INFINITY : sel; m2 = fmaxf(m2, __shfl_xor(m2, 1)); m2 = fmaxf(m2, __shfl_xor(m2, 2)); m2 = fmaxf(m2, __shfl_xor(m2, 4));
            const float gs = m1 + m2;
            int grank = 0;
#pragma unroll
            for (int gg = 0; gg < 8; ++gg) { const float o = __builtin_bit_cast(float, __builtin_amdgcn_readlane(__builtin_bit_cast(int, gs), gg * 8)); grank += (o > gs || (o == gs && gg < g)) ? 1 : 0; }
            const float ms = grank < 4 ? sel : -INFINITY;
            int rank = TOPK; float mc = ms;
#pragma unroll
            for (int r = 0; r < TOPK; ++r) { float mx = mc;
#pragma unroll
                for (int o = 1; o < 64; o <<= 1) mx = fmaxf(mx, __shfl_xor(mx, o));
                const unsigned long long bm = __ballot(mc == mx); const int win = __ffsll((long long)bm) - 1;
                if (lane == win) { rank = r; mc = -INFINITY; } }
            const bool chosen = rank < TOPK;
            const float wsum = wave_sum(chosen ? score : 0.f);
            chv[i] = chosen; rankv[i] = rank; wv[i] = score / wsum * RSCALE; posv[i] = 0u;
            if (chosen) posv[i] = __hip_atomic_fetch_add(cnt_l + lane, 1u, __ATOMIC_RELAXED, __HIP_MEMORY_SCOPE_WORKGROUP); }
        __syncthreads();
        if (F.tid < 64) base_l[F.tid] = __hip_atomic_fetch_add(gcnt + 64 * F.tid, cnt_l[F.tid], __ATOMIC_RELAXED, __HIP_MEMORY_SCOPE_AGENT);
        __syncthreads();
#pragma unroll
        for (int i = 0; i < 4; ++i) if (chv[i]) { const int t = row0 + 4 * wave + i, pair = t * 8 + rankv[i];
            LIST[(size_t)lane * LIST_CAP + base_l[lane] + posv[i]] = (unsigned long long)(unsigned)pair | ((unsigned long long)__builtin_bit_cast(unsigned, wv[i]) << 32);
            PE[pair] = lane; PWt[pair] = wv[i]; }
        __syncthreads();
    }
}

namespace pg8 {
struct UnitG { int kind, slot, nvalid, pm, pn, row0; const char* bptr; };
constexpr int P6_PRE = AUX_OFF + 1024;
constexpr int P6_ROWS = AUX_OFF + 2048;
struct SchedG {
    const LAS int* pre; const LAS int* cnts; const LAS int* cum; const char* wgu; const char* wsh; int G, c, nr, total;
    __device__ __forceinline__ bool next(int i, UnitG& u) const {
        const int idx = i * G + c; if (idx >= total) return false;
        if (idx < nr) { int e = (int)__builtin_popcountll(__ballot(pre[1 + (threadIdx.x & 63)] <= idx));
            e = __builtin_amdgcn_readfirstlane(e); const int j = idx - __builtin_amdgcn_readfirstlane(pre[e]); const int nv = __builtin_amdgcn_readfirstlane(cnts[e]) - 256 * j;
            u.kind = 0; u.slot = i; u.nvalid = nv < 256 ? nv : 256; u.pm = e; u.pn = j; u.row0 = 256 * idx; u.bptr = wgu + (size_t)e * 256 * D * 2; }
        else { const int s = idx - nr; u.kind = 1; u.slot = i; u.nvalid = 256; u.pm = s >> 1; u.pn = s & 1; u.row0 = (s >> 1) * 256; u.bptr = wsh + (size_t)(s & 1) * 256 * D * 2; }
        return true; }
};
struct EpiGU {
    static constexpr bool PERM = true;
    bf16_t* HM; bf16_t* SH; int* SLOT; const LAS unsigned long long* rowinfo;
    __device__ __forceinline__ void operator()(const f32x4 (&acc)[2][2][4][2], const UnitG& u, int wr, int wc, int fr, int fq) const {
#pragma unroll
        for (int ai = 0; ai < 2; ++ai)
#pragma unroll
            for (int m = 0; m < 4; ++m) { const int r = ai * HALF + wr * 64 + m * 16 + fr;
                bf16_t* dst; float w;
                if (u.kind == 0) { const unsigned long long ri = rowinfo[u.slot * 256 + r]; dst = HM + (size_t)(u.row0 + r) * ED + wc * 32 + 8 * fq; w = __builtin_bit_cast(float, (unsigned)(ri >> 32));
                    if (wc == 0 && fq == 0) SLOT[u.row0 + r] = (r < u.nvalid) ? (int)(unsigned)ri : M * 8; }
                else { dst = SH + (size_t)(u.pm * 256 + r) * SHD + u.pn * 128 + wc * 32 + 8 * fq; w = 1.f; }
                const f32x4 g0 = acc[ai][0][m][0], g1 = acc[ai][0][m][1], u0 = acc[ai][1][m][0], u1 = acc[ai][1][m][1];
                float v[8];
#pragma unroll
                for (int j = 0; j < 4; ++j) { v[j] = g0[j] * fsigmoid(g0[j]) * u0[j] * w; v[4 + j] = g1[j] * fsigmoid(g1[j]) * u1[j] * w; }
                u32x4 o; o.x = cvt_pk_bf16(v[0], v[1]); o.y = cvt_pk_bf16(v[2], v[3]); o.z = cvt_pk_bf16(v[4], v[5]); o.w = cvt_pk_bf16(v[6], v[7]);
                if (r < u.nvalid) *(u32x4*)dst = o; }
    }
};
template <class Epi, class Sched>
__device__ __forceinline__ void gemm_phase_g(PG8_LAS unsigned char* lds, const bf16_t* A, int K, const Sched& S, const Epi& E, const PG8_LAS unsigned long long* rowinfo) {
    int tid_ = threadIdx.x; asm volatile("" : "+v"(tid_));
    const int tid = tid_, wid = __builtin_amdgcn_readfirstlane(tid >> 6), lane = tid & 63, wr = wid >> 2, wc = wid & 3, fr = lane & 15, fq = lane >> 4;
    const int nt = K / BK;
    int RA[2], CA[2]; unsigned voffB[2];
#pragma unroll
    for (int i = 0; i < 2; ++i) { int R, C; stage_rc(tid * 16 + i * 8192, R, C); const int Rb = Epi::PERM ? ((R & ~31) + perm32(R & 31)) : R; RA[i] = R; CA[i] = C; voffB[i] = (unsigned)(Rb * K + C) * 2u; }
    const size_t kstep = (size_t)(BK * 2);
    const size_t hstep = (size_t)HALF * K * 2;
    const unsigned ldsw = (unsigned)wid * 1024u;
    const int aoff = lds_byte(wr * 64 + fr, fq * 8), boff = lds_byte(wc * 32 + fr, fq * 8);
#define PG8_AOFF(u, o0, o1) do { _Pragma("unroll") for (int _i = 0; _i < 2; ++_i) { unsigned r0_, r1_; \
        if ((u).kind == 0) { r0_ = (unsigned)rowinfo[(u).slot * 256 + RA[_i]] >> 3; r1_ = (unsigned)rowinfo[(u).slot * 256 + HALF + RA[_i]] >> 3; } \
        else { r0_ = (unsigned)((u).row0 + RA[_i]); r1_ = r0_ + HALF; } \
        o0[_i] = (r0_ * (unsigned)K + (unsigned)CA[_i]) * 2u; o1[_i] = (r1_ * (unsigned)K + (unsigned)CA[_i]) * 2u; } } while (0)
#define PG8_SA(b, h) (((b) * 2 + (h)) * HTB)
#define PG8_SB(b, h) ((4 + (b) * 2 + (h)) * HTB)
#define PG8_STAGE(bufoff, gbase, voff) do { _Pragma("unroll") for (int _i = 0; _i < 2; ++_i) \
        __builtin_amdgcn_global_load_lds((const unsigned*)((const char*)(gbase) + (voff)[_i]), (PG8_LAS unsigned*)(lds + (bufoff) + ldsw + _i * 8192), 16, 0, 0); } while (0)
#define PG8_LDA(dst, b, h) do { _Pragma("unroll") for (int m = 0; m < 4; ++m) _Pragma("unroll") for (int k = 0; k < 2; ++k) dst[m][k] = *(const PG8_LAS bf16x8*)(lds + PG8_SA(b, h) + aoff + m * 2048 + k * 1024); } while (0)
#define PG8_LDB(dst, b, h) do { _Pragma("unroll") for (int n = 0; n < 2; ++n) _Pragma("unroll") for (int k = 0; k < 2; ++k) dst[n][k] = *(const PG8_LAS bf16x8*)(lds + PG8_SB(b, h) + boff + n * 2048 + k * 1024); } while (0)
#define PG8_MMA(ai, bj, At, Bt) do { __builtin_amdgcn_s_setprio(1); _Pragma("unroll") for (int m = 0; m < 4; ++m) _Pragma("unroll") for (int n = 0; n < 2; ++n) _Pragma("unroll") for (int k = 0; k < 2; ++k) \
        acc[ai][bj][m][n] = __builtin_amdgcn_mfma_f32_16x16x32_bf16(Bt[n][k], At[m][k], acc[ai][bj][m][n], 0, 0, 0); __builtin_amdgcn_s_setprio(0); } while (0)
#define PG8_WAIT_V(n) asm volatile("s_waitcnt vmcnt(" #n ")" ::: "memory")
#define PG8_WAIT_L(n) asm volatile("s_waitcnt lgkmcnt(" #n ")" ::: "memory")
#define PG8_BAR __builtin_amdgcn_s_barrier()
#define PG8_SCHED __builtin_amdgcn_sched_barrier(0)
    UnitG cur, nxt; int ui = 0;
    if (!S.next(0, cur)) return;
    f32x4 acc[2][2][4][2];
#pragma unroll
    for (int a = 0; a < 2; ++a)
#pragma unroll
        for (int b = 0; b < 2; ++b)
#pragma unroll
            for (int m = 0; m < 4; ++m)
#pragma unroll
                for (int n = 0; n < 2; ++n) acc[a][b][m][n] = (f32x4){0.f, 0.f, 0.f, 0.f};
    bf16x8 At[4][2], B0[2][2], B1[2][2];
    const char* cA = (const char*)A; const char* cB = cur.bptr;
    unsigned vA0[2], vA1[2], nA0[2], nA1[2];
    PG8_AOFF(cur, vA0, vA1);
    PG8_STAGE(PG8_SB(0, 0), cB, voffB); PG8_STAGE(PG8_SB(0, 1), cB + hstep, voffB); PG8_STAGE(PG8_SA(0, 0), cA, vA0); PG8_STAGE(PG8_SA(0, 1), cA, vA1);
    if (wr == 1) PG8_BAR;
    PG8_WAIT_V(2); PG8_BAR;
    PG8_STAGE(PG8_SB(1, 0), cB + kstep, voffB); PG8_STAGE(PG8_SA(1, 0), cA + kstep, vA0); PG8_STAGE(PG8_SB(1, 1), cB + hstep + kstep, voffB);
    PG8_WAIT_V(6); PG8_BAR;
    for (;;) {
        const bool has_next = S.next(ui + 1, nxt);
        const char* nB = has_next ? nxt.bptr : cB;
        if (has_next) { PG8_AOFF(nxt, nA0, nA1); } else {
#pragma unroll
            for (int _i = 0; _i < 2; ++_i) { nA0[_i] = vA0[_i]; nA1[_i] = vA1[_i]; } }
#pragma nounroll
        for (int t = 0; t < nt; t += 2) {
            const bool last = (t == nt - 2);
            const char* a1 = cA + (size_t)(t + 1) * kstep;
            const char* a2 = last ? cA : cA + (size_t)(t + 2) * kstep; const char* b2 = last ? nB : cB + (size_t)(t + 2) * kstep;
            const char* a3 = a2 + kstep; const char* b3 = b2 + kstep;
            unsigned s0[2], s1[2];
#pragma unroll
            for (int _i = 0; _i < 2; ++_i) { s0[_i] = last ? nA0[_i] : vA0[_i]; s1[_i] = last ? nA1[_i] : vA1[_i]; }
            PG8_LDB(B0, 0, 0); PG8_LDB(B1, 0, 1); PG8_SCHED; PG8_LDA(At, 0, 0); PG8_STAGE(PG8_SA(1, 1), a1, vA1);
            PG8_WAIT_V(8); PG8_WAIT_L(0); PG8_BAR; PG8_MMA(0, 0, At, B0); PG8_MMA(0, 1, At, B1); PG8_BAR; PG8_SCHED;
            PG8_LDA(At, 0, 1); PG8_STAGE(PG8_SB(0, 0), b2, voffB); PG8_STAGE(PG8_SB(0, 1), b2 + hstep, voffB); PG8_STAGE(PG8_SA(0, 0), a2, s0);
            PG8_WAIT_V(8); PG8_WAIT_L(0); PG8_BAR; PG8_MMA(1, 0, At, B0); PG8_MMA(1, 1, At, B1); PG8_BAR; PG8_SCHED;
            PG8_LDB(B0, 1, 0); PG8_LDB(B1, 1, 1); PG8_SCHED; PG8_LDA(At, 1, 0); PG8_STAGE(PG8_SA(0, 1), a2, s1);
            PG8_WAIT_V(8); PG8_WAIT_L(0); PG8_BAR; PG8_MMA(0, 0, At, B0); PG8_MMA(0, 1, At, B1); PG8_BAR; PG8_SCHED;
            PG8_LDA(At, 1, 1); PG8_STAGE(PG8_SB(1, 0), b3, voffB); PG8_STAGE(PG8_SB(1, 1), b3 + hstep, voffB); PG8_STAGE(PG8_SA(1, 0), a3, s0);
            PG8_WAIT_V(8); PG8_WAIT_L(0); PG8_BAR; PG8_MMA(1, 0, At, B0); PG8_MMA(1, 1, At, B1); PG8_BAR; PG8_SCHED;
        }
        if (wr == 0) PG8_BAR;
        E(acc, cur, wr, wc, fr, fq);
        if (!has_next) break;
#pragma unroll
        for (int a = 0; a < 2; ++a)
#pragma unroll
            for (int b = 0; b < 2; ++b)
#pragma unroll
                for (int m = 0; m < 4; ++m)
#pragma unroll
                    for (int n = 0; n < 2; ++n) acc[a][b][m][n] = (f32x4){0.f, 0.f, 0.f, 0.f};
        cur = nxt; cB = nB; ++ui;
#pragma unroll
        for (int _i = 0; _i < 2; ++_i) { vA0[_i] = nA0[_i]; vA1[_i] = nA1[_i]; }
        if (wr == 1) PG8_BAR;
    }
    PG8_WAIT_V(0);
    PG8_BAR;
#undef PG8_AOFF
#undef PG8_SA
#undef PG8_SB
#undef PG8_STAGE
#undef PG8_LDA
#undef PG8_LDB
#undef PG8_MMA
#undef PG8_WAIT_V
#undef PG8_WAIT_L
#undef PG8_BAR
#undef PG8_SCHED
}
}

__device__ __forceinline__ void p6_gateup(Frame& F, const Args& a) {
    unsigned char* ws = a.ws; gu32* gcnt = F.ctl + CW_CNT; const unsigned long long* LIST = (const unsigned long long*)(ws + WS_LIST);
    LAS int* pre = (LAS int*)(F.lds + pg8::P6_PRE); LAS int* cnts = pre + 65; LAS int* cum = cnts + 64; LAS unsigned long long* rowinfo = (LAS unsigned long long*)(F.lds + pg8::P6_ROWS);
    if (F.tid < 64) cnts[F.tid] = (int)__hip_atomic_load(gcnt + 64 * F.tid, RLX_AGENT);
    __syncthreads();
    if (F.tid == 0) { int s = 0, r = 0; for (int e = 0; e < 64; ++e) { pre[e] = s; cum[e] = r; s += (cnts[e] + 255) >> 8; r += cnts[e]; } pre[64] = s; cum[64] = r; }
    __syncthreads();
    pg8::SchedG S; S.pre = pre; S.cnts = cnts; S.cum = cum; S.wgu = (const char*)(ws + WS_WGU); S.wsh = (const char*)(ws + WS_WSHGU); S.G = F.G; S.c = (int)blockIdx.x; S.nr = __builtin_amdgcn_readfirstlane(pre[64]); S.total = S.nr + 2 * (M / 256);
    for (int i = 0; i < 3; ++i) { pg8::UnitG u; if (!S.next(i, u)) break;
        if (u.kind == 0 && F.tid < 256) { const int r = F.tid; rowinfo[i * 256 + r] = (r < u.nvalid) ? LIST[(size_t)u.pm * LIST_CAP + 256 * u.pn + r] : 0ull; } }
    __syncthreads();
    pg8::EpiGU E{(bf16_t*)(ws + WS_HM), (bf16_t*)(ws + WS_SH), (int*)(ws + WS_SLOT), rowinfo};
    pg8::gemm_phase_g<pg8::EpiGU, pg8::SchedG>(F.lds + RING_OFF, (const bf16_t*)(ws + WS_H2), D, S, E, rowinfo);
    { const int rounds = (S.total + F.G - 1) / F.G, firstidle = S.total - (rounds - 1) * F.G;
      const int c = (int)blockIdx.x, nidle = F.G - firstidle;
      if (nidle > 0) { if (c >= firstidle) titem_run(F, a, true, 64 * 64 + 4 * 32, (c - firstidle) * NWAVES + F.wave, nidle * NWAVES); }
      else titem_run(F, a, true, 64 * 64 + 4 * 32, c * NWAVES + F.wave, F.G * NWAVES); }
}

namespace pg8 {
struct SchedYr {
    const LAS int* pre; int G, c, total;
    __device__ __forceinline__ bool next(int i, Unit& u) const {
        const int idx = i * G + c; if (idx >= total) return false;
        const int t = idx >> 2, pnl = idx & 3; int e = (int)__builtin_popcountll(__ballot(pre[1 + (threadIdx.x & 63)] <= t));
        e = __builtin_amdgcn_readfirstlane(e); u.pm = t; u.pn = 4 * e + pnl; return true; }
    __device__ __forceinline__ void a_ready(const Unit&) const {}
    __device__ __forceinline__ void done(const Unit&) const {}
};
constexpr float YSCALE = 8.f;
struct EpiStoreF8 {
    static constexpr bool PERM = true, AFTER_DRAIN = false;
    unsigned char* O; const PG8_LAS int* rowmap_l; int G, c;
    __device__ __forceinline__ void operator()(const f32x4 (&acc)[2][2][4][2], const Unit& u, int wr, int wc, int fr, int fq) const {
        const int slot = (4 * u.pm + (u.pn & 3) - c) / G; const PG8_LAS int* rm = rowmap_l + slot * 256 + wr * 64 + fr; const int col0 = (u.pn & 3) * BM + wc * 32 + 8 * fq;
#pragma unroll
        for (int ai = 0; ai < 2; ++ai)
#pragma unroll
            for (int m = 0; m < 4; ++m) { const int orow = rm[ai * HALF + m * 16]; unsigned char* rowp = O + (size_t)orow * 1024 + col0;
#pragma unroll
                for (int bj = 0; bj < 2; ++bj) { const f32x4 v0 = acc[ai][bj][m][0] * YSCALE, v1 = acc[ai][bj][m][1] * YSCALE;
                    unsigned lo = 0u, hi = 0u;
                    lo = __builtin_amdgcn_cvt_pk_fp8_f32(v0[0], v0[1], lo, false); lo = __builtin_amdgcn_cvt_pk_fp8_f32(v0[2], v0[3], lo, true);
                    hi = __builtin_amdgcn_cvt_pk_fp8_f32(v1[0], v1[1], hi, false); hi = __builtin_amdgcn_cvt_pk_fp8_f32(v1[2], v1[3], hi, true);
                    *(unsigned long long*)(rowp + bj * HALF) = (unsigned long long)lo | ((unsigned long long)hi << 32); } }
    }
};
struct EpiStore {
    static constexpr bool PERM = true, AFTER_DRAIN = false;
    bf16_t* O; int ldc, colmask;
    __device__ __forceinline__ void operator()(const f32x4 (&acc)[2][2][4][2], const Unit& u, int wr, int wc, int fr, int fq) const {
        const int row0 = u.pm * BM + wr * 64 + fr, col0 = (u.pn & colmask) * BM + wc * 32 + 8 * fq;
#pragma unroll
        for (int ai = 0; ai < 2; ++ai)
#pragma unroll
            for (int m = 0; m < 4; ++m) { bf16_t* rowp = O + (size_t)(row0 + ai * HALF + m * 16) * ldc + col0;
#pragma unroll
                for (int bj = 0; bj < 2; ++bj) { const f32x4 v0 = acc[ai][bj][m][0], v1 = acc[ai][bj][m][1];
                    u32x4 w; w.x = cvt_pk_bf16(v0[0], v0[1]); w.y = cvt_pk_bf16(v0[2], v0[3]); w.z = cvt_pk_bf16(v1[0], v1[1]); w.w = cvt_pk_bf16(v1[2], v1[3]);
                    *(u32x4*)(rowp + bj * HALF) = w; } }
    }
};
}
__device__ __forceinline__ void p7_down(Frame& F, const Args& a) {
    unsigned char* ws = a.ws; gu32* gcnt = F.ctl + CW_CNT;
    LAS int* pre = (LAS int*)(F.lds + pg8::P6_PRE); LAS int* cnts = pre + 65;
    if (F.tid < 64) cnts[F.tid] = (int)__hip_atomic_load(gcnt + 64 * F.tid, RLX_AGENT);
    __syncthreads();
    if (F.tid == 0) { int s = 0; for (int e = 0; e < 64; ++e) { pre[e] = s; s += (cnts[e] + 255) >> 8; } pre[64] = s; }
    __syncthreads();
    { pg8::SchedYr S; S.pre = pre; S.G = F.G; S.c = (int)blockIdx.x; S.total = 4 * __builtin_amdgcn_readfirstlane(pre[64]);
      int kk = ED; asm volatile("" : "+s"(kk));
      LAS int* rml = (LAS int*)(F.lds + AUX_OFF + 2048); const int* rowmap = (const int*)(ws + WS_SLOT);
      for (int i = 0; i * F.G + S.c < S.total && i < 12; ++i) { if (F.tid < 256) rml[i * 256 + F.tid] = rowmap[256 * ((i * F.G + S.c) >> 2) + F.tid]; }
      __syncthreads();
      pg8::Gemm g{(const bf16_t*)(ws + WS_HM), (const bf16_t*)(ws + WS_WD), 0, 0, kk}; pg8::EpiStoreF8 E{ws + WS_YH, rml, F.G, S.c};
      pg8::gemm_phase<pg8::EpiStoreF8, pg8::SchedYr, true, true>(F.lds + RING_OFF, g, S, E); }
    { pg8::StaticOrder S; S.init(M, D, F.G, (int)blockIdx.x);
      int kk = SHD; asm volatile("" : "+s"(kk));
      pg8::Gemm g{(const bf16_t*)(ws + WS_SH), (const bf16_t*)(ws + WS_WSHD), M, D, kk}; pg8::EpiStore E{(bf16_t*)(ws + WS_YSH), D, 3};
      pg8::gemm_phase<pg8::EpiStore, pg8::StaticOrder, true, true>(F.lds + RING_OFF, g, S, E); }
}
__device__ __forceinline__ void p8_combine(Frame& F, const Args& a) {
    unsigned char* ws = a.ws; const unsigned char* Y8 = ws + WS_YH; const bf16_t* YSH = (const bf16_t*)(ws + WS_YSH);
    const float* mod = (const float*)(ws + WS_MOD); float* OUT = a.out; const int lane = F.lane;
    for (int tb = (F.vcu * NWAVES + F.wave) * 8; tb < M; tb += F.G * NWAVES * 8) {
        const int b = tb / SEQ; const float* gate = mod + (size_t)b * 6 * D + 5 * D + lane * 16;
        f32x4 gv[4];
#pragma unroll
        for (int i = 0; i < 4; ++i) gv[i] = *(const f32x4*)(gate + 4 * i);
#pragma nounroll
        for (int i = 0; i < 8; i += 2) {
            v4u y[2][8], ys[2][2]; f32x4 x[2][4];
#pragma unroll
            for (int q = 0; q < 2; ++q) { const int t = tb + i + q;
#pragma unroll
                for (int k = 0; k < 8; ++k) y[q][k] = *(const GAS v4u*)(Y8 + ((size_t)t * 8 + k) * 1024 + lane * 16);
                const GAS v4u* sp = (const GAS v4u*)(YSH + (size_t)t * D + lane * 16); ys[q][0] = sp[0]; ys[q][1] = sp[1];
                const GAS f32x4* o = (const GAS f32x4*)(OUT + (size_t)t * D + lane * 16);
#pragma unroll
                for (int j = 0; j < 4; ++j) x[q][j] = o[j]; }
#pragma unroll
            for (int q = 0; q < 2; ++q) { const int t = tb + i + q; float acc[16];
#pragma unroll
                for (int j = 0; j < 16; ++j) acc[j] = 0.f;
#pragma unroll
                for (int k = 0; k < 8; ++k) { const unsigned w4[4] = {y[q][k].x, y[q][k].y, y[q][k].z, y[q][k].w};
#pragma unroll
                    for (int j = 0; j < 4; ++j) { const pg8::f32x2_t lo = __builtin_amdgcn_cvt_pk_f32_fp8((int)w4[j], false), hi = __builtin_amdgcn_cvt_pk_f32_fp8((int)w4[j], true);
                        acc[4 * j] += lo.x; acc[4 * j + 1] += lo.y; acc[4 * j + 2] += hi.x; acc[4 * j + 3] += hi.y; } }
                GAS f32x4* o = (GAS f32x4*)(OUT + (size_t)t * D + lane * 16);
#pragma unroll
                for (int j = 0; j < 4; ++j) { const unsigned s0 = (j < 2 ? ys[q][0] : ys[q][1])[2 * (j & 1)], s1 = (j < 2 ? ys[q][0] : ys[q][1])[2 * (j & 1) + 1];
                    const f32x4 sh = {bf2f(s0 & 0xffffu), bf2f(s0 >> 16), bf2f(s1 & 0xffffu), bf2f(s1 >> 16)};
                    const f32x4 rt = {acc[4 * j], acc[4 * j + 1], acc[4 * j + 2], acc[4 * j + 3]};
                    o[j] = x[q][j] + gv[j] * (rt * (1.f / pg8::YSCALE) + sh); } }
        }
    }
}

__global__ void __launch_bounds__(NWAVES * 64, 2) mk_fwd(Args args) {
    extern __shared__ __attribute__((aligned(16))) unsigned char lds[];
    Frame F;
    F.lds = (LAS unsigned char*)lds; F.MISC = (volatile LAS unsigned*)(F.lds + MISC_OFF);
    F.tid = threadIdx.x; F.lane = F.tid & 63; F.wave = __builtin_amdgcn_readfirstlane(F.tid >> 6);
    F.G = gridDim.x; { const int bx = blockIdx.x; F.vcu = (F.G % 8 == 0) ? (bx % 8) * (F.G / 8) + bx / 8 : bx; }
    unsigned char* ws = args.ws; F.ctl = (gu32*)(ws + WS_CTL);
    for (int u = F.tid; u < (LDS_BYTES - LDSCTL_OFF) / 4; u += NWAVES * 64) ((LAS unsigned*)(F.lds + LDSCTL_OFF))[u] = 0u;
    __syncthreads();
    XcdBarrier bar; bar.bar = (unsigned*)(F.ctl + CW_BAR); bar.x = 0; bar.st = nullptr;
    if (args.use_bar) bar = xcd_barrier_post((unsigned*)(F.ctl + CW_BAR), F.MISC + 8);
    const int lo = args.ph_lo, hi = args.ph_hi;
#define IN(k) (lo <= (k) && (k) < hi)
#define SEAM(k) do { if (IN(k) && IN((k) + 1)) xcd_barrier(bar); } while (0)
#define PHASE(p, ...) do { if (IN(p)) { const int reps_ = (DBL_PHASE == (p)) ? 2 : 1; for (int rep_ = 0; rep_ < reps_; ++rep_) { __VA_ARGS__; if (rep_ + 1 < reps_) xcd_barrier(bar); } } SEAM(p); } while (0)
    PHASE(0, p0a(F, args));
    PHASE(1, p0b(F, args));
    PHASE(2, {
        pg8::Gemm g{(const bf16_t*)(ws + WS_XN), (const bf16_t*)(ws + WS_WIN), M, INW, D}; pg8::StaticOrder S; S.init(M, INW, F.G, (int)blockIdx.x);
        pg8::EpiProj E{(bf16_t*)(ws + WS_Q), (bf16_t*)(ws + WS_K), (bf16_t*)(ws + WS_V), (bf16_t*)(ws + WS_U), (bf16_t*)(ws + WS_GA), (bf16_t*)(ws + WS_GB), args.in[6], args.in[7]};
        pg8::gemm_phase<pg8::EpiProj, pg8::StaticOrder, true, true>(F.lds + RING_OFF, g, S, E); });
    PHASE(3, {
        const bf16_t* Q = (const bf16_t*)(ws + WS_Q); const bf16_t* K = (const bf16_t*)(ws + WS_K); const bf16_t* V = (const bf16_t*)(ws + WS_V);
        for (int u = blockIdx.x; u < BATCH * NH * (SEQ / 256); u += F.G) { const int qb = u & 15, bh = u >> 4;
            sb::attn_unit(bh >> 3, bh & 7, qb, Q, K, V, (bf16_t*)(ws + WS_OSB), F.lds + RING_OFF + F.wave * sb::WAVE_LDS, F.wave, F.lane); }
        p2_pool(F, (const bf16_t*)(ws + WS_U), (bf16_t*)(ws + WS_MIX)); });
    PHASE(4, {
        pg8::StaticOrder S; S.init(M, D, F.G, (int)blockIdx.x);
        { pg8::Gemm g{(const bf16_t*)(ws + WS_OSB), (const bf16_t*)(ws + WS_WSB), M, D, SBW}; pg8::EpiMerge E{(const bf16_t*)(ws + WS_GA), (bf16_t*)(ws + WS_MERGED), 0};
          pg8::gemm_phase<pg8::EpiMerge, pg8::StaticOrder, true, true>(F.lds + RING_OFF, g, S, E); }
        { pg8::Gemm g{(const bf16_t*)(ws + WS_MIX), (const bf16_t*)(ws + WS_WEFF), M, D, PW}; pg8::EpiMerge E{(const bf16_t*)(ws + WS_GB), (bf16_t*)(ws + WS_MERGED), 1};
          pg8::gemm_phase<pg8::EpiMerge, pg8::StaticOrder, true, true>(F.lds + RING_OFF, g, S, E); } });
    PHASE(5, {
        pg8::Gemm g{(const bf16_t*)(ws + WS_MERGED), (const bf16_t*)(ws + WS_WOUT), M, D, D}; pg8::StaticOrder S; S.init(M, D, F.G, (int)blockIdx.x);
        pg8::EpiX1 E{args.in[0], (const float*)(ws + WS_MOD) + 2 * D, args.out};
        pg8::gemm_phase<pg8::EpiX1, pg8::StaticOrder, true, true>(F.lds + RING_OFF, g, S, E); });
    PHASE(6, {
        if (rep_ > 0) { if (blockIdx.x == 0 && F.tid < 64) __hip_atomic_store(F.ctl + CW_CNT + 64 * F.tid, 0u, RLX_AGENT); xcd_barrier(bar); }
        p5_route(F, args); });
    PHASE(7, p6_gateup(F, args));
    PHASE(8, p7_down(F, args));
    if (IN(9)) { p8_combine(F, args); }
#undef PHASE
#undef IN
#undef SEAM
}
constexpr int N_PHASES = 10;
extern "C" void kernel_launch(void* const* d_in, const int* in_sizes, int n_in, void* d_out, int out_size, void* d_ws, size_t ws_size, hipStream_t stream) {
    static int grid = 0;
    if (grid == 0) {
        if (n_in != 22 || out_size != M * D || ws_size < WS_END) { fprintf(stderr, "kernel_launch: unexpected shapes n_in %d out %d ws %zu\n", n_in, out_size, ws_size); grid = -1; return; }
        int dev = 0, cus = 0, per_cu = 0;
        if (hipGetDevice(&dev) != hipSuccess || hipDeviceGetAttribute(&cus, hipDeviceAttributeMultiprocessorCount, dev) != hipSuccess) { grid = -1; return; }
        if (hipFuncSetAttribute((const void*)mk_fwd, hipFuncAttributeMaxDynamicSharedMemorySize, LDS_BYTES) != hipSuccess) { fprintf(stderr, "kernel_launch: hipFuncSetAttribute failed\n"); grid = -1; return; }
        if (hipOccupancyMaxActiveBlocksPerMultiprocessor(&per_cu, (const void*)mk_fwd, NWAVES * 64, LDS_BYTES) != hipSuccess || per_cu < 1) fprintf(stderr, "kernel_launch: occupancy query says %d per CU\n", per_cu);
        (void)hipGetLastError();
        grid = cus;
    }
    if (grid < 0) return;
    unsigned char* ws = (unsigned char*)d_ws;
    if (hipMemsetAsync(ws + WS_CTL, 0, CTL_ZERO_BYTES, stream) != hipSuccess) { fprintf(stderr, "kernel_launch: memset failed\n"); return; }
    Args a{};
    for (int i = 0; i < 22; ++i) a.in[i] = (const float*)d_in[i];
    a.out = (float*)d_out; a.ws = ws; a.ph_lo = 0; a.ph_hi = N_PHASES; a.use_bar = 1;
    hipLaunchKernelGGL(mk_fwd, dim3(grid), dim3(NWAVES * 64), LDS_BYTES, stream, a);
}
```

```cpp
#include <hip/hip_runtime.h>
#include <cstdint>
#include <cstdio>

typedef unsigned short bf16_t;
constexpr int D = 1024, BATCH = 4, SEQ = 4096, M = BATCH * SEQ, NH = 8, HD = 64, SBW = 512, PW = 512, INW = 4096;
constexpr int NE = 64, ED = 128, TOPK = 8, SHD = 256;
constexpr float EPS = 1e-6f, RSCALE = 2.5f;

constexpr size_t MiB = 1u << 20;
constexpr size_t WS_CTL = 0, WS_MOD = 1 * MiB, WS_PE = 2 * MiB, WS_PW = 3 * MiB, WS_LIST = 4 * MiB;
constexpr size_t WS_XN = 74 * MiB, WS_OSB = 74 * MiB, WS_MIX = 90 * MiB, WS_H2 = 74 * MiB;
constexpr size_t WS_Q = 106 * MiB, WS_K = 122 * MiB, WS_V = 138 * MiB, WS_MERGED = 106 * MiB;
constexpr size_t WS_SLOT = 190 * MiB, WS_SH = 192 * MiB, WS_HM = 200 * MiB;
constexpr size_t WS_YH = 12 * MiB, WS_YSH = 156 * MiB;
constexpr size_t WS_U = 154 * MiB, WS_GA = 170 * MiB, WS_GB = 202 * MiB, WS_END = 256 * MiB;

__device__ __forceinline__ unsigned f2bf(float f) { unsigned u = __builtin_bit_cast(unsigned, f); return (u + 0x7fffu + ((u >> 16) & 1u)) >> 16; }
__device__ __forceinline__ float bf2f(unsigned h) { return __builtin_bit_cast(float, h << 16); }
__device__ __forceinline__ float wave_sum(float v) {
#pragma unroll
    for (int o = 1; o < 64; o <<= 1) v += __shfl_xor(v, o);
    return v;
}
__device__ __forceinline__ float sigmoidf_(float v) { return 1.f / (1.f + __expf(-v)); }
__device__ __forceinline__ float siluf_(float v) { return v / (1.f + __expf(-v)); }

namespace pg8 {
#define PG8_LAS __attribute__((address_space(3)))
typedef short bf16x8 __attribute__((ext_vector_type(8)));
typedef float f32x4 __attribute__((ext_vector_type(4)));
typedef unsigned u32x4 __attribute__((ext_vector_type(4)));
constexpr int BM = 256, BK = 64, HALF = 128, HTB = HALF * BK * 2  , STAGE_BYTES = 8 * HTB, NXCD = 8, WGM = 8;

__host__ __device__ __forceinline__ int lds_byte(int r, int c) { const int st = (r >> 4) * 2 + (c >> 5), rr = r & 15, cc = c & 31, ob = rr * 64 + cc * 2; return st * 1024 + (ob ^ (((ob >> 9) & 1) << 5)); }
__host__ __device__ __forceinline__ void stage_rc(int b, int& R, int& C) { const int st = b / 1024, sb = b % 1024, swz = sb ^ (((sb >> 9) & 1) << 5); R = (st >> 1) * 16 + swz / 64; C = (st & 1) * 32 + (swz % 64) / 2; }
__host__ __device__ __forceinline__ int perm32(int rho) { const int n = rho >> 4, i = rho & 15; return 8 * (i >> 2) + 4 * n + (i & 3); }

struct Unit { int pm, pn; };
struct Gemm { const bf16_t* A; const bf16_t* Bt; int M, N, K; };

struct StaticOrder {
    int nM, nN, nwg, G, c;
    __host__ __device__ void init(int M_, int N_, int G_, int c_) { nM = M_ / BM; nN = N_ / BM; nwg = nM * nN; G = G_; c = c_; }
    __host__ __device__ bool next(int i, Unit& u) const {
        const long L = (long)i * G + c; if (L >= nwg) return false;
        int wgid = (int)L; { const int q = nwg / NXCD, r = nwg % NXCD, xcd = wgid % NXCD, off = wgid / NXCD; wgid = (xcd < r ? xcd * (q + 1) : r * (q + 1) + (xcd - r) * q) + off; }
        const int nig = WGM * nN, gid = wgid / nig, fm = gid * WGM, gsz = (nM - fm) < WGM ? (nM - fm) : WGM;
        u.pm = fm + ((wgid % nig) % gsz); u.pn = (wgid % nig) / gsz; return true;
    }
    __device__ __forceinline__ void a_ready(const Unit&) const {}
    __device__ __forceinline__ void done(const Unit&) const {}
};
typedef float f32x2_t __attribute__((ext_vector_type(2))); typedef __bf16 bf16x2_t __attribute__((ext_vector_type(2)));
__device__ __forceinline__ unsigned cvt_pk_bf16(float lo, float hi) { f32x2_t v = {lo, hi}; bf16x2_t b = __builtin_convertvector(v, bf16x2_t); return __builtin_bit_cast(unsigned, b); }
__device__ __forceinline__ float fsigmoid(float v) { return __builtin_amdgcn_rcpf(1.f + __builtin_amdgcn_exp2f(-1.4426950408889634f * v)); }
constexpr float QSCALE = 0.125f * 1.4426950408889634f;

struct EpiProj {
    static constexpr bool PERM = true, AFTER_DRAIN = false;
    bf16_t *Q, *K, *V, *U, *GA, *GB; const float* gq; const float* gk;
    __device__ __forceinline__ void operator()(const f32x4 (&acc)[2][2][4][2], const Unit& u, int wr, int wc, int fr, int fq) const {
        const int row0 = u.pm * BM + wr * 64 + fr; const int sec = u.pn;
        if (sec < 4) {
            const bool isq = sec < 2; const float* g = isq ? gq : gk; bf16_t* base = (isq ? Q : K) + ((sec & 1) * 4 + wc) * 64 + 8 * fq;
            const float qs = isq ? QSCALE : 1.f;
            f32x4 gv[2][2];
#pragma unroll
            for (int bj = 0; bj < 2; ++bj)
#pragma unroll
                for (int n = 0; n < 2; ++n) gv[bj][n] = *(const f32x4*)(g + 32 * bj + 8 * fq + 4 * n);
#pragma unroll
            for (int ai = 0; ai < 2; ++ai)
#pragma unroll
                for (int m = 0; m < 4; ++m) {
                    float ss = 0.f;
#pragma unroll
                    for (int bj = 0; bj < 2; ++bj)
#pragma unroll
                        for (int n = 0; n < 2; ++n) { const f32x4 x = acc[ai][bj][m][n]; ss += (x[0] * x[0] + x[1] * x[1]) + (x[2] * x[2] + x[3] * x[3]); }
                    ss += __shfl_xor(ss, 16); ss += __shfl_xor(ss, 32);
                    const float r = rsqrtf(ss * (1.f / 64.f) + EPS) * qs;
                    bf16_t* rowp = base + (size_t)(row0 + ai * HALF + m * 16) * 512;
#pragma unroll
                    for (int bj = 0; bj < 2; ++bj) { const f32x4 v0 = acc[ai][bj][m][0] * gv[bj][0] * r, v1 = acc[ai][bj][m][1] * gv[bj][1] * r;
                        u32x4 w; w.x = cvt_pk_bf16(v0[0], v0[1]); w.y = cvt_pk_bf16(v0[2], v0[3]); w.z = cvt_pk_bf16(v1[0], v1[1]); w.w = cvt_pk_bf16(v1[2], v1[3]);
                        *(u32x4*)(rowp + 32 * bj) = w; }
                }
        } else if (sec < 8) {
            bf16_t* base = (sec < 6 ? V : U) + (sec & 1) * 256 + wc * 32 + 8 * fq;
#pragma unroll
            for (int ai = 0; ai < 2; ++ai)
#pragma unroll
                for (int m = 0; m < 4; ++m) { bf16_t* rowp = base + (size_t)(row0 + ai * HALF + m * 16) * 512;
#pragma unroll
                    for (int bj = 0; bj < 2; ++bj) { const f32x4 v0 = acc[ai][bj][m][0], v1 = acc[ai][bj][m][1];
                        u32x4 w; w.x = cvt_pk_bf16(v0[0], v0[1]); w.y = cvt_pk_bf16(v0[2], v0[3]); w.z = cvt_pk_bf16(v1[0], v1[1]); w.w = cvt_pk_bf16(v1[2], v1[3]);
                        *(u32x4*)(rowp + bj * HALF) = w; } }
        } else {
            bf16_t* base = (sec < 12 ? GA : GB) + ((sec - 8) & 3) * 256 + wc * 32 + 8 * fq;
#pragma unroll
            for (int ai = 0; ai < 2; ++ai)
#pragma unroll
                for (int m = 0; m < 4; ++m) { bf16_t* rowp = base + (size_t)(row0 + ai * HALF + m * 16) * 1024;
#pragma unroll
                    for (int bj = 0; bj < 2; ++bj) { const f32x4 v0 = acc[ai][bj][m][0], v1 = acc[ai][bj][m][1];
                        u32x4 w; w.x = cvt_pk_bf16(fsigmoid(v0[0]), fsigmoid(v0[1])); w.y = cvt_pk_bf16(fsigmoid(v0[2]), fsigmoid(v0[3])); w.z = cvt_pk_bf16(fsigmoid(v1[0]), fsigmoid(v1[1])); w.w = cvt_pk_bf16(fsigmoid(v1[2]), fsigmoid(v1[3]));
                        *(u32x4*)(rowp + bj * HALF) = w; } }
        }
    }
};

struct EpiMerge {
    static constexpr bool PERM = true, AFTER_DRAIN = false;
    const bf16_t* G; bf16_t* MG; int add;
    __device__ __forceinline__ void operator()(const f32x4 (&acc)[2][2][4][2], const Unit& u, int wr, int wc, int fr, int fq) const {
        const int row0 = u.pm * BM + wr * 64 + fr, col0 = u.pn * BM + wc * 32 + 8 * fq;
#pragma unroll
        for (int ai = 0; ai < 2; ++ai)
#pragma unroll
            for (int m = 0; m < 4; ++m) { const size_t off = (size_t)(row0 + ai * HALF + m * 16) * 1024 + col0;
#pragma unroll
                for (int bj = 0; bj < 2; ++bj) { const u32x4 g = *(const u32x4*)(G + off + bj * HALF); const f32x4 a0 = acc[ai][bj][m][0], a1 = acc[ai][bj][m][1];
                    float v[8] = {bf2f(g.x & 0xffffu) * a0[0], bf2f(g.x >> 16) * a0[1], bf2f(g.y & 0xffffu) * a0[2], bf2f(g.y >> 16) * a0[3], bf2f(g.z & 0xffffu) * a1[0], bf2f(g.z >> 16) * a1[1], bf2f(g.w & 0xffffu) * a1[2], bf2f(g.w >> 16) * a1[3]};
                    if (add) { const u32x4 o = *(const u32x4*)(MG + off + bj * HALF);
                        v[0] += bf2f(o.x & 0xffffu); v[1] += bf2f(o.x >> 16); v[2] += bf2f(o.y & 0xffffu); v[3] += bf2f(o.y >> 16); v[4] += bf2f(o.z & 0xffffu); v[5] += bf2f(o.z >> 16); v[6] += bf2f(o.w & 0xffffu); v[7] += bf2f(o.w >> 16); }
                    u32x4 w; w.x = cvt_pk_bf16(v[0], v[1]); w.y = cvt_pk_bf16(v[2], v[3]); w.z = cvt_pk_bf16(v[4], v[5]); w.w = cvt_pk_bf16(v[6], v[7]);
                    *(u32x4*)(MG + off + bj * HALF) = w; } }
    }
};
struct EpiX1 {
    static constexpr bool PERM = false, AFTER_DRAIN = false;
    const float* x; const float* gate; float* X1;
    __device__ __forceinline__ void operator()(const f32x4 (&acc)[2][2][4][2], const Unit& u, int wr, int wc, int fr, int fq) const {
        const int row0 = u.pm * BM + wr * 64 + fr, col0 = u.pn * BM + wc * 32 + 4 * fq; const int b = (u.pm * BM) / SEQ;
        f32x4 gv[2][2];
#pragma unroll
        for (int bj = 0; bj < 2; ++bj)
#pragma unroll
            for (int n = 0; n < 2; ++n) gv[bj][n] = *(const f32x4*)(gate + (size_t)b * 6 * D + col0 + bj * HALF + n * 16);
#pragma unroll
        for (int ai = 0; ai < 2; ++ai)
#pragma unroll
            for (int m = 0; m < 4; ++m) { const size_t off = (size_t)(row0 + ai * HALF + m * 16) * D + col0;
#pragma unroll
                for (int bj = 0; bj < 2; ++bj)
#pragma unroll
                    for (int n = 0; n < 2; ++n) *(f32x4*)(X1 + off + bj * HALF + n * 16) = *(const f32x4*)(x + off + bj * HALF + n * 16) + gv[bj][n] * acc[ai][bj][m][n]; }
    }
};

template <class Epi, class Sched, bool ALIGN_EPI = false, bool SP2 = false>
__device__ __forceinline__ void gemm_phase(PG8_LAS unsigned char* lds, const Gemm g, const Sched& S, const Epi& E) {
    int tid_ = threadIdx.x; asm volatile("" : "+v"(tid_));
    const int tid = tid_, wid = __builtin_amdgcn_readfirstlane(tid >> 6), lane = tid & 63, wr = wid >> 2, wc = wid & 3, fr = lane & 15, fq = lane >> 4;
    const int K = g.K, nt = K / BK;
    unsigned voffA[2], voffB[2];
#pragma unroll
    for (int i = 0; i < 2; ++i) { int R, C; stage_rc(tid * 16 + i * 8192, R, C); const int Rb = Epi::PERM ? ((R & ~31) + perm32(R & 31)) : R;
        voffA[i] = (unsigned)(R * K + C) * 2u; voffB[i] = (unsigned)(Rb * K + C) * 2u; }
    const size_t kstep = (size_t)(BK * 2);
    const size_t hstep = (size_t)HALF * K * 2;
    const size_t tstep = 2 * hstep;
    const unsigned ldsw = (unsigned)wid * 1024u;
    const int aoff = lds_byte(wr * 64 + fr, fq * 8), boff = lds_byte(wc * 32 + fr, fq * 8);
#define PG8_SA(b, h) (((b) * 2 + (h)) * HTB)
#define PG8_SB(b, h) ((4 + (b) * 2 + (h)) * HTB)
#define PG8_STAGE(bufoff, gbase, voff) do { _Pragma("unroll") for (int _i = 0; _i < 2; ++_i) \
        __builtin_amdgcn_global_load_lds((const unsigned*)((const char*)(gbase) + (voff)[_i]), (PG8_LAS unsigned*)(lds + (bufoff) + ldsw + _i * 8192), 16, 0, 0); } while (0)
#define PG8_LDA(dst, b, h) do { _Pragma("unroll") for (int m = 0; m < 4; ++m) _Pragma("unroll") for (int k = 0; k < 2; ++k) dst[m][k] = *(const PG8_LAS bf16x8*)(lds + PG8_SA(b, h) + aoff + m * 2048 + k * 1024); } while (0)
#define PG8_LDB(dst, b, h) do { _Pragma("unroll") for (int n = 0; n < 2; ++n) _Pragma("unroll") for (int k = 0; k < 2; ++k) dst[n][k] = *(const PG8_LAS bf16x8*)(lds + PG8_SB(b, h) + boff + n * 2048 + k * 1024); } while (0)
#define PG8_MMA(ai, bj, At, Bt) do { __builtin_amdgcn_s_setprio(1); _Pragma("unroll") for (int m = 0; m < 4; ++m) _Pragma("unroll") for (int n = 0; n < 2; ++n) _Pragma("unroll") for (int k = 0; k < 2; ++k) \
        acc[ai][bj][m][n] = __builtin_amdgcn_mfma_f32_16x16x32_bf16(Bt[n][k], At[m][k], acc[ai][bj][m][n], 0, 0, 0); __builtin_amdgcn_s_setprio(0); } while (0)
#define PG8_WAIT_V(n) asm volatile("s_waitcnt vmcnt(" #n ")" ::: "memory")
#define PG8_WAIT_L(n) asm volatile("s_waitcnt lgkmcnt(" #n ")" ::: "memory")
#define PG8_BAR __builtin_amdgcn_s_barrier()
#define PG8_SCHED __builtin_amdgcn_sched_barrier(0)
    Unit cur, nxt; int ui = 0;
    if (!S.next(0, cur)) return;
    f32x4 acc[2][2][4][2];
#pragma unroll
    for (int a = 0; a < 2; ++a)
#pragma unroll
        for (int b = 0; b < 2; ++b)
#pragma unroll
            for (int m = 0; m < 4; ++m)
#pragma unroll
                for (int n = 0; n < 2; ++n) acc[a][b][m][n] = (f32x4){0.f, 0.f, 0.f, 0.f};
    bf16x8 At[4][2], B0[2][2], B1[2][2];
    const char* cA = (const char*)g.A + (size_t)cur.pm * tstep; const char* cB = (const char*)g.Bt + (size_t)cur.pn * tstep;
    S.a_ready(cur);
    if constexpr (SP2) {
        PG8_STAGE(PG8_SB(0, 0), cB, voffB); PG8_STAGE(PG8_SB(0, 1), cB + hstep, voffB); PG8_STAGE(PG8_SA(0, 0), cA, voffA); PG8_STAGE(PG8_SA(0, 1), cA + hstep, voffA);
        if (wr == 1) PG8_BAR;
        PG8_WAIT_V(2); PG8_BAR;
        PG8_STAGE(PG8_SB(1, 0), cB + kstep, voffB); PG8_STAGE(PG8_SA(1, 0), cA + kstep, voffA); PG8_STAGE(PG8_SB(1, 1), cB + hstep + kstep, voffB);
        PG8_WAIT_V(6); PG8_BAR;
    } else {
        PG8_STAGE(PG8_SB(0, 0), cB, voffB); PG8_STAGE(PG8_SA(0, 0), cA, voffA); PG8_STAGE(PG8_SB(0, 1), cB + hstep, voffB); PG8_STAGE(PG8_SA(0, 1), cA + hstep, voffA);
        if (wr == 1) PG8_BAR;
        PG8_WAIT_V(4); PG8_BAR;
        PG8_STAGE(PG8_SB(1, 0), cB + kstep, voffB); PG8_STAGE(PG8_SA(1, 0), cA + kstep, voffA); PG8_STAGE(PG8_SB(1, 1), cB + hstep + kstep, voffB);
        PG8_WAIT_V(6); PG8_BAR;
    }
    for (;;) {
        const bool has_next = S.next(ui + 1, nxt);
        const char* nA = has_next ? (const char*)g.A + (size_t)nxt.pm * tstep : cA; const char* nB = has_next ? (const char*)g.Bt + (size_t)nxt.pn * tstep : cB;
#pragma nounroll
        for (int t = 0; t < nt; t += 2) {
            const bool last = (t == nt - 2);
            const char* a1 = cA + (size_t)(t + 1) * kstep;
            const char* a2 = last ? nA : cA + (size_t)(t + 2) * kstep; const char* b2 = last ? nB : cB + (size_t)(t + 2) * kstep;
            const char* a3 = a2 + kstep; const char* b3 = b2 + kstep;
            if (last && has_next) S.a_ready(nxt);
            if constexpr (SP2) {
            PG8_LDB(B0, 0, 0); PG8_LDB(B1, 0, 1); PG8_SCHED; PG8_LDA(At, 0, 0); PG8_STAGE(PG8_SA(1, 1), a1 + hstep, voffA);
            PG8_WAIT_V(8); PG8_WAIT_L(0); PG8_BAR; PG8_MMA(0, 0, At, B0); PG8_MMA(0, 1, At, B1); PG8_BAR; PG8_SCHED;
            PG8_LDA(At, 0, 1); PG8_STAGE(PG8_SB(0, 0), b2, voffB); PG8_STAGE(PG8_SB(0, 1), b2 + hstep, voffB); PG8_STAGE(PG8_SA(0, 0), a2, voffA);
            PG8_WAIT_V(8); PG8_WAIT_L(0); PG8_BAR; PG8_MMA(1, 0, At, B0); PG8_MMA(1, 1, At, B1); PG8_BAR; PG8_SCHED;
            PG8_LDB(B0, 1, 0); PG8_LDB(B1, 1, 1); PG8_SCHED; PG8_LDA(At, 1, 0); PG8_STAGE(PG8_SA(0, 1), a2 + hstep, voffA);
            PG8_WAIT_V(8); PG8_WAIT_L(0); PG8_BAR; PG8_MMA(0, 0, At, B0); PG8_MMA(0, 1, At, B1); PG8_BAR; PG8_SCHED;
            PG8_LDA(At, 1, 1); PG8_STAGE(PG8_SB(1, 0), b3, voffB); PG8_STAGE(PG8_SB(1, 1), b3 + hstep, voffB); PG8_STAGE(PG8_SA(1, 0), a3, voffA);
            PG8_WAIT_V(8); PG8_WAIT_L(0); PG8_BAR; PG8_MMA(1, 0, At, B0); PG8_MMA(1, 1, At, B1); PG8_BAR; PG8_SCHED;
            } else {
            PG8_LDB(B0, 0, 0); PG8_SCHED; PG8_LDA(At, 0, 0); PG8_STAGE(PG8_SA(1, 1), a1 + hstep, voffA);
            PG8_WAIT_L(8); PG8_BAR; PG8_WAIT_L(0); PG8_MMA(0, 0, At, B0); PG8_BAR; PG8_SCHED;
            PG8_LDB(B1, 0, 1); PG8_STAGE(PG8_SB(0, 0), b2, voffB);
            PG8_BAR; PG8_WAIT_L(0); PG8_MMA(0, 1, At, B1); PG8_BAR;
            PG8_LDA(At, 0, 1); PG8_STAGE(PG8_SA(0, 0), a2, voffA);
            PG8_BAR; PG8_WAIT_L(0); PG8_MMA(1, 0, At, B0); PG8_BAR; PG8_SCHED;
            PG8_STAGE(PG8_SB(0, 1), b2 + hstep, voffB);
            PG8_WAIT_V(6); PG8_BAR; PG8_MMA(1, 1, At, B1); PG8_BAR;
            PG8_LDB(B0, 1, 0); PG8_SCHED; PG8_LDA(At, 1, 0); PG8_STAGE(PG8_SA(0, 1), a2 + hstep, voffA);
            PG8_WAIT_L(8); PG8_BAR; PG8_WAIT_L(0); PG8_MMA(0, 0, At, B0); PG8_BAR; PG8_SCHED;
            PG8_LDB(B1, 1, 1); PG8_STAGE(PG8_SB(1, 0), b3, voffB);
            PG8_BAR; PG8_WAIT_L(0); PG8_MMA(0, 1, At, B1); PG8_BAR;
            PG8_LDA(At, 1, 1); PG8_STAGE(PG8_SA(1, 0), a3, voffA);
            PG8_BAR; PG8_WAIT_L(0); PG8_MMA(1, 0, At, B0); PG8_BAR; PG8_SCHED;
            PG8_STAGE(PG8_SB(1, 1), b3 + hstep, voffB);
            PG8_WAIT_V(6); PG8_BAR; PG8_MMA(1, 1, At, B1); PG8_BAR;
            }
        }
        if constexpr (ALIGN_EPI) { if (wr == 0) PG8_BAR; }
        if constexpr (!Epi::AFTER_DRAIN) { E(acc, cur, wr, wc, fr, fq); S.done(cur); }
        if (!has_next) break;
#pragma unroll
        for (int a = 0; a < 2; ++a)
#pragma unroll
            for (int b = 0; b < 2; ++b)
#pragma unroll
                for (int m = 0; m < 4; ++m)
#pragma unroll
                    for (int n = 0; n < 2; ++n) acc[a][b][m][n] = (f32x4){0.f, 0.f, 0.f, 0.f};
        cur = nxt; cA = nA; cB = nB; ++ui;
        if constexpr (ALIGN_EPI) { if (wr == 1) PG8_BAR; }
    }
    PG8_WAIT_V(0);
    if constexpr (!ALIGN_EPI) { if (wr == 0) PG8_BAR; }
    PG8_BAR;
    if constexpr (Epi::AFTER_DRAIN) { E.fused(acc, cur, wr, wc, fr, fq, lds, wid, lane); S.done(cur); }
#undef PG8_SA
#undef PG8_SB
#undef PG8_STAGE
#undef PG8_LDA
#undef PG8_LDB
#undef PG8_MMA
#undef PG8_WAIT_V
#undef PG8_WAIT_L
#undef PG8_BAR
#undef PG8_SCHED
}
}
using pg8::f32x4; using pg8::bf16x8;
#define GAS __attribute__((address_space(1)))
#define LAS __attribute__((address_space(3)))
typedef unsigned v4u __attribute__((ext_vector_type(4)));
typedef GAS unsigned gu32;
typedef GAS unsigned long long gu64;
#define RLX_AGENT __ATOMIC_RELAXED, __HIP_MEMORY_SCOPE_AGENT
#define LDS_WAIT() asm volatile("s_waitcnt lgkmcnt(0)" ::: "memory")
#define VM_WAIT() asm volatile("s_waitcnt vmcnt(0)" ::: "memory")
__device__ __forceinline__ unsigned long long rt() { return __builtin_amdgcn_s_memrealtime(); }
__device__ __forceinline__ unsigned pk2(float lo, float hi) { return f2bf(lo) | (f2bf(hi) << 16); }

#define XB_TMO      128
#define XB_XCNT(j)  (256  + 64 * (j))
#define XB_XSUB(j)  (1280 + 64 * (j))
#define XB_XGEN(j)  (2304 + 64 * (j))
#define XB_TOP      3328
#define XB_TOPGEN   3392
#define XCD_BAR_WORDS 3456
#define XB_SPIN_CAP (1u << 18)

__device__ __forceinline__ unsigned xb_ld(unsigned* p)              { return __hip_atomic_load(p, __ATOMIC_RELAXED, __HIP_MEMORY_SCOPE_AGENT); }
__device__ __forceinline__ unsigned xb_add(unsigned* p, unsigned v) { return __hip_atomic_fetch_add(p, v, __ATOMIC_RELAXED, __HIP_MEMORY_SCOPE_AGENT); }
__device__ __forceinline__ unsigned xb_xcc_id() { return (unsigned)__builtin_amdgcn_s_getreg((3 << 11) | 20) & 0xFu; }
#define XB_SPIN(cond, bar) do { unsigned _sp = 0; while (cond) { __builtin_amdgcn_s_sleep(1); \
    if ((++_sp & 255u) == 0u) { if (xb_ld(&(bar)[XB_TMO])) break; if (_sp > XB_SPIN_CAP) { atomicAdd(&(bar)[XB_TMO], 1u); break; } } } } while (0)

struct XcdBarrier {
    unsigned* bar; unsigned x;
    volatile LAS unsigned* st;
};

__device__ __forceinline__ XcdBarrier xcd_barrier_post(unsigned* bar, volatile LAS unsigned* st) {
    XcdBarrier b; b.bar = bar; b.x = xb_xcc_id(); b.st = st;
    if (threadIdx.x == 0) (void)xb_add(&bar[XB_XCNT(b.x)], 1u);
    return b;
}
__device__ __forceinline__ void xcd_barrier_complete(unsigned* bar, unsigned x, unsigned& nloc, unsigned& nx) {
    const unsigned G = gridDim.x * gridDim.y * gridDim.z;
    unsigned sum, cnt, mine, sp = 0u;
    for (;;) {
        sum = 0u; cnt = 0u; mine = 0u;
#pragma unroll
        for (unsigned j = 0; j < 16; ++j) { const unsigned c = xb_ld(&bar[XB_XCNT(j)]); sum += c; cnt += (c > 0u) ? 1u : 0u; mine = (j == x) ? c : mine; }
        if (sum == G) break;
        __builtin_amdgcn_s_sleep(1);
        if ((++sp & 255u) == 0u) { if (xb_ld(&bar[XB_TMO])) break; if (sp > XB_SPIN_CAP) { atomicAdd(&bar[XB_TMO], 1u); break; } }
    }
    nloc = mine > 0u ? mine : 1u; nx = cnt > 0u ? cnt : 1u;
}

__device__ __forceinline__ void xcd_barrier(const XcdBarrier& b) {
    asm volatile("s_waitcnt vmcnt(0)" ::: "memory");
    __syncthreads();
    if (threadIdx.x == 0) {
        unsigned* bar = b.bar;
        __builtin_amdgcn_s_waitcnt(0);
        unsigned nloc = b.st[0], nx = b.st[1];
        if (nloc == 0u) { xcd_barrier_complete(bar, b.x, nloc, nx); b.st[0] = nloc; b.st[1] = nx; }
        const unsigned old = xb_add(&bar[XB_XSUB(b.x)], 1u);
        const unsigned gen = old / nloc;
        if (old + 1u == (gen + 1u) * nloc) {
            __builtin_amdgcn_fence(__ATOMIC_RELEASE, "agent");
            asm volatile("s_waitcnt vmcnt(0)" ::: "memory");
            const unsigned og = xb_add(&bar[XB_TOP], 1u);
            const unsigned tg = og / nx;
            if (og + 1u == (tg + 1u) * nx) xb_add(&bar[XB_TOPGEN], 1u);
            else XB_SPIN(xb_ld(&bar[XB_TOPGEN]) == tg, bar);
            __builtin_amdgcn_fence(__ATOMIC_ACQUIRE, "agent");
            xb_add(&bar[XB_XGEN(b.x)], 1u);
            asm volatile("s_waitcnt vmcnt(0)" ::: "memory");
        } else {
            XB_SPIN(xb_ld(&bar[XB_XGEN(b.x)]) == gen, bar);
            __builtin_amdgcn_fence(__ATOMIC_ACQUIRE, "agent");
            asm volatile("s_waitcnt vmcnt(0)" ::: "memory");
        }
    }
    __syncthreads();
}

constexpr int NWAVES = 8;
#ifndef DBL_PHASE
#define DBL_PHASE -1
#endif
constexpr size_t WS_MODP = 1 * MiB + 128 * 1024;
constexpr size_t WS_WIN = 12 * MiB, WS_WSB = 20 * MiB, WS_WEFF = 21 * MiB, WS_WOUT = 22 * MiB, WS_WGU = 24 * MiB;
constexpr size_t WS_WSHGU = 237 * MiB, WS_WD = 238 * MiB, WS_WSHD = 254 * MiB, WS_WRH = 254 * MiB + 512 * 1024, WS_WRL = WS_WRH + 128 * 1024;
constexpr size_t CTL_ZERO_BYTES = 256 * 1024;
constexpr int CW_TMO = 0, CW_CODE = 1, CW_BAR = 4096, CW_CNT = 16384;
constexpr int RING_OFF = 0, RING_BYTES = 131072, AUX_OFF = RING_BYTES, LDS_BYTES = 163840, LDSCTL_OFF = LDS_BYTES - 1024, MISC_OFF = LDSCTL_OFF + 320;

struct Frame {
    LAS unsigned char* lds; volatile LAS unsigned* MISC; gu32* ctl;
    int tid, lane, wave, vcu, G;
};
struct Args { const float* in[22]; float* out; unsigned char* ws; int ph_lo, ph_hi, use_bar, pad; };

struct TItem { const float* W; bf16_t* dst; int ldw, ldk, k0, n0; };
__device__ __forceinline__ void titem_load(const TItem& t, f32x4 (&v)[8], int lane) {
    const int kr = lane >> 3, n4 = (lane & 7) * 4;
#pragma unroll
    for (int i = 0; i < 8; ++i) v[i] = *(const GAS f32x4*)(t.W + (size_t)(t.k0 + kr + 8 * i) * t.ldw + t.n0 + n4);
}
__device__ __forceinline__ void titem_store(const TItem& t, const f32x4 (&v)[8], LAS float* scr, int lane) {
    { const int kr = lane >> 3, n4 = (lane & 7) * 4;
#pragma unroll
      for (int i = 0; i < 8; ++i) { LAS float* d = scr + (kr + 8 * i) * 33 + n4; d[0] = v[i].x; d[1] = v[i].y; d[2] = v[i].z; d[3] = v[i].w; } }
    LDS_WAIT(); asm volatile("" ::: "memory");
    const int c = lane & 7;
#pragma unroll
    for (int j = 0; j < 4; ++j) { const int n = (lane >> 3) + 8 * j; const LAS float* sp = scr + (8 * c) * 33 + n;
        v4u o; o.x = pk2(sp[0 * 33], sp[1 * 33]); o.y = pk2(sp[2 * 33], sp[3 * 33]); o.z = pk2(sp[4 * 33], sp[5 * 33]); o.w = pk2(sp[6 * 33], sp[7 * 33]);
        *(GAS v4u*)(t.dst + (size_t)n * t.ldk + t.k0 + 8 * c) = o; }
    LDS_WAIT(); asm volatile("" ::: "memory");
}
__device__ __forceinline__ TItem titem_decode(int it, const Args& a, bool late) {
    unsigned char* ws = a.ws; TItem t;
    constexpr int I_IN = 16 * 128, I_SB = 8 * 32, I_OUT = 16 * 32, I_EG = 64 * 64, I_EU = 64 * 64, I_ED = 64 * 64, I_SG = 16 * 8, I_SU = 16 * 8;
    int r = it;
    if (late) {
        if (r < I_ED) { const int e = r >> 6, q = r & 63, kb = q >> 5, nb = q & 31; t.W = a.in[18] + (size_t)e * ED * D; t.ldw = D; t.k0 = kb * 64; t.n0 = nb * 32; t.dst = (bf16_t*)(ws + WS_WD) + ((size_t)e * D + nb * 32) * ED; t.ldk = ED; return t; } r -= I_ED;
        { const int kb = r >> 5, nb = r & 31; t.W = a.in[21]; t.ldw = D; t.k0 = kb * 64; t.n0 = nb * 32; t.dst = (bf16_t*)(ws + WS_WSHD) + (size_t)(nb * 32) * SHD; t.ldk = SHD; return t; } }
    if (r < I_IN) { const int kb = r >> 7, nb = r & 127, n0 = nb * 32; int d0 = n0;
        if (n0 < 1024) d0 = (n0 & ~255) + 128 * ((n0 >> 5) & 1) + 32 * ((n0 >> 6) & 3);
        t.W = a.in[5]; t.ldw = INW; t.k0 = kb * 64; t.n0 = n0; t.dst = (bf16_t*)(ws + WS_WIN) + (size_t)d0 * D; t.ldk = D; return t; } r -= I_IN;
    if (r < I_SB) { const int kb = r >> 5, nb = r & 31; t.W = a.in[8]; t.ldw = D; t.k0 = kb * 64; t.n0 = nb * 32; t.dst = (bf16_t*)(ws + WS_WSB) + (size_t)(nb * 32) * SBW; t.ldk = SBW; return t; } r -= I_SB;
    if (r < I_OUT) { const int kb = r >> 5, nb = r & 31; t.W = a.in[12]; t.ldw = D; t.k0 = kb * 64; t.n0 = nb * 32; t.dst = (bf16_t*)(ws + WS_WOUT) + (size_t)(nb * 32) * D; t.ldk = D; return t; } r -= I_OUT;
    if (r < I_EG) { const int e = r >> 6, q = r & 63, kb = q >> 2, nb = q & 3; t.W = a.in[16] + (size_t)e * D * ED; t.ldw = ED; t.k0 = kb * 64; t.n0 = nb * 32; t.dst = (bf16_t*)(ws + WS_WGU) + ((size_t)e * 256 + nb * 32) * D; t.ldk = D; return t; } r -= I_EG;
    if (r < I_EU) { const int e = r >> 6, q = r & 63, kb = q >> 2, nb = q & 3; t.W = a.in[17] + (size_t)e * D * ED; t.ldw = ED; t.k0 = kb * 64; t.n0 = nb * 32; t.dst = (bf16_t*)(ws + WS_WGU) + ((size_t)e * 256 + 128 + nb * 32) * D; t.ldk = D; return t; } r -= I_EU;
    if (r < I_SG) { const int kb = r >> 3, nb = r & 7, n0 = nb * 32; t.W = a.in[19]; t.ldw = SHD; t.k0 = kb * 64; t.n0 = n0; t.dst = (bf16_t*)(ws + WS_WSHGU) + (size_t)((n0 >> 7) * 256 + (n0 & 127)) * D; t.ldk = D; return t; } r -= I_SG;
    { const int kb = r >> 3, nb = r & 7, n0 = nb * 32; t.W = a.in[20]; t.ldw = SHD; t.k0 = kb * 64; t.n0 = n0; t.dst = (bf16_t*)(ws + WS_WSHGU) + (size_t)((n0 >> 7) * 256 + 128 + (n0 & 127)) * D; t.ldk = D; return t; }
}

__device__ __forceinline__ void titem_run(Frame& F, const Args& a, bool late, int nitems, int first, int stride) {
    LAS float* scr = (LAS float*)(F.lds + RING_OFF + F.wave * 16384); const int lane = F.lane;
    f32x4 va[8], vb[8]; TItem cur, nxt; int it = first;
    if (it < nitems) { cur = titem_decode(it, a, late); titem_load(cur, va, lane); }
    for (; it < nitems; it += 2 * stride) {
        const bool h1 = it + stride < nitems, h2 = it + 2 * stride < nitems;
        if (h1) { nxt = titem_decode(it + stride, a, late); titem_load(nxt, vb, lane); }
        titem_store(cur, va, scr, lane);
        if (h2) { cur = titem_decode(it + 2 * stride, a, late); titem_load(cur, va, lane); }
        if (h1) titem_store(nxt, vb, scr, lane);
    }
}

__device__ __forceinline__ void p0a(Frame& F, const Args& a) {
    unsigned char* ws = a.ws;
    const int gw = F.vcu * NWAVES + F.wave, NGW = F.G * NWAVES, lane = F.lane;
    LAS float* silu_t = (LAS float*)(F.lds + AUX_OFF + 1024);
    { const float* c = a.in[1]; for (int i = F.tid; i < 4 * D; i += NWAVES * 64) ((LAS float*)(F.lds + RING_OFF + 65536))[i] = siluf_(c[i]); }
    LAS float* silu = (LAS float*)(F.lds + RING_OFF + 65536);
    (void)silu_t;
    if (F.G == 256) { const float* wg = a.in[9]; const float* ps = a.in[10]; const float* wpo = a.in[11]; bf16_t* WE = (bf16_t*)(ws + WS_WEFF);
        const int g = F.vcu >> 6, nb = (F.vcu & 63) * 16; LAS float* wgt = (LAS float*)(F.lds + RING_OFF);
        for (int i = F.tid; i < 128 * 128; i += NWAVES * 64) { const int cc = i >> 7, d = i & 127; wgt[d * 128 + cc] = wg[(size_t)g * 16384 + i]; }
        __syncthreads();
        const int cc = F.tid & 127, nq = (F.tid >> 7) * 4; float acc4[4] = {0.f, 0.f, 0.f, 0.f};
        for (int d = 0; d < 128; ++d) { const float wv = wgt[d * 128 + cc] * ps[g * 128 + d]; const float* wr = wpo + (size_t)(g * 128 + d) * D + nb + nq;
#pragma unroll
            for (int j = 0; j < 4; ++j) acc4[j] += wv * wr[j]; }
#pragma unroll
        for (int j = 0; j < 4; ++j) WE[(size_t)(nb + nq + j) * PW + g * 128 + cc] = (bf16_t)f2bf(acc4[j]);
    }
    __syncthreads();
    { const float* w_ada = a.in[2]; float* MODP = (float*)(ws + WS_MODP);
      for (int it = gw; it < 96 * 8; it += NGW) { const int cg = it % 96, ks = it / 96;
          const float* w = w_ada + (size_t)(ks * 128) * (6 * D) + cg * 64 + lane;
          float a0 = 0.f, a1 = 0.f, a2 = 0.f, a3 = 0.f;
#pragma unroll 8
          for (int k = 0; k < 128; ++k) { const float wv = w[(size_t)k * (6 * D)]; const int kk = ks * 128 + k;
              a0 += silu[kk] * wv; a1 += silu[D + kk] * wv; a2 += silu[2 * D + kk] * wv; a3 += silu[3 * D + kk] * wv; }
          float* o = MODP + (size_t)ks * 4 * 6 * D + cg * 64 + lane;
          o[0] = a0; o[6 * D] = a1; o[12 * D] = a2; o[18 * D] = a3; } }
    __syncthreads();
    titem_run(F, a, false, 16 * 128 + 8 * 32 + 16 * 32 + 2 * 64 * 64 + 2 * 16 * 8, gw, NGW);
    { const float* wr = a.in[14]; bf16_t* WH = (bf16_t*)(ws + WS_WRH); bf16_t* WL = (bf16_t*)(ws + WS_WRL);
      for (int i = (F.vcu * NWAVES * 64 + F.tid); i < D * NE; i += F.G * NWAVES * 64) { const int e = i >> 10, k = i & 1023; const float v = wr[k * NE + e];
          const unsigned h = f2bf(v); WH[i] = (bf16_t)h; WL[i] = (bf16_t)f2bf(v - bf2f(h)); } }
}
__device__ __forceinline__ void p0b(Frame& F, const Args& a) {
    unsigned char* ws = a.ws; const float* MODP = (const float*)(ws + WS_MODP); const float* b_ada = a.in[3];
    if (F.tid < 96) { const int idx = 96 * F.vcu + F.tid, b = idx / (6 * D), j = idx % (6 * D); float v = b_ada[j];
#pragma unroll
        for (int ks = 0; ks < 8; ++ks) v += MODP[(size_t)(ks * 4 + b) * 6 * D + j];
        ((float*)(ws + WS_MOD))[idx] = v; }
    const int rows_per = M / F.G, r0 = F.vcu * rows_per, b = r0 / SEQ;
    LAS float* gsv = (LAS float*)(F.lds + RING_OFF); LAS float* shv = gsv + D;
    for (int k = F.tid; k < D; k += NWAVES * 64) { float sh = b_ada[k], sc = b_ada[D + k];
#pragma unroll
        for (int ks = 0; ks < 8; ++ks) { sh += MODP[(size_t)(ks * 4 + b) * 6 * D + k]; sc += MODP[(size_t)(ks * 4 + b) * 6 * D + D + k]; }
        gsv[k] = a.in[4][k] * (1.f + sc); shv[k] = sh; }
    __syncthreads();
    const float* x = a.in[0]; bf16_t* XN = (bf16_t*)(ws + WS_XN);
    for (int i = F.wave; i < rows_per; i += NWAVES) { const int row = r0 + i;
        const GAS f32x4* xr = (const GAS f32x4*)(x + (size_t)row * D) + F.lane;
        f32x4 v[4]; float s = 0.f;
#pragma unroll
        for (int j = 0; j < 4; ++j) { v[j] = xr[64 * j]; s += (v[j].x * v[j].x + v[j].y * v[j].y) + (v[j].z * v[j].z + v[j].w * v[j].w); }
        const float r = rsqrtf(wave_sum(s) * (1.f / D) + EPS);
        GAS unsigned long long* o8 = (GAS unsigned long long*)(XN + (size_t)row * D) + F.lane;
#pragma unroll
        for (int j = 0; j < 4; ++j) { const f32x4 gg = *(const LAS f32x4*)(gsv + 4 * F.lane + 256 * j), ss = *(const LAS f32x4*)(shv + 4 * F.lane + 256 * j);
            const f32x4 h = v[j] * r * gg + ss;
            o8[64 * j] = (unsigned long long)pk2(h.x, h.y) | ((unsigned long long)pk2(h.z, h.w) << 32); } }
    __syncthreads();
}

namespace sb {
using pg8::bf16x8; using pg8::f32x4; typedef float f32x16 __attribute__((ext_vector_type(16))); typedef short v4i16_t __attribute__((ext_vector_type(4)));
typedef short s16x4 __attribute__((ext_vector_type(4)));
constexpr int VPITCH = 128, VBYTES = 64 * VPITCH, WAVE_LDS = 2 * VBYTES;
constexpr float EXIT_THR = -152.f;
__device__ __forceinline__ int crow(int r, int hi) { return (r & 3) + 8 * (r >> 2) + 4 * hi; }
__device__ __forceinline__ s16x4 vtr(LAS const unsigned char* p) { return __builtin_bit_cast(s16x4, __builtin_amdgcn_ds_read_tr16_b64_v4i16((LAS v4i16_t*)p)); }
__device__ __forceinline__ unsigned pkbf(float lo, float hi) { return pg8::cvt_pk_bf16(lo, hi); }

__device__ __forceinline__ void attn_unit(int b, int h, int qb, const bf16_t* Q, const bf16_t* K, const bf16_t* V, bf16_t* O, LAS unsigned char* vlds, int wid, int lane) {
    const int r32 = lane & 31, hi = lane >> 5;
    const int t0 = qb * 256 + wid * 32;
    const size_t rowbase = (size_t)b * SEQ;
    const bf16_t* Kh = K + rowbase * 512 + h * 64; const bf16_t* Vh = V + rowbase * 512 + h * 64;
    bf16x8 qr[4];
#pragma unroll
    for (int d0 = 0; d0 < 4; ++d0) qr[d0] = *(const bf16x8*)(Q + (rowbase + t0 + r32) * 512 + h * 64 + d0 * 16 + hi * 8);
    f32x16 o0 = {}, o1 = {};
    float carry = 0.f;
    int kt = t0 >> 6;
    bf16x8 kf[8];
#define SB_LOADK(KT) do { const int kb_ = (KT) * 64; \
        _Pragma("unroll") for (int d0 = 0; d0 < 4; ++d0) { kf[2 * d0] = *(const bf16x8*)(Kh + (size_t)(kb_ + r32) * 512 + d0 * 16 + hi * 8); kf[2 * d0 + 1] = *(const bf16x8*)(Kh + (size_t)(kb_ + 32 + r32) * 512 + d0 * 16 + hi * 8); } } while (0)
#define SB_DMAV(KT, BUF) do { const int kb_ = (KT) * 64; \
        _Pragma("unroll") for (int i = 0; i < 8; ++i) __builtin_amdgcn_global_load_lds((const unsigned*)(Vh + (size_t)(kb_ + 8 * i + (lane >> 3)) * 512 + (lane & 7) * 8), (LAS unsigned*)(vlds + (BUF) * VBYTES + i * 1024), 16, 0, 0); } while (0)
    int cur = 0;
    SB_DMAV(kt, 0);
    SB_LOADK(kt);
    const int trbase = (4 * hi + ((lane & 15) >> 2)) * VPITCH + (16 * ((lane >> 4) & 1) + 4 * (lane & 3)) * 2;
    bool diag = true;
    for (;; --kt) {
        const int kbase = kt * 64;
        f32x16 p0 = {}, p1 = {};
#pragma unroll
        for (int d0 = 0; d0 < 4; ++d0) { p0 = __builtin_amdgcn_mfma_f32_32x32x16_bf16(kf[2 * d0], qr[d0], p0, 0, 0, 0); p1 = __builtin_amdgcn_mfma_f32_32x32x16_bf16(kf[2 * d0 + 1], qr[d0], p1, 0, 0, 0); }
        asm volatile("" ::: "memory");
        if (kt > 0) { SB_DMAV(kt - 1, cur ^ 1); SB_LOADK(kt - 1); }
        asm volatile("" ::: "memory");
        bf16x8 pa[4]; float suf = 0.f;
        const int qrel = t0 + r32 - kbase;
#define SB_HALF(P, KOFF, PA0, PA1) do { f32x16 sp_; \
        _Pragma("unroll") for (int r = 0; r < 16; ++r) sp_[r] = __builtin_amdgcn_logf(1.f + __builtin_amdgcn_exp2f(P[r])); \
        if (diag) { _Pragma("unroll") for (int r = 0; r < 16; ++r) if (crow(r, hi) + (KOFF) >= qrel) sp_[r] = 0.f; } \
        float e_[4], og_[4], R_[4]; \
        _Pragma("unroll") for (int c = 0; c < 4; ++c) { sp_[4 * c + 2] += sp_[4 * c + 3]; sp_[4 * c + 1] += sp_[4 * c + 2]; sp_[4 * c] += sp_[4 * c + 1]; e_[c] = sp_[4 * c]; } \
        _Pragma("unroll") for (int c = 0; c < 4; ++c) og_[c] = __shfl_xor(e_[c], 32); \
        _Pragma("unroll") for (int c = 3; c >= 0; --c) { R_[c] = carry - (suf + (hi == 0 ? og_[c] : 0.f)); suf += e_[c] + og_[c]; } \
        _Pragma("unroll") for (int r = 0; r < 16; ++r) P[r] = __builtin_amdgcn_exp2f(P[r] - sp_[r] + R_[r >> 2]); \
        if (diag) { _Pragma("unroll") for (int r = 0; r < 16; ++r) if (crow(r, hi) + (KOFF) >= qrel) P[r] = 0.f; } \
        pg8::u32x4 w_; w_.x = pkbf(P[0], P[1]); w_.y = pkbf(P[2], P[3]); w_.z = pkbf(P[4], P[5]); w_.w = pkbf(P[6], P[7]); PA0 = __builtin_bit_cast(bf16x8, w_); \
        w_.x = pkbf(P[8], P[9]); w_.y = pkbf(P[10], P[11]); w_.z = pkbf(P[12], P[13]); w_.w = pkbf(P[14], P[15]); PA1 = __builtin_bit_cast(bf16x8, w_); } while (0)
        SB_HALF(p1, 32, pa[2], pa[3]);
        SB_HALF(p0, 0, pa[0], pa[1]);
#undef SB_HALF
        carry -= suf;
        diag = false;
        if (kt > 0) asm volatile("s_waitcnt vmcnt(16)" ::: "memory"); else asm volatile("s_waitcnt vmcnt(0)" ::: "memory");
        LAS const unsigned char* vb = vlds + cur * VBYTES + trbase;
#pragma unroll
        for (int s = 0; s < 4; ++s) {
            LAS const unsigned char* vp = vb + (16 * s) * VPITCH;
            const s16x4 a0 = vtr(vp), a1 = vtr(vp + 8 * VPITCH), b0 = vtr(vp + 64), b1 = vtr(vp + 8 * VPITCH + 64);
            const bf16x8 v0 = {a0[0], a0[1], a0[2], a0[3], a1[0], a1[1], a1[2], a1[3]}, v1 = {b0[0], b0[1], b0[2], b0[3], b1[0], b1[1], b1[2], b1[3]};
            o0 = __builtin_amdgcn_mfma_f32_32x32x16_bf16(pa[s], v0, o0, 0, 0, 0);
            o1 = __builtin_amdgcn_mfma_f32_32x32x16_bf16(pa[s], v1, o1, 0, 0, 0);
        }
        asm volatile("s_waitcnt lgkmcnt(0)" ::: "memory");
        cur ^= 1;
        if (kt == 0 || __all(carry < EXIT_THR)) break;
    }
    asm volatile("s_waitcnt vmcnt(0)" ::: "memory");
#undef SB_LOADK
#undef SB_DMAV
    bf16_t* Ow = O + (rowbase + t0) * 512 + h * 64 + r32;
#pragma unroll
    for (int r = 0; r < 16; ++r) { const int q = crow(r, hi); Ow[(size_t)q * 512] = (bf16_t)f2bf(o0[r]); Ow[(size_t)q * 512 + 32] = (bf16_t)f2bf(o1[r]); }
}
}

__device__ __forceinline__ void p2_pool(Frame& F, const bf16_t* U, bf16_t* MIX) {
    const int rows_per = M / F.G; const int col8 = F.lane, w = 2 << (col8 >> 4);
    for (int rb = F.wave * 8; rb < rows_per; rb += NWAVES * 8) { const int t0 = F.vcu * rows_per + rb;
        v4u ld[23];
#pragma unroll
        for (int i = 0; i < 23; ++i) ld[i] = *(const GAS v4u*)(U + ((long)(t0 - 15 + i)) * PW + col8 * 8);
#pragma unroll
        for (int r = 0; r < 8; ++r) { const int tl = (t0 + r) % SEQ; const int cnt = (tl + 1) < w ? (tl + 1) : w;
            float acc[8];
#pragma unroll
            for (int j = 0; j < 8; ++j) acc[j] = 0.f;
#pragma unroll
            for (int i = 0; i < 16; ++i) { const v4u u = ld[15 + r - i]; const float m = (i < cnt) ? 1.f : 0.f;
                acc[0] += m * bf2f(u.x & 0xffffu); acc[1] += m * bf2f(u.x >> 16); acc[2] += m * bf2f(u.y & 0xffffu); acc[3] += m * bf2f(u.y >> 16);
                acc[4] += m * bf2f(u.z & 0xffffu); acc[5] += m * bf2f(u.z >> 16); acc[6] += m * bf2f(u.w & 0xffffu); acc[7] += m * bf2f(u.w >> 16); }
            const float inv = 1.f / (float)cnt; const v4u self = ld[15 + r];
            v4u o; o.x = pk2(acc[0] * inv - bf2f(self.x & 0xffffu), acc[1] * inv - bf2f(self.x >> 16)); o.y = pk2(acc[2] * inv - bf2f(self.y & 0xffffu), acc[3] * inv - bf2f(self.y >> 16));
            o.z = pk2(acc[4] * inv - bf2f(self.z & 0xffffu), acc[5] * inv - bf2f(self.z >> 16)); o.w = pk2(acc[6] * inv - bf2f(self.w & 0xffffu), acc[7] * inv - bf2f(self.w >> 16));
            *(GAS v4u*)(MIX + (size_t)(t0 + r) * PW + col8 * 8) = o; } }
}

constexpr int P5_TAB = AUX_OFF + 2048;
constexpr int P5_CNT = AUX_OFF + 1024;
constexpr int LIST_CAP = 16384;
typedef float f32x16 __attribute__((ext_vector_type(16)));
__device__ __forceinline__ void p5_route(Frame& F, const Args& a) {
    unsigned char* ws = a.ws; const float* X1 = a.out; const float* g2 = a.in[13]; const float* mod = (const float*)(ws + WS_MOD); const float* rbias = a.in[15];
    bf16_t* H2 = (bf16_t*)(ws + WS_H2); int* PE = (int*)(ws + WS_PE);
    const bf16_t* WH = (const bf16_t*)(ws + WS_WRH); const bf16_t* WL = (const bf16_t*)(ws + WS_WRL);
    unsigned long long* LIST = (unsigned long long*)(ws + WS_LIST); gu32* gcnt = F.ctl + CW_CNT;
    LAS unsigned char* Ahi = F.lds + RING_OFF; LAS unsigned char* Alo = Ahi + 65536; LAS float* part = (LAS float*)Ahi;
    LAS float* gsv = (LAS float*)(F.lds + P5_TAB); LAS float* shv = gsv + D; LAS unsigned* cnt_l = (LAS unsigned*)(F.lds + P5_CNT); LAS unsigned* base_l = cnt_l + 64; LAS float* rr = (LAS float*)(base_l + 64);
    const int lane = F.lane, wave = F.wave, r32 = lane & 31, hi = lane >> 5;
    const int rows_per = M / F.G;
    for (int row0 = F.vcu * rows_per; row0 < (F.vcu + 1) * rows_per; row0 += 64) {
        const int b = row0 / SEQ;
        for (int k = F.tid; k < D; k += NWAVES * 64) { gsv[k] = g2[k] * (1.f + mod[b * 6 * D + 4 * D + k]); shv[k] = mod[b * 6 * D + 3 * D + k]; }
        if (F.tid < 64) cnt_l[F.tid] = 0u;
        { f32x4 v[8][4];
#pragma unroll
          for (int i = 0; i < 8; ++i) { const GAS f32x4* xr = (const GAS f32x4*)(X1 + (size_t)(row0 + 8 * wave + i) * D) + lane;
#pragma unroll
              for (int j = 0; j < 4; ++j) v[i][j] = xr[64 * j]; }
#pragma unroll
          for (int i = 0; i < 8; ++i) { float s = 0.f;
#pragma unroll
              for (int j = 0; j < 4; ++j) s += (v[i][j].x * v[i][j].x + v[i][j].y * v[i][j].y) + (v[i][j].z * v[i][j].z + v[i][j].w * v[i][j].w);
              s = wave_sum(s); if (lane == 0) rr[8 * wave + i] = rsqrtf(s * (1.f / D) + EPS); } }
        __syncthreads();
        f32x16 acc[2][2];
#pragma unroll
        for (int x = 0; x < 2; ++x)
#pragma unroll
            for (int y = 0; y < 2; ++y) acc[x][y] = f32x16{};
#pragma unroll
        for (int kh = 0; kh < 2; ++kh) {
#pragma unroll
            for (int i = 0; i < 8; ++i) { const int rl = 8 * wave + i, row = row0 + rl; const float r = rr[rl];
                const GAS f32x4* xr = (const GAS f32x4*)(X1 + (size_t)row * D + 512 * kh) + lane;
                GAS unsigned long long* o8 = (GAS unsigned long long*)(H2 + (size_t)row * D + 512 * kh) + lane;
#pragma unroll
                for (int j = 0; j < 2; ++j) { const f32x4 xv = xr[64 * j];
                    const f32x4 gg = *(const LAS f32x4*)(gsv + 512 * kh + 4 * lane + 256 * j), ss = *(const LAS f32x4*)(shv + 512 * kh + 4 * lane + 256 * j);
                    const f32x4 h = xv * r * gg + ss;
                    const unsigned h0 = f2bf(h.x), h1 = f2bf(h.y), h2_ = f2bf(h.z), h3 = f2bf(h.w);
                    const unsigned long long hh = (unsigned long long)(h0 | (h1 << 16)) | ((unsigned long long)(h2_ | (h3 << 16)) << 32);
                    o8[64 * j] = hh;
                    const unsigned long long ll = (unsigned long long)pk2(h.x - bf2f(h0), h.y - bf2f(h1)) | ((unsigned long long)pk2(h.z - bf2f(h2_), h.w - bf2f(h3)) << 32);
                    const int chunk = (lane >> 1) + 32 * j, off = rl * 1024 + ((chunk ^ (rl & 15)) << 4) + ((lane & 1) << 3);
                    *(LAS unsigned long long*)(Ahi + off) = hh; *(LAS unsigned long long*)(Alo + off) = ll; } }
            __syncthreads();
#pragma unroll
            for (int s4 = 0; s4 < 4; ++s4) { const int chunk = 8 * wave + 2 * s4 + hi, kg = 512 * kh + 64 * wave + 16 * s4 + 8 * hi;
                const bf16x8 bh0 = *(const bf16x8*)(WH + (size_t)r32 * D + kg), bh1 = *(const bf16x8*)(WH + (size_t)(32 + r32) * D + kg);
                const bf16x8 bl0 = *(const bf16x8*)(WL + (size_t)r32 * D + kg), bl1 = *(const bf16x8*)(WL + (size_t)(32 + r32) * D + kg);
#pragma unroll
                for (int x = 0; x < 2; ++x) { const int rw = 32 * x + r32, off = rw * 1024 + ((chunk ^ (rw & 15)) << 4);
                    const bf16x8 ah = *(const LAS bf16x8*)(Ahi + off), al = *(const LAS bf16x8*)(Alo + off);
                    acc[x][0] = __builtin_amdgcn_mfma_f32_32x32x16_bf16(ah, bh0, acc[x][0], 0, 0, 0); acc[x][1] = __builtin_amdgcn_mfma_f32_32x32x16_bf16(ah, bh1, acc[x][1], 0, 0, 0);
                    acc[x][0] = __builtin_amdgcn_mfma_f32_32x32x16_bf16(al, bh0, acc[x][0], 0, 0, 0); acc[x][1] = __builtin_amdgcn_mfma_f32_32x32x16_bf16(al, bh1, acc[x][1], 0, 0, 0);
                    acc[x][0] = __builtin_amdgcn_mfma_f32_32x32x16_bf16(ah, bl0, acc[x][0], 0, 0, 0); acc[x][1] = __builtin_amdgcn_mfma_f32_32x32x16_bf16(ah, bl1, acc[x][1], 0, 0, 0); } }
            __syncthreads();
        }
#pragma unroll
        for (int x = 0; x < 2; ++x)
#pragma unroll
            for (int r = 0; r < 16; ++r) { const int rw = 32 * x + (r & 3) + 8 * (r >> 2) + 4 * hi; part[wave * 4096 + rw * 64 + r32] = acc[x][0][r]; part[wave * 4096 + rw * 64 + 32 + r32] = acc[x][1][r]; }
        __syncthreads();
        float scq[8];
#pragma unroll
        for (int q = 0; q < 8; ++q) { const int rl = wave + 8 * q; float logit = 0.f;
#pragma unroll
            for (int w = 0; w < 8; ++w) logit += part[w * 4096 + rl * 64 + lane];
            scq[q] = 1.f / (1.f + expf(-logit)); }
        __syncthreads();
        LAS float* scoreT = (LAS float*)(F.lds + RING_OFF);
#pragma unroll
        for (int q = 0; q < 8; ++q) scoreT[lane * 65 + wave + 8 * q] = scq[q];
        __syncthreads();
        if (wave == 0) {
            float sel[64];
#pragma unroll
            for (int e = 0; e < 64; ++e) sel[e] = scoreT[e * 65 + lane] + rbias[e];
            float gs[8];
#pragma unroll
            for (int g = 0; g < 8; ++g) { float m1 = sel[8 * g], m2 = -INFINITY;
#pragma unroll
                for (int j = 1; j < 8; ++j) { const float v = sel[8 * g + j]; const float lo = fminf(m1, v); m1 = fmaxf(m1, v); m2 = fmaxf(m2, lo); }
                gs[g] = m1 + m2; }
            unsigned gmask = 0u;
#pragma unroll
            for (int g = 0; g < 8; ++g) { int rk = 0;
#pragma unroll
                for (int h = 0; h < 8; ++h) if (h != g) rk += (gs[h] > gs[g] || (gs[h] == gs[g] && h < g)) ? 1 : 0;
                gmask |= (rk < 4) ? (1u << g) : 0u; }
#pragma unroll
            for (int e = 0; e < 64; ++e) sel[e] = ((gmask >> (e >> 3)) & 1u) ? sel[e] : -INFINITY;
            unsigned long long taken = 0ull; int ex[8]; float ws_[8]; float wsum = 0.f;
#pragma unroll
            for (int r = 0; r < TOPK; ++r) { float best = -INFINITY; int bi = 0;
#pragma unroll
                for (int e = 0; e < 64; ++e) { const bool c = !((taken >> e) & 1ull) && sel[e] > best; best = c ? sel[e] : best; bi = c ? e : bi; }
                taken |= 1ull << bi; ex[r] = bi; ws_[r] = scoreT[bi * 65 + lane]; wsum += ws_[r]; }
            const float wn = RSCALE / wsum;
#pragma unroll
            for (int r = 0; r < TOPK; ++r) { const unsigned pos = __hip_atomic_fetch_add(cnt_l + ex[r], 1u, __ATOMIC_RELAXED, __HIP_MEMORY_SCOPE_WORKGROUP);
                LAS unsigned* pk = (LAS unsigned*)(F.lds + RING_OFF + 32768) + (lane * 8 + r) * 4; pk[0] = (unsigned)ex[r]; pk[1] = pos; pk[2] = __builtin_bit_cast(unsigned, ws_[r] * wn); }
        }
        __syncthreads();
        if (F.tid < 64) base_l[F.tid] = __hip_atomic_fetch_add(gcnt + 64 * F.tid, cnt_l[F.tid], __ATOMIC_RELAXED, __HIP_MEMORY_SCOPE_AGENT);
        __syncthreads();
        { LAS const unsigned* pk = (LAS const unsigned*)(F.lds + RING_OFF + 32768) + F.tid * 4; const unsigned e = pk[0], pos = pk[1], wb = pk[2];
          const int pair = (row0 + (F.tid >> 3)) * 8 + (F.tid & 7);
          LIST[(size_t)e * LIST_CAP + base_l[e] + pos] = (unsigned long long)(unsigned)pair | ((unsigned long long)wb << 32);
          PE[pair] = (int)e; }
        __syncthreads();
    }
}

namespace pg8 {
struct UnitG { int kind, slot, nvalid, pm, pn, row0; const char* bptr; };
constexpr int P6_PRE = AUX_OFF + 1024;
constexpr int P6_ROWS = AUX_OFF + 2048;
struct SchedG {
    const LAS int* pre; const LAS int* cnts; const LAS int* cum; const char* wgu; const char* wsh; int G, c, nr, total;
    __device__ __forceinline__ bool next(int i, UnitG& u) const {
        const int idx = i * G + c; if (idx >= total) return false;
        if (idx < nr) { int e = (int)__builtin_popcountll(__ballot(pre[1 + (threadIdx.x & 63)] <= idx));
            e = __builtin_amdgcn_readfirstlane(e); const int j = idx - __builtin_amdgcn_readfirstlane(pre[e]); const int nv = __builtin_amdgcn_readfirstlane(cnts[e]) - 256 * j;
            u.kind = 0; u.slot = i; u.nvalid = nv < 256 ? nv : 256; u.pm = e; u.pn = j; u.row0 = 256 * idx; u.bptr = wgu + (size_t)e * 256 * D * 2; }
        else { const int s = idx - nr; u.kind = 1; u.slot = i; u.nvalid = 256; u.pm = s >> 1; u.pn = s & 1; u.row0 = (s >> 1) * 256; u.bptr = wsh + (size_t)(s & 1) * 256 * D * 2; }
        return true; }
};
struct EpiGU {
    static constexpr bool PERM = true;
    bf16_t* HM; bf16_t* SH; int* SLOT; const LAS unsigned long long* rowinfo;
    __device__ __forceinline__ void operator()(const f32x4 (&acc)[2][2][4][2], const UnitG& u, int wr, int wc, int fr, int fq) const {
#pragma unroll
        for (int ai = 0; ai < 2; ++ai)
#pragma unroll
            for (int m = 0; m < 4; ++m) { const int r = ai * HALF + wr * 64 + m * 16 + fr;
                bf16_t* dst; float w;
                if (u.kind == 0) { const unsigned long long ri = rowinfo[u.slot * 256 + r]; dst = HM + (size_t)(u.row0 + r) * ED + wc * 32 + 8 * fq; w = __builtin_bit_cast(float, (unsigned)(ri >> 32));
                    if (wc == 0 && fq == 0) SLOT[u.row0 + r] = (r < u.nvalid) ? (int)(unsigned)ri : M * 8; }
                else { dst = SH + (size_t)(u.pm * 256 + r) * SHD + u.pn * 128 + wc * 32 + 8 * fq; w = 1.f; }
                const f32x4 g0 = acc[ai][0][m][0], g1 = acc[ai][0][m][1], u0 = acc[ai][1][m][0], u1 = acc[ai][1][m][1];
                float v[8];
#pragma unroll
                for (int j = 0; j < 4; ++j) { v[j] = g0[j] * fsigmoid(g0[j]) * u0[j] * w; v[4 + j] = g1[j] * fsigmoid(g1[j]) * u1[j] * w; }
                u32x4 o; o.x = cvt_pk_bf16(v[0], v[1]); o.y = cvt_pk_bf16(v[2], v[3]); o.z = cvt_pk_bf16(v[4], v[5]); o.w = cvt_pk_bf16(v[6], v[7]);
                if (r < u.nvalid) *(u32x4*)dst = o; }
    }
};
template <class Epi, class Sched>
__device__ __forceinline__ void gemm_phase_g(PG8_LAS unsigned char* lds, const bf16_t* A, int K, const Sched& S, const Epi& E, const PG8_LAS unsigned long long* rowinfo) {
    int tid_ = threadIdx.x; asm volatile("" : "+v"(tid_));
    const int tid = tid_, wid = __builtin_amdgcn_readfirstlane(tid >> 6), lane = tid & 63, wr = wid >> 2, wc = wid & 3, fr = lane & 15, fq = lane >> 4;
    const int nt = K / BK;
    int RA[2], CA[2]; unsigned voffB[2];
#pragma unroll
    for (int i = 0; i < 2; ++i) { int R, C; stage_rc(tid * 16 + i * 8192, R, C); const int Rb = Epi::PERM ? ((R & ~31) + perm32(R & 31)) : R; RA[i] = R; CA[i] = C; voffB[i] = (unsigned)(Rb * K + C) * 2u; }
    const size_t kstep = (size_t)(BK * 2);
    const size_t hstep = (size_t)HALF * K * 2;
    const unsigned ldsw = (unsigned)wid * 1024u;
    const int aoff = lds_byte(wr * 64 + fr, fq * 8), boff = lds_byte(wc * 32 + fr, fq * 8);
#define PG8_AOFF(u, o0, o1) do { _Pragma("unroll") for (int _i = 0; _i < 2; ++_i) { unsigned r0_, r1_; \
        if ((u).kind == 0) { r0_ = (unsigned)rowinfo[(u).slot * 256 + RA[_i]] >> 3; r1_ = (unsigned)rowinfo[(u).slot * 256 + HALF + RA[_i]] >> 3; } \
        else { r0_ = (unsigned)((u).row0 + RA[_i]); r1_ = r0_ + HALF; } \
        o0[_i] = (r0_ * (unsigned)K + (unsigned)CA[_i]) * 2u; o1[_i] = (r1_ * (unsigned)K + (unsigned)CA[_i]) * 2u; } } while (0)
#define PG8_SA(b, h) (((b) * 2 + (h)) * HTB)
#define PG8_SB(b, h) ((4 + (b) * 2 + (h)) * HTB)
#define PG8_STAGE(bufoff, gbase, voff) do { _Pragma("unroll") for (int _i = 0; _i < 2; ++_i) \
        __builtin_amdgcn_global_load_lds((const unsigned*)((const char*)(gbase) + (voff)[_i]), (PG8_LAS unsigned*)(lds + (bufoff) + ldsw + _i * 8192), 16, 0, 0); } while (0)
#define PG8_LDA(dst, b, h) do { _Pragma("unroll") for (int m = 0; m < 4; ++m) _Pragma("unroll") for (int k = 0; k < 2; ++k) dst[m][k] = *(const PG8_LAS bf16x8*)(lds + PG8_SA(b, h) + aoff + m * 2048 + k * 1024); } while (0)
#define PG8_LDB(dst, b, h) do { _Pragma("unroll") for (int n = 0; n < 2; ++n) _Pragma("unroll") for (int k = 0; k < 2; ++k) dst[n][k] = *(const PG8_LAS bf16x8*)(lds + PG8_SB(b, h) + boff + n * 2048 + k * 1024); } while (0)
#define PG8_MMA(ai, bj, At, Bt) do { __builtin_amdgcn_s_setprio(1); _Pragma("unroll") for (int m = 0; m < 4; ++m) _Pragma("unroll") for (int n = 0; n < 2; ++n) _Pragma("unroll") for (int k = 0; k < 2; ++k) \
        acc[ai][bj][m][n] = __builtin_amdgcn_mfma_f32_16x16x32_bf16(Bt[n][k], At[m][k], acc[ai][bj][m][n], 0, 0, 0); __builtin_amdgcn_s_setprio(0); } while (0)
#define PG8_WAIT_V(n) asm volatile("s_waitcnt vmcnt(" #n ")" ::: "memory")
#define PG8_WAIT_L(n) asm volatile("s_waitcnt lgkmcnt(" #n ")" ::: "memory")
#define PG8_BAR __builtin_amdgcn_s_barrier()
#define PG8_SCHED __builtin_amdgcn_sched_barrier(0)
    UnitG cur, nxt; int ui = 0;
    if (!S.next(0, cur)) return;
    f32x4 acc[2][2][4][2];
#pragma unroll
    for (int a = 0; a < 2; ++a)
#pragma unroll
        for (int b = 0; b < 2; ++b)
#pragma unroll
            for (int m = 0; m < 4; ++m)
#pragma unroll
                for (int n = 0; n < 2; ++n) acc[a][b][m][n] = (f32x4){0.f, 0.f, 0.f, 0.f};
    bf16x8 At[4][2], B0[2][2], B1[2][2];
    const char* cA = (const char*)A; const char* cB = cur.bptr;
    unsigned vA0[2], vA1[2], nA0[2], nA1[2];
    PG8_AOFF(cur, vA0, vA1);
    PG8_STAGE(PG8_SB(0, 0), cB, voffB); PG8_STAGE(PG8_SB(0, 1), cB + hstep, voffB); PG8_STAGE(PG8_SA(0, 0), cA, vA0); PG8_STAGE(PG8_SA(0, 1), cA, vA1);
    if (wr == 1) PG8_BAR;
    PG8_WAIT_V(2); PG8_BAR;
    PG8_STAGE(PG8_SB(1, 0), cB + kstep, voffB); PG8_STAGE(PG8_SA(1, 0), cA + kstep, vA0); PG8_STAGE(PG8_SB(1, 1), cB + hstep + kstep, voffB);
    PG8_WAIT_V(6); PG8_BAR;
    for (;;) {
        const bool has_next = S.next(ui + 1, nxt);
        const char* nB = has_next ? nxt.bptr : cB;
        if (has_next) { PG8_AOFF(nxt, nA0, nA1); } else {
#pragma unroll
            for (int _i = 0; _i < 2; ++_i) { nA0[_i] = vA0[_i]; nA1[_i] = vA1[_i]; } }
#pragma nounroll
        for (int t = 0; t < nt; t += 2) {
            const bool last = (t == nt - 2);
            const char* a1 = cA + (size_t)(t + 1) * kstep;
            const char* a2 = last ? cA : cA + (size_t)(t + 2) * kstep; const char* b2 = last ? nB : cB + (size_t)(t + 2) * kstep;
            const char* a3 = a2 + kstep; const char* b3 = b2 + kstep;
            unsigned s0[2], s1[2];
#pragma unroll
            for (int _i = 0; _i < 2; ++_i) { s0[_i] = last ? nA0[_i] : vA0[_i]; s1[_i] = last ? nA1[_i] : vA1[_i]; }
            PG8_LDB(B0, 0, 0); PG8_LDB(B1, 0, 1); PG8_SCHED; PG8_LDA(At, 0, 0); PG8_STAGE(PG8_SA(1, 1), a1, vA1);
            PG8_WAIT_V(8); PG8_WAIT_L(0); PG8_BAR; PG8_MMA(0, 0, At, B0); PG8_MMA(0, 1, At, B1); PG8_BAR; PG8_SCHED;
            PG8_LDA(At, 0, 1); PG8_STAGE(PG8_SB(0, 0), b2, voffB); PG8_STAGE(PG8_SB(0, 1), b2 + hstep, voffB); PG8_STAGE(PG8_SA(0, 0), a2, s0);
            PG8_WAIT_V(8); PG8_WAIT_L(0); PG8_BAR; PG8_MMA(1, 0, At, B0); PG8_MMA(1, 1, At, B1); PG8_BAR; PG8_SCHED;
            PG8_LDB(B0, 1, 0); PG8_LDB(B1, 1, 1); PG8_SCHED; PG8_LDA(At, 1, 0); PG8_STAGE(PG8_SA(0, 1), a2, s1);
            PG8_WAIT_V(8); PG8_WAIT_L(0); PG8_BAR; PG8_MMA(0, 0, At, B0); PG8_MMA(0, 1, At, B1); PG8_BAR; PG8_SCHED;
            PG8_LDA(At, 1, 1); PG8_STAGE(PG8_SB(1, 0), b3, voffB); PG8_STAGE(PG8_SB(1, 1), b3 + hstep, voffB); PG8_STAGE(PG8_SA(1, 0), a3, s0);
            PG8_WAIT_V(8); PG8_WAIT_L(0); PG8_BAR; PG8_MMA(1, 0, At, B0); PG8_MMA(1, 1, At, B1); PG8_BAR; PG8_SCHED;
        }
        if (wr == 0) PG8_BAR;
        E(acc, cur, wr, wc, fr, fq);
        if (!has_next) break;
#pragma unroll
        for (int a = 0; a < 2; ++a)
#pragma unroll
            for (int b = 0; b < 2; ++b)
#pragma unroll
                for (int m = 0; m < 4; ++m)
#pragma unroll
                    for (int n = 0; n < 2; ++n) acc[a][b][m][n] = (f32x4){0.f, 0.f, 0.f, 0.f};
        cur = nxt; cB = nB; ++ui;
#pragma unroll
        for (int _i = 0; _i < 2; ++_i) { vA0[_i] = nA0[_i]; vA1[_i] = nA1[_i]; }
        if (wr == 1) PG8_BAR;
    }
    PG8_WAIT_V(0);
    PG8_BAR;
#undef PG8_AOFF
#undef PG8_SA
#undef PG8_SB
#undef PG8_STAGE
#undef PG8_LDA
#undef PG8_LDB
#undef PG8_MMA
#undef PG8_WAIT_V
#undef PG8_WAIT_L
#undef PG8_BAR
#undef PG8_SCHED
}
}

__device__ __forceinline__ void p6_gateup(Frame& F, const Args& a) {
    unsigned char* ws = a.ws; gu32* gcnt = F.ctl + CW_CNT; const unsigned long long* LIST = (const unsigned long long*)(ws + WS_LIST);
    LAS int* pre = (LAS int*)(F.lds + pg8::P6_PRE); LAS int* cnts = pre + 65; LAS int* cum = cnts + 64; LAS unsigned long long* rowinfo = (LAS unsigned long long*)(F.lds + pg8::P6_ROWS);
    if (F.tid < 64) cnts[F.tid] = (int)__hip_atomic_load(gcnt + 64 * F.tid, RLX_AGENT);
    __syncthreads();
    if (F.tid == 0) { int s = 0, r = 0; for (int e = 0; e < 64; ++e) { pre[e] = s; cum[e] = r; s += (cnts[e] + 255) >> 8; r += cnts[e]; } pre[64] = s; cum[64] = r; }
    __syncthreads();
    pg8::SchedG S; S.pre = pre; S.cnts = cnts; S.cum = cum; S.wgu = (const char*)(ws + WS_WGU); S.wsh = (const char*)(ws + WS_WSHGU); S.G = F.G; S.c = (int)blockIdx.x; S.nr = __builtin_amdgcn_readfirstlane(pre[64]); S.total = S.nr + 2 * (M / 256);
    for (int i = 0; i < 3; ++i) { pg8::UnitG u; if (!S.next(i, u)) break;
        if (u.kind == 0 && F.tid < 256) { const int r = F.tid; rowinfo[i * 256 + r] = (r < u.nvalid) ? LIST[(size_t)u.pm * LIST_CAP + 256 * u.pn + r] : 0ull; } }
    __syncthreads();
    pg8::EpiGU E{(bf16_t*)(ws + WS_HM), (bf16_t*)(ws + WS_SH), (int*)(ws + WS_SLOT), rowinfo};
    pg8::gemm_phase_g<pg8::EpiGU, pg8::SchedG>(F.lds + RING_OFF, (const bf16_t*)(ws + WS_H2), D, S, E, rowinfo);
    { const int rounds = (S.total + F.G - 1) / F.G, firstidle = S.total - (rounds - 1) * F.G;
      const int c = (int)blockIdx.x, nidle = F.G - firstidle;
      if (nidle > 0) { if (c >= firstidle) titem_run(F, a, true, 64 * 64 + 4 * 32, (c - firstidle) * NWAVES + F.wave, nidle * NWAVES); }
      else titem_run(F, a, true, 64 * 64 + 4 * 32, c * NWAVES + F.wave, F.G * NWAVES); }
}

namespace pg8 {
struct SchedYr {
    const LAS int* pre; int G, c, total;
    __device__ __forceinline__ bool next(int i, Unit& u) const {
        const int idx = i * G + c; if (idx >= total) return false;
        const int t = idx >> 2, pnl = idx & 3; int e = (int)__builtin_popcountll(__ballot(pre[1 + (threadIdx.x & 63)] <= t));
        e = __builtin_amdgcn_readfirstlane(e); u.pm = t; u.pn = 4 * e + pnl; return true; }
    __device__ __forceinline__ void a_ready(const Unit&) const {}
    __device__ __forceinline__ void done(const Unit&) const {}
};
constexpr float YSCALE = 8.f;
struct EpiStoreF8 {
    static constexpr bool PERM = true, AFTER_DRAIN = false;
    unsigned char* O; const PG8_LAS int* rowmap_l; int G, c;
    __device__ __forceinline__ void operator()(const f32x4 (&acc)[2][2][4][2], const Unit& u, int wr, int wc, int fr, int fq) const {
        const int slot = (4 * u.pm + (u.pn & 3) - c) / G; const PG8_LAS int* rm = rowmap_l + slot * 256 + wr * 64 + fr; const int col0 = (u.pn & 3) * BM + wc * 32 + 8 * fq;
#pragma unroll
        for (int ai = 0; ai < 2; ++ai)
#pragma unroll
            for (int m = 0; m < 4; ++m) { const int orow = rm[ai * HALF + m * 16]; unsigned char* rowp = O + (size_t)orow * 1024 + col0;
#pragma unroll
                for (int bj = 0; bj < 2; ++bj) { const f32x4 v0 = acc[ai][bj][m][0] * YSCALE, v1 = acc[ai][bj][m][1] * YSCALE;
                    unsigned lo = 0u, hi = 0u;
                    lo = __builtin_amdgcn_cvt_pk_fp8_f32(v0[0], v0[1], lo, false); lo = __builtin_amdgcn_cvt_pk_fp8_f32(v0[2], v0[3], lo, true);
                    hi = __builtin_amdgcn_cvt_pk_fp8_f32(v1[0], v1[1], hi, false); hi = __builtin_amdgcn_cvt_pk_fp8_f32(v1[2], v1[3], hi, true);
                    *(unsigned long long*)(rowp + bj * HALF) = (unsigned long long)lo | ((unsigned long long)hi << 32); } }
    }
};
struct EpiStore {
    static constexpr bool PERM = true, AFTER_DRAIN = false;
    bf16_t* O; int ldc, colmask;
    __device__ __forceinline__ void operator()(const f32x4 (&acc)[2][2][4][2], const Unit& u, int wr, int wc, int fr, int fq) const {
        const int row0 = u.pm * BM + wr * 64 + fr, col0 = (u.pn & colmask) * BM + wc * 32 + 8 * fq;
#pragma unroll
        for (int ai = 0; ai < 2; ++ai)
#pragma unroll
            for (int m = 0; m < 4; ++m) { bf16_t* rowp = O + (size_t)(row0 + ai * HALF + m * 16) * ldc + col0;
#pragma unroll
                for (int bj = 0; bj < 2; ++bj) { const f32x4 v0 = acc[ai][bj][m][0], v1 = acc[ai][bj][m][1];
                    u32x4 w; w.x = cvt_pk_bf16(v0[0], v0[1]); w.y = cvt_pk_bf16(v0[2], v0[3]); w.z = cvt_pk_bf16(v1[0], v1[1]); w.w = cvt_pk_bf16(v1[2], v1[3]);
                    *(u32x4*)(rowp + bj * HALF) = w; } }
    }
};
}
__device__ __forceinline__ void p7_down(Frame& F, const Args& a) {
    unsigned char* ws = a.ws; gu32* gcnt = F.ctl + CW_CNT;
    LAS int* pre = (LAS int*)(F.lds + pg8::P6_PRE); LAS int* cnts = pre + 65;
    if (F.tid < 64) cnts[F.tid] = (int)__hip_atomic_load(gcnt + 64 * F.tid, RLX_AGENT);
    __syncthreads();
    if (F.tid == 0) { int s = 0; for (int e = 0; e < 64; ++e) { pre[e] = s; s += (cnts[e] + 255) >> 8; } pre[64] = s; }
    __syncthreads();
    { pg8::SchedYr S; S.pre = pre; S.G = F.G; S.c = (int)blockIdx.x; S.total = 4 * __builtin_amdgcn_readfirstlane(pre[64]);
      int kk = ED; asm volatile("" : "+s"(kk));
      LAS int* rml = (LAS int*)(F.lds + AUX_OFF + 2048); const int* rowmap = (const int*)(ws + WS_SLOT);
      for (int i = 0; i * F.G + S.c < S.total && i < 12; ++i) { if (F.tid < 256) rml[i * 256 + F.tid] = rowmap[256 * ((i * F.G + S.c) >> 2) + F.tid]; }
      __syncthreads();
      pg8::Gemm g{(const bf16_t*)(ws + WS_HM), (const bf16_t*)(ws + WS_WD), 0, 0, kk}; pg8::EpiStoreF8 E{ws + WS_YH, rml, F.G, S.c};
      pg8::gemm_phase<pg8::EpiStoreF8, pg8::SchedYr, true, true>(F.lds + RING_OFF, g, S, E); }
    { pg8::StaticOrder S; S.init(M, D, F.G, (int)blockIdx.x);
      int kk = SHD; asm volatile("" : "+s"(kk));
      pg8::Gemm g{(const bf16_t*)(ws + WS_SH), (const bf16_t*)(ws + WS_WSHD), M, D, kk}; pg8::EpiStore E{(bf16_t*)(ws + WS_YSH), D, 3};
      pg8::gemm_phase<pg8::EpiStore, pg8::StaticOrder, true, true>(F.lds + RING_OFF, g, S, E); }
}
__device__ __forceinline__ void p8_combine(Frame& F, const Args& a) {
    unsigned char* ws = a.ws; const unsigned char* Y8 = ws + WS_YH; const bf16_t* YSH = (const bf16_t*)(ws + WS_YSH);
    const float* mod = (const float*)(ws + WS_MOD); float* OUT = a.out; const int lane = F.lane;
    for (int tb = (F.vcu * NWAVES + F.wave) * 8; tb < M; tb += F.G * NWAVES * 8) {
        const int b = tb / SEQ; const float* gate = mod + (size_t)b * 6 * D + 5 * D + lane * 16;
        f32x4 gv[4];
#pragma unroll
        for (int i = 0; i < 4; ++i) gv[i] = *(const f32x4*)(gate + 4 * i);
#pragma nounroll
        for (int i = 0; i < 8; i += 2) {
            v4u y[2][8], ys[2][2]; f32x4 x[2][4];
#pragma unroll
            for (int q = 0; q < 2; ++q) { const int t = tb + i + q;
#pragma unroll
                for (int k = 0; k < 8; ++k) y[q][k] = *(const GAS v4u*)(Y8 + ((size_t)t * 8 + k) * 1024 + lane * 16);
                const GAS v4u* sp = (const GAS v4u*)(YSH + (size_t)t * D + lane * 16); ys[q][0] = sp[0]; ys[q][1] = sp[1];
                const GAS f32x4* o = (const GAS f32x4*)(OUT + (size_t)t * D + lane * 16);
#pragma unroll
                for (int j = 0; j < 4; ++j) x[q][j] = o[j]; }
#pragma unroll
            for (int q = 0; q < 2; ++q) { const int t = tb + i + q; float acc[16];
#pragma unroll
                for (int j = 0; j < 16; ++j) acc[j] = 0.f;
#pragma unroll
                for (int k = 0; k < 8; ++k) { const unsigned w4[4] = {y[q][k].x, y[q][k].y, y[q][k].z, y[q][k].w};
#pragma unroll
                    for (int j = 0; j < 4; ++j) { const pg8::f32x2_t lo = __builtin_amdgcn_cvt_pk_f32_fp8((int)w4[j], false), hi = __builtin_amdgcn_cvt_pk_f32_fp8((int)w4[j], true);
                        acc[4 * j] += lo.x; acc[4 * j + 1] += lo.y; acc[4 * j + 2] += hi.x; acc[4 * j + 3] += hi.y; } }
                GAS f32x4* o = (GAS f32x4*)(OUT + (size_t)t * D + lane * 16);
#pragma unroll
                for (int j = 0; j < 4; ++j) { const unsigned s0 = (j < 2 ? ys[q][0] : ys[q][1])[2 * (j & 1)], s1 = (j < 2 ? ys[q][0] : ys[q][1])[2 * (j & 1) + 1];
                    const f32x4 sh = {bf2f(s0 & 0xffffu), bf2f(s0 >> 16), bf2f(s1 & 0xffffu), bf2f(s1 >> 16)};
                    const f32x4 rt = {acc[4 * j], acc[4 * j + 1], acc[4 * j + 2], acc[4 * j + 3]};
                    o[j] = x[q][j] + gv[j] * (rt * (1.f / pg8::YSCALE) + sh); } }
        }
    }
}

__global__ void __launch_bounds__(NWAVES * 64, 2) mk_fwd(Args args) {
    extern __shared__ __attribute__((aligned(16))) unsigned char lds[];
    Frame F;
    F.lds = (LAS unsigned char*)lds; F.MISC = (volatile LAS unsigned*)(F.lds + MISC_OFF);
    F.tid = threadIdx.x; F.lane = F.tid & 63; F.wave = __builtin_amdgcn_readfirstlane(F.tid >> 6);
    F.G = gridDim.x; { const int bx = blockIdx.x; F.vcu = (F.G % 8 == 0) ? (bx % 8) * (F.G / 8) + bx / 8 : bx; }
    unsigned char* ws = args.ws; F.ctl = (gu32*)(ws + WS_CTL);
    for (int u = F.tid; u < (LDS_BYTES - LDSCTL_OFF) / 4; u += NWAVES * 64) ((LAS unsigned*)(F.lds + LDSCTL_OFF))[u] = 0u;
    __syncthreads();
    XcdBarrier bar; bar.bar = (unsigned*)(F.ctl + CW_BAR); bar.x = 0; bar.st = nullptr;
    if (args.use_bar) bar = xcd_barrier_post((unsigned*)(F.ctl + CW_BAR), F.MISC + 8);
    const int lo = args.ph_lo, hi = args.ph_hi;
#define IN(k) (lo <= (k) && (k) < hi)
#define SEAM(k) do { if (IN(k) && IN((k) + 1)) xcd_barrier(bar); } while (0)
#define PHASE(p, ...) do { if (IN(p)) { const int reps_ = (DBL_PHASE == (p)) ? 2 : 1; for (int rep_ = 0; rep_ < reps_; ++rep_) { __VA_ARGS__; if (rep_ + 1 < reps_) xcd_barrier(bar); } } SEAM(p); } while (0)
    PHASE(0, p0a(F, args));
    PHASE(1, p0b(F, args));
    PHASE(2, {
        pg8::Gemm g{(const bf16_t*)(ws + WS_XN), (const bf16_t*)(ws + WS_WIN), M, INW, D}; pg8::StaticOrder S; S.init(M, INW, F.G, (int)blockIdx.x);
        pg8::EpiProj E{(bf16_t*)(ws + WS_Q), (bf16_t*)(ws + WS_K), (bf16_t*)(ws + WS_V), (bf16_t*)(ws + WS_U), (bf16_t*)(ws + WS_GA), (bf16_t*)(ws + WS_GB), args.in[6], args.in[7]};
        pg8::gemm_phase<pg8::EpiProj, pg8::StaticOrder, true, true>(F.lds + RING_OFF, g, S, E); });
    PHASE(3, {
        const bf16_t* Q = (const bf16_t*)(ws + WS_Q); const bf16_t* K = (const bf16_t*)(ws + WS_K); const bf16_t* V = (const bf16_t*)(ws + WS_V);
        for (int u = blockIdx.x; u < BATCH * NH * (SEQ / 256); u += F.G) { const int qb = u & 15, bh = u >> 4;
            sb::attn_unit(bh >> 3, bh & 7, qb, Q, K, V, (bf16_t*)(ws + WS_OSB), F.lds + RING_OFF + F.wave * sb::WAVE_LDS, F.wave, F.lane); }
        p2_pool(F, (const bf16_t*)(ws + WS_U), (bf16_t*)(ws + WS_MIX)); });
    PHASE(4, {
        pg8::StaticOrder S; S.init(M, D, F.G, (int)blockIdx.x);
        { pg8::Gemm g{(const bf16_t*)(ws + WS_OSB), (const bf16_t*)(ws + WS_WSB), M, D, SBW}; pg8::EpiMerge E{(const bf16_t*)(ws + WS_GA), (bf16_t*)(ws + WS_MERGED), 0};
          pg8::gemm_phase<pg8::EpiMerge, pg8::StaticOrder, true, true>(F.lds + RING_OFF, g, S, E); }
        { pg8::Gemm g{(const bf16_t*)(ws + WS_MIX), (const bf16_t*)(ws + WS_WEFF), M, D, PW}; pg8::EpiMerge E{(const bf16_t*)(ws + WS_GB), (bf16_t*)(ws + WS_MERGED), 1};
          pg8::gemm_phase<pg8::EpiMerge, pg8::StaticOrder, true, true>(F.lds + RING_OFF, g, S, E); } });
    PHASE(5, {
        pg8::Gemm g{(const bf16_t*)(ws + WS_MERGED), (const bf16_t*)(ws + WS_WOUT), M, D, D}; pg8::StaticOrder S; S.init(M, D, F.G, (int)blockIdx.x);
        pg8::EpiX1 E{args.in[0], (const float*)(ws + WS_MOD) + 2 * D, args.out};
        pg8::gemm_phase<pg8::EpiX1, pg8::StaticOrder, true, true>(F.lds + RING_OFF, g, S, E); });
    PHASE(6, {
        if (rep_ > 0) { if (blockIdx.x == 0 && F.tid < 64) __hip_atomic_store(F.ctl + CW_CNT + 64 * F.tid, 0u, RLX_AGENT); xcd_barrier(bar); }
        p5_route(F, args); });
    PHASE(7, p6_gateup(F, args));
    PHASE(8, p7_down(F, args));
    if (IN(9)) { p8_combine(F, args); }
#undef PHASE
#undef IN
#undef SEAM
}
constexpr int N_PHASES = 10;
extern "C" void kernel_launch(void* const* d_in, const int* in_sizes, int n_in, void* d_out, int out_size, void* d_ws, size_t ws_size, hipStream_t stream) {
    static int grid = 0;
    if (grid == 0) {
        if (n_in != 22 || out_size != M * D || ws_size < WS_END) { fprintf(stderr, "kernel_launch: unexpected shapes n_in %d out %d ws %zu\n", n_in, out_size, ws_size); grid = -1; return; }
        int dev = 0, cus = 0, per_cu = 0;
        if (hipGetDevice(&dev) != hipSuccess || hipDeviceGetAttribute(&cus, hipDeviceAttributeMultiprocessorCount, dev) != hipSuccess) { grid = -1; return; }
        if (hipFuncSetAttribute((const void*)mk_fwd, hipFuncAttributeMaxDynamicSharedMemorySize, LDS_BYTES) != hipSuccess) { fprintf(stderr, "kernel_launch: hipFuncSetAttribute failed\n"); grid = -1; return; }
        if (hipOccupancyMaxActiveBlocksPerMultiprocessor(&per_cu, (const void*)mk_fwd, NWAVES * 64, LDS_BYTES) != hipSuccess || per_cu < 1) fprintf(stderr, "kernel_launch: occupancy query says %d per CU\n", per_cu);
        (void)hipGetLastError();
        grid = cus;
    }
    if (grid < 0) return;
    unsigned char* ws = (unsigned char*)d_ws;
    if (hipMemsetAsync(ws + WS_CTL, 0, CTL_ZERO_BYTES, stream) != hipSuccess) { fprintf(stderr, "kernel_launch: memset failed\n"); return; }
    Args a{};
    for (int i = 0; i < 22; ++i) a.in[i] = (const float*)d_in[i];
    a.out = (float*)d_out; a.ws = ws; a.ph_lo = 0; a.ph_hi = N_PHASES; a.use_bar = 1;
    hipLaunchKernelGGL(mk_fwd, dim3(grid), dim3(NWAVES * 64), LDS_BYTES, stream, a);
}
```

```cpp
#include <hip/hip_runtime.h>
#include <cstdint>
#include <cstdio>

typedef unsigned short bf16_t;
constexpr int D = 1024, BATCH = 4, SEQ = 4096, M = BATCH * SEQ, NH = 8, HD = 64, SBW = 512, PW = 512, INW = 4096;
constexpr int NE = 64, ED = 128, TOPK = 8, SHD = 256;
constexpr float EPS = 1e-6f, RSCALE = 2.5f;

constexpr size_t MiB = 1u << 20;
constexpr size_t WS_CTL = 0, WS_MOD = 1 * MiB, WS_PE = 2 * MiB, WS_PW = 3 * MiB, WS_LIST = 4 * MiB;
constexpr size_t WS_XN = 74 * MiB, WS_OSB = 74 * MiB, WS_MIX = 90 * MiB, WS_H2 = 74 * MiB;
constexpr size_t WS_Q = 106 * MiB, WS_K = 122 * MiB, WS_V = 138 * MiB, WS_MERGED = 106 * MiB;
constexpr size_t WS_SLOT = 190 * MiB, WS_SH = 192 * MiB, WS_HM = 200 * MiB;
constexpr size_t WS_YH = 12 * MiB, WS_YSH = 156 * MiB;
constexpr size_t WS_U = 154 * MiB, WS_GA = 170 * MiB, WS_GB = 202 * MiB, WS_END = 256 * MiB;

__device__ __forceinline__ unsigned f2bf(float f) { unsigned u = __builtin_bit_cast(unsigned, f); return (u + 0x7fffu + ((u >> 16) & 1u)) >> 16; }
__device__ __forceinline__ float bf2f(unsigned h) { return __builtin_bit_cast(float, h << 16); }
__device__ __forceinline__ float wave_sum(float v) {
#pragma unroll
    for (int o = 1; o < 64; o <<= 1) v += __shfl_xor(v, o);
    return v;
}
__device__ __forceinline__ float sigmoidf_(float v) { return 1.f / (1.f + __expf(-v)); }
__device__ __forceinline__ float siluf_(float v) { return v / (1.f + __expf(-v)); }

namespace pg8 {
#define PG8_LAS __attribute__((address_space(3)))
typedef short bf16x8 __attribute__((ext_vector_type(8)));
typedef float f32x4 __attribute__((ext_vector_type(4)));
typedef unsigned u32x4 __attribute__((ext_vector_type(4)));
constexpr int BM = 256, BK = 64, HALF = 128, HTB = HALF * BK * 2  , STAGE_BYTES = 8 * HTB, NXCD = 8, WGM = 8;

__host__ __device__ __forceinline__ int lds_byte(int r, int c) { const int st = (r >> 4) * 2 + (c >> 5), rr = r & 15, cc = c & 31, ob = rr * 64 + cc * 2; return st * 1024 + (ob ^ (((ob >> 9) & 1) << 5)); }
__host__ __device__ __forceinline__ void stage_rc(int b, int& R, int& C) { const int st = b / 1024, sb = b % 1024, swz = sb ^ (((sb >> 9) & 1) << 5); R = (st >> 1) * 16 + swz / 64; C = (st & 1) * 32 + (swz % 64) / 2; }
__host__ __device__ __forceinline__ int perm32(int rho) { const int n = rho >> 4, i = rho & 15; return 8 * (i >> 2) + 4 * n + (i & 3); }

struct Unit { int pm, pn; };
struct Gemm { const bf16_t* A; const bf16_t* Bt; int M, N, K; };

struct StaticOrder {
    int nM, nN, nwg, G, c;
    __host__ __device__ void init(int M_, int N_, int G_, int c_) { nM = M_ / BM; nN = N_ / BM; nwg = nM * nN; G = G_; c = c_; }
    __host__ __device__ bool next(int i, Unit& u) const {
        const long L = (long)i * G + c; if (L >= nwg) return false;
        int wgid = (int)L; { const int q = nwg / NXCD, r = nwg % NXCD, xcd = wgid % NXCD, off = wgid / NXCD; wgid = (xcd < r ? xcd * (q + 1) : r * (q + 1) + (xcd - r) * q) + off; }
        const int nig = WGM * nN, gid = wgid / nig, fm = gid * WGM, gsz = (nM - fm) < WGM ? (nM - fm) : WGM;
        u.pm = fm + ((wgid % nig) % gsz); u.pn = (wgid % nig) / gsz; return true;
    }
    __device__ __forceinline__ void a_ready(const Unit&) const {}
    __device__ __forceinline__ void done(const Unit&) const {}
};
typedef float f32x2_t __attribute__((ext_vector_type(2))); typedef __bf16 bf16x2_t __attribute__((ext_vector_type(2)));
__device__ __forceinline__ unsigned cvt_pk_bf16(float lo, float hi) { f32x2_t v = {lo, hi}; bf16x2_t b = __builtin_convertvector(v, bf16x2_t); return __builtin_bit_cast(unsigned, b); }
__device__ __forceinline__ float fsigmoid(float v) { return __builtin_amdgcn_rcpf(1.f + __builtin_amdgcn_exp2f(-1.4426950408889634f * v)); }
constexpr float QSCALE = 0.125f * 1.4426950408889634f;

struct EpiProj {
    static constexpr bool PERM = true, AFTER_DRAIN = false;
    bf16_t *Q, *K, *V, *U, *GA, *GB; const float* gq; const float* gk;
    __device__ __forceinline__ void operator()(const f32x4 (&acc)[2][2][4][2], const Unit& u, int wr, int wc, int fr, int fq) const {
        const int row0 = u.pm * BM + wr * 64 + fr; const int sec = u.pn;
        if (sec < 4) {
            const bool isq = sec < 2; const float* g = isq ? gq : gk; bf16_t* base = (isq ? Q : K) + ((sec & 1) * 4 + wc) * 64 + 8 * fq;
            const float qs = isq ? QSCALE : 1.f;
            f32x4 gv[2][2];
#pragma unroll
            for (int bj = 0; bj < 2; ++bj)
#pragma unroll
                for (int n = 0; n < 2; ++n) gv[bj][n] = *(const f32x4*)(g + 32 * bj + 8 * fq + 4 * n);
#pragma unroll
            for (int ai = 0; ai < 2; ++ai)
#pragma unroll
                for (int m = 0; m < 4; ++m) {
                    float ss = 0.f;
#pragma unroll
                    for (int bj = 0; bj < 2; ++bj)
#pragma unroll
                        for (int n = 0; n < 2; ++n) { const f32x4 x = acc[ai][bj][m][n]; ss += (x[0] * x[0] + x[1] * x[1]) + (x[2] * x[2] + x[3] * x[3]); }
                    ss += __shfl_xor(ss, 16); ss += __shfl_xor(ss, 32);
                    const float r = rsqrtf(ss * (1.f / 64.f) + EPS) * qs;
                    bf16_t* rowp = base + (size_t)(row0 + ai * HALF + m * 16) * 512;
#pragma unroll
                    for (int bj = 0; bj < 2; ++bj) { const f32x4 v0 = acc[ai][bj][m][0] * gv[bj][0] * r, v1 = acc[ai][bj][m][1] * gv[bj][1] * r;
                        u32x4 w; w.x = cvt_pk_bf16(v0[0], v0[1]); w.y = cvt_pk_bf16(v0[2], v0[3]); w.z = cvt_pk_bf16(v1[0], v1[1]); w.w = cvt_pk_bf16(v1[2], v1[3]);
                        *(u32x4*)(rowp + 32 * bj) = w; }
                }
        } else if (sec < 8) {
            bf16_t* base = (sec < 6 ? V : U) + (sec & 1) * 256 + wc * 32 + 8 * fq;
#pragma unroll
            for (int ai = 0; ai < 2; ++ai)
#pragma unroll
                for (int m = 0; m < 4; ++m) { bf16_t* rowp = base + (size_t)(row0 + ai * HALF + m * 16) * 512;
#pragma unroll
                    for (int bj = 0; bj < 2; ++bj) { const f32x4 v0 = acc[ai][bj][m][0], v1 = acc[ai][bj][m][1];
                        u32x4 w; w.x = cvt_pk_bf16(v0[0], v0[1]); w.y = cvt_pk_bf16(v0[2], v0[3]); w.z = cvt_pk_bf16(v1[0], v1[1]); w.w = cvt_pk_bf16(v1[2], v1[3]);
                        *(u32x4*)(rowp + bj * HALF) = w; } }
        } else {
            bf16_t* base = (sec < 12 ? GA : GB) + ((sec - 8) & 3) * 256 + wc * 32 + 8 * fq;
#pragma unroll
            for (int ai = 0; ai < 2; ++ai)
#pragma unroll
                for (int m = 0; m < 4; ++m) { bf16_t* rowp = base + (size_t)(row0 + ai * HALF + m * 16) * 1024;
#pragma unroll
                    for (int bj = 0; bj < 2; ++bj) { const f32x4 v0 = acc[ai][bj][m][0], v1 = acc[ai][bj][m][1];
                        u32x4 w; w.x = cvt_pk_bf16(fsigmoid(v0[0]), fsigmoid(v0[1])); w.y = cvt_pk_bf16(fsigmoid(v0[2]), fsigmoid(v0[3])); w.z = cvt_pk_bf16(fsigmoid(v1[0]), fsigmoid(v1[1])); w.w = cvt_pk_bf16(fsigmoid(v1[2]), fsigmoid(v1[3]));
                        *(u32x4*)(rowp + bj * HALF) = w; } }
        }
    }
};

struct EpiMerge {
    static constexpr bool PERM = true, AFTER_DRAIN = false;
    const bf16_t* G; bf16_t* MG; int add;
    __device__ __forceinline__ void operator()(const f32x4 (&acc)[2][2][4][2], const Unit& u, int wr, int wc, int fr, int fq) const {
        const int row0 = u.pm * BM + wr * 64 + fr, col0 = u.pn * BM + wc * 32 + 8 * fq;
#pragma unroll
        for (int ai = 0; ai < 2; ++ai)
#pragma unroll
            for (int m = 0; m < 4; ++m) { const size_t off = (size_t)(row0 + ai * HALF + m * 16) * 1024 + col0;
#pragma unroll
                for (int bj = 0; bj < 2; ++bj) { const u32x4 g = *(const u32x4*)(G + off + bj * HALF); const f32x4 a0 = acc[ai][bj][m][0], a1 = acc[ai][bj][m][1];
                    float v[8] = {bf2f(g.x & 0xffffu) * a0[0], bf2f(g.x >> 16) * a0[1], bf2f(g.y & 0xffffu) * a0[2], bf2f(g.y >> 16) * a0[3], bf2f(g.z & 0xffffu) * a1[0], bf2f(g.z >> 16) * a1[1], bf2f(g.w & 0xffffu) * a1[2], bf2f(g.w >> 16) * a1[3]};
                    if (add) { const u32x4 o = *(const u32x4*)(MG + off + bj * HALF);
                        v[0] += bf2f(o.x & 0xffffu); v[1] += bf2f(o.x >> 16); v[2] += bf2f(o.y & 0xffffu); v[3] += bf2f(o.y >> 16); v[4] += bf2f(o.z & 0xffffu); v[5] += bf2f(o.z >> 16); v[6] += bf2f(o.w & 0xffffu); v[7] += bf2f(o.w >> 16); }
                    u32x4 w; w.x = cvt_pk_bf16(v[0], v[1]); w.y = cvt_pk_bf16(v[2], v[3]); w.z = cvt_pk_bf16(v[4], v[5]); w.w = cvt_pk_bf16(v[6], v[7]);
                    *(u32x4*)(MG + off + bj * HALF) = w; } }
    }
};
struct EpiX1 {
    static constexpr bool PERM = false, AFTER_DRAIN = false;
    const float* x; const float* gate; float* X1;
    __device__ __forceinline__ void operator()(const f32x4 (&acc)[2][2][4][2], const Unit& u, int wr, int wc, int fr, int fq) const {
        const int row0 = u.pm * BM + wr * 64 + fr, col0 = u.pn * BM + wc * 32 + 4 * fq; const int b = (u.pm * BM) / SEQ;
        f32x4 gv[2][2];
#pragma unroll
        for (int bj = 0; bj < 2; ++bj)
#pragma unroll
            for (int n = 0; n < 2; ++n) gv[bj][n] = *(const f32x4*)(gate + (size_t)b * 6 * D + col0 + bj * HALF + n * 16);
#pragma unroll
        for (int ai = 0; ai < 2; ++ai)
#pragma unroll
            for (int m = 0; m < 4; ++m) { const size_t off = (size_t)(row0 + ai * HALF + m * 16) * D + col0;
#pragma unroll
                for (int bj = 0; bj < 2; ++bj)
#pragma unroll
                    for (int n = 0; n < 2; ++n) *(f32x4*)(X1 + off + bj * HALF + n * 16) = *(const f32x4*)(x + off + bj * HALF + n * 16) + gv[bj][n] * acc[ai][bj][m][n]; }
    }
};

template <class Epi, class Sched, bool ALIGN_EPI = false, bool SP2 = false>
__device__ __forceinline__ void gemm_phase(PG8_LAS unsigned char* lds, const Gemm g, const Sched& S, const Epi& E) {
    int tid_ = threadIdx.x; asm volatile("" : "+v"(tid_));
    const int tid = tid_, wid = __builtin_amdgcn_readfirstlane(tid >> 6), lane = tid & 63, wr = wid >> 2, wc = wid & 3, fr = lane & 15, fq = lane >> 4;
    const int K = g.K, nt = K / BK;
    unsigned voffA[2], voffB[2];
#pragma unroll
    for (int i = 0; i < 2; ++i) { int R, C; stage_rc(tid * 16 + i * 8192, R, C); const int Rb = Epi::PERM ? ((R & ~31) + perm32(R & 31)) : R;
        voffA[i] = (unsigned)(R * K + C) * 2u; voffB[i] = (unsigned)(Rb * K + C) * 2u; }
    const size_t kstep = (size_t)(BK * 2);
    const size_t hstep = (size_t)HALF * K * 2;
    const size_t tstep = 2 * hstep;
    const unsigned ldsw = (unsigned)wid * 1024u;
    const int aoff = lds_byte(wr * 64 + fr, fq * 8), boff = lds_byte(wc * 32 + fr, fq * 8);
#define PG8_SA(b, h) (((b) * 2 + (h)) * HTB)
#define PG8_SB(b, h) ((4 + (b) * 2 + (h)) * HTB)
#define PG8_STAGE(bufoff, gbase, voff) do { _Pragma("unroll") for (int _i = 0; _i < 2; ++_i) \
        __builtin_amdgcn_global_load_lds((const unsigned*)((const char*)(gbase) + (voff)[_i]), (PG8_LAS unsigned*)(lds + (bufoff) + ldsw + _i * 8192), 16, 0, 0); } while (0)
#define PG8_LDA(dst, b, h) do { _Pragma("unroll") for (int m = 0; m < 4; ++m) _Pragma("unroll") for (int k = 0; k < 2; ++k) dst[m][k] = *(const PG8_LAS bf16x8*)(lds + PG8_SA(b, h) + aoff + m * 2048 + k * 1024); } while (0)
#define PG8_LDB(dst, b, h) do { _Pragma("unroll") for (int n = 0; n < 2; ++n) _Pragma("unroll") for (int k = 0; k < 2; ++k) dst[n][k] = *(const PG8_LAS bf16x8*)(lds + PG8_SB(b, h) + boff + n * 2048 + k * 1024); } while (0)
#define PG8_MMA(ai, bj, At, Bt) do { __builtin_amdgcn_s_setprio(1); _Pragma("unroll") for (int m = 0; m < 4; ++m) _Pragma("unroll") for (int n = 0; n < 2; ++n) _Pragma("unroll") for (int k = 0; k < 2; ++k) \
        acc[ai][bj][m][n] = __builtin_amdgcn_mfma_f32_16x16x32_bf16(Bt[n][k], At[m][k], acc[ai][bj][m][n], 0, 0, 0); __builtin_amdgcn_s_setprio(0); } while (0)
#define PG8_WAIT_V(n) asm volatile("s_waitcnt vmcnt(" #n ")" ::: "memory")
#define PG8_WAIT_L(n) asm volatile("s_waitcnt lgkmcnt(" #n ")" ::: "memory")
#define PG8_BAR __builtin_amdgcn_s_barrier()
#define PG8_SCHED __builtin_amdgcn_sched_barrier(0)
    Unit cur, nxt; int ui = 0;
    if (!S.next(0, cur)) return;
    f32x4 acc[2][2][4][2];
#pragma unroll
    for (int a = 0; a < 2; ++a)
#pragma unroll
        for (int b = 0; b < 2; ++b)
#pragma unroll
            for (int m = 0; m < 4; ++m)
#pragma unroll
                for (int n = 0; n < 2; ++n) acc[a][b][m][n] = (f32x4){0.f, 0.f, 0.f, 0.f};
    bf16x8 At[4][2], B0[2][2], B1[2][2];
    const char* cA = (const char*)g.A + (size_t)cur.pm * tstep; const char* cB = (const char*)g.Bt + (size_t)cur.pn * tstep;
    S.a_ready(cur);
    if constexpr (SP2) {
        PG8_STAGE(PG8_SB(0, 0), cB, voffB); PG8_STAGE(PG8_SB(0, 1), cB + hstep, voffB); PG8_STAGE(PG8_SA(0, 0), cA, voffA); PG8_STAGE(PG8_SA(0, 1), cA + hstep, voffA);
        if (wr == 1) PG8_BAR;
        PG8_WAIT_V(2); PG8_BAR;
        PG8_STAGE(PG8_SB(1, 0), cB + kstep, voffB); PG8_STAGE(PG8_SA(1, 0), cA + kstep, voffA); PG8_STAGE(PG8_SB(1, 1), cB + hstep + kstep, voffB);
        PG8_WAIT_V(6); PG8_BAR;
    } else {
        PG8_STAGE(PG8_SB(0, 0), cB, voffB); PG8_STAGE(PG8_SA(0, 0), cA, voffA); PG8_STAGE(PG8_SB(0, 1), cB + hstep, voffB); PG8_STAGE(PG8_SA(0, 1), cA + hstep, voffA);
        if (wr == 1) PG8_BAR;
        PG8_WAIT_V(4); PG8_BAR;
        PG8_STAGE(PG8_SB(1, 0), cB + kstep, voffB); PG8_STAGE(PG8_SA(1, 0), cA + kstep, voffA); PG8_STAGE(PG8_SB(1, 1), cB + hstep + kstep, voffB);
        PG8_WAIT_V(6); PG8_BAR;
    }
    for (;;) {
        const bool has_next = S.next(ui + 1, nxt);
        const char* nA = has_next ? (const char*)g.A + (size_t)nxt.pm * tstep : cA; const char* nB = has_next ? (const char*)g.Bt + (size_t)nxt.pn * tstep : cB;
#pragma nounroll
        for (int t = 0; t < nt; t += 2) {
            const bool last = (t == nt - 2);
            const char* a1 = cA + (size_t)(t + 1) * kstep;
            const char* a2 = last ? nA : cA + (size_t)(t + 2) * kstep; const char* b2 = last ? nB : cB + (size_t)(t + 2) * kstep;
            const char* a3 = a2 + kstep; const char* b3 = b2 + kstep;
            if (last && has_next) S.a_ready(nxt);
            if constexpr (SP2) {
            PG8_LDB(B0, 0, 0); PG8_LDB(B1, 0, 1); PG8_SCHED; PG8_LDA(At, 0, 0); PG8_STAGE(PG8_SA(1, 1), a1 + hstep, voffA);
            PG8_WAIT_V(8); PG8_WAIT_L(0); PG8_BAR; PG8_MMA(0, 0, At, B0); PG8_MMA(0, 1, At, B1); PG8_BAR; PG8_SCHED;
            PG8_LDA(At, 0, 1); PG8_STAGE(PG8_SB(0, 0), b2, voffB); PG8_STAGE(PG8_SB(0, 1), b2 + hstep, voffB); PG8_STAGE(PG8_SA(0, 0), a2, voffA);
            PG8_WAIT_V(8); PG8_WAIT_L(0); PG8_BAR; PG8_MMA(1, 0, At, B0); PG8_MMA(1, 1, At, B1); PG8_BAR; PG8_SCHED;
            PG8_LDB(B0, 1, 0); PG8_LDB(B1, 1, 1); PG8_SCHED; PG8_LDA(At, 1, 0); PG8_STAGE(PG8_SA(0, 1), a2 + hstep, voffA);
            PG8_WAIT_V(8); PG8_WAIT_L(0); PG8_BAR; PG8_MMA(0, 0, At, B0); PG8_MMA(0, 1, At, B1); PG8_BAR; PG8_SCHED;
            PG8_LDA(At, 1, 1); PG8_STAGE(PG8_SB(1, 0), b3, voffB); PG8_STAGE(PG8_SB(1, 1), b3 + hstep, voffB); PG8_STAGE(PG8_SA(1, 0), a3, voffA);
            PG8_WAIT_V(8); PG8_WAIT_L(0); PG8_BAR; PG8_MMA(1, 0, At, B0); PG8_MMA(1, 1, At, B1); PG8_BAR; PG8_SCHED;
            } else {
            PG8_LDB(B0, 0, 0); PG8_SCHED; PG8_LDA(At, 0, 0); PG8_STAGE(PG8_SA(1, 1), a1 + hstep, voffA);
            PG8_WAIT_L(8); PG8_BAR; PG8_WAIT_L(0); PG8_MMA(0, 0, At, B0); PG8_BAR; PG8_SCHED;
            PG8_LDB(B1, 0, 1); PG8_STAGE(PG8_SB(0, 0), b2, voffB);
            PG8_BAR; PG8_WAIT_L(0); PG8_MMA(0, 1, At, B1); PG8_BAR;
            PG8_LDA(At, 0, 1); PG8_STAGE(PG8_SA(0, 0), a2, voffA);
            PG8_BAR; PG8_WAIT_L(0); PG8_MMA(1, 0, At, B0); PG8_BAR; PG8_SCHED;
            PG8_STAGE(PG8_SB(0, 1), b2 + hstep, voffB);
            PG8_WAIT_V(6); PG8_BAR; PG8_MMA(1, 1, At, B1); PG8_BAR;
            PG8_LDB(B0, 1, 0); PG8_SCHED; PG8_LDA(At, 1, 0); PG8_STAGE(PG8_SA(0, 1), a2 + hstep, voffA);
            PG8_WAIT_L(8); PG8_BAR; PG8_WAIT_L(0); PG8_MMA(0, 0, At, B0); PG8_BAR; PG8_SCHED;
            PG8_LDB(B1, 1, 1); PG8_STAGE(PG8_SB(1, 0), b3, voffB);
            PG8_BAR; PG8_WAIT_L(0); PG8_MMA(0, 1, At, B1); PG8_BAR;
            PG8_LDA(At, 1, 1); PG8_STAGE(PG8_SA(1, 0), a3, voffA);
            PG8_BAR; PG8_WAIT_L(0); PG8_MMA(1, 0, At, B0); PG8_BAR; PG8_SCHED;
            PG8_STAGE(PG8_SB(1, 1), b3 + hstep, voffB);
            PG8_WAIT_V(6); PG8_BAR; PG8_MMA(1, 1, At, B1); PG8_BAR;
            }
        }
        if constexpr (ALIGN_EPI) { if (wr == 0) PG8_BAR; }
        if constexpr (!Epi::AFTER_DRAIN) { E(acc, cur, wr, wc, fr, fq); S.done(cur); }
        if (!has_next) break;
#pragma unroll
        for (int a = 0; a < 2; ++a)
#pragma unroll
            for (int b = 0; b < 2; ++b)
#pragma unroll
                for (int m = 0; m < 4; ++m)
#pragma unroll
                    for (int n = 0; n < 2; ++n) acc[a][b][m][n] = (f32x4){0.f, 0.f, 0.f, 0.f};
        cur = nxt; cA = nA; cB = nB; ++ui;
        if constexpr (ALIGN_EPI) { if (wr == 1) PG8_BAR; }
    }
    PG8_WAIT_V(0);
    if constexpr (!ALIGN_EPI) { if (wr == 0) PG8_BAR; }
    PG8_BAR;
    if constexpr (Epi::AFTER_DRAIN) { E.fused(acc, cur, wr, wc, fr, fq, lds, wid, lane); S.done(cur); }
#undef PG8_SA
#undef PG8_SB
#undef PG8_STAGE
#undef PG8_LDA
#undef PG8_LDB
#undef PG8_MMA
#undef PG8_WAIT_V
#undef PG8_WAIT_L
#undef PG8_BAR
#undef PG8_SCHED
}
}
using pg8::f32x4; using pg8::bf16x8;
#define GAS __attribute__((address_space(1)))
#define LAS __attribute__((address_space(3)))
typedef unsigned v4u __attribute__((ext_vector_type(4)));
typedef GAS unsigned gu32;
typedef GAS unsigned long long gu64;
#define RLX_AGENT __ATOMIC_RELAXED, __HIP_MEMORY_SCOPE_AGENT
#define LDS_WAIT() asm volatile("s_waitcnt lgkmcnt(0)" ::: "memory")
#define VM_WAIT() asm volatile("s_waitcnt vmcnt(0)" ::: "memory")
__device__ __forceinline__ unsigned long long rt() { return __builtin_amdgcn_s_memrealtime(); }
__device__ __forceinline__ unsigned pk2(float lo, float hi) { return pg8::cvt_pk_bf16(lo, hi); }

#define XB_TMO      128
#define XB_XCNT(j)  (256  + 64 * (j))
#define XB_XSUB(j)  (1280 + 64 * (j))
#define XB_XGEN(j)  (2304 + 64 * (j))
#define XB_TOP      3328
#define XB_TOPGEN   3392
#define XCD_BAR_WORDS 3456
#define XB_SPIN_CAP (1u << 18)

__device__ __forceinline__ unsigned xb_ld(unsigned* p)              { return __hip_atomic_load(p, __ATOMIC_RELAXED, __HIP_MEMORY_SCOPE_AGENT); }
__device__ __forceinline__ unsigned xb_add(unsigned* p, unsigned v) { return __hip_atomic_fetch_add(p, v, __ATOMIC_RELAXED, __HIP_MEMORY_SCOPE_AGENT); }
__device__ __forceinline__ unsigned xb_xcc_id() { return (unsigned)__builtin_amdgcn_s_getreg((3 << 11) | 20) & 0xFu; }
#define XB_SPIN(cond, bar) do { unsigned _sp = 0; while (cond) { __builtin_amdgcn_s_sleep(1); \
    if ((++_sp & 255u) == 0u) { if (xb_ld(&(bar)[XB_TMO])) break; if (_sp > XB_SPIN_CAP) { atomicAdd(&(bar)[XB_TMO], 1u); break; } } } } while (0)

struct XcdBarrier {
    unsigned* bar; unsigned x;
    volatile LAS unsigned* st;
};

__device__ __forceinline__ XcdBarrier xcd_barrier_post(unsigned* bar, volatile LAS unsigned* st) {
    XcdBarrier b; b.bar = bar; b.x = xb_xcc_id(); b.st = st;
    if (threadIdx.x == 0) (void)xb_add(&bar[XB_XCNT(b.x)], 1u);
    return b;
}
__device__ __forceinline__ void xcd_barrier_complete(unsigned* bar, unsigned x, unsigned& nloc, unsigned& nx) {
    const unsigned G = gridDim.x * gridDim.y * gridDim.z;
    unsigned sum, cnt, mine, sp = 0u;
    for (;;) {
        sum = 0u; cnt = 0u; mine = 0u;
#pragma unroll
        for (unsigned j = 0; j < 16; ++j) { const unsigned c = xb_ld(&bar[XB_XCNT(j)]); sum += c; cnt += (c > 0u) ? 1u : 0u; mine = (j == x) ? c : mine; }
        if (sum == G) break;
        __builtin_amdgcn_s_sleep(1);
        if ((++sp & 255u) == 0u) { if (xb_ld(&bar[XB_TMO])) break; if (sp > XB_SPIN_CAP) { atomicAdd(&bar[XB_TMO], 1u); break; } }
    }
    nloc = mine > 0u ? mine : 1u; nx = cnt > 0u ? cnt : 1u;
}

__device__ __forceinline__ void xcd_barrier(const XcdBarrier& b) {
    asm volatile("s_waitcnt vmcnt(0)" ::: "memory");
    __syncthreads();
    if (threadIdx.x == 0) {
        unsigned* bar = b.bar;
        __builtin_amdgcn_s_waitcnt(0);
        unsigned nloc = b.st[0], nx = b.st[1];
        if (nloc == 0u) { xcd_barrier_complete(bar, b.x, nloc, nx); b.st[0] = nloc; b.st[1] = nx; }
        const unsigned old = xb_add(&bar[XB_XSUB(b.x)], 1u);
        const unsigned gen = old / nloc;
        if (old + 1u == (gen + 1u) * nloc) {
            __builtin_amdgcn_fence(__ATOMIC_RELEASE, "agent");
            asm volatile("s_waitcnt vmcnt(0)" ::: "memory");
            const unsigned og = xb_add(&bar[XB_TOP], 1u);
            const unsigned tg = og / nx;
            if (og + 1u == (tg + 1u) * nx) xb_add(&bar[XB_TOPGEN], 1u);
            else XB_SPIN(xb_ld(&bar[XB_TOPGEN]) == tg, bar);
            __builtin_amdgcn_fence(__ATOMIC_ACQUIRE, "agent");
            xb_add(&bar[XB_XGEN(b.x)], 1u);
            asm volatile("s_waitcnt vmcnt(0)" ::: "memory");
        } else {
            XB_SPIN(xb_ld(&bar[XB_XGEN(b.x)]) == gen, bar);
            __builtin_amdgcn_fence(__ATOMIC_ACQUIRE, "agent");
            asm volatile("s_waitcnt vmcnt(0)" ::: "memory");
        }
    }
    __syncthreads();
}

constexpr int NWAVES = 8;
#ifndef DBL_PHASE
#define DBL_PHASE -1
#endif
constexpr size_t WS_MODP = 1 * MiB + 128 * 1024;
constexpr size_t WS_WIN = 12 * MiB, WS_WSB = 20 * MiB, WS_WEFF = 21 * MiB, WS_WOUT = 22 * MiB, WS_WGU = 24 * MiB;
constexpr size_t WS_WSHGU = 237 * MiB, WS_WD = 238 * MiB, WS_WSHD = 254 * MiB, WS_WRH = 254 * MiB + 512 * 1024, WS_WRL = WS_WRH + 128 * 1024;
constexpr size_t CTL_ZERO_BYTES = 256 * 1024;
constexpr int CW_TMO = 0, CW_CODE = 1, CW_BAR = 4096, CW_CNT = 16384;
constexpr int RING_OFF = 0, RING_BYTES = 131072, AUX_OFF = RING_BYTES, LDS_BYTES = 163840, LDSCTL_OFF = LDS_BYTES - 1024, MISC_OFF = LDSCTL_OFF + 320;

struct Frame {
    LAS unsigned char* lds; volatile LAS unsigned* MISC; gu32* ctl;
    int tid, lane, wave, vcu, G;
};
struct Args { const float* in[22]; float* out; unsigned char* ws; int ph_lo, ph_hi, use_bar, pad; };

struct TItem { const float* W; bf16_t* dst; int ldw, ldk, k0, n0; };
__device__ __forceinline__ void titem_load(const TItem& t, f32x4 (&v)[8], int lane) {
    const int kr = lane >> 3, n4 = (lane & 7) * 4;
#pragma unroll
    for (int i = 0; i < 8; ++i) v[i] = *(const GAS f32x4*)(t.W + (size_t)(t.k0 + kr + 8 * i) * t.ldw + t.n0 + n4);
}
__device__ __forceinline__ void titem_store(const TItem& t, const f32x4 (&v)[8], LAS float* scr, int lane) {
    { const int kr = lane >> 3, n4 = (lane & 7) * 4;
#pragma unroll
      for (int i = 0; i < 8; ++i) { LAS float* d = scr + (kr + 8 * i) * 33 + n4; d[0] = v[i].x; d[1] = v[i].y; d[2] = v[i].z; d[3] = v[i].w; } }
    LDS_WAIT(); asm volatile("" ::: "memory");
    const int c = lane & 7;
#pragma unroll
    for (int j = 0; j < 4; ++j) { const int n = (lane >> 3) + 8 * j; const LAS float* sp = scr + (8 * c) * 33 + n;
        v4u o; o.x = pk2(sp[0 * 33], sp[1 * 33]); o.y = pk2(sp[2 * 33], sp[3 * 33]); o.z = pk2(sp[4 * 33], sp[5 * 33]); o.w = pk2(sp[6 * 33], sp[7 * 33]);
        *(GAS v4u*)(t.dst + (size_t)n * t.ldk + t.k0 + 8 * c) = o; }
    LDS_WAIT(); asm volatile("" ::: "memory");
}
__device__ __forceinline__ TItem titem_decode(int it, const Args& a, bool late) {
    unsigned char* ws = a.ws; TItem t;
    constexpr int I_IN = 16 * 128, I_SB = 8 * 32, I_OUT = 16 * 32, I_EG = 64 * 64, I_EU = 64 * 64, I_ED = 64 * 64, I_SG = 16 * 8, I_SU = 16 * 8;
    int r = it;
    if (late) {
        if (r < I_ED) { const int e = r >> 6, q = r & 63, kb = q >> 5, nb = q & 31; t.W = a.in[18] + (size_t)e * ED * D; t.ldw = D; t.k0 = kb * 64; t.n0 = nb * 32; t.dst = (bf16_t*)(ws + WS_WD) + ((size_t)e * D + nb * 32) * ED; t.ldk = ED; return t; } r -= I_ED;
        { const int kb = r >> 5, nb = r & 31; t.W = a.in[21]; t.ldw = D; t.k0 = kb * 64; t.n0 = nb * 32; t.dst = (bf16_t*)(ws + WS_WSHD) + (size_t)(nb * 32) * SHD; t.ldk = SHD; return t; } }
    if (r < I_IN) { const int kb = r >> 7, nb = r & 127, n0 = nb * 32; int d0 = n0;
        if (n0 < 1024) d0 = (n0 & ~255) + 128 * ((n0 >> 5) & 1) + 32 * ((n0 >> 6) & 3);
        t.W = a.in[5]; t.ldw = INW; t.k0 = kb * 64; t.n0 = n0; t.dst = (bf16_t*)(ws + WS_WIN) + (size_t)d0 * D; t.ldk = D; return t; } r -= I_IN;
    if (r < I_SB) { const int kb = r >> 5, nb = r & 31; t.W = a.in[8]; t.ldw = D; t.k0 = kb * 64; t.n0 = nb * 32; t.dst = (bf16_t*)(ws + WS_WSB) + (size_t)(nb * 32) * SBW; t.ldk = SBW; return t; } r -= I_SB;
    if (r < I_OUT) { const int kb = r >> 5, nb = r & 31; t.W = a.in[12]; t.ldw = D; t.k0 = kb * 64; t.n0 = nb * 32; t.dst = (bf16_t*)(ws + WS_WOUT) + (size_t)(nb * 32) * D; t.ldk = D; return t; } r -= I_OUT;
    if (r < I_EG) { const int e = r >> 6, q = r & 63, kb = q >> 2, nb = q & 3; t.W = a.in[16] + (size_t)e * D * ED; t.ldw = ED; t.k0 = kb * 64; t.n0 = nb * 32; t.dst = (bf16_t*)(ws + WS_WGU) + ((size_t)e * 256 + nb * 32) * D; t.ldk = D; return t; } r -= I_EG;
    if (r < I_EU) { const int e = r >> 6, q = r & 63, kb = q >> 2, nb = q & 3; t.W = a.in[17] + (size_t)e * D * ED; t.ldw = ED; t.k0 = kb * 64; t.n0 = nb * 32; t.dst = (bf16_t*)(ws + WS_WGU) + ((size_t)e * 256 + 128 + nb * 32) * D; t.ldk = D; return t; } r -= I_EU;
    if (r < I_SG) { const int kb = r >> 3, nb = r & 7, n0 = nb * 32; t.W = a.in[19]; t.ldw = SHD; t.k0 = kb * 64; t.n0 = n0; t.dst = (bf16_t*)(ws + WS_WSHGU) + (size_t)((n0 >> 7) * 256 + (n0 & 127)) * D; t.ldk = D; return t; } r -= I_SG;
    { const int kb = r >> 3, nb = r & 7, n0 = nb * 32; t.W = a.in[20]; t.ldw = SHD; t.k0 = kb * 64; t.n0 = n0; t.dst = (bf16_t*)(ws + WS_WSHGU) + (size_t)((n0 >> 7) * 256 + 128 + (n0 & 127)) * D; t.ldk = D; return t; }
}

__device__ __forceinline__ void titem_run(Frame& F, const Args& a, bool late, int nitems, int first, int stride) {
    LAS float* scr = (LAS float*)(F.lds + RING_OFF + F.wave * 16384); const int lane = F.lane;
    f32x4 va[8], vb[8]; TItem cur, nxt; int it = first;
    if (it < nitems) { cur = titem_decode(it, a, late); titem_load(cur, va, lane); }
    for (; it < nitems; it += 2 * stride) {
        const bool h1 = it + stride < nitems, h2 = it + 2 * stride < nitems;
        if (h1) { nxt = titem_decode(it + stride, a, late); titem_load(nxt, vb, lane); }
        titem_store(cur, va, scr, lane);
        if (h2) { cur = titem_decode(it + 2 * stride, a, late); titem_load(cur, va, lane); }
        if (h1) titem_store(nxt, vb, scr, lane);
    }
}

__device__ __forceinline__ void p0a(Frame& F, const Args& a) {
    unsigned char* ws = a.ws;
    const int gw = F.vcu * NWAVES + F.wave, NGW = F.G * NWAVES, lane = F.lane;
    LAS float* silu_t = (LAS float*)(F.lds + AUX_OFF + 1024);
    { const float* c = a.in[1]; for (int i = F.tid; i < 4 * D; i += NWAVES * 64) ((LAS float*)(F.lds + RING_OFF + 65536))[i] = siluf_(c[i]); }
    LAS float* silu = (LAS float*)(F.lds + RING_OFF + 65536);
    (void)silu_t;
    if (F.G == 256) { const float* wg = a.in[9]; const float* ps = a.in[10]; const float* wpo = a.in[11]; bf16_t* WE = (bf16_t*)(ws + WS_WEFF);
        const int g = F.vcu >> 6, nb = (F.vcu & 63) * 16; LAS float* wgt = (LAS float*)(F.lds + RING_OFF);
        for (int i = F.tid; i < 128 * 128; i += NWAVES * 64) { const int cc = i >> 7, d = i & 127; wgt[d * 128 + cc] = wg[(size_t)g * 16384 + i]; }
        __syncthreads();
        const int cc = F.tid & 127, nq = (F.tid >> 7) * 4; float acc4[4] = {0.f, 0.f, 0.f, 0.f};
        for (int d = 0; d < 128; ++d) { const float wv = wgt[d * 128 + cc] * ps[g * 128 + d]; const float* wr = wpo + (size_t)(g * 128 + d) * D + nb + nq;
#pragma unroll
            for (int j = 0; j < 4; ++j) acc4[j] += wv * wr[j]; }
#pragma unroll
        for (int j = 0; j < 4; ++j) WE[(size_t)(nb + nq + j) * PW + g * 128 + cc] = (bf16_t)f2bf(acc4[j]);
    }
    __syncthreads();
    { const float* w_ada = a.in[2]; float* MODP = (float*)(ws + WS_MODP);
      for (int it = gw; it < 96 * 8; it += NGW) { const int cg = it % 96, ks = it / 96;
          const float* w = w_ada + (size_t)(ks * 128) * (6 * D) + cg * 64 + lane;
          float a0 = 0.f, a1 = 0.f, a2 = 0.f, a3 = 0.f;
#pragma unroll 8
          for (int k = 0; k < 128; ++k) { const float wv = w[(size_t)k * (6 * D)]; const int kk = ks * 128 + k;
              a0 += silu[kk] * wv; a1 += silu[D + kk] * wv; a2 += silu[2 * D + kk] * wv; a3 += silu[3 * D + kk] * wv; }
          float* o = MODP + (size_t)ks * 4 * 6 * D + cg * 64 + lane;
          o[0] = a0; o[6 * D] = a1; o[12 * D] = a2; o[18 * D] = a3; } }
    __syncthreads();
    titem_run(F, a, false, 16 * 128 + 8 * 32 + 16 * 32 + 2 * 64 * 64 + 2 * 16 * 8, gw, NGW);
    { const float* wr = a.in[14]; bf16_t* WH = (bf16_t*)(ws + WS_WRH); bf16_t* WL = (bf16_t*)(ws + WS_WRL);
      for (int i = (F.vcu * NWAVES * 64 + F.tid); i < D * NE; i += F.G * NWAVES * 64) { const int e = i >> 10, k = i & 1023; const float v = wr[k * NE + e];
          const int pos = ((((k >> 4) * 2 + (e >> 5)) * 64) + 32 * ((k >> 3) & 1) + (e & 31)) * 8 + (k & 7);
          const unsigned h = f2bf(v); WH[pos] = (bf16_t)h; WL[pos] = (bf16_t)f2bf(v - bf2f(h)); } }
}
__device__ __forceinline__ void p0b(Frame& F, const Args& a) {
    unsigned char* ws = a.ws; const float* MODP = (const float*)(ws + WS_MODP); const float* b_ada = a.in[3];
    if (F.tid < 96) { const int idx = 96 * F.vcu + F.tid, b = idx / (6 * D), j = idx % (6 * D); float v = b_ada[j];
#pragma unroll
        for (int ks = 0; ks < 8; ++ks) v += MODP[(size_t)(ks * 4 + b) * 6 * D + j];
        ((float*)(ws + WS_MOD))[idx] = v; }
    const int rows_per = M / F.G, r0 = F.vcu * rows_per, b = r0 / SEQ;
    LAS float* gsv = (LAS float*)(F.lds + RING_OFF); LAS float* shv = gsv + D;
    for (int k = F.tid; k < D; k += NWAVES * 64) { float sh = b_ada[k], sc = b_ada[D + k];
#pragma unroll
        for (int ks = 0; ks < 8; ++ks) { sh += MODP[(size_t)(ks * 4 + b) * 6 * D + k]; sc += MODP[(size_t)(ks * 4 + b) * 6 * D + D + k]; }
        gsv[k] = a.in[4][k] * (1.f + sc); shv[k] = sh; }
    __syncthreads();
    const float* x = a.in[0]; bf16_t* XN = (bf16_t*)(ws + WS_XN);
    for (int i = F.wave; i < rows_per; i += NWAVES) { const int row = r0 + i;
        const GAS f32x4* xr = (const GAS f32x4*)(x + (size_t)row * D) + F.lane;
        f32x4 v[4]; float s = 0.f;
#pragma unroll
        for (int j = 0; j < 4; ++j) { v[j] = xr[64 * j]; s += (v[j].x * v[j].x + v[j].y * v[j].y) + (v[j].z * v[j].z + v[j].w * v[j].w); }
        const float r = rsqrtf(wave_sum(s) * (1.f / D) + EPS);
        GAS unsigned long long* o8 = (GAS unsigned long long*)(XN + (size_t)row * D) + F.lane;
#pragma unroll
        for (int j = 0; j < 4; ++j) { const f32x4 gg = *(const LAS f32x4*)(gsv + 4 * F.lane + 256 * j), ss = *(const LAS f32x4*)(shv + 4 * F.lane + 256 * j);
            const f32x4 h = v[j] * r * gg + ss;
            o8[64 * j] = (unsigned long long)pk2(h.x, h.y) | ((unsigned long long)pk2(h.z, h.w) << 32); } }
    __syncthreads();
}

namespace sb {
using pg8::bf16x8; using pg8::f32x4; typedef float f32x16 __attribute__((ext_vector_type(16))); typedef short v4i16_t __attribute__((ext_vector_type(4)));
typedef short s16x4 __attribute__((ext_vector_type(4)));
constexpr int VPITCH = 128, VBYTES = 64 * VPITCH, WAVE_LDS = 2 * VBYTES;
constexpr float EXIT_THR = -152.f;
__device__ __forceinline__ int crow(int r, int hi) { return (r & 3) + 8 * (r >> 2) + 4 * hi; }
__device__ __forceinline__ s16x4 vtr(LAS const unsigned char* p) { return __builtin_bit_cast(s16x4, __builtin_amdgcn_ds_read_tr16_b64_v4i16((LAS v4i16_t*)p)); }
__device__ __forceinline__ unsigned pkbf(float lo, float hi) { return pg8::cvt_pk_bf16(lo, hi); }

__device__ __forceinline__ void attn_unit(int b, int h, int qb, const bf16_t* Q, const bf16_t* K, const bf16_t* V, bf16_t* O, LAS unsigned char* vlds, int wid, int lane) {
    const int r32 = lane & 31, hi = lane >> 5;
    const int t0 = qb * 256 + wid * 32;
    const size_t rowbase = (size_t)b * SEQ;
    const bf16_t* Kh = K + rowbase * 512 + h * 64; const bf16_t* Vh = V + rowbase * 512 + h * 64;
    bf16x8 qr[4];
#pragma unroll
    for (int d0 = 0; d0 < 4; ++d0) qr[d0] = *(const bf16x8*)(Q + (rowbase + t0 + r32) * 512 + h * 64 + d0 * 16 + hi * 8);
    f32x16 o0 = {}, o1 = {};
    float carry = 0.f;
    int kt = t0 >> 6;
    bf16x8 kf[8];
#define SB_LOADK(KT) do { const int kb_ = (KT) * 64; \
        _Pragma("unroll") for (int d0 = 0; d0 < 4; ++d0) { kf[2 * d0] = *(const bf16x8*)(Kh + (size_t)(kb_ + r32) * 512 + d0 * 16 + hi * 8); kf[2 * d0 + 1] = *(const bf16x8*)(Kh + (size_t)(kb_ + 32 + r32) * 512 + d0 * 16 + hi * 8); } } while (0)
#define SB_DMAV(KT, BUF) do { const int kb_ = (KT) * 64; \
        _Pragma("unroll") for (int i = 0; i < 8; ++i) __builtin_amdgcn_global_load_lds((const unsigned*)(Vh + (size_t)(kb_ + 8 * i + (lane >> 3)) * 512 + (lane & 7) * 8), (LAS unsigned*)(vlds + (BUF) * VBYTES + i * 1024), 16, 0, 0); } while (0)
    int cur = 0;
    SB_DMAV(kt, 0);
    SB_LOADK(kt);
    const int trbase = (4 * hi + ((lane & 15) >> 2)) * VPITCH + (16 * ((lane >> 4) & 1) + 4 * (lane & 3)) * 2;
    bool diag = true;
    for (;; --kt) {
        const int kbase = kt * 64;
        f32x16 p0 = {}, p1 = {};
#pragma unroll
        for (int d0 = 0; d0 < 4; ++d0) { p0 = __builtin_amdgcn_mfma_f32_32x32x16_bf16(kf[2 * d0], qr[d0], p0, 0, 0, 0); p1 = __builtin_amdgcn_mfma_f32_32x32x16_bf16(kf[2 * d0 + 1], qr[d0], p1, 0, 0, 0); }
        asm volatile("" ::: "memory");
        if (kt > 0) { SB_DMAV(kt - 1, cur ^ 1); SB_LOADK(kt - 1); }
        asm volatile("" ::: "memory");
        bf16x8 pa[4]; float suf = 0.f;
        const int qrel = t0 + r32 - kbase;
#define SB_HALF(P, KOFF, PA0, PA1) do { f32x16 sp_; \
        _Pragma("unroll") for (int r = 0; r < 16; ++r) sp_[r] = __builtin_amdgcn_logf(1.f + __builtin_amdgcn_exp2f(P[r])); \
        if (diag) { _Pragma("unroll") for (int r = 0; r < 16; ++r) if (crow(r, hi) + (KOFF) >= qrel) sp_[r] = 0.f; } \
        float e_[4], og_[4], R_[4]; \
        _Pragma("unroll") for (int c = 0; c < 4; ++c) { sp_[4 * c + 2] += sp_[4 * c + 3]; sp_[4 * c + 1] += sp_[4 * c + 2]; sp_[4 * c] += sp_[4 * c + 1]; e_[c] = sp_[4 * c]; } \
        _Pragma("unroll") for (int c = 0; c < 4; ++c) og_[c] = __shfl_xor(e_[c], 32); \
        _Pragma("unroll") for (int c = 3; c >= 0; --c) { R_[c] = carry - (suf + (hi == 0 ? og_[c] : 0.f)); suf += e_[c] + og_[c]; } \
        _Pragma("unroll") for (int r = 0; r < 16; ++r) P[r] = __builtin_amdgcn_exp2f(P[r] - sp_[r] + R_[r >> 2]); \
        if (diag) { _Pragma("unroll") for (int r = 0; r < 16; ++r) if (crow(r, hi) + (KOFF) >= qrel) P[r] = 0.f; } \
        pg8::u32x4 w_; w_.x = pkbf(P[0], P[1]); w_.y = pkbf(P[2], P[3]); w_.z = pkbf(P[4], P[5]); w_.w = pkbf(P[6], P[7]); PA0 = __builtin_bit_cast(bf16x8, w_); \
        w_.x = pkbf(P[8], P[9]); w_.y = pkbf(P[10], P[11]); w_.z = pkbf(P[12], P[13]); w_.w = pkbf(P[14], P[15]); PA1 = __builtin_bit_cast(bf16x8, w_); } while (0)
        SB_HALF(p1, 32, pa[2], pa[3]);
        SB_HALF(p0, 0, pa[0], pa[1]);
#undef SB_HALF
        carry -= suf;
        diag = false;
        if (kt > 0) asm volatile("s_waitcnt vmcnt(16)" ::: "memory"); else asm volatile("s_waitcnt vmcnt(0)" ::: "memory");
        LAS const unsigned char* vb = vlds + cur * VBYTES + trbase;
#pragma unroll
        for (int s = 0; s < 4; ++s) {
            LAS const unsigned char* vp = vb + (16 * s) * VPITCH;
            const s16x4 a0 = vtr(vp), a1 = vtr(vp + 8 * VPITCH), b0 = vtr(vp + 64), b1 = vtr(vp + 8 * VPITCH + 64);
            const bf16x8 v0 = {a0[0], a0[1], a0[2], a0[3], a1[0], a1[1], a1[2], a1[3]}, v1 = {b0[0], b0[1], b0[2], b0[3], b1[0], b1[1], b1[2], b1[3]};
            o0 = __builtin_amdgcn_mfma_f32_32x32x16_bf16(pa[s], v0, o0, 0, 0, 0);
            o1 = __builtin_amdgcn_mfma_f32_32x32x16_bf16(pa[s], v1, o1, 0, 0, 0);
        }
        asm volatile("s_waitcnt lgkmcnt(0)" ::: "memory");
        cur ^= 1;
        if (kt == 0 || __all(carry < EXIT_THR)) break;
    }
    asm volatile("s_waitcnt vmcnt(0)" ::: "memory");
#undef SB_LOADK
#undef SB_DMAV
    bf16_t* Ow = O + (rowbase + t0) * 512 + h * 64 + r32;
#pragma unroll
    for (int r = 0; r < 16; ++r) { const int q = crow(r, hi); Ow[(size_t)q * 512] = (bf16_t)f2bf(o0[r]); Ow[(size_t)q * 512 + 32] = (bf16_t)f2bf(o1[r]); }
}
}

__device__ __forceinline__ void p2_pool(Frame& F, const bf16_t* U, bf16_t* MIX) {
    const int rows_per = M / F.G; const int col8 = F.lane, w = 2 << (col8 >> 4);
    for (int rb = F.wave * 8; rb < rows_per; rb += NWAVES * 8) { const int t0 = F.vcu * rows_per + rb;
        v4u ld[23];
#pragma unroll
        for (int i = 0; i < 23; ++i) ld[i] = *(const GAS v4u*)(U + ((long)(t0 - 15 + i)) * PW + col8 * 8);
#pragma unroll
        for (int r = 0; r < 8; ++r) { const int tl = (t0 + r) % SEQ; const int cnt = (tl + 1) < w ? (tl + 1) : w;
            float acc[8];
#pragma unroll
            for (int j = 0; j < 8; ++j) acc[j] = 0.f;
#pragma unroll
            for (int i = 0; i < 16; ++i) { const v4u u = ld[15 + r - i]; const float m = (i < cnt) ? 1.f : 0.f;
                acc[0] += m * bf2f(u.x & 0xffffu); acc[1] += m * bf2f(u.x >> 16); acc[2] += m * bf2f(u.y & 0xffffu); acc[3] += m * bf2f(u.y >> 16);
                acc[4] += m * bf2f(u.z & 0xffffu); acc[5] += m * bf2f(u.z >> 16); acc[6] += m * bf2f(u.w & 0xffffu); acc[7] += m * bf2f(u.w >> 16); }
            const float inv = 1.f / (float)cnt; const v4u self = ld[15 + r];
            v4u o; o.x = pk2(acc[0] * inv - bf2f(self.x & 0xffffu), acc[1] * inv - bf2f(self.x >> 16)); o.y = pk2(acc[2] * inv - bf2f(self.y & 0xffffu), acc[3] * inv - bf2f(self.y >> 16));
            o.z = pk2(acc[4] * inv - bf2f(self.z & 0xffffu), acc[5] * inv - bf2f(self.z >> 16)); o.w = pk2(acc[6] * inv - bf2f(self.w & 0xffffu), acc[7] * inv - bf2f(self.w >> 16));
            *(GAS v4u*)(MIX + (size_t)(t0 + r) * PW + col8 * 8) = o; } }
}

constexpr int P5_TAB = AUX_OFF + 2048;
constexpr int P5_CNT = AUX_OFF + 1024;
constexpr int LIST_CAP = 16384;
typedef float f32x16 __attribute__((ext_vector_type(16)));
__device__ __forceinline__ void p5_route(Frame& F, const Args& a) {
    unsigned char* ws = a.ws; const float* X1 = a.out; const float* g2 = a.in[13]; const float* mod = (const float*)(ws + WS_MOD); const float* rbias = a.in[15];
    bf16_t* H2 = (bf16_t*)(ws + WS_H2); int* PE = (int*)(ws + WS_PE);
    const bf16_t* WH = (const bf16_t*)(ws + WS_WRH); const bf16_t* WL = (const bf16_t*)(ws + WS_WRL);
    unsigned long long* LIST = (unsigned long long*)(ws + WS_LIST); gu32* gcnt = F.ctl + CW_CNT;
    LAS unsigned char* Ahi = F.lds + RING_OFF; LAS unsigned char* Alo = Ahi + 65536; LAS float* part = (LAS float*)Ahi;
    LAS float* gsv = (LAS float*)(F.lds + P5_TAB); LAS float* shv = gsv + D; LAS unsigned* cnt_l = (LAS unsigned*)(F.lds + P5_CNT); LAS unsigned* base_l = cnt_l + 64; LAS float* rr = (LAS float*)(base_l + 64);
    const int lane = F.lane, wave = __builtin_amdgcn_readfirstlane(F.wave), r32 = lane & 31, hi = lane >> 5;
    const int row0 = F.vcu * 64;
    if (row0 < M) {
        const int b = row0 / SEQ;
        for (int k = F.tid; k < D; k += NWAVES * 64) { gsv[k] = g2[k] * (1.f + mod[b * 6 * D + 4 * D + k]); shv[k] = mod[b * 6 * D + 3 * D + k]; }
        if (F.tid < 64) cnt_l[F.tid] = 0u;
        { f32x4 v[8][4];
#pragma unroll
          for (int i = 0; i < 8; ++i) { const GAS f32x4* xr = (const GAS f32x4*)(X1 + (size_t)(row0 + 8 * wave + i) * D) + lane;
#pragma unroll
              for (int j = 0; j < 4; ++j) v[i][j] = xr[64 * j]; }
#pragma unroll
          for (int i = 0; i < 8; ++i) { float s = 0.f;
#pragma unroll
              for (int j = 0; j < 4; ++j) s += (v[i][j].x * v[i][j].x + v[i][j].y * v[i][j].y) + (v[i][j].z * v[i][j].z + v[i][j].w * v[i][j].w);
              s = wave_sum(s); if (lane == 0) rr[8 * wave + i] = rsqrtf(s * (1.f / D) + EPS); } }
        __syncthreads();
        f32x16 acc[2][2];
        const char* whb = (const char*)WH + wave * 8192; const char* wlb = (const char*)WL + wave * 8192;
#pragma unroll
        for (int x = 0; x < 2; ++x)
#pragma unroll
            for (int y = 0; y < 2; ++y) acc[x][y] = f32x16{};
#pragma unroll
        for (int kh = 0; kh < 2; ++kh) {
            bf16x8 bh[4][2], bl[4][2];
#pragma unroll
            for (int s4 = 0; s4 < 4; ++s4)
#pragma unroll
                for (int t = 0; t < 2; ++t) { const int fo = kh * 65536 + (s4 * 2 + t) * 1024;
                    bh[s4][t] = *(const bf16x8*)(whb + fo + lane * 16); bl[s4][t] = *(const bf16x8*)(wlb + fo + lane * 16); }
#pragma unroll
            for (int i = 0; i < 8; ++i) { const int rl = 8 * wave + i, row = row0 + rl; const float r = rr[rl];
                if ((i & 1) == 0) __builtin_amdgcn_sched_barrier(0);
                const GAS f32x4* xr = (const GAS f32x4*)(X1 + (size_t)row * D + 512 * kh) + lane;
                GAS unsigned long long* o8 = (GAS unsigned long long*)(H2 + (size_t)row * D + 512 * kh) + lane;
#pragma unroll
                for (int j = 0; j < 2; ++j) { const f32x4 xv = xr[64 * j];
                    const f32x4 gg = *(const LAS f32x4*)(gsv + 512 * kh + 4 * lane + 256 * j), ss = *(const LAS f32x4*)(shv + 512 * kh + 4 * lane + 256 * j);
                    const f32x4 h = xv * r * gg + ss;
                    const unsigned p01 = pk2(h.x, h.y), p23 = pk2(h.z, h.w);
                    const unsigned long long hh = (unsigned long long)p01 | ((unsigned long long)p23 << 32);
                    o8[64 * j] = hh;
                    const unsigned long long ll = (unsigned long long)pk2(h.x - __builtin_bit_cast(float, p01 << 16), h.y - __builtin_bit_cast(float, p01 & 0xffff0000u))
                                                | ((unsigned long long)pk2(h.z - __builtin_bit_cast(float, p23 << 16), h.w - __builtin_bit_cast(float, p23 & 0xffff0000u)) << 32);
                    const int chunk = (lane >> 1) + 32 * j, off = rl * 1024 + ((chunk ^ (rl & 15)) << 4) + ((lane & 1) << 3);
                    *(LAS unsigned long long*)(Ahi + off) = hh; *(LAS unsigned long long*)(Alo + off) = ll; } }
            __syncthreads();
#pragma unroll
            for (int s4 = 0; s4 < 4; ++s4) { const int chunk = 8 * wave + 2 * s4 + hi;
                const bf16x8 bh0 = bh[s4][0], bh1 = bh[s4][1], bl0 = bl[s4][0], bl1 = bl[s4][1];
#pragma unroll
                for (int x = 0; x < 2; ++x) { const int rw = 32 * x + r32, off = rw * 1024 + ((chunk ^ (rw & 15)) << 4);
                    const bf16x8 ah = *(const LAS bf16x8*)(Ahi + off), al = *(const LAS bf16x8*)(Alo + off);
                    acc[x][0] = __builtin_amdgcn_mfma_f32_32x32x16_bf16(ah, bh0, acc[x][0], 0, 0, 0); acc[x][1] = __builtin_amdgcn_mfma_f32_32x32x16_bf16(ah, bh1, acc[x][1], 0, 0, 0);
                    acc[x][0] = __builtin_amdgcn_mfma_f32_32x32x16_bf16(al, bh0, acc[x][0], 0, 0, 0); acc[x][1] = __builtin_amdgcn_mfma_f32_32x32x16_bf16(al, bh1, acc[x][1], 0, 0, 0);
                    acc[x][0] = __builtin_amdgcn_mfma_f32_32x32x16_bf16(ah, bl0, acc[x][0], 0, 0, 0); acc[x][1] = __builtin_amdgcn_mfma_f32_32x32x16_bf16(ah, bl1, acc[x][1], 0, 0, 0); } }
            __syncthreads();
        }
#pragma unroll
        for (int x = 0; x < 2; ++x)
#pragma unroll
            for (int r = 0; r < 16; ++r) { const int rw = 32 * x + (r & 3) + 8 * (r >> 2) + 4 * hi; part[wave * 4096 + rw * 64 + r32] = acc[x][0][r]; part[wave * 4096 + rw * 64 + 32 + r32] = acc[x][1][r]; }
        __syncthreads();
        float scq[8];
#pragma unroll
        for (int q = 0; q < 8; ++q) { const int rl = wave + 8 * q; float logit = 0.f;
#pragma unroll
            for (int w = 0; w < 8; ++w) logit += part[w * 4096 + rl * 64 + lane];
            scq[q] = 1.f / (1.f + expf(-logit)); }
        __syncthreads();
        LAS float* scoreT = (LAS float*)(F.lds + RING_OFF);
#pragma unroll
        for (int q = 0; q < 8; ++q) scoreT[lane * 65 + wave + 8 * q] = scq[q];
        __syncthreads();
        if (wave == 0) {
            float sel[64];
#pragma unroll
            for (int e = 0; e < 64; ++e) sel[e] = scoreT[e * 65 + lane] + rbias[e];
            float gs[8];
#pragma unroll
            for (int g = 0; g < 8; ++g) { float m1 = sel[8 * g], m2 = -INFINITY;
#pragma unroll
                for (int j = 1; j < 8; ++j) { const float v = sel[8 * g + j]; const float lo = fminf(m1, v); m1 = fmaxf(m1, v); m2 = fmaxf(m2, lo); }
                gs[g] = m1 + m2; }
            unsigned gmask = 0u;
#pragma unroll
            for (int g = 0; g < 8; ++g) { int rk = 0;
#pragma unroll
                for (int h = 0; h < 8; ++h) if (h != g) rk += (gs[h] > gs[g] || (gs[h] == gs[g] && h < g)) ? 1 : 0;
                gmask |= (rk < 4) ? (1u << g) : 0u; }
#pragma unroll
            for (int e = 0; e < 64; ++e) sel[e] = ((gmask >> (e >> 3)) & 1u) ? sel[e] : -INFINITY;
            unsigned long long taken = 0ull; int ex[8]; float ws_[8]; float wsum = 0.f;
#pragma unroll
            for (int r = 0; r < TOPK; ++r) { float best = -INFINITY; int bi = 0;
#pragma unroll
                for (int e = 0; e < 64; ++e) { const bool c = !((taken >> e) & 1ull) && sel[e] > best; best = c ? sel[e] : best; bi = c ? e : bi; }
                taken |= 1ull << bi; ex[r] = bi; ws_[r] = scoreT[bi * 65 + lane]; wsum += ws_[r]; }
            const float wn = RSCALE / wsum;
#pragma unroll
            for (int r = 0; r < TOPK; ++r) { const unsigned pos = __hip_atomic_fetch_add(cnt_l + ex[r], 1u, __ATOMIC_RELAXED, __HIP_MEMORY_SCOPE_WORKGROUP);
                LAS unsigned* pk = (LAS unsigned*)(F.lds + RING_OFF + 32768) + (lane * 8 + r) * 4; pk[0] = (unsigned)ex[r]; pk[1] = pos; pk[2] = __builtin_bit_cast(unsigned, ws_[r] * wn); }
        }
        __syncthreads();
        if (F.tid < 64) base_l[F.tid] = __hip_atomic_fetch_add(gcnt + 64 * F.tid, cnt_l[F.tid], __ATOMIC_RELAXED, __HIP_MEMORY_SCOPE_AGENT);
        __syncthreads();
        { LAS const unsigned* pk = (LAS const unsigned*)(F.lds + RING_OFF + 32768) + F.tid * 4; const unsigned e = pk[0], pos = pk[1], wb = pk[2];
          const int pair = (row0 + (F.tid >> 3)) * 8 + (F.tid & 7);
          LIST[(size_t)e * LIST_CAP + base_l[e] + pos] = (unsigned long long)(unsigned)pair | ((unsigned long long)wb << 32);
          PE[pair] = (int)e; }
        __syncthreads();
    }
}

namespace pg8 {
struct UnitG { int kind, slot, nvalid, pm, pn, row0; const char* bptr; };
constexpr int P6_PRE = AUX_OFF + 1024;
constexpr int P6_ROWS = AUX_OFF + 2048;
struct SchedG {
    const LAS int* pre; const LAS int* cnts; const LAS int* cum; const char* wgu; const char* wsh; int G, c, nr, total;
    __device__ __forceinline__ bool next(int i, UnitG& u) const {
        const int idx = i * G + c; if (idx >= total) return false;
        if (idx < nr) { int e = (int)__builtin_popcountll(__ballot(pre[1 + (threadIdx.x & 63)] <= idx));
            e = __builtin_amdgcn_readfirstlane(e); const int j = idx - __builtin_amdgcn_readfirstlane(pre[e]); const int nv = __builtin_amdgcn_readfirstlane(cnts[e]) - 256 * j;
            u.kind = 0; u.slot = i; u.nvalid = nv < 256 ? nv : 256; u.pm = e; u.pn = j; u.row0 = 256 * idx; u.bptr = wgu + (size_t)e * 256 * D * 2; }
        else { const int s = idx - nr; u.kind = 1; u.slot = i; u.nvalid = 256; u.pm = s >> 1; u.pn = s & 1; u.row0 = (s >> 1) * 256; u.bptr = wsh + (size_t)(s & 1) * 256 * D * 2; }
        return true; }
};
struct EpiGU {
    static constexpr bool PERM = true;
    bf16_t* HM; bf16_t* SH; int* SLOT; const LAS unsigned long long* rowinfo;
    __device__ __forceinline__ void operator()(const f32x4 (&acc)[2][2][4][2], const UnitG& u, int wr, int wc, int fr, int fq) const {
#pragma unroll
        for (int ai = 0; ai < 2; ++ai)
#pragma unroll
            for (int m = 0; m < 4; ++m) { const int r = ai * HALF + wr * 64 + m * 16 + fr;
                bf16_t* dst; float w;
                if (u.kind == 0) { const unsigned long long ri = rowinfo[u.slot * 256 + r]; dst = HM + (size_t)(u.row0 + r) * ED + wc * 32 + 8 * fq; w = __builtin_bit_cast(float, (unsigned)(ri >> 32));
                    if (wc == 0 && fq == 0) SLOT[u.row0 + r] = (r < u.nvalid) ? (int)(unsigned)ri : M * 8; }
                else { dst = SH + (size_t)(u.pm * 256 + r) * SHD + u.pn * 128 + wc * 32 + 8 * fq; w = 1.f; }
                const f32x4 g0 = acc[ai][0][m][0], g1 = acc[ai][0][m][1], u0 = acc[ai][1][m][0], u1 = acc[ai][1][m][1];
                float v[8];
#pragma unroll
                for (int j = 0; j < 4; ++j) { v[j] = g0[j] * fsigmoid(g0[j]) * u0[j] * w; v[4 + j] = g1[j] * fsigmoid(g1[j]) * u1[j] * w; }
                u32x4 o; o.x = cvt_pk_bf16(v[0], v[1]); o.y = cvt_pk_bf16(v[2], v[3]); o.z = cvt_pk_bf16(v[4], v[5]); o.w = cvt_pk_bf16(v[6], v[7]);
                if (r < u.nvalid) *(u32x4*)dst = o; }
    }
};
template <class Epi, class Sched>
__device__ __forceinline__ void gemm_phase_g(PG8_LAS unsigned char* lds, const bf16_t* A, int K, const Sched& S, const Epi& E, const PG8_LAS unsigned long long* rowinfo) {
    int tid_ = threadIdx.x; asm volatile("" : "+v"(tid_));
    const int tid = tid_, wid = __builtin_amdgcn_readfirstlane(tid >> 6), lane = tid & 63, wr = wid >> 2, wc = wid & 3, fr = lane & 15, fq = lane >> 4;
    const int nt = K / BK;
    int RA[2], CA[2]; unsigned voffB[2];
#pragma unroll
    for (int i = 0; i < 2; ++i) { int R, C; stage_rc(tid * 16 + i * 8192, R, C); const int Rb = Epi::PERM ? ((R & ~31) + perm32(R & 31)) : R; RA[i] = R; CA[i] = C; voffB[i] = (unsigned)(Rb * K + C) * 2u; }
    const size_t kstep = (size_t)(BK * 2);
    const size_t hstep = (size_t)HALF * K * 2;
    const unsigned ldsw = (unsigned)wid * 1024u;
    const int aoff = lds_byte(wr * 64 + fr, fq * 8), boff = lds_byte(wc * 32 + fr, fq * 8);
#define PG8_AOFF(u, o0, o1) do { _Pragma("unroll") for (int _i = 0; _i < 2; ++_i) { unsigned r0_, r1_; \
        if ((u).kind == 0) { r0_ = (unsigned)rowinfo[(u).slot * 256 + RA[_i]] >> 3; r1_ = (unsigned)rowinfo[(u).slot * 256 + HALF + RA[_i]] >> 3; } \
        else { r0_ = (unsigned)((u).row0 + RA[_i]); r1_ = r0_ + HALF; } \
        o0[_i] = (r0_ * (unsigned)K + (unsigned)CA[_i]) * 2u; o1[_i] = (r1_ * (unsigned)K + (unsigned)CA[_i]) * 2u; } } while (0)
#define PG8_SA(b, h) (((b) * 2 + (h)) * HTB)
#define PG8_SB(b, h) ((4 + (b) * 2 + (h)) * HTB)
#define PG8_STAGE(bufoff, gbase, voff) do { _Pragma("unroll") for (int _i = 0; _i < 2; ++_i) \
        __builtin_amdgcn_global_load_lds((const unsigned*)((const char*)(gbase) + (voff)[_i]), (PG8_LAS unsigned*)(lds + (bufoff) + ldsw + _i * 8192), 16, 0, 0); } while (0)
#define PG8_LDA(dst, b, h) do { _Pragma("unroll") for (int m = 0; m < 4; ++m) _Pragma("unroll") for (int k = 0; k < 2; ++k) dst[m][k] = *(const PG8_LAS bf16x8*)(lds + PG8_SA(b, h) + aoff + m * 2048 + k * 1024); } while (0)
#define PG8_LDB(dst, b, h) do { _Pragma("unroll") for (int n = 0; n < 2; ++n) _Pragma("unroll") for (int k = 0; k < 2; ++k) dst[n][k] = *(const PG8_LAS bf16x8*)(lds + PG8_SB(b, h) + boff + n * 2048 + k * 1024); } while (0)
#define PG8_MMA(ai, bj, At, Bt) do { __builtin_amdgcn_s_setprio(1); _Pragma("unroll") for (int m = 0; m < 4; ++m) _Pragma("unroll") for (int n = 0; n < 2; ++n) _Pragma("unroll") for (int k = 0; k < 2; ++k) \
        acc[ai][bj][m][n] = __builtin_amdgcn_mfma_f32_16x16x32_bf16(Bt[n][k], At[m][k], acc[ai][bj][m][n], 0, 0, 0); __builtin_amdgcn_s_setprio(0); } while (0)
#define PG8_WAIT_V(n) asm volatile("s_waitcnt vmcnt(" #n ")" ::: "memory")
#define PG8_WAIT_L(n) asm volatile("s_waitcnt lgkmcnt(" #n ")" ::: "memory")
#define PG8_BAR __builtin_amdgcn_s_barrier()
#define PG8_SCHED __builtin_amdgcn_sched_barrier(0)
    UnitG cur, nxt; int ui = 0;
    if (!S.next(0, cur)) return;
    f32x4 acc[2][2][4][2];
#pragma unroll
    for (int a = 0; a < 2; ++a)
#pragma unroll
        for (int b = 0; b < 2; ++b)
#pragma unroll
            for (int m = 0; m < 4; ++m)
#pragma unroll
                for (int n = 0; n < 2; ++n) acc[a][b][m][n] = (f32x4){0.f, 0.f, 0.f, 0.f};
    bf16x8 At[4][2], B0[2][2], B1[2][2];
    const char* cA = (const char*)A; const char* cB = cur.bptr;
    unsigned vA0[2], vA1[2], nA0[2], nA1[2];
    PG8_AOFF(cur, vA0, vA1);
    PG8_STAGE(PG8_SB(0, 0), cB, voffB); PG8_STAGE(PG8_SB(0, 1), cB + hstep, voffB); PG8_STAGE(PG8_SA(0, 0), cA, vA0); PG8_STAGE(PG8_SA(0, 1), cA, vA1);
    if (wr == 1) PG8_BAR;
    PG8_WAIT_V(2); PG8_BAR;
    PG8_STAGE(PG8_SB(1, 0), cB + kstep, voffB); PG8_STAGE(PG8_SA(1, 0), cA + kstep, vA0); PG8_STAGE(PG8_SB(1, 1), cB + hstep + kstep, voffB);
    PG8_WAIT_V(6); PG8_BAR;
    for (;;) {
        const bool has_next = S.next(ui + 1, nxt);
        const char* nB = has_next ? nxt.bptr : cB;
        if (has_next) { PG8_AOFF(nxt, nA0, nA1); } else {
#pragma unroll
            for (int _i = 0; _i < 2; ++_i) { nA0[_i] = vA0[_i]; nA1[_i] = vA1[_i]; } }
#pragma nounroll
        for (int t = 0; t < nt; t += 2) {
            const bool last = (t == nt - 2);
            const char* a1 = cA + (size_t)(t + 1) * kstep;
            const char* a2 = last ? cA : cA + (size_t)(t + 2) * kstep; const char* b2 = last ? nB : cB + (size_t)(t + 2) * kstep;
            const char* a3 = a2 + kstep; const char* b3 = b2 + kstep;
            unsigned s0[2], s1[2];
#pragma unroll
            for (int _i = 0; _i < 2; ++_i) { s0[_i] = last ? nA0[_i] : vA0[_i]; s1[_i] = last ? nA1[_i] : vA1[_i]; }
            PG8_LDB(B0, 0, 0); PG8_LDB(B1, 0, 1); PG8_SCHED; PG8_LDA(At, 0, 0); PG8_STAGE(PG8_SA(1, 1), a1, vA1);
            PG8_WAIT_V(8); PG8_WAIT_L(0); PG8_BAR; PG8_MMA(0, 0, At, B0); PG8_MMA(0, 1, At, B1); PG8_BAR; PG8_SCHED;
            PG8_LDA(At, 0, 1); PG8_STAGE(PG8_SB(0, 0), b2, voffB); PG8_STAGE(PG8_SB(0, 1), b2 + hstep, voffB); PG8_STAGE(PG8_SA(0, 0), a2, s0);
            PG8_WAIT_V(8); PG8_WAIT_L(0); PG8_BAR; PG8_MMA(1, 0, At, B0); PG8_MMA(1, 1, At, B1); PG8_BAR; PG8_SCHED;
            PG8_LDB(B0, 1, 0); PG8_LDB(B1, 1, 1); PG8_SCHED; PG8_LDA(At, 1, 0); PG8_STAGE(PG8_SA(0, 1), a2, s1);
            PG8_WAIT_V(8); PG8_WAIT_L(0); PG8_BAR; PG8_MMA(0, 0, At, B0); PG8_MMA(0, 1, At, B1); PG8_BAR; PG8_SCHED;
            PG8_LDA(At, 1, 1); PG8_STAGE(PG8_SB(1, 0), b3, voffB); PG8_STAGE(PG8_SB(1, 1), b3 + hstep, voffB); PG8_STAGE(PG8_SA(1, 0), a3, s0);
            PG8_WAIT_V(8); PG8_WAIT_L(0); PG8_BAR; PG8_MMA(1, 0, At, B0); PG8_MMA(1, 1, At, B1); PG8_BAR; PG8_SCHED;
        }
        if (wr == 0) PG8_BAR;
        E(acc, cur, wr, wc, fr, fq);
        if (!has_next) break;
#pragma unroll
        for (int a = 0; a < 2; ++a)
#pragma unroll
            for (int b = 0; b < 2; ++b)
#pragma unroll
                for (int m = 0; m < 4; ++m)
#pragma unroll
                    for (int n = 0; n < 2; ++n) acc[a][b][m][n] = (f32x4){0.f, 0.f, 0.f, 0.f};
        cur = nxt; cB = nB; ++ui;
#pragma unroll
        for (int _i = 0; _i < 2; ++_i) { vA0[_i] = nA0[_i]; vA1[_i] = nA1[_i]; }
        if (wr == 1) PG8_BAR;
    }
    PG8_WAIT_V(0);
    PG8_BAR;
#undef PG8_AOFF
#undef PG8_SA
#undef PG8_SB
#undef PG8_STAGE
#undef PG8_LDA
#undef PG8_LDB
#undef PG8_MMA
#undef PG8_WAIT_V
#undef PG8_WAIT_L
#undef PG8_BAR
#undef PG8_SCHED
}
}

__device__ __forceinline__ void p6_gateup(Frame& F, const Args& a) {
    unsigned char* ws = a.ws; gu32* gcnt = F.ctl + CW_CNT; const unsigned long long* LIST = (const unsigned long long*)(ws + WS_LIST);
    LAS int* pre = (LAS int*)(F.lds + pg8::P6_PRE); LAS int* cnts = pre + 65; LAS int* cum = cnts + 64; LAS unsigned long long* rowinfo = (LAS unsigned long long*)(F.lds + pg8::P6_ROWS);
    if (F.tid < 64) cnts[F.tid] = (int)__hip_atomic_load(gcnt + 64 * F.tid, RLX_AGENT);
    __syncthreads();
    if (F.tid == 0) { int s = 0, r = 0; for (int e = 0; e < 64; ++e) { pre[e] = s; cum[e] = r; s += (cnts[e] + 255) >> 8; r += cnts[e]; } pre[64] = s; cum[64] = r; }
    __syncthreads();
    pg8::SchedG S; S.pre = pre; S.cnts = cnts; S.cum = cum; S.wgu = (const char*)(ws + WS_WGU); S.wsh = (const char*)(ws + WS_WSHGU); S.G = F.G; S.c = (int)blockIdx.x; S.nr = __builtin_amdgcn_readfirstlane(pre[64]); S.total = S.nr + 2 * (M / 256);
    for (int i = 0; i < 3; ++i) { pg8::UnitG u; if (!S.next(i, u)) break;
        if (u.kind == 0 && F.tid < 256) { const int r = F.tid; rowinfo[i * 256 + r] = (r < u.nvalid) ? LIST[(size_t)u.pm * LIST_CAP + 256 * u.pn + r] : 0ull; } }
    __syncthreads();
    pg8::EpiGU E{(bf16_t*)(ws + WS_HM), (bf16_t*)(ws + WS_SH), (int*)(ws + WS_SLOT), rowinfo};
    pg8::gemm_phase_g<pg8::EpiGU, pg8::SchedG>(F.lds + RING_OFF, (const bf16_t*)(ws + WS_H2), D, S, E, rowinfo);
    { const int rounds = (S.total + F.G - 1) / F.G, firstidle = S.total - (rounds - 1) * F.G;
      const int c = (int)blockIdx.x, nidle = F.G - firstidle;
      if (nidle > 0) { if (c >= firstidle) titem_run(F, a, true, 64 * 64 + 4 * 32, (c - firstidle) * NWAVES + F.wave, nidle * NWAVES); }
      else titem_run(F, a, true, 64 * 64 + 4 * 32, c * NWAVES + F.wave, F.G * NWAVES); }
}

namespace pg8 {
struct SchedYr {
    const LAS int* pre; int G, c, total;
    __device__ __forceinline__ bool next(int i, Unit& u) const {
        const int idx = i * G + c; if (idx >= total) return false;
        const int t = idx >> 2, pnl = idx & 3; int e = (int)__builtin_popcountll(__ballot(pre[1 + (threadIdx.x & 63)] <= t));
        e = __builtin_amdgcn_readfirstlane(e); u.pm = t; u.pn = 4 * e + pnl; return true; }
    __device__ __forceinline__ void a_ready(const Unit&) const {}
    __device__ __forceinline__ void done(const Unit&) const {}
};
constexpr float YSCALE = 8.f;
struct EpiStoreF8 {
    static constexpr bool PERM = true, AFTER_DRAIN = false;
    unsigned char* O; const PG8_LAS int* rowmap_l; int G, c;
    __device__ __forceinline__ void operator()(const f32x4 (&acc)[2][2][4][2], const Unit& u, int wr, int wc, int fr, int fq) const {
        const int slot = (4 * u.pm + (u.pn & 3) - c) / G; const PG8_LAS int* rm = rowmap_l + slot * 256 + wr * 64 + fr; const int col0 = (u.pn & 3) * BM + wc * 32 + 8 * fq;
#pragma unroll
        for (int ai = 0; ai < 2; ++ai)
#pragma unroll
            for (int m = 0; m < 4; ++m) { const int orow = rm[ai * HALF + m * 16]; unsigned char* rowp = O + (size_t)orow * 1024 + col0;
#pragma unroll
                for (int bj = 0; bj < 2; ++bj) { const f32x4 v0 = acc[ai][bj][m][0] * YSCALE, v1 = acc[ai][bj][m][1] * YSCALE;
                    unsigned lo = 0u, hi = 0u;
                    lo = __builtin_amdgcn_cvt_pk_fp8_f32(v0[0], v0[1], lo, false); lo = __builtin_amdgcn_cvt_pk_fp8_f32(v0[2], v0[3], lo, true);
                    hi = __builtin_amdgcn_cvt_pk_fp8_f32(v1[0], v1[1], hi, false); hi = __builtin_amdgcn_cvt_pk_fp8_f32(v1[2], v1[3], hi, true);
                    *(unsigned long long*)(rowp + bj * HALF) = (unsigned long long)lo | ((unsigned long long)hi << 32); } }
    }
};
struct EpiStore {
    static constexpr bool PERM = true, AFTER_DRAIN = false;
    bf16_t* O; int ldc, colmask;
    __device__ __forceinline__ void operator()(const f32x4 (&acc)[2][2][4][2], const Unit& u, int wr, int wc, int fr, int fq) const {
        const int row0 = u.pm * BM + wr * 64 + fr, col0 = (u.pn & colmask) * BM + wc * 32 + 8 * fq;
#pragma unroll
        for (int ai = 0; ai < 2; ++ai)
#pragma unroll
            for (int m = 0; m < 4; ++m) { bf16_t* rowp = O + (size_t)(row0 + ai * HALF + m * 16) * ldc + col0;
#pragma unroll
                for (int bj = 0; bj < 2; ++bj) { const f32x4 v0 = acc[ai][bj][m][0], v1 = acc[ai][bj][m][1];
                    u32x4 w; w.x = cvt_pk_bf16(v0[0], v0[1]); w.y = cvt_pk_bf16(v0[2], v0[3]); w.z = cvt_pk_bf16(v1[0], v1[1]); w.w = cvt_pk_bf16(v1[2], v1[3]);
                    *(u32x4*)(rowp + bj * HALF) = w; } }
    }
};
}
__device__ __forceinline__ void p7_down(Frame& F, const Args& a) {
    unsigned char* ws = a.ws; gu32* gcnt = F.ctl + CW_CNT;
    LAS int* pre = (LAS int*)(F.lds + pg8::P6_PRE); LAS int* cnts = pre + 65;
    if (F.tid < 64) cnts[F.tid] = (int)__hip_atomic_load(gcnt + 64 * F.tid, RLX_AGENT);
    __syncthreads();
    if (F.tid == 0) { int s = 0; for (int e = 0; e < 64; ++e) { pre[e] = s; s += (cnts[e] + 255) >> 8; } pre[64] = s; }
    __syncthreads();
    { pg8::SchedYr S; S.pre = pre; S.G = F.G; S.c = (int)blockIdx.x; S.total = 4 * __builtin_amdgcn_readfirstlane(pre[64]);
      int kk = ED; asm volatile("" : "+s"(kk));
      LAS int* rml = (LAS int*)(F.lds + AUX_OFF + 2048); const int* rowmap = (const int*)(ws + WS_SLOT);
      for (int i = 0; i * F.G + S.c < S.total && i < 12; ++i) { if (F.tid < 256) rml[i * 256 + F.tid] = rowmap[256 * ((i * F.G + S.c) >> 2) + F.tid]; }
      __syncthreads();
      pg8::Gemm g{(const bf16_t*)(ws + WS_HM), (const bf16_t*)(ws + WS_WD), 0, 0, kk}; pg8::EpiStoreF8 E{ws + WS_YH, rml, F.G, S.c};
      pg8::gemm_phase<pg8::EpiStoreF8, pg8::SchedYr, true, true>(F.lds + RING_OFF, g, S, E); }
    { pg8::StaticOrder S; S.init(M, D, F.G, (int)blockIdx.x);
      int kk = SHD; asm volatile("" : "+s"(kk));
      pg8::Gemm g{(const bf16_t*)(ws + WS_SH), (const bf16_t*)(ws + WS_WSHD), M, D, kk}; pg8::EpiStore E{(bf16_t*)(ws + WS_YSH), D, 3};
      pg8::gemm_phase<pg8::EpiStore, pg8::StaticOrder, true, true>(F.lds + RING_OFF, g, S, E); }
}
__device__ __forceinline__ void p8_combine(Frame& F, const Args& a) {
    unsigned char* ws = a.ws; const unsigned char* Y8 = ws + WS_YH; const bf16_t* YSH = (const bf16_t*)(ws + WS_YSH);
    const float* mod = (const float*)(ws + WS_MOD); float* OUT = a.out; const int lane = F.lane;
    for (int tb = (F.vcu * NWAVES + F.wave) * 8; tb < M; tb += F.G * NWAVES * 8) {
        const int b = tb / SEQ; const float* gate = mod + (size_t)b * 6 * D + 5 * D + lane * 16;
        f32x4 gv[4];
#pragma unroll
        for (int i = 0; i < 4; ++i) gv[i] = *(const f32x4*)(gate + 4 * i);
#pragma nounroll
        for (int i = 0; i < 8; i += 2) {
            v4u y[2][8], ys[2][2]; f32x4 x[2][4];
#pragma unroll
            for (int q = 0; q < 2; ++q) { const int t = tb + i + q;
#pragma unroll
                for (int k = 0; k < 8; ++k) y[q][k] = *(const GAS v4u*)(Y8 + ((size_t)t * 8 + k) * 1024 + lane * 16);
                const GAS v4u* sp = (const GAS v4u*)(YSH + (size_t)t * D + lane * 16); ys[q][0] = sp[0]; ys[q][1] = sp[1];
                const GAS f32x4* o = (const GAS f32x4*)(OUT + (size_t)t * D + lane * 16);
#pragma unroll
                for (int j = 0; j < 4; ++j) x[q][j] = o[j]; }
#pragma unroll
            for (int q = 0; q < 2; ++q) { const int t = tb + i + q; float acc[16];
#pragma unroll
                for (int j = 0; j < 16; ++j) acc[j] = 0.f;
#pragma unroll
                for (int k = 0; k < 8; ++k) { const unsigned w4[4] = {y[q][k].x, y[q][k].y, y[q][k].z, y[q][k].w};
#pragma unroll
                    for (int j = 0; j < 4; ++j) { const pg8::f32x2_t lo = __builtin_amdgcn_cvt_pk_f32_fp8((int)w4[j], false), hi = __builtin_amdgcn_cvt_pk_f32_fp8((int)w4[j], true);
                        acc[4 * j] += lo.x; acc[4 * j + 1] += lo.y; acc[4 * j + 2] += hi.x; acc[4 * j + 3] += hi.y; } }
                GAS f32x4* o = (GAS f32x4*)(OUT + (size_t)t * D + lane * 16);
#pragma unroll
                for (int j = 0; j < 4; ++j) { const unsigned s0 = (j < 2 ? ys[q][0] : ys[q][1])[2 * (j & 1)], s1 = (j < 2 ? ys[q][0] : ys[q][1])[2 * (j & 1) + 1];
                    const f32x4 sh = {bf2f(s0 & 0xffffu), bf2f(s0 >> 16), bf2f(s1 & 0xffffu), bf2f(s1 >> 16)};
                    const f32x4 rt = {acc[4 * j], acc[4 * j + 1], acc[4 * j + 2], acc[4 * j + 3]};
                    o[j] = x[q][j] + gv[j] * (rt * (1.f / pg8::YSCALE) + sh); } }
        }
    }
}

__global__ void __launch_bounds__(NWAVES * 64, 2) mk_fwd(Args args) {
    extern __shared__ __attribute__((aligned(16))) unsigned char lds[];
    Frame F;
    F.lds = (LAS unsigned char*)lds; F.MISC = (volatile LAS unsigned*)(F.lds + MISC_OFF);
    F.tid = threadIdx.x; F.lane = F.tid & 63; F.wave = __builtin_amdgcn_readfirstlane(F.tid >> 6);
    F.G = gridDim.x; { const int bx = blockIdx.x; F.vcu = (F.G % 8 == 0) ? (bx % 8) * (F.G / 8) + bx / 8 : bx; }
    unsigned char* ws = args.ws; F.ctl = (gu32*)(ws + WS_CTL);
    for (int u = F.tid; u < (LDS_BYTES - LDSCTL_OFF) / 4; u += NWAVES * 64) ((LAS unsigned*)(F.lds + LDSCTL_OFF))[u] = 0u;
    __syncthreads();
    XcdBarrier bar; bar.bar = (unsigned*)(F.ctl + CW_BAR); bar.x = 0; bar.st = nullptr;
    if (args.use_bar) bar = xcd_barrier_post((unsigned*)(F.ctl + CW_BAR), F.MISC + 8);
    const int lo = args.ph_lo, hi = args.ph_hi;
#define IN(k) (lo <= (k) && (k) < hi)
#define SEAM(k) do { if (IN(k) && IN((k) + 1)) xcd_barrier(bar); } while (0)
#define PHASE(p, ...) do { if (IN(p)) { const int reps_ = (DBL_PHASE == (p)) ? 2 : 1; for (int rep_ = 0; rep_ < reps_; ++rep_) { __VA_ARGS__; if (rep_ + 1 < reps_) xcd_barrier(bar); } } SEAM(p); } while (0)
    PHASE(0, p0a(F, args));
    PHASE(1, p0b(F, args));
    PHASE(2, {
        pg8::Gemm g{(const bf16_t*)(ws + WS_XN), (const bf16_t*)(ws + WS_WIN), M, INW, D}; pg8::StaticOrder S; S.init(M, INW, F.G, (int)blockIdx.x);
        pg8::EpiProj E{(bf16_t*)(ws + WS_Q), (bf16_t*)(ws + WS_K), (bf16_t*)(ws + WS_V), (bf16_t*)(ws + WS_U), (bf16_t*)(ws + WS_GA), (bf16_t*)(ws + WS_GB), args.in[6], args.in[7]};
        pg8::gemm_phase<pg8::EpiProj, pg8::StaticOrder, true, true>(F.lds + RING_OFF, g, S, E); });
    PHASE(3, {
        const bf16_t* Q = (const bf16_t*)(ws + WS_Q); const bf16_t* K = (const bf16_t*)(ws + WS_K); const bf16_t* V = (const bf16_t*)(ws + WS_V);
        for (int u = blockIdx.x; u < BATCH * NH * (SEQ / 256); u += F.G) { const int qb = u & 15, bh = u >> 4;
            sb::attn_unit(bh >> 3, bh & 7, qb, Q, K, V, (bf16_t*)(ws + WS_OSB), F.lds + RING_OFF + F.wave * sb::WAVE_LDS, F.wave, F.lane); }
        p2_pool(F, (const bf16_t*)(ws + WS_U), (bf16_t*)(ws + WS_MIX)); });
    PHASE(4, {
        pg8::StaticOrder S; S.init(M, D, F.G, (int)blockIdx.x);
        { pg8::Gemm g{(const bf16_t*)(ws + WS_OSB), (const bf16_t*)(ws + WS_WSB), M, D, SBW}; pg8::EpiMerge E{(const bf16_t*)(ws + WS_GA), (bf16_t*)(ws + WS_MERGED), 0};
          pg8::gemm_phase<pg8::EpiMerge, pg8::StaticOrder, true, true>(F.lds + RING_OFF, g, S, E); }
        { pg8::Gemm g{(const bf16_t*)(ws + WS_MIX), (const bf16_t*)(ws + WS_WEFF), M, D, PW}; pg8::EpiMerge E{(const bf16_t*)(ws + WS_GB), (bf16_t*)(ws + WS_MERGED), 1};
          pg8::gemm_phase<pg8::EpiMerge, pg8::StaticOrder, true, true>(F.lds + RING_OFF, g, S, E); } });
    PHASE(5, {
        pg8::Gemm g{(const bf16_t*)(ws + WS_MERGED), (const bf16_t*)(ws + WS_WOUT), M, D, D}; pg8::StaticOrder S; S.init(M, D, F.G, (int)blockIdx.x);
        pg8::EpiX1 E{args.in[0], (const float*)(ws + WS_MOD) + 2 * D, args.out};
        pg8::gemm_phase<pg8::EpiX1, pg8::StaticOrder, true, true>(F.lds + RING_OFF, g, S, E); });
    PHASE(6, {
        if (rep_ > 0) { if (blockIdx.x == 0 && F.tid < 64) __hip_atomic_store(F.ctl + CW_CNT + 64 * F.tid, 0u, RLX_AGENT); xcd_barrier(bar); }
        p5_route(F, args); });
    PHASE(7, p6_gateup(F, args));
    PHASE(8, p7_down(F, args));
    if (IN(9)) { p8_combine(F, args); }
#undef PHASE
#undef IN
#undef SEAM
}
constexpr int N_PHASES = 10;
extern "C" void kernel_launch(void* const* d_in, const int* in_sizes, int n_in, void* d_out, int out_size, void* d_ws, size_t ws_size, hipStream_t stream) {
    static int grid = 0;
    if (grid == 0) {
        if (n_in != 22 || out_size != M * D || ws_size < WS_END) { fprintf(stderr, "kernel_launch: unexpected shapes n_in %d out %d ws %zu\n", n_in, out_size, ws_size); grid = -1; return; }
        int dev = 0, cus = 0, per_cu = 0;
        if (hipGetDevice(&dev) != hipSuccess || hipDeviceGetAttribute(&cus, hipDeviceAttributeMultiprocessorCount, dev) != hipSuccess) { grid = -1; return; }
        if (hipFuncSetAttribute((const void*)mk_fwd, hipFuncAttributeMaxDynamicSharedMemorySize, LDS_BYTES) != hipSuccess) { fprintf(stderr, "kernel_launch: hipFuncSetAttribute failed\n"); grid = -1; return; }
        if (hipOccupancyMaxActiveBlocksPerMultiprocessor(&per_cu, (const void*)mk_fwd, NWAVES * 64, LDS_BYTES) != hipSuccess || per_cu < 1) fprintf(stderr, "kernel_launch: occupancy query says %d per CU\n", per_cu);
        (void)hipGetLastError();
        grid = cus;
        if (grid * 64 < M) { fprintf(stderr, "kernel_launch: %d CUs cannot cover %d rows in the one-block-per-workgroup phases\n", cus, M); grid = -1; return; }
    }
    if (grid < 0) return;
    unsigned char* ws = (unsigned char*)d_ws;
    if (hipMemsetAsync(ws + WS_CTL, 0, CTL_ZERO_BYTES, stream) != hipSuccess) { fprintf(stderr, "kernel_launch: memset failed\n"); return; }
    Args a{};
    for (int i = 0; i < 22; ++i) a.in[i] = (const float*)d_in[i];
    a.out = (float*)d_out; a.ws = ws; a.ph_lo = 0; a.ph_hi = N_PHASES; a.use_bar = 1;
    hipLaunchKernelGGL(mk_fwd, dim3(grid), dim3(NWAVES * 64), LDS_BYTES, stream, a);
}
```

```cpp
#include <hip/hip_runtime.h>
#include <cstdint>
#include <cstdio>

typedef unsigned short bf16_t;
constexpr int D = 1024, BATCH = 4, SEQ = 4096, M = BATCH * SEQ, NH = 8, HD = 64, SBW = 512, PW = 512, INW = 4096;
constexpr int NE = 64, ED = 128, TOPK = 8, SHD = 256;
constexpr float EPS = 1e-6f, RSCALE = 2.5f;

constexpr size_t MiB = 1u << 20;
constexpr size_t WS_CTL = 0, WS_MOD = 1 * MiB, WS_PE = 2 * MiB, WS_PW = 3 * MiB, WS_LIST = 4 * MiB;
constexpr size_t WS_XN = 74 * MiB, WS_OSB = 74 * MiB, WS_MIX = 90 * MiB, WS_H2 = 74 * MiB;
constexpr size_t WS_Q = 106 * MiB, WS_K = 122 * MiB, WS_V = 138 * MiB, WS_MERGED = 106 * MiB;
constexpr size_t WS_SLOT = 190 * MiB, WS_SH = 192 * MiB, WS_HM = 200 * MiB;
constexpr size_t WS_YH = 12 * MiB, WS_YSH = 156 * MiB;
constexpr size_t WS_U = 154 * MiB, WS_GA = 170 * MiB, WS_GB = 202 * MiB, WS_END = 256 * MiB;

__device__ __forceinline__ unsigned f2bf(float f) { unsigned u = __builtin_bit_cast(unsigned, f); return (u + 0x7fffu + ((u >> 16) & 1u)) >> 16; }
__device__ __forceinline__ float bf2f(unsigned h) { return __builtin_bit_cast(float, h << 16); }
__device__ __forceinline__ float wave_sum(float v) {
#pragma unroll
    for (int o = 1; o < 64; o <<= 1) v += __shfl_xor(v, o);
    return v;
}
__device__ __forceinline__ float sigmoidf_(float v) { return 1.f / (1.f + __expf(-v)); }
__device__ __forceinline__ float siluf_(float v) { return v / (1.f + __expf(-v)); }

namespace pg8 {
#define PG8_LAS __attribute__((address_space(3)))
typedef short bf16x8 __attribute__((ext_vector_type(8)));
typedef float f32x4 __attribute__((ext_vector_type(4)));
typedef unsigned u32x4 __attribute__((ext_vector_type(4)));
constexpr int BM = 256, BK = 64, HALF = 128, HTB = HALF * BK * 2  , STAGE_BYTES = 8 * HTB, NXCD = 8, WGM = 8;

__host__ __device__ __forceinline__ int lds_byte(int r, int c) { const int st = (r >> 4) * 2 + (c >> 5), rr = r & 15, cc = c & 31, ob = rr * 64 + cc * 2; return st * 1024 + (ob ^ (((ob >> 9) & 1) << 5)); }
__host__ __device__ __forceinline__ void stage_rc(int b, int& R, int& C) { const int st = b / 1024, sb = b % 1024, swz = sb ^ (((sb >> 9) & 1) << 5); R = (st >> 1) * 16 + swz / 64; C = (st & 1) * 32 + (swz % 64) / 2; }
__host__ __device__ __forceinline__ int perm32(int rho) { const int n = rho >> 4, i = rho & 15; return 8 * (i >> 2) + 4 * n + (i & 3); }

struct Unit { int pm, pn; };
struct Gemm { const bf16_t* A; const bf16_t* Bt; int M, N, K; };

struct StaticOrder {
    int nM, nN, nwg, G, c;
    __host__ __device__ void init(int M_, int N_, int G_, int c_) { nM = M_ / BM; nN = N_ / BM; nwg = nM * nN; G = G_; c = c_; }
    __host__ __device__ bool next(int i, Unit& u) const {
        const long L = (long)i * G + c; if (L >= nwg) return false;
        int wgid = (int)L; { const int q = nwg / NXCD, r = nwg % NXCD, xcd = wgid % NXCD, off = wgid / NXCD; wgid = (xcd < r ? xcd * (q + 1) : r * (q + 1) + (xcd - r) * q) + off; }
        const int nig = WGM * nN, gid = wgid / nig, fm = gid * WGM, gsz = (nM - fm) < WGM ? (nM - fm) : WGM;
        u.pm = fm + ((wgid % nig) % gsz); u.pn = (wgid % nig) / gsz; return true;
    }
    __device__ __forceinline__ void a_ready(const Unit&) const {}
    __device__ __forceinline__ void done(const Unit&) const {}
};
typedef float f32x2_t __attribute__((ext_vector_type(2))); typedef __bf16 bf16x2_t __attribute__((ext_vector_type(2)));
__device__ __forceinline__ unsigned cvt_pk_bf16(float lo, float hi) { f32x2_t v = {lo, hi}; bf16x2_t b = __builtin_convertvector(v, bf16x2_t); return __builtin_bit_cast(unsigned, b); }
__device__ __forceinline__ float fsigmoid(float v) { return __builtin_amdgcn_rcpf(1.f + __builtin_amdgcn_exp2f(-1.4426950408889634f * v)); }
constexpr float QSCALE = 0.125f * 1.4426950408889634f;

struct EpiProj {
    static constexpr bool PERM = true, AFTER_DRAIN = false;
    bf16_t *Q, *K, *V, *U, *GA, *GB; const float* gq; const float* gk;
    __device__ __forceinline__ void operator()(const f32x4 (&acc)[2][2][4][2], const Unit& u, int wr, int wc, int fr, int fq) const {
        const int row0 = u.pm * BM + wr * 64 + fr; const int sec = u.pn;
        if (sec < 4) {
            const bool isq = sec < 2; const float* g = isq ? gq : gk; bf16_t* base = (isq ? Q : K) + ((sec & 1) * 4 + wc) * 64 + 8 * fq;
            const float qs = isq ? QSCALE : 1.f;
            f32x4 gv[2][2];
#pragma unroll
            for (int bj = 0; bj < 2; ++bj)
#pragma unroll
                for (int n = 0; n < 2; ++n) gv[bj][n] = *(const f32x4*)(g + 32 * bj + 8 * fq + 4 * n);
#pragma unroll
            for (int ai = 0; ai < 2; ++ai)
#pragma unroll
                for (int m = 0; m < 4; ++m) {
                    float ss = 0.f;
#pragma unroll
                    for (int bj = 0; bj < 2; ++bj)
#pragma unroll
                        for (int n = 0; n < 2; ++n) { const f32x4 x = acc[ai][bj][m][n]; ss += (x[0] * x[0] + x[1] * x[1]) + (x[2] * x[2] + x[3] * x[3]); }
                    ss += __shfl_xor(ss, 16); ss += __shfl_xor(ss, 32);
                    const float r = rsqrtf(ss * (1.f / 64.f) + EPS) * qs;
                    bf16_t* rowp = base + (size_t)(row0 + ai * HALF + m * 16) * 512;
#pragma unroll
                    for (int bj = 0; bj < 2; ++bj) { const f32x4 v0 = acc[ai][bj][m][0] * gv[bj][0] * r, v1 = acc[ai][bj][m][1] * gv[bj][1] * r;
                        u32x4 w; w.x = cvt_pk_bf16(v0[0], v0[1]); w.y = cvt_pk_bf16(v0[2], v0[3]); w.z = cvt_pk_bf16(v1[0], v1[1]); w.w = cvt_pk_bf16(v1[2], v1[3]);
                        *(u32x4*)(rowp + 32 * bj) = w; }
                }
        } else if (sec < 8) {
            bf16_t* base = (sec < 6 ? V : U) + (sec & 1) * 256 + wc * 32 + 8 * fq;
#pragma unroll
            for (int ai = 0; ai < 2; ++ai)
#pragma unroll
                for (int m = 0; m < 4; ++m) { bf16_t* rowp = base + (size_t)(row0 + ai * HALF + m * 16) * 512;
#pragma unroll
                    for (int bj = 0; bj < 2; ++bj) { const f32x4 v0 = acc[ai][bj][m][0], v1 = acc[ai][bj][m][1];
                        u32x4 w; w.x = cvt_pk_bf16(v0[0], v0[1]); w.y = cvt_pk_bf16(v0[2], v0[3]); w.z = cvt_pk_bf16(v1[0], v1[1]); w.w = cvt_pk_bf16(v1[2], v1[3]);
                        *(u32x4*)(rowp + bj * HALF) = w; } }
        } else {
            bf16_t* base = (sec < 12 ? GA : GB) + ((sec - 8) & 3) * 256 + wc * 32 + 8 * fq;
#pragma unroll
            for (int ai = 0; ai < 2; ++ai)
#pragma unroll
                for (int m = 0; m < 4; ++m) { bf16_t* rowp = base + (size_t)(row0 + ai * HALF + m * 16) * 1024;
#pragma unroll
                    for (int bj = 0; bj < 2; ++bj) { const f32x4 v0 = acc[ai][bj][m][0], v1 = acc[ai][bj][m][1];
                        u32x4 w; w.x = cvt_pk_bf16(fsigmoid(v0[0]), fsigmoid(v0[1])); w.y = cvt_pk_bf16(fsigmoid(v0[2]), fsigmoid(v0[3])); w.z = cvt_pk_bf16(fsigmoid(v1[0]), fsigmoid(v1[1])); w.w = cvt_pk_bf16(fsigmoid(v1[2]), fsigmoid(v1[3]));
                        *(u32x4*)(rowp + bj * HALF) = w; } }
        }
    }
};

struct EpiMerge {
    static constexpr bool PERM = true, AFTER_DRAIN = false;
    const bf16_t* G; bf16_t* MG; int add;
    __device__ __forceinline__ void operator()(const f32x4 (&acc)[2][2][4][2], const Unit& u, int wr, int wc, int fr, int fq) const {
        const int row0 = u.pm * BM + wr * 64 + fr, col0 = u.pn * BM + wc * 32 + 8 * fq;
#pragma unroll
        for (int ai = 0; ai < 2; ++ai)
#pragma unroll
            for (int m = 0; m < 4; ++m) { const size_t off = (size_t)(row0 + ai * HALF + m * 16) * 1024 + col0;
#pragma unroll
                for (int bj = 0; bj < 2; ++bj) { const u32x4 g = *(const u32x4*)(G + off + bj * HALF); const f32x4 a0 = acc[ai][bj][m][0], a1 = acc[ai][bj][m][1];
                    float v[8] = {bf2f(g.x & 0xffffu) * a0[0], bf2f(g.x >> 16) * a0[1], bf2f(g.y & 0xffffu) * a0[2], bf2f(g.y >> 16) * a0[3], bf2f(g.z & 0xffffu) * a1[0], bf2f(g.z >> 16) * a1[1], bf2f(g.w & 0xffffu) * a1[2], bf2f(g.w >> 16) * a1[3]};
                    if (add) { const u32x4 o = *(const u32x4*)(MG + off + bj * HALF);
                        v[0] += bf2f(o.x & 0xffffu); v[1] += bf2f(o.x >> 16); v[2] += bf2f(o.y & 0xffffu); v[3] += bf2f(o.y >> 16); v[4] += bf2f(o.z & 0xffffu); v[5] += bf2f(o.z >> 16); v[6] += bf2f(o.w & 0xffffu); v[7] += bf2f(o.w >> 16); }
                    u32x4 w; w.x = cvt_pk_bf16(v[0], v[1]); w.y = cvt_pk_bf16(v[2], v[3]); w.z = cvt_pk_bf16(v[4], v[5]); w.w = cvt_pk_bf16(v[6], v[7]);
                    *(u32x4*)(MG + off + bj * HALF) = w; } }
    }
};
struct EpiX1 {
    static constexpr bool PERM = false, AFTER_DRAIN = false;
    const float* x; const float* gate; float* X1;
    __device__ __forceinline__ void operator()(const f32x4 (&acc)[2][2][4][2], const Unit& u, int wr, int wc, int fr, int fq) const {
        const int row0 = u.pm * BM + wr * 64 + fr, col0 = u.pn * BM + wc * 32 + 4 * fq; const int b = (u.pm * BM) / SEQ;
        f32x4 gv[2][2];
#pragma unroll
        for (int bj = 0; bj < 2; ++bj)
#pragma unroll
            for (int n = 0; n < 2; ++n) gv[bj][n] = *(const f32x4*)(gate + (size_t)b * 6 * D + col0 + bj * HALF + n * 16);
#pragma unroll
        for (int ai = 0; ai < 2; ++ai)
#pragma unroll
            for (int m = 0; m < 4; ++m) { const size_t off = (size_t)(row0 + ai * HALF + m * 16) * D + col0;
#pragma unroll
                for (int bj = 0; bj < 2; ++bj)
#pragma unroll
                    for (int n = 0; n < 2; ++n) *(f32x4*)(X1 + off + bj * HALF + n * 16) = *(const f32x4*)(x + off + bj * HALF + n * 16) + gv[bj][n] * acc[ai][bj][m][n]; }
    }
};

template <class Epi, class Sched, bool ALIGN_EPI = false, bool SP2 = false>
__device__ __forceinline__ void gemm_phase(PG8_LAS unsigned char* lds, const Gemm g, const Sched& S, const Epi& E) {
    int tid_ = threadIdx.x; asm volatile("" : "+v"(tid_));
    const int tid = tid_, wid = __builtin_amdgcn_readfirstlane(tid >> 6), lane = tid & 63, wr = wid >> 2, wc = wid & 3, fr = lane & 15, fq = lane >> 4;
    const int K = g.K, nt = K / BK;
    unsigned voffA[2], voffB[2];
#pragma unroll
    for (int i = 0; i < 2; ++i) { int R, C; stage_rc(tid * 16 + i * 8192, R, C); const int Rb = Epi::PERM ? ((R & ~31) + perm32(R & 31)) : R;
        voffA[i] = (unsigned)(R * K + C) * 2u; voffB[i] = (unsigned)(Rb * K + C) * 2u; }
    const size_t kstep = (size_t)(BK * 2);
    const size_t hstep = (size_t)HALF * K * 2;
    const size_t tstep = 2 * hstep;
    const unsigned ldsw = (unsigned)wid * 1024u;
    const int aoff = lds_byte(wr * 64 + fr, fq * 8), boff = lds_byte(wc * 32 + fr, fq * 8);
#define PG8_SA(b, h) (((b) * 2 + (h)) * HTB)
#define PG8_SB(b, h) ((4 + (b) * 2 + (h)) * HTB)
#define PG8_STAGE(bufoff, gbase, voff) do { _Pragma("unroll") for (int _i = 0; _i < 2; ++_i) \
        __builtin_amdgcn_global_load_lds((const unsigned*)((const char*)(gbase) + (voff)[_i]), (PG8_LAS unsigned*)(lds + (bufoff) + ldsw + _i * 8192), 16, 0, 0); } while (0)
#define PG8_LDA(dst, b, h) do { _Pragma("unroll") for (int m = 0; m < 4; ++m) _Pragma("unroll") for (int k = 0; k < 2; ++k) dst[m][k] = *(const PG8_LAS bf16x8*)(lds + PG8_SA(b, h) + aoff + m * 2048 + k * 1024); } while (0)
#define PG8_LDB(dst, b, h) do { _Pragma("unroll") for (int n = 0; n < 2; ++n) _Pragma("unroll") for (int k = 0; k < 2; ++k) dst[n][k] = *(const PG8_LAS bf16x8*)(lds + PG8_SB(b, h) + boff + n * 2048 + k * 1024); } while (0)
#define PG8_MMA(ai, bj, At, Bt) do { __builtin_amdgcn_s_setprio(1); _Pragma("unroll") for (int m = 0; m < 4; ++m) _Pragma("unroll") for (int n = 0; n < 2; ++n) _Pragma("unroll") for (int k = 0; k < 2; ++k) \
        acc[ai][bj][m][n] = __builtin_amdgcn_mfma_f32_16x16x32_bf16(Bt[n][k], At[m][k], acc[ai][bj][m][n], 0, 0, 0); __builtin_amdgcn_s_setprio(0); } while (0)
#define PG8_WAIT_V(n) asm volatile("s_waitcnt vmcnt(" #n ")" ::: "memory")
#define PG8_WAIT_L(n) asm volatile("s_waitcnt lgkmcnt(" #n ")" ::: "memory")
#define PG8_BAR __builtin_amdgcn_s_barrier()
#define PG8_SCHED __builtin_amdgcn_sched_barrier(0)
    Unit cur, nxt; int ui = 0;
    if (!S.next(0, cur)) return;
    f32x4 acc[2][2][4][2];
#pragma unroll
    for (int a = 0; a < 2; ++a)
#pragma unroll
        for (int b = 0; b < 2; ++b)
#pragma unroll
            for (int m = 0; m < 4; ++m)
#pragma unroll
                for (int n = 0; n < 2; ++n) acc[a][b][m][n] = (f32x4){0.f, 0.f, 0.f, 0.f};
    bf16x8 At[4][2], B0[2][2], B1[2][2];
    const char* cA = (const char*)g.A + (size_t)cur.pm * tstep; const char* cB = (const char*)g.Bt + (size_t)cur.pn * tstep;
    S.a_ready(cur);
    if constexpr (SP2) {
        PG8_STAGE(PG8_SB(0, 0), cB, voffB); PG8_STAGE(PG8_SB(0, 1), cB + hstep, voffB); PG8_STAGE(PG8_SA(0, 0), cA, voffA); PG8_STAGE(PG8_SA(0, 1), cA + hstep, voffA);
        if (wr == 1) PG8_BAR;
        PG8_WAIT_V(2); PG8_BAR;
        PG8_STAGE(PG8_SB(1, 0), cB + kstep, voffB); PG8_STAGE(PG8_SA(1, 0), cA + kstep, voffA); PG8_STAGE(PG8_SB(1, 1), cB + hstep + kstep, voffB);
        PG8_WAIT_V(6); PG8_BAR;
    } else {
        PG8_STAGE(PG8_SB(0, 0), cB, voffB); PG8_STAGE(PG8_SA(0, 0), cA, voffA); PG8_STAGE(PG8_SB(0, 1), cB + hstep, voffB); PG8_STAGE(PG8_SA(0, 1), cA + hstep, voffA);
        if (wr == 1) PG8_BAR;
        PG8_WAIT_V(4); PG8_BAR;
        PG8_STAGE(PG8_SB(1, 0), cB + kstep, voffB); PG8_STAGE(PG8_SA(1, 0), cA + kstep, voffA); PG8_STAGE(PG8_SB(1, 1), cB + hstep + kstep, voffB);
        PG8_WAIT_V(6); PG8_BAR;
    }
    for (;;) {
        const bool has_next = S.next(ui + 1, nxt);
        const char* nA = has_next ? (const char*)g.A + (size_t)nxt.pm * tstep : cA; const char* nB = has_next ? (const char*)g.Bt + (size_t)nxt.pn * tstep : cB;
#pragma nounroll
        for (int t = 0; t < nt; t += 2) {
            const bool last = (t == nt - 2);
            const char* a1 = cA + (size_t)(t + 1) * kstep;
            const char* a2 = last ? nA : cA + (size_t)(t + 2) * kstep; const char* b2 = last ? nB : cB + (size_t)(t + 2) * kstep;
            const char* a3 = a2 + kstep; const char* b3 = b2 + kstep;
            if (last && has_next) S.a_ready(nxt);
            if constexpr (SP2) {
            PG8_LDB(B0, 0, 0); PG8_LDB(B1, 0, 1); PG8_SCHED; PG8_LDA(At, 0, 0); PG8_STAGE(PG8_SA(1, 1), a1 + hstep, voffA);
            PG8_WAIT_V(8); PG8_WAIT_L(0); PG8_BAR; PG8_MMA(0, 0, At, B0); PG8_MMA(0, 1, At, B1); PG8_BAR; PG8_SCHED;
            PG8_LDA(At, 0, 1); PG8_STAGE(PG8_SB(0, 0), b2, voffB); PG8_STAGE(PG8_SB(0, 1), b2 + hstep, voffB); PG8_STAGE(PG8_SA(0, 0), a2, voffA);
            PG8_WAIT_V(8); PG8_WAIT_L(0); PG8_BAR; PG8_MMA(1, 0, At, B0); PG8_MMA(1, 1, At, B1); PG8_BAR; PG8_SCHED;
            PG8_LDB(B0, 1, 0); PG8_LDB(B1, 1, 1); PG8_SCHED; PG8_LDA(At, 1, 0); PG8_STAGE(PG8_SA(0, 1), a2 + hstep, voffA);
            PG8_WAIT_V(8); PG8_WAIT_L(0); PG8_BAR; PG8_MMA(0, 0, At, B0); PG8_MMA(0, 1, At, B1); PG8_BAR; PG8_SCHED;
            PG8_LDA(At, 1, 1); PG8_STAGE(PG8_SB(1, 0), b3, voffB); PG8_STAGE(PG8_SB(1, 1), b3 + hstep, voffB); PG8_STAGE(PG8_SA(1, 0), a3, voffA);
            PG8_WAIT_V(8); PG8_WAIT_L(0); PG8_BAR; PG8_MMA(1, 0, At, B0); PG8_MMA(1, 1, At, B1); PG8_BAR; PG8_SCHED;
            } else {
            PG8_LDB(B0, 0, 0); PG8_SCHED; PG8_LDA(At, 0, 0); PG8_STAGE(PG8_SA(1, 1), a1 + hstep, voffA);
            PG8_WAIT_L(8); PG8_BAR; PG8_WAIT_L(0); PG8_MMA(0, 0, At, B0); PG8_BAR; PG8_SCHED;
            PG8_LDB(B1, 0, 1); PG8_STAGE(PG8_SB(0, 0), b2, voffB);
            PG8_BAR; PG8_WAIT_L(0); PG8_MMA(0, 1, At, B1); PG8_BAR;
            PG8_LDA(At, 0, 1); PG8_STAGE(PG8_SA(0, 0), a2, voffA);
            PG8_BAR; PG8_WAIT_L(0); PG8_MMA(1, 0, At, B0); PG8_BAR; PG8_SCHED;
            PG8_STAGE(PG8_SB(0, 1), b2 + hstep, voffB);
            PG8_WAIT_V(6); PG8_BAR; PG8_MMA(1, 1, At, B1); PG8_BAR;
            PG8_LDB(B0, 1, 0); PG8_SCHED; PG8_LDA(At, 1, 0); PG8_STAGE(PG8_SA(0, 1), a2 + hstep, voffA);
            PG8_WAIT_L(8); PG8_BAR; PG8_WAIT_L(0); PG8_MMA(0, 0, At, B0); PG8_BAR; PG8_SCHED;
            PG8_LDB(B1, 1, 1); PG8_STAGE(PG8_SB(1, 0), b3, voffB);
            PG8_BAR; PG8_WAIT_L(0); PG8_MMA(0, 1, At, B1); PG8_BAR;
            PG8_LDA(At, 1, 1); PG8_STAGE(PG8_SA(1, 0), a3, voffA);
            PG8_BAR; PG8_WAIT_L(0); PG8_MMA(1, 0, At, B0); PG8_BAR; PG8_SCHED;
            PG8_STAGE(PG8_SB(1, 1), b3 + hstep, voffB);
            PG8_WAIT_V(6); PG8_BAR; PG8_MMA(1, 1, At, B1); PG8_BAR;
            }
        }
        if constexpr (ALIGN_EPI) { if (wr == 0) PG8_BAR; }
        if constexpr (!Epi::AFTER_DRAIN) { E(acc, cur, wr, wc, fr, fq); S.done(cur); }
        if (!has_next) break;
#pragma unroll
        for (int a = 0; a < 2; ++a)
#pragma unroll
            for (int b = 0; b < 2; ++b)
#pragma unroll
                for (int m = 0; m < 4; ++m)
#pragma unroll
                    for (int n = 0; n < 2; ++n) acc[a][b][m][n] = (f32x4){0.f, 0.f, 0.f, 0.f};
        cur = nxt; cA = nA; cB = nB; ++ui;
        if constexpr (ALIGN_EPI) { if (wr == 1) PG8_BAR; }
    }
    PG8_WAIT_V(0);
    if constexpr (!ALIGN_EPI) { if (wr == 0) PG8_BAR; }
    PG8_BAR;
    if constexpr (Epi::AFTER_DRAIN) { E.fused(acc, cur, wr, wc, fr, fq, lds, wid, lane); S.done(cur); }
#undef PG8_SA
#undef PG8_SB
#undef PG8_STAGE
#undef PG8_LDA
#undef PG8_LDB
#undef PG8_MMA
#undef PG8_WAIT_V
#undef PG8_WAIT_L
#undef PG8_BAR
#undef PG8_SCHED
}
}
using pg8::f32x4; using pg8::bf16x8;
#define GAS __attribute__((address_space(1)))
#define LAS __attribute__((address_space(3)))
typedef unsigned v4u __attribute__((ext_vector_type(4)));
typedef GAS unsigned gu32;
typedef GAS unsigned long long gu64;
#define RLX_AGENT __ATOMIC_RELAXED, __HIP_MEMORY_SCOPE_AGENT
#define LDS_WAIT() asm volatile("s_waitcnt lgkmcnt(0)" ::: "memory")
#define VM_WAIT() asm volatile("s_waitcnt vmcnt(0)" ::: "memory")
__device__ __forceinline__ unsigned long long rt() { return __builtin_amdgcn_s_memrealtime(); }
__device__ __forceinline__ unsigned pk2(float lo, float hi) { return pg8::cvt_pk_bf16(lo, hi); }

#define XB_TMO      128
#define XB_XCNT(j)  (256  + 64 * (j))
#define XB_XSUB(j)  (1280 + 64 * (j))
#define XB_XGEN(j)  (2304 + 64 * (j))
#define XB_TOP      3328
#define XB_TOPGEN   3392
#define XCD_BAR_WORDS 3456
#define XB_SPIN_CAP (1u << 18)

__device__ __forceinline__ unsigned xb_ld(unsigned* p)              { return __hip_atomic_load(p, __ATOMIC_RELAXED, __HIP_MEMORY_SCOPE_AGENT); }
__device__ __forceinline__ unsigned xb_add(unsigned* p, unsigned v) { return __hip_atomic_fetch_add(p, v, __ATOMIC_RELAXED, __HIP_MEMORY_SCOPE_AGENT); }
__device__ __forceinline__ unsigned xb_xcc_id() { return (unsigned)__builtin_amdgcn_s_getreg((3 << 11) | 20) & 0xFu; }
#define XB_SPIN(cond, bar) do { unsigned _sp = 0; while (cond) { __builtin_amdgcn_s_sleep(1); \
    if ((++_sp & 255u) == 0u) { if (xb_ld(&(bar)[XB_TMO])) break; if (_sp > XB_SPIN_CAP) { atomicAdd(&(bar)[XB_TMO], 1u); break; } } } } while (0)

struct XcdBarrier {
    unsigned* bar; unsigned x;
    volatile LAS unsigned* st;
};

__device__ __forceinline__ XcdBarrier xcd_barrier_post(unsigned* bar, volatile LAS unsigned* st) {
    XcdBarrier b; b.bar = bar; b.x = xb_xcc_id(); b.st = st;
    if (threadIdx.x == 0) (void)xb_add(&bar[XB_XCNT(b.x)], 1u);
    return b;
}
__device__ __forceinline__ void xcd_barrier_complete(unsigned* bar, unsigned x, unsigned& nloc, unsigned& nx) {
    const unsigned G = gridDim.x * gridDim.y * gridDim.z;
    unsigned sum, cnt, mine, sp = 0u;
    for (;;) {
        sum = 0u; cnt = 0u; mine = 0u;
#pragma unroll
        for (unsigned j = 0; j < 16; ++j) { const unsigned c = xb_ld(&bar[XB_XCNT(j)]); sum += c; cnt += (c > 0u) ? 1u : 0u; mine = (j == x) ? c : mine; }
        if (sum == G) break;
        __builtin_amdgcn_s_sleep(1);
        if ((++sp & 255u) == 0u) { if (xb_ld(&bar[XB_TMO])) break; if (sp > XB_SPIN_CAP) { atomicAdd(&bar[XB_TMO], 1u); break; } }
    }
    nloc = mine > 0u ? mine : 1u; nx = cnt > 0u ? cnt : 1u;
}

__device__ __forceinline__ void xcd_barrier(const XcdBarrier& b) {
    asm volatile("s_waitcnt vmcnt(0)" ::: "memory");
    __syncthreads();
    if (threadIdx.x == 0) {
        unsigned* bar = b.bar;
        __builtin_amdgcn_s_waitcnt(0);
        unsigned nloc = b.st[0], nx = b.st[1];
        if (nloc == 0u) { xcd_barrier_complete(bar, b.x, nloc, nx); b.st[0] = nloc; b.st[1] = nx; }
        const unsigned old = xb_add(&bar[XB_XSUB(b.x)], 1u);
        const unsigned gen = old / nloc;
        if (old + 1u == (gen + 1u) * nloc) {
            __builtin_amdgcn_fence(__ATOMIC_RELEASE, "agent");
            asm volatile("s_waitcnt vmcnt(0)" ::: "memory");
            const unsigned og = xb_add(&bar[XB_TOP], 1u);
            const unsigned tg = og / nx;
            if (og + 1u == (tg + 1u) * nx) xb_add(&bar[XB_TOPGEN], 1u);
            else XB_SPIN(xb_ld(&bar[XB_TOPGEN]) == tg, bar);
            __builtin_amdgcn_fence(__ATOMIC_ACQUIRE, "agent");
            xb_add(&bar[XB_XGEN(b.x)], 1u);
            asm volatile("s_waitcnt vmcnt(0)" ::: "memory");
        } else {
            XB_SPIN(xb_ld(&bar[XB_XGEN(b.x)]) == gen, bar);
            __builtin_amdgcn_fence(__ATOMIC_ACQUIRE, "agent");
            asm volatile("s_waitcnt vmcnt(0)" ::: "memory");
        }
    }
    __syncthreads();
}

constexpr int NWAVES = 8;
#ifndef DBL_PHASE
#define DBL_PHASE -1
#endif
constexpr size_t WS_MODP = 1 * MiB + 128 * 1024;
constexpr size_t WS_WIN = 12 * MiB, WS_WSB = 20 * MiB, WS_WEFF = 21 * MiB, WS_WOUT = 22 * MiB, WS_WGU = 24 * MiB;
constexpr size_t WS_WSHGU = 237 * MiB, WS_WD = 238 * MiB, WS_WSHD = 254 * MiB, WS_WRH = 254 * MiB + 512 * 1024, WS_WRL = WS_WRH + 128 * 1024;
constexpr size_t CTL_ZERO_BYTES = 256 * 1024;
constexpr int CW_TMO = 0, CW_CODE = 1, CW_BAR = 4096, CW_CNT = 16384;
constexpr int RING_OFF = 0, RING_BYTES = 131072, AUX_OFF = RING_BYTES, LDS_BYTES = 163840, LDSCTL_OFF = LDS_BYTES - 1024, MISC_OFF = LDSCTL_OFF + 320;

struct Frame {
    LAS unsigned char* lds; volatile LAS unsigned* MISC; gu32* ctl;
    int tid, lane, wave, vcu, G;
};
struct Args { const float* in[22]; float* out; unsigned char* ws; int ph_lo, ph_hi, use_bar, pad; };

struct TItem { const float* W; bf16_t* dst; int ldw, ldk, k0, n0, perm; };
__device__ __forceinline__ void titem_load(const TItem& t, f32x4 (&v)[8], int lane) {
    const int kr = lane >> 3, n4 = (lane & 7) * 4;
#pragma unroll
    for (int i = 0; i < 8; ++i) v[i] = *(const GAS f32x4*)(t.W + (size_t)(t.k0 + kr + 8 * i) * t.ldw + t.n0 + n4);
}
__device__ __forceinline__ void titem_store(const TItem& t, const f32x4 (&v)[8], LAS float* scr, int lane) {
    { const int kr = lane >> 3, n4 = (lane & 7) * 4;
#pragma unroll
      for (int i = 0; i < 8; ++i) { LAS float* d = scr + (kr + 8 * i) * 33 + n4; d[0] = v[i].x; d[1] = v[i].y; d[2] = v[i].z; d[3] = v[i].w; } }
    LDS_WAIT(); asm volatile("" ::: "memory");
    const int c = lane & 7;
#pragma unroll
    for (int j = 0; j < 4; ++j) { const int n = (lane >> 3) + 8 * j, drow = t.perm ? 128 * (j & 1) + 8 * (j >> 1) + (lane >> 3) : n; const LAS float* sp = scr + (8 * c) * 33 + n;
        v4u o; o.x = pk2(sp[0 * 33], sp[1 * 33]); o.y = pk2(sp[2 * 33], sp[3 * 33]); o.z = pk2(sp[4 * 33], sp[5 * 33]); o.w = pk2(sp[6 * 33], sp[7 * 33]);
        *(GAS v4u*)(t.dst + (size_t)drow * t.ldk + t.k0 + 8 * c) = o; }
    LDS_WAIT(); asm volatile("" ::: "memory");
}
__device__ __forceinline__ TItem titem_decode(int it, const Args& a, bool late) {
    unsigned char* ws = a.ws; TItem t; t.perm = 0;
    constexpr int I_IN = 16 * 128, I_SB = 8 * 32, I_OUT = 16 * 32, I_EG = 64 * 64, I_EU = 64 * 64, I_ED = 64 * 64, I_SG = 16 * 8, I_SU = 16 * 8;
    int r = it;
    if (late) {
        if (r < I_ED) { const int e = r >> 6, q = r & 63, kb = q >> 5, nb = q & 31; t.W = a.in[18] + (size_t)e * ED * D; t.ldw = D; t.k0 = kb * 64; t.n0 = nb * 32;
            const int n0 = nb * 32, cl = n0 & 255; t.perm = 1; t.dst = (bf16_t*)(ws + WS_WD) + ((size_t)e * D + (n0 & ~255) + 32 * (cl >> 6) + 16 * ((cl >> 5) & 1)) * ED; t.ldk = ED; return t; } r -= I_ED;
        { const int kb = r >> 5, nb = r & 31; t.W = a.in[21]; t.ldw = D; t.k0 = kb * 64; t.n0 = nb * 32; t.dst = (bf16_t*)(ws + WS_WSHD) + (size_t)(nb * 32) * SHD; t.ldk = SHD; return t; } }
    if (r < I_IN) { const int kb = r >> 7, nb = r & 127, n0 = nb * 32; int d0 = n0;
        if (n0 < 1024) d0 = (n0 & ~255) + 128 * ((n0 >> 5) & 1) + 32 * ((n0 >> 6) & 3);
        t.W = a.in[5]; t.ldw = INW; t.k0 = kb * 64; t.n0 = n0; t.dst = (bf16_t*)(ws + WS_WIN) + (size_t)d0 * D; t.ldk = D; return t; } r -= I_IN;
    if (r < I_SB) { const int kb = r >> 5, nb = r & 31; t.W = a.in[8]; t.ldw = D; t.k0 = kb * 64; t.n0 = nb * 32; t.dst = (bf16_t*)(ws + WS_WSB) + (size_t)(nb * 32) * SBW; t.ldk = SBW; return t; } r -= I_SB;
    if (r < I_OUT) { const int kb = r >> 5, nb = r & 31; t.W = a.in[12]; t.ldw = D; t.k0 = kb * 64; t.n0 = nb * 32; t.dst = (bf16_t*)(ws + WS_WOUT) + (size_t)(nb * 32) * D; t.ldk = D; return t; } r -= I_OUT;
    if (r < I_EG) { const int e = r >> 6, q = r & 63, kb = q >> 2, nb = q & 3; t.W = a.in[16] + (size_t)e * D * ED; t.ldw = ED; t.k0 = kb * 64; t.n0 = nb * 32; t.dst = (bf16_t*)(ws + WS_WGU) + ((size_t)e * 256 + nb * 32) * D; t.ldk = D; return t; } r -= I_EG;
    if (r < I_EU) { const int e = r >> 6, q = r & 63, kb = q >> 2, nb = q & 3; t.W = a.in[17] + (size_t)e * D * ED; t.ldw = ED; t.k0 = kb * 64; t.n0 = nb * 32; t.dst = (bf16_t*)(ws + WS_WGU) + ((size_t)e * 256 + 128 + nb * 32) * D; t.ldk = D; return t; } r -= I_EU;
    if (r < I_SG) { const int kb = r >> 3, nb = r & 7, n0 = nb * 32; t.W = a.in[19]; t.ldw = SHD; t.k0 = kb * 64; t.n0 = n0; t.dst = (bf16_t*)(ws + WS_WSHGU) + (size_t)((n0 >> 7) * 256 + (n0 & 127)) * D; t.ldk = D; return t; } r -= I_SG;
    { const int kb = r >> 3, nb = r & 7, n0 = nb * 32; t.W = a.in[20]; t.ldw = SHD; t.k0 = kb * 64; t.n0 = n0; t.dst = (bf16_t*)(ws + WS_WSHGU) + (size_t)((n0 >> 7) * 256 + 128 + (n0 & 127)) * D; t.ldk = D; return t; }
}

__device__ __forceinline__ void titem_run(Frame& F, const Args& a, bool late, int nitems, int first, int stride) {
    LAS float* scr = (LAS float*)(F.lds + RING_OFF + F.wave * 16384); const int lane = F.lane;
    f32x4 va[8], vb[8]; TItem cur, nxt; int it = first;
    if (it < nitems) { cur = titem_decode(it, a, late); titem_load(cur, va, lane); }
    for (; it < nitems; it += 2 * stride) {
        const bool h1 = it + stride < nitems, h2 = it + 2 * stride < nitems;
        if (h1) { nxt = titem_decode(it + stride, a, late); titem_load(nxt, vb, lane); }
        titem_store(cur, va, scr, lane);
        if (h2) { cur = titem_decode(it + 2 * stride, a, late); titem_load(cur, va, lane); }
        if (h1) titem_store(nxt, vb, scr, lane);
    }
}

__device__ __forceinline__ void p0a(Frame& F, const Args& a) {
    unsigned char* ws = a.ws;
    const int gw = F.vcu * NWAVES + F.wave, NGW = F.G * NWAVES, lane = F.lane;
    LAS float* silu_t = (LAS float*)(F.lds + AUX_OFF + 1024);
    { const float* c = a.in[1]; for (int i = F.tid; i < 4 * D; i += NWAVES * 64) ((LAS float*)(F.lds + RING_OFF + 65536))[i] = siluf_(c[i]); }
    LAS float* silu = (LAS float*)(F.lds + RING_OFF + 65536);
    (void)silu_t;
    if (F.G == 256) { const float* wg = a.in[9]; const float* ps = a.in[10]; const float* wpo = a.in[11]; bf16_t* WE = (bf16_t*)(ws + WS_WEFF);
        const int g = F.vcu >> 6, nb = (F.vcu & 63) * 16; LAS float* wgt = (LAS float*)(F.lds + RING_OFF);
        for (int i = F.tid; i < 128 * 128; i += NWAVES * 64) { const int cc = i >> 7, d = i & 127; wgt[d * 128 + cc] = wg[(size_t)g * 16384 + i]; }
        __syncthreads();
        const int cc = F.tid & 127, nq = (F.tid >> 7) * 4; float acc4[4] = {0.f, 0.f, 0.f, 0.f};
        for (int d = 0; d < 128; ++d) { const float wv = wgt[d * 128 + cc] * ps[g * 128 + d]; const float* wr = wpo + (size_t)(g * 128 + d) * D + nb + nq;
#pragma unroll
            for (int j = 0; j < 4; ++j) acc4[j] += wv * wr[j]; }
#pragma unroll
        for (int j = 0; j < 4; ++j) WE[(size_t)(nb + nq + j) * PW + g * 128 + cc] = (bf16_t)f2bf(acc4[j]);
    }
    __syncthreads();
    { const float* w_ada = a.in[2]; float* MODP = (float*)(ws + WS_MODP);
      for (int it = gw; it < 96 * 8; it += NGW) { const int cg = it % 96, ks = it / 96;
          const float* w = w_ada + (size_t)(ks * 128) * (6 * D) + cg * 64 + lane;
          float a0 = 0.f, a1 = 0.f, a2 = 0.f, a3 = 0.f;
#pragma unroll 8
          for (int k = 0; k < 128; ++k) { const float wv = w[(size_t)k * (6 * D)]; const int kk = ks * 128 + k;
              a0 += silu[kk] * wv; a1 += silu[D + kk] * wv; a2 += silu[2 * D + kk] * wv; a3 += silu[3 * D + kk] * wv; }
          float* o = MODP + (size_t)ks * 4 * 6 * D + cg * 64 + lane;
          o[0] = a0; o[6 * D] = a1; o[12 * D] = a2; o[18 * D] = a3; } }
    __syncthreads();
    titem_run(F, a, false, 16 * 128 + 8 * 32 + 16 * 32 + 2 * 64 * 64 + 2 * 16 * 8, gw, NGW);
    { const float* wr = a.in[14]; bf16_t* WH = (bf16_t*)(ws + WS_WRH); bf16_t* WL = (bf16_t*)(ws + WS_WRL);
      for (int i = (F.vcu * NWAVES * 64 + F.tid); i < D * NE; i += F.G * NWAVES * 64) { const int e = i >> 10, k = i & 1023; const float v = wr[k * NE + e];
          const int pos = ((((k >> 4) * 2 + (e >> 5)) * 64) + 32 * ((k >> 3) & 1) + (e & 31)) * 8 + (k & 7);
          const unsigned h = f2bf(v); WH[pos] = (bf16_t)h; WL[pos] = (bf16_t)f2bf(v - bf2f(h)); } }
}
__device__ __forceinline__ void p0b(Frame& F, const Args& a) {
    unsigned char* ws = a.ws; const float* MODP = (const float*)(ws + WS_MODP); const float* b_ada = a.in[3];
    if (F.tid < 96) { const int idx = 96 * F.vcu + F.tid, b = idx / (6 * D), j = idx % (6 * D); float v = b_ada[j];
#pragma unroll
        for (int ks = 0; ks < 8; ++ks) v += MODP[(size_t)(ks * 4 + b) * 6 * D + j];
        ((float*)(ws + WS_MOD))[idx] = v; }
    const int rows_per = M / F.G, r0 = F.vcu * rows_per, b = r0 / SEQ;
    LAS float* gsv = (LAS float*)(F.lds + RING_OFF); LAS float* shv = gsv + D;
    for (int k = F.tid; k < D; k += NWAVES * 64) { float sh = b_ada[k], sc = b_ada[D + k];
#pragma unroll
        for (int ks = 0; ks < 8; ++ks) { sh += MODP[(size_t)(ks * 4 + b) * 6 * D + k]; sc += MODP[(size_t)(ks * 4 + b) * 6 * D + D + k]; }
        gsv[k] = a.in[4][k] * (1.f + sc); shv[k] = sh; }
    __syncthreads();
    const float* x = a.in[0]; bf16_t* XN = (bf16_t*)(ws + WS_XN);
    for (int i = F.wave; i < rows_per; i += NWAVES) { const int row = r0 + i;
        const GAS f32x4* xr = (const GAS f32x4*)(x + (size_t)row * D) + F.lane;
        f32x4 v[4]; float s = 0.f;
#pragma unroll
        for (int j = 0; j < 4; ++j) { v[j] = xr[64 * j]; s += (v[j].x * v[j].x + v[j].y * v[j].y) + (v[j].z * v[j].z + v[j].w * v[j].w); }
        const float r = rsqrtf(wave_sum(s) * (1.f / D) + EPS);
        GAS unsigned long long* o8 = (GAS unsigned long long*)(XN + (size_t)row * D) + F.lane;
#pragma unroll
        for (int j = 0; j < 4; ++j) { const f32x4 gg = *(const LAS f32x4*)(gsv + 4 * F.lane + 256 * j), ss = *(const LAS f32x4*)(shv + 4 * F.lane + 256 * j);
            const f32x4 h = v[j] * r * gg + ss;
            o8[64 * j] = (unsigned long long)pk2(h.x, h.y) | ((unsigned long long)pk2(h.z, h.w) << 32); } }
    __syncthreads();
}

namespace sb {
using pg8::bf16x8; using pg8::f32x4; typedef float f32x16 __attribute__((ext_vector_type(16))); typedef short v4i16_t __attribute__((ext_vector_type(4)));
typedef short s16x4 __attribute__((ext_vector_type(4)));
constexpr int VPITCH = 128, VBYTES = 64 * VPITCH, WAVE_LDS = 2 * VBYTES;
constexpr float EXIT_THR = -152.f;
__device__ __forceinline__ int crow(int r, int hi) { return (r & 3) + 8 * (r >> 2) + 4 * hi; }
__device__ __forceinline__ s16x4 vtr(LAS const unsigned char* p) { return __builtin_bit_cast(s16x4, __builtin_amdgcn_ds_read_tr16_b64_v4i16((LAS v4i16_t*)p)); }
__device__ __forceinline__ unsigned pkbf(float lo, float hi) { return pg8::cvt_pk_bf16(lo, hi); }

__device__ __forceinline__ void attn_unit(int b, int h, int qb, const bf16_t* Q, const bf16_t* K, const bf16_t* V, bf16_t* O, LAS unsigned char* vlds, int wid, int lane) {
    const int r32 = lane & 31, hi = lane >> 5;
    const int t0 = qb * 256 + wid * 32;
    const size_t rowbase = (size_t)b * SEQ;
    const bf16_t* Kh = K + rowbase * 512 + h * 64; const bf16_t* Vh = V + rowbase * 512 + h * 64;
    bf16x8 qr[4];
#pragma unroll
    for (int d0 = 0; d0 < 4; ++d0) qr[d0] = *(const bf16x8*)(Q + (rowbase + t0 + r32) * 512 + h * 64 + d0 * 16 + hi * 8);
    f32x16 o0 = {}, o1 = {};
    float carry = 0.f;
    int kt = t0 >> 6;
    bf16x8 kf[8];
#define SB_LOADK(KT) do { const int kb_ = (KT) * 64; \
        _Pragma("unroll") for (int d0 = 0; d0 < 4; ++d0) { kf[2 * d0] = *(const bf16x8*)(Kh + (size_t)(kb_ + r32) * 512 + d0 * 16 + hi * 8); kf[2 * d0 + 1] = *(const bf16x8*)(Kh + (size_t)(kb_ + 32 + r32) * 512 + d0 * 16 + hi * 8); } } while (0)
#define SB_DMAV(KT, BUF) do { const int kb_ = (KT) * 64; \
        _Pragma("unroll") for (int i = 0; i < 8; ++i) __builtin_amdgcn_global_load_lds((const unsigned*)(Vh + (size_t)(kb_ + 8 * i + (lane >> 3)) * 512 + (lane & 7) * 8), (LAS unsigned*)(vlds + (BUF) * VBYTES + i * 1024), 16, 0, 0); } while (0)
    int cur = 0;
    SB_DMAV(kt, 0);
    SB_LOADK(kt);
    const int trbase = (4 * hi + ((lane & 15) >> 2)) * VPITCH + (16 * ((lane >> 4) & 1) + 4 * (lane & 3)) * 2;
    bool diag = true;
    for (;; --kt) {
        const int kbase = kt * 64;
        f32x16 p0 = {}, p1 = {};
#pragma unroll
        for (int d0 = 0; d0 < 4; ++d0) { p0 = __builtin_amdgcn_mfma_f32_32x32x16_bf16(kf[2 * d0], qr[d0], p0, 0, 0, 0); p1 = __builtin_amdgcn_mfma_f32_32x32x16_bf16(kf[2 * d0 + 1], qr[d0], p1, 0, 0, 0); }
        asm volatile("" ::: "memory");
        if (kt > 0) { SB_DMAV(kt - 1, cur ^ 1); SB_LOADK(kt - 1); }
        asm volatile("" ::: "memory");
        bf16x8 pa[4]; float suf = 0.f;
        const int qrel = t0 + r32 - kbase;
#define SB_HALF(P, KOFF, PA0, PA1) do { f32x16 sp_; \
        _Pragma("unroll") for (int r = 0; r < 16; ++r) sp_[r] = __builtin_amdgcn_logf(1.f + __builtin_amdgcn_exp2f(P[r])); \
        if (diag) { _Pragma("unroll") for (int r = 0; r < 16; ++r) if (crow(r, hi) + (KOFF) >= qrel) sp_[r] = 0.f; } \
        float e_[4], og_[4], R_[4]; \
        _Pragma("unroll") for (int c = 0; c < 4; ++c) { sp_[4 * c + 2] += sp_[4 * c + 3]; sp_[4 * c + 1] += sp_[4 * c + 2]; sp_[4 * c] += sp_[4 * c + 1]; e_[c] = sp_[4 * c]; } \
        _Pragma("unroll") for (int c = 0; c < 4; ++c) og_[c] = __shfl_xor(e_[c], 32); \
        _Pragma("unroll") for (int c = 3; c >= 0; --c) { R_[c] = carry - (suf + (hi == 0 ? og_[c] : 0.f)); suf += e_[c] + og_[c]; } \
        _Pragma("unroll") for (int r = 0; r < 16; ++r) P[r] = __builtin_amdgcn_exp2f(P[r] - sp_[r] + R_[r >> 2]); \
        if (diag) { _Pragma("unroll") for (int r = 0; r < 16; ++r) if (crow(r, hi) + (KOFF) >= qrel) P[r] = 0.f; } \
        pg8::u32x4 w_; w_.x = pkbf(P[0], P[1]); w_.y = pkbf(P[2], P[3]); w_.z = pkbf(P[4], P[5]); w_.w = pkbf(P[6], P[7]); PA0 = __builtin_bit_cast(bf16x8, w_); \
        w_.x = pkbf(P[8], P[9]); w_.y = pkbf(P[10], P[11]); w_.z = pkbf(P[12], P[13]); w_.w = pkbf(P[14], P[15]); PA1 = __builtin_bit_cast(bf16x8, w_); } while (0)
        SB_HALF(p1, 32, pa[2], pa[3]);
        SB_HALF(p0, 0, pa[0], pa[1]);
#undef SB_HALF
        carry -= suf;
        diag = false;
        if (kt > 0) asm volatile("s_waitcnt vmcnt(16)" ::: "memory"); else asm volatile("s_waitcnt vmcnt(0)" ::: "memory");
        LAS const unsigned char* vb = vlds + cur * VBYTES + trbase;
#pragma unroll
        for (int s = 0; s < 4; ++s) {
            LAS const unsigned char* vp = vb + (16 * s) * VPITCH;
            const s16x4 a0 = vtr(vp), a1 = vtr(vp + 8 * VPITCH), b0 = vtr(vp + 64), b1 = vtr(vp + 8 * VPITCH + 64);
            const bf16x8 v0 = {a0[0], a0[1], a0[2], a0[3], a1[0], a1[1], a1[2], a1[3]}, v1 = {b0[0], b0[1], b0[2], b0[3], b1[0], b1[1], b1[2], b1[3]};
            o0 = __builtin_amdgcn_mfma_f32_32x32x16_bf16(pa[s], v0, o0, 0, 0, 0);
            o1 = __builtin_amdgcn_mfma_f32_32x32x16_bf16(pa[s], v1, o1, 0, 0, 0);
        }
        asm volatile("s_waitcnt lgkmcnt(0)" ::: "memory");
        cur ^= 1;
        if (kt == 0 || __all(carry < EXIT_THR)) break;
    }
    asm volatile("s_waitcnt vmcnt(0)" ::: "memory");
#undef SB_LOADK
#undef SB_DMAV
    bf16_t* Ow = O + (rowbase + t0) * 512 + h * 64 + r32;
#pragma unroll
    for (int r = 0; r < 16; ++r) { const int q = crow(r, hi); Ow[(size_t)q * 512] = (bf16_t)f2bf(o0[r]); Ow[(size_t)q * 512 + 32] = (bf16_t)f2bf(o1[r]); }
}
}

__device__ __forceinline__ void p2_pool(Frame& F, const bf16_t* U, bf16_t* MIX) {
    const int rows_per = M / F.G; const int col8 = F.lane, w = 2 << (col8 >> 4);
    for (int rb = F.wave * 8; rb < rows_per; rb += NWAVES * 8) { const int t0 = F.vcu * rows_per + rb;
        v4u ld[23];
#pragma unroll
        for (int i = 0; i < 23; ++i) ld[i] = *(const GAS v4u*)(U + ((long)(t0 - 15 + i)) * PW + col8 * 8);
#pragma unroll
        for (int r = 0; r < 8; ++r) { const int tl = (t0 + r) % SEQ; const int cnt = (tl + 1) < w ? (tl + 1) : w;
            float acc[8];
#pragma unroll
            for (int j = 0; j < 8; ++j) acc[j] = 0.f;
#pragma unroll
            for (int i = 0; i < 16; ++i) { const v4u u = ld[15 + r - i]; const float m = (i < cnt) ? 1.f : 0.f;
                acc[0] += m * bf2f(u.x & 0xffffu); acc[1] += m * bf2f(u.x >> 16); acc[2] += m * bf2f(u.y & 0xffffu); acc[3] += m * bf2f(u.y >> 16);
                acc[4] += m * bf2f(u.z & 0xffffu); acc[5] += m * bf2f(u.z >> 16); acc[6] += m * bf2f(u.w & 0xffffu); acc[7] += m * bf2f(u.w >> 16); }
            const float inv = 1.f / (float)cnt; const v4u self = ld[15 + r];
            v4u o; o.x = pk2(acc[0] * inv - bf2f(self.x & 0xffffu), acc[1] * inv - bf2f(self.x >> 16)); o.y = pk2(acc[2] * inv - bf2f(self.y & 0xffffu), acc[3] * inv - bf2f(self.y >> 16));
            o.z = pk2(acc[4] * inv - bf2f(self.z & 0xffffu), acc[5] * inv - bf2f(self.z >> 16)); o.w = pk2(acc[6] * inv - bf2f(self.w & 0xffffu), acc[7] * inv - bf2f(self.w >> 16));
            *(GAS v4u*)(MIX + (size_t)(t0 + r) * PW + col8 * 8) = o; } }
}

constexpr int P5_TAB = AUX_OFF + 2048;
constexpr int P5_CNT = AUX_OFF + 1024;
constexpr int LIST_CAP = 16384;
typedef float f32x16 __attribute__((ext_vector_type(16)));
__device__ __forceinline__ void p5_route(Frame& F, const Args& a) {
    unsigned char* ws = a.ws; const float* X1 = a.out; const float* g2 = a.in[13]; const float* mod = (const float*)(ws + WS_MOD); const float* rbias = a.in[15];
    bf16_t* H2 = (bf16_t*)(ws + WS_H2); int* PE = (int*)(ws + WS_PE);
    const bf16_t* WH = (const bf16_t*)(ws + WS_WRH); const bf16_t* WL = (const bf16_t*)(ws + WS_WRL);
    unsigned long long* LIST = (unsigned long long*)(ws + WS_LIST); gu32* gcnt = F.ctl + CW_CNT;
    LAS unsigned char* Ahi = F.lds + RING_OFF; LAS unsigned char* Alo = Ahi + 65536; LAS float* part = (LAS float*)Ahi;
    LAS float* gsv = (LAS float*)(F.lds + P5_TAB); LAS float* shv = gsv + D; LAS unsigned* cnt_l = (LAS unsigned*)(F.lds + P5_CNT); LAS unsigned* base_l = cnt_l + 64; LAS float* rr = (LAS float*)(base_l + 64);
    const int lane = F.lane, wave = __builtin_amdgcn_readfirstlane(F.wave), r32 = lane & 31, hi = lane >> 5;
    const int row0 = F.vcu * 64;
    if (row0 < M) {
        const int b = row0 / SEQ;
        for (int k = F.tid; k < D; k += NWAVES * 64) { gsv[k] = g2[k] * (1.f + mod[b * 6 * D + 4 * D + k]); shv[k] = mod[b * 6 * D + 3 * D + k]; }
        if (F.tid < 64) cnt_l[F.tid] = 0u;
        { f32x4 v[8][4];
#pragma unroll
          for (int i = 0; i < 8; ++i) { const GAS f32x4* xr = (const GAS f32x4*)(X1 + (size_t)(row0 + 8 * wave + i) * D) + lane;
#pragma unroll
              for (int j = 0; j < 4; ++j) v[i][j] = xr[64 * j]; }
#pragma unroll
          for (int i = 0; i < 8; ++i) { float s = 0.f;
#pragma unroll
              for (int j = 0; j < 4; ++j) s += (v[i][j].x * v[i][j].x + v[i][j].y * v[i][j].y) + (v[i][j].z * v[i][j].z + v[i][j].w * v[i][j].w);
              s = wave_sum(s); if (lane == 0) rr[8 * wave + i] = rsqrtf(s * (1.f / D) + EPS); } }
        __syncthreads();
        f32x16 acc[2][2];
        const char* whb = (const char*)WH + wave * 8192; const char* wlb = (const char*)WL + wave * 8192;
#pragma unroll
        for (int x = 0; x < 2; ++x)
#pragma unroll
            for (int y = 0; y < 2; ++y) acc[x][y] = f32x16{};
#pragma unroll
        for (int kh = 0; kh < 2; ++kh) {
            bf16x8 bh[4][2], bl[4][2];
#pragma unroll
            for (int s4 = 0; s4 < 4; ++s4)
#pragma unroll
                for (int t = 0; t < 2; ++t) { const int fo = kh * 65536 + (s4 * 2 + t) * 1024;
                    bh[s4][t] = *(const bf16x8*)(whb + fo + lane * 16); bl[s4][t] = *(const bf16x8*)(wlb + fo + lane * 16); }
#pragma unroll
            for (int i = 0; i < 8; ++i) { const int rl = 8 * wave + i, row = row0 + rl; const float r = rr[rl];
                if ((i & 1) == 0) __builtin_amdgcn_sched_barrier(0);
                const GAS f32x4* xr = (const GAS f32x4*)(X1 + (size_t)row * D + 512 * kh) + lane;
                GAS unsigned long long* o8 = (GAS unsigned long long*)(H2 + (size_t)row * D + 512 * kh) + lane;
#pragma unroll
                for (int j = 0; j < 2; ++j) { const f32x4 xv = xr[64 * j];
                    const f32x4 gg = *(const LAS f32x4*)(gsv + 512 * kh + 4 * lane + 256 * j), ss = *(const LAS f32x4*)(shv + 512 * kh + 4 * lane + 256 * j);
                    const f32x4 h = xv * r * gg + ss;
                    const unsigned p01 = pk2(h.x, h.y), p23 = pk2(h.z, h.w);
                    const unsigned long long hh = (unsigned long long)p01 | ((unsigned long long)p23 << 32);
                    o8[64 * j] = hh;
                    const unsigned long long ll = (unsigned long long)pk2(h.x - __builtin_bit_cast(float, p01 << 16), h.y - __builtin_bit_cast(float, p01 & 0xffff0000u))
                                                | ((unsigned long long)pk2(h.z - __builtin_bit_cast(float, p23 << 16), h.w - __builtin_bit_cast(float, p23 & 0xffff0000u)) << 32);
                    const int chunk = (lane >> 1) + 32 * j, off = rl * 1024 + ((chunk ^ (rl & 15)) << 4) + ((lane & 1) << 3);
                    *(LAS unsigned long long*)(Ahi + off) = hh; *(LAS unsigned long long*)(Alo + off) = ll; } }
            __syncthreads();
#pragma unroll
            for (int s4 = 0; s4 < 4; ++s4) { const int chunk = 8 * wave + 2 * s4 + hi;
                const bf16x8 bh0 = bh[s4][0], bh1 = bh[s4][1], bl0 = bl[s4][0], bl1 = bl[s4][1];
#pragma unroll
                for (int x = 0; x < 2; ++x) { const int rw = 32 * x + r32, off = rw * 1024 + ((chunk ^ (rw & 15)) << 4);
                    const bf16x8 ah = *(const LAS bf16x8*)(Ahi + off), al = *(const LAS bf16x8*)(Alo + off);
                    acc[x][0] = __builtin_amdgcn_mfma_f32_32x32x16_bf16(ah, bh0, acc[x][0], 0, 0, 0); acc[x][1] = __builtin_amdgcn_mfma_f32_32x32x16_bf16(ah, bh1, acc[x][1], 0, 0, 0);
                    acc[x][0] = __builtin_amdgcn_mfma_f32_32x32x16_bf16(al, bh0, acc[x][0], 0, 0, 0); acc[x][1] = __builtin_amdgcn_mfma_f32_32x32x16_bf16(al, bh1, acc[x][1], 0, 0, 0);
                    acc[x][0] = __builtin_amdgcn_mfma_f32_32x32x16_bf16(ah, bl0, acc[x][0], 0, 0, 0); acc[x][1] = __builtin_amdgcn_mfma_f32_32x32x16_bf16(ah, bl1, acc[x][1], 0, 0, 0); } }
            __syncthreads();
        }
#pragma unroll
        for (int x = 0; x < 2; ++x)
#pragma unroll
            for (int r = 0; r < 16; ++r) { const int rw = 32 * x + (r & 3) + 8 * (r >> 2) + 4 * hi; part[wave * 4096 + rw * 64 + r32] = acc[x][0][r]; part[wave * 4096 + rw * 64 + 32 + r32] = acc[x][1][r]; }
        __syncthreads();
        float scq[8];
#pragma unroll
        for (int q = 0; q < 8; ++q) { const int rl = wave + 8 * q; float logit = 0.f;
#pragma unroll
            for (int w = 0; w < 8; ++w) logit += part[w * 4096 + rl * 64 + lane];
            scq[q] = 1.f / (1.f + expf(-logit)); }
        __syncthreads();
        LAS float* scoreT = (LAS float*)(F.lds + RING_OFF);
#pragma unroll
        for (int q = 0; q < 8; ++q) scoreT[lane * 65 + wave + 8 * q] = scq[q];
        __syncthreads();
        if (wave == 0) {
            float sel[64];
#pragma unroll
            for (int e = 0; e < 64; ++e) sel[e] = scoreT[e * 65 + lane] + rbias[e];
            float gs[8];
#pragma unroll
            for (int g = 0; g < 8; ++g) { float m1 = sel[8 * g], m2 = -INFINITY;
#pragma unroll
                for (int j = 1; j < 8; ++j) { const float v = sel[8 * g + j]; const float lo = fminf(m1, v); m1 = fmaxf(m1, v); m2 = fmaxf(m2, lo); }
                gs[g] = m1 + m2; }
            unsigned gmask = 0u;
#pragma unroll
            for (int g = 0; g < 8; ++g) { int rk = 0;
#pragma unroll
                for (int h = 0; h < 8; ++h) if (h != g) rk += (gs[h] > gs[g] || (gs[h] == gs[g] && h < g)) ? 1 : 0;
                gmask |= (rk < 4) ? (1u << g) : 0u; }
#pragma unroll
            for (int e = 0; e < 64; ++e) sel[e] = ((gmask >> (e >> 3)) & 1u) ? sel[e] : -INFINITY;
            unsigned long long taken = 0ull; int ex[8]; float ws_[8]; float wsum = 0.f;
#pragma unroll
            for (int r = 0; r < TOPK; ++r) { float best = -INFINITY; int bi = 0;
#pragma unroll
                for (int e = 0; e < 64; ++e) { const bool c = !((taken >> e) & 1ull) && sel[e] > best; best = c ? sel[e] : best; bi = c ? e : bi; }
                taken |= 1ull << bi; ex[r] = bi; ws_[r] = scoreT[bi * 65 + lane]; wsum += ws_[r]; }
            const float wn = RSCALE / wsum;
#pragma unroll
            for (int r = 0; r < TOPK; ++r) { const unsigned pos = __hip_atomic_fetch_add(cnt_l + ex[r], 1u, __ATOMIC_RELAXED, __HIP_MEMORY_SCOPE_WORKGROUP);
                LAS unsigned* pk = (LAS unsigned*)(F.lds + RING_OFF + 32768) + (lane * 8 + r) * 4; pk[0] = (unsigned)ex[r]; pk[1] = pos; pk[2] = __builtin_bit_cast(unsigned, ws_[r] * wn); }
        }
        __syncthreads();
        if (F.tid < 64) base_l[F.tid] = __hip_atomic_fetch_add(gcnt + 64 * F.tid, cnt_l[F.tid], __ATOMIC_RELAXED, __HIP_MEMORY_SCOPE_AGENT);
        __syncthreads();
        { LAS const unsigned* pk = (LAS const unsigned*)(F.lds + RING_OFF + 32768) + F.tid * 4; const unsigned e = pk[0], pos = pk[1], wb = pk[2];
          const int pair = (row0 + (F.tid >> 3)) * 8 + (F.tid & 7);
          LIST[(size_t)e * LIST_CAP + base_l[e] + pos] = (unsigned long long)(unsigned)pair | ((unsigned long long)wb << 32);
          PE[pair] = (int)e; }
        __syncthreads();
    }
}

namespace pg8 {
struct UnitG { int kind, slot, nvalid, pm, pn, row0; const char* bptr; };
constexpr int P6_PRE = AUX_OFF + 1024;
constexpr int P6_ROWS = AUX_OFF + 2048;
struct SchedG {
    const LAS int* pre; const LAS int* cnts; const LAS int* cum; const char* wgu; const char* wsh; int G, c, nr, total;
    __device__ __forceinline__ bool next(int i, UnitG& u) const {
        const int idx = i * G + c; if (idx >= total) return false;
        if (idx < nr) { int e = (int)__builtin_popcountll(__ballot(pre[1 + (threadIdx.x & 63)] <= idx));
            e = __builtin_amdgcn_readfirstlane(e); const int j = idx - __builtin_amdgcn_readfirstlane(pre[e]); const int nv = __builtin_amdgcn_readfirstlane(cnts[e]) - 256 * j;
            u.kind = 0; u.slot = i; u.nvalid = nv < 256 ? nv : 256; u.pm = e; u.pn = j; u.row0 = 256 * idx; u.bptr = wgu + (size_t)e * 256 * D * 2; }
        else { const int s = idx - nr; u.kind = 1; u.slot = i; u.nvalid = 256; u.pm = s >> 1; u.pn = s & 1; u.row0 = (s >> 1) * 256; u.bptr = wsh + (size_t)(s & 1) * 256 * D * 2; }
        return true; }
};
struct EpiGU {
    static constexpr bool PERM = true;
    bf16_t* HM; bf16_t* SH; int* SLOT; const LAS unsigned long long* rowinfo;
    __device__ __forceinline__ void operator()(const f32x4 (&acc)[2][2][4][2], const UnitG& u, int wr, int wc, int fr, int fq) const {
#pragma unroll
        for (int ai = 0; ai < 2; ++ai)
#pragma unroll
            for (int m = 0; m < 4; ++m) { const int r = ai * HALF + wr * 64 + m * 16 + fr;
                bf16_t* dst; float w;
                if (u.kind == 0) { const unsigned long long ri = rowinfo[u.slot * 256 + r]; dst = HM + (size_t)(u.row0 + r) * ED + wc * 32 + 8 * fq; w = __builtin_bit_cast(float, (unsigned)(ri >> 32));
                    if (wc == 0 && fq == 0) SLOT[u.row0 + r] = (r < u.nvalid) ? (int)(unsigned)ri : M * 8; }
                else { dst = SH + (size_t)(u.pm * 256 + r) * SHD + u.pn * 128 + wc * 32 + 8 * fq; w = 1.f; }
                const f32x4 g0 = acc[ai][0][m][0], g1 = acc[ai][0][m][1], u0 = acc[ai][1][m][0], u1 = acc[ai][1][m][1];
                float v[8];
#pragma unroll
                for (int j = 0; j < 4; ++j) { v[j] = g0[j] * fsigmoid(g0[j]) * u0[j] * w; v[4 + j] = g1[j] * fsigmoid(g1[j]) * u1[j] * w; }
                u32x4 o; o.x = cvt_pk_bf16(v[0], v[1]); o.y = cvt_pk_bf16(v[2], v[3]); o.z = cvt_pk_bf16(v[4], v[5]); o.w = cvt_pk_bf16(v[6], v[7]);
                if (r < u.nvalid) *(u32x4*)dst = o; }
    }
};
template <class Epi, class Sched>
__device__ __forceinline__ void gemm_phase_g(PG8_LAS unsigned char* lds, const bf16_t* A, int K, const Sched& S, const Epi& E, const PG8_LAS unsigned long long* rowinfo) {
    int tid_ = threadIdx.x; asm volatile("" : "+v"(tid_));
    const int tid = tid_, wid = __builtin_amdgcn_readfirstlane(tid >> 6), lane = tid & 63, wr = wid >> 2, wc = wid & 3, fr = lane & 15, fq = lane >> 4;
    const int nt = K / BK;
    int RA[2], CA[2]; unsigned voffB[2];
#pragma unroll
    for (int i = 0; i < 2; ++i) { int R, C; stage_rc(tid * 16 + i * 8192, R, C); const int Rb = Epi::PERM ? ((R & ~31) + perm32(R & 31)) : R; RA[i] = R; CA[i] = C; voffB[i] = (unsigned)(Rb * K + C) * 2u; }
    const size_t kstep = (size_t)(BK * 2);
    const size_t hstep = (size_t)HALF * K * 2;
    const unsigned ldsw = (unsigned)wid * 1024u;
    const int aoff = lds_byte(wr * 64 + fr, fq * 8), boff = lds_byte(wc * 32 + fr, fq * 8);
#define PG8_AOFF(u, o0, o1) do { _Pragma("unroll") for (int _i = 0; _i < 2; ++_i) { unsigned r0_, r1_; \
        if ((u).kind == 0) { r0_ = (unsigned)rowinfo[(u).slot * 256 + RA[_i]] >> 3; r1_ = (unsigned)rowinfo[(u).slot * 256 + HALF + RA[_i]] >> 3; } \
        else { r0_ = (unsigned)((u).row0 + RA[_i]); r1_ = r0_ + HALF; } \
        o0[_i] = (r0_ * (unsigned)K + (unsigned)CA[_i]) * 2u; o1[_i] = (r1_ * (unsigned)K + (unsigned)CA[_i]) * 2u; } } while (0)
#define PG8_SA(b, h) (((b) * 2 + (h)) * HTB)
#define PG8_SB(b, h) ((4 + (b) * 2 + (h)) * HTB)
#define PG8_STAGE(bufoff, gbase, voff) do { _Pragma("unroll") for (int _i = 0; _i < 2; ++_i) \
        __builtin_amdgcn_global_load_lds((const unsigned*)((const char*)(gbase) + (voff)[_i]), (PG8_LAS unsigned*)(lds + (bufoff) + ldsw + _i * 8192), 16, 0, 0); } while (0)
#define PG8_LDA(dst, b, h) do { _Pragma("unroll") for (int m = 0; m < 4; ++m) _Pragma("unroll") for (int k = 0; k < 2; ++k) dst[m][k] = *(const PG8_LAS bf16x8*)(lds + PG8_SA(b, h) + aoff + m * 2048 + k * 1024); } while (0)
#define PG8_LDB(dst, b, h) do { _Pragma("unroll") for (int n = 0; n < 2; ++n) _Pragma("unroll") for (int k = 0; k < 2; ++k) dst[n][k] = *(const PG8_LAS bf16x8*)(lds + PG8_SB(b, h) + boff + n * 2048 + k * 1024); } while (0)
#define PG8_MMA(ai, bj, At, Bt) do { __builtin_amdgcn_s_setprio(1); _Pragma("unroll") for (int m = 0; m < 4; ++m) _Pragma("unroll") for (int n = 0; n < 2; ++n) _Pragma("unroll") for (int k = 0; k < 2; ++k) \
        acc[ai][bj][m][n] = __builtin_amdgcn_mfma_f32_16x16x32_bf16(Bt[n][k], At[m][k], acc[ai][bj][m][n], 0, 0, 0); __builtin_amdgcn_s_setprio(0); } while (0)
#define PG8_WAIT_V(n) asm volatile("s_waitcnt vmcnt(" #n ")" ::: "memory")
#define PG8_WAIT_L(n) asm volatile("s_waitcnt lgkmcnt(" #n ")" ::: "memory")
#define PG8_BAR __builtin_amdgcn_s_barrier()
#define PG8_SCHED __builtin_amdgcn_sched_barrier(0)
    UnitG cur, nxt; int ui = 0;
    if (!S.next(0, cur)) return;
    f32x4 acc[2][2][4][2];
#pragma unroll
    for (int a = 0; a < 2; ++a)
#pragma unroll
        for (int b = 0; b < 2; ++b)
#pragma unroll
            for (int m = 0; m < 4; ++m)
#pragma unroll
                for (int n = 0; n < 2; ++n) acc[a][b][m][n] = (f32x4){0.f, 0.f, 0.f, 0.f};
    bf16x8 At[4][2], B0[2][2], B1[2][2];
    const char* cA = (const char*)A; const char* cB = cur.bptr;
    unsigned vA0[2], vA1[2], nA0[2], nA1[2];
    PG8_AOFF(cur, vA0, vA1);
    PG8_STAGE(PG8_SB(0, 0), cB, voffB); PG8_STAGE(PG8_SB(0, 1), cB + hstep, voffB); PG8_STAGE(PG8_SA(0, 0), cA, vA0); PG8_STAGE(PG8_SA(0, 1), cA, vA1);
    if (wr == 1) PG8_BAR;
    PG8_WAIT_V(2); PG8_BAR;
    PG8_STAGE(PG8_SB(1, 0), cB + kstep, voffB); PG8_STAGE(PG8_SA(1, 0), cA + kstep, vA0); PG8_STAGE(PG8_SB(1, 1), cB + hstep + kstep, voffB);
    PG8_WAIT_V(6); PG8_BAR;
    for (;;) {
        const bool has_next = S.next(ui + 1, nxt);
        const char* nB = has_next ? nxt.bptr : cB;
        if (has_next) { PG8_AOFF(nxt, nA0, nA1); } else {
#pragma unroll
            for (int _i = 0; _i < 2; ++_i) { nA0[_i] = vA0[_i]; nA1[_i] = vA1[_i]; } }
#pragma nounroll
        for (int t = 0; t < nt; t += 2) {
            const bool last = (t == nt - 2);
            const char* a1 = cA + (size_t)(t + 1) * kstep;
            const char* a2 = last ? cA : cA + (size_t)(t + 2) * kstep; const char* b2 = last ? nB : cB + (size_t)(t + 2) * kstep;
            const char* a3 = a2 + kstep; const char* b3 = b2 + kstep;
            unsigned s0[2], s1[2];
#pragma unroll
            for (int _i = 0; _i < 2; ++_i) { s0[_i] = last ? nA0[_i] : vA0[_i]; s1[_i] = last ? nA1[_i] : vA1[_i]; }
            PG8_LDB(B0, 0, 0); PG8_LDB(B1, 0, 1); PG8_SCHED; PG8_LDA(At, 0, 0); PG8_STAGE(PG8_SA(1, 1), a1, vA1);
            PG8_WAIT_V(8); PG8_WAIT_L(0); PG8_BAR; PG8_MMA(0, 0, At, B0); PG8_MMA(0, 1, At, B1); PG8_BAR; PG8_SCHED;
            PG8_LDA(At, 0, 1); PG8_STAGE(PG8_SB(0, 0), b2, voffB); PG8_STAGE(PG8_SB(0, 1), b2 + hstep, voffB); PG8_STAGE(PG8_SA(0, 0), a2, s0);
            PG8_WAIT_V(8); PG8_WAIT_L(0); PG8_BAR; PG8_MMA(1, 0, At, B0); PG8_MMA(1, 1, At, B1); PG8_BAR; PG8_SCHED;
            PG8_LDB(B0, 1, 0); PG8_LDB(B1, 1, 1); PG8_SCHED; PG8_LDA(At, 1, 0); PG8_STAGE(PG8_SA(0, 1), a2, s1);
            PG8_WAIT_V(8); PG8_WAIT_L(0); PG8_BAR; PG8_MMA(0, 0, At, B0); PG8_MMA(0, 1, At, B1); PG8_BAR; PG8_SCHED;
            PG8_LDA(At, 1, 1); PG8_STAGE(PG8_SB(1, 0), b3, voffB); PG8_STAGE(PG8_SB(1, 1), b3 + hstep, voffB); PG8_STAGE(PG8_SA(1, 0), a3, s0);
            PG8_WAIT_V(8); PG8_WAIT_L(0); PG8_BAR; PG8_MMA(1, 0, At, B0); PG8_MMA(1, 1, At, B1); PG8_BAR; PG8_SCHED;
        }
        if (wr == 0) PG8_BAR;
        E(acc, cur, wr, wc, fr, fq);
        if (!has_next) break;
#pragma unroll
        for (int a = 0; a < 2; ++a)
#pragma unroll
            for (int b = 0; b < 2; ++b)
#pragma unroll
                for (int m = 0; m < 4; ++m)
#pragma unroll
                    for (int n = 0; n < 2; ++n) acc[a][b][m][n] = (f32x4){0.f, 0.f, 0.f, 0.f};
        cur = nxt; cB = nB; ++ui;
#pragma unroll
        for (int _i = 0; _i < 2; ++_i) { vA0[_i] = nA0[_i]; vA1[_i] = nA1[_i]; }
        if (wr == 1) PG8_BAR;
    }
    PG8_WAIT_V(0);
    PG8_BAR;
#undef PG8_AOFF
#undef PG8_SA
#undef PG8_SB
#undef PG8_STAGE
#undef PG8_LDA
#undef PG8_LDB
#undef PG8_MMA
#undef PG8_WAIT_V
#undef PG8_WAIT_L
#undef PG8_BAR
#undef PG8_SCHED
}
}

__device__ __forceinline__ void p6_gateup(Frame& F, const Args& a) {
    unsigned char* ws = a.ws; gu32* gcnt = F.ctl + CW_CNT; const unsigned long long* LIST = (const unsigned long long*)(ws + WS_LIST);
    LAS int* pre = (LAS int*)(F.lds + pg8::P6_PRE); LAS int* cnts = pre + 65; LAS int* cum = cnts + 64; LAS unsigned long long* rowinfo = (LAS unsigned long long*)(F.lds + pg8::P6_ROWS);
    if (F.tid < 64) cnts[F.tid] = (int)__hip_atomic_load(gcnt + 64 * F.tid, RLX_AGENT);
    __syncthreads();
    if (F.tid == 0) { int s = 0, r = 0; for (int e = 0; e < 64; ++e) { pre[e] = s; cum[e] = r; s += (cnts[e] + 255) >> 8; r += cnts[e]; } pre[64] = s; cum[64] = r; }
    __syncthreads();
    pg8::SchedG S; S.pre = pre; S.cnts = cnts; S.cum = cum; S.wgu = (const char*)(ws + WS_WGU); S.wsh = (const char*)(ws + WS_WSHGU); S.G = F.G; S.c = (int)blockIdx.x; S.nr = __builtin_amdgcn_readfirstlane(pre[64]); S.total = S.nr + 2 * (M / 256);
    for (int i = 0; i < 3; ++i) { pg8::UnitG u; if (!S.next(i, u)) break;
        if (u.kind == 0 && F.tid < 256) { const int r = F.tid; rowinfo[i * 256 + r] = (r < u.nvalid) ? LIST[(size_t)u.pm * LIST_CAP + 256 * u.pn + r] : 0ull; } }
    __syncthreads();
    pg8::EpiGU E{(bf16_t*)(ws + WS_HM), (bf16_t*)(ws + WS_SH), (int*)(ws + WS_SLOT), rowinfo};
    pg8::gemm_phase_g<pg8::EpiGU, pg8::SchedG>(F.lds + RING_OFF, (const bf16_t*)(ws + WS_H2), D, S, E, rowinfo);
    { const int rounds = (S.total + F.G - 1) / F.G, firstidle = S.total - (rounds - 1) * F.G;
      const int c = (int)blockIdx.x, nidle = F.G - firstidle;
      if (nidle > 0) { if (c >= firstidle) titem_run(F, a, true, 64 * 64 + 4 * 32, (c - firstidle) * NWAVES + F.wave, nidle * NWAVES); }
      else titem_run(F, a, true, 64 * 64 + 4 * 32, c * NWAVES + F.wave, F.G * NWAVES); }
}

namespace pg8 {
struct SchedYr {
    const LAS int* pre; int G, c, total;
    __device__ __forceinline__ bool next(int i, Unit& u) const {
        const int idx = i * G + c; if (idx >= total) return false;
        const int t = idx >> 2, pnl = idx & 3; int e = (int)__builtin_popcountll(__ballot(pre[1 + (threadIdx.x & 63)] <= t));
        e = __builtin_amdgcn_readfirstlane(e); u.pm = t; u.pn = 4 * e + pnl; return true; }
    __device__ __forceinline__ void a_ready(const Unit&) const {}
    __device__ __forceinline__ void done(const Unit&) const {}
};
constexpr float YSCALE = 8.f;
struct EpiStoreF8 {
    static constexpr bool PERM = true, AFTER_DRAIN = false;
    unsigned char* O; const PG8_LAS int* rowmap_l; int G, c;
    __device__ __forceinline__ void operator()(const f32x4 (&acc)[2][2][4][2], const Unit& u, int wr, int wc, int fr, int fq) const {
        const int slot = (4 * u.pm + (u.pn & 3) - c) / G; const PG8_LAS int* rm = rowmap_l + slot * 256 + wr * 64 + fr; const int col0 = (u.pn & 3) * BM + wc * 64 + 16 * fq;
#pragma unroll
        for (int ai = 0; ai < 2; ++ai)
#pragma unroll
            for (int m = 0; m < 4; ++m) { const int orow = rm[ai * HALF + m * 16]; u32x4 w;
#pragma unroll
                for (int bj = 0; bj < 2; ++bj) { const f32x4 v0 = acc[ai][bj][m][0] * YSCALE, v1 = acc[ai][bj][m][1] * YSCALE;
                    unsigned lo = 0u, hi = 0u;
                    lo = __builtin_amdgcn_cvt_pk_fp8_f32(v0[0], v0[1], lo, false); lo = __builtin_amdgcn_cvt_pk_fp8_f32(v0[2], v0[3], lo, true);
                    hi = __builtin_amdgcn_cvt_pk_fp8_f32(v1[0], v1[1], hi, false); hi = __builtin_amdgcn_cvt_pk_fp8_f32(v1[2], v1[3], hi, true);
                    if (bj == 0) { w.x = lo; w.y = hi; } else { w.z = lo; w.w = hi; } }
                *(u32x4*)(O + (size_t)orow * 1024 + col0) = w; }
    }
};
struct EpiStore {
    static constexpr bool PERM = true, AFTER_DRAIN = false;
    bf16_t* O; int ldc, colmask;
    __device__ __forceinline__ void operator()(const f32x4 (&acc)[2][2][4][2], const Unit& u, int wr, int wc, int fr, int fq) const {
        const int row0 = u.pm * BM + wr * 64 + fr, col0 = (u.pn & colmask) * BM + wc * 32 + 8 * fq;
#pragma unroll
        for (int ai = 0; ai < 2; ++ai)
#pragma unroll
            for (int m = 0; m < 4; ++m) { bf16_t* rowp = O + (size_t)(row0 + ai * HALF + m * 16) * ldc + col0;
#pragma unroll
                for (int bj = 0; bj < 2; ++bj) { const f32x4 v0 = acc[ai][bj][m][0], v1 = acc[ai][bj][m][1];
                    u32x4 w; w.x = cvt_pk_bf16(v0[0], v0[1]); w.y = cvt_pk_bf16(v0[2], v0[3]); w.z = cvt_pk_bf16(v1[0], v1[1]); w.w = cvt_pk_bf16(v1[2], v1[3]);
                    *(u32x4*)(rowp + bj * HALF) = w; } }
    }
};
}
__device__ __forceinline__ void p7_down(Frame& F, const Args& a) {
    unsigned char* ws = a.ws; gu32* gcnt = F.ctl + CW_CNT;
    LAS int* pre = (LAS int*)(F.lds + pg8::P6_PRE); LAS int* cnts = pre + 65;
    if (F.tid < 64) cnts[F.tid] = (int)__hip_atomic_load(gcnt + 64 * F.tid, RLX_AGENT);
    __syncthreads();
    if (F.tid == 0) { int s = 0; for (int e = 0; e < 64; ++e) { pre[e] = s; s += (cnts[e] + 255) >> 8; } pre[64] = s; }
    __syncthreads();
    { pg8::SchedYr S; S.pre = pre; S.G = F.G; S.c = (int)blockIdx.x; S.total = 4 * __builtin_amdgcn_readfirstlane(pre[64]);
      int kk = ED; asm volatile("" : "+s"(kk));
      LAS int* rml = (LAS int*)(F.lds + AUX_OFF + 2048); const int* rowmap = (const int*)(ws + WS_SLOT);
      for (int i = 0; i * F.G + S.c < S.total && i < 12; ++i) { if (F.tid < 256) rml[i * 256 + F.tid] = rowmap[256 * ((i * F.G + S.c) >> 2) + F.tid]; }
      __syncthreads();
      pg8::Gemm g{(const bf16_t*)(ws + WS_HM), (const bf16_t*)(ws + WS_WD), 0, 0, kk}; pg8::EpiStoreF8 E{ws + WS_YH, rml, F.G, S.c};
      pg8::gemm_phase<pg8::EpiStoreF8, pg8::SchedYr, true, true>(F.lds + RING_OFF, g, S, E); }
    { pg8::StaticOrder S; S.init(M, D, F.G, (int)blockIdx.x);
      int kk = SHD; asm volatile("" : "+s"(kk));
      pg8::Gemm g{(const bf16_t*)(ws + WS_SH), (const bf16_t*)(ws + WS_WSHD), M, D, kk}; pg8::EpiStore E{(bf16_t*)(ws + WS_YSH), D, 3};
      pg8::gemm_phase<pg8::EpiStore, pg8::StaticOrder, true, true>(F.lds + RING_OFF, g, S, E); }
}
__device__ __forceinline__ void p8_combine(Frame& F, const Args& a) {
    unsigned char* ws = a.ws; const unsigned char* Y8 = ws + WS_YH; const bf16_t* YSH = (const bf16_t*)(ws + WS_YSH);
    const float* mod = (const float*)(ws + WS_MOD); float* OUT = a.out; const int lane = F.lane;
    for (int tb = (F.vcu * NWAVES + F.wave) * 8; tb < M; tb += F.G * NWAVES * 8) {
        const int b = tb / SEQ; const float* gate = mod + (size_t)b * 6 * D + 5 * D + lane * 16;
        f32x4 gv[4];
#pragma unroll
        for (int i = 0; i < 4; ++i) gv[i] = *(const f32x4*)(gate + 4 * i);
#pragma nounroll
        for (int i = 0; i < 8; i += 2) {
            v4u y[2][8], ys[2][2]; f32x4 x[2][4];
#pragma unroll
            for (int q = 0; q < 2; ++q) { const int t = tb + i + q;
#pragma unroll
                for (int k = 0; k < 8; ++k) y[q][k] = *(const GAS v4u*)(Y8 + ((size_t)t * 8 + k) * 1024 + lane * 16);
                const GAS v4u* sp = (const GAS v4u*)(YSH + (size_t)t * D + lane * 16); ys[q][0] = sp[0]; ys[q][1] = sp[1];
                const GAS f32x4* o = (const GAS f32x4*)(OUT + (size_t)t * D + lane * 16);
#pragma unroll
                for (int j = 0; j < 4; ++j) x[q][j] = o[j]; }
#pragma unroll
            for (int q = 0; q < 2; ++q) { const int t = tb + i + q; float acc[16];
#pragma unroll
                for (int j = 0; j < 16; ++j) acc[j] = 0.f;
#pragma unroll
                for (int k = 0; k < 8; ++k) { const unsigned w4[4] = {y[q][k].x, y[q][k].y, y[q][k].z, y[q][k].w};
#pragma unroll
                    for (int j = 0; j < 4; ++j) { const pg8::f32x2_t lo = __builtin_amdgcn_cvt_pk_f32_fp8((int)w4[j], false), hi = __builtin_amdgcn_cvt_pk_f32_fp8((int)w4[j], true);
                        acc[4 * j] += lo.x; acc[4 * j + 1] += lo.y; acc[4 * j + 2] += hi.x; acc[4 * j + 3] += hi.y; } }
                GAS f32x4* o = (GAS f32x4*)(OUT + (size_t)t * D + lane * 16);
#pragma unroll
                for (int j = 0; j < 4; ++j) { const unsigned s0 = (j < 2 ? ys[q][0] : ys[q][1])[2 * (j & 1)], s1 = (j < 2 ? ys[q][0] : ys[q][1])[2 * (j & 1) + 1];
                    const f32x4 sh = {bf2f(s0 & 0xffffu), bf2f(s0 >> 16), bf2f(s1 & 0xffffu), bf2f(s1 >> 16)};
                    const f32x4 rt = {acc[4 * j], acc[4 * j + 1], acc[4 * j + 2], acc[4 * j + 3]};
                    o[j] = x[q][j] + gv[j] * (rt * (1.f / pg8::YSCALE) + sh); } }
        }
    }
}

__global__ void __launch_bounds__(NWAVES * 64, 2) mk_fwd(Args args) {
    extern __shared__ __attribute__((aligned(16))) unsigned char lds[];
    Frame F;
    F.lds = (LAS unsigned char*)lds; F.MISC = (volatile LAS unsigned*)(F.lds + MISC_OFF);
    F.tid = threadIdx.x; F.lane = F.tid & 63; F.wave = __builtin_amdgcn_readfirstlane(F.tid >> 6);
    F.G = gridDim.x; { const int bx = blockIdx.x; F.vcu = (F.G % 8 == 0) ? (bx % 8) * (F.G / 8) + bx / 8 : bx; }
    unsigned char* ws = args.ws; F.ctl = (gu32*)(ws + WS_CTL);
    for (int u = F.tid; u < (LDS_BYTES - LDSCTL_OFF) / 4; u += NWAVES * 64) ((LAS unsigned*)(F.lds + LDSCTL_OFF))[u] = 0u;
    __syncthreads();
    XcdBarrier bar; bar.bar = (unsigned*)(F.ctl + CW_BAR); bar.x = 0; bar.st = nullptr;
    if (args.use_bar) bar = xcd_barrier_post((unsigned*)(F.ctl + CW_BAR), F.MISC + 8);
    const int lo = args.ph_lo, hi = args.ph_hi;
#define IN(k) (lo <= (k) && (k) < hi)
#define SEAM(k) do { if (IN(k) && IN((k) + 1)) xcd_barrier(bar); } while (0)
#define PHASE(p, ...) do { if (IN(p)) { const int reps_ = (DBL_PHASE == (p)) ? 2 : 1; for (int rep_ = 0; rep_ < reps_; ++rep_) { __VA_ARGS__; if (rep_ + 1 < reps_) xcd_barrier(bar); } } SEAM(p); } while (0)
    PHASE(0, p0a(F, args));
    PHASE(1, p0b(F, args));
    PHASE(2, {
        pg8::Gemm g{(const bf16_t*)(ws + WS_XN), (const bf16_t*)(ws + WS_WIN), M, INW, D}; pg8::StaticOrder S; S.init(M, INW, F.G, (int)blockIdx.x);
        pg8::EpiProj E{(bf16_t*)(ws + WS_Q), (bf16_t*)(ws + WS_K), (bf16_t*)(ws + WS_V), (bf16_t*)(ws + WS_U), (bf16_t*)(ws + WS_GA), (bf16_t*)(ws + WS_GB), args.in[6], args.in[7]};
        pg8::gemm_phase<pg8::EpiProj, pg8::StaticOrder, true, true>(F.lds + RING_OFF, g, S, E); });
    PHASE(3, {
        const bf16_t* Q = (const bf16_t*)(ws + WS_Q); const bf16_t* K = (const bf16_t*)(ws + WS_K); const bf16_t* V = (const bf16_t*)(ws + WS_V);
        for (int u = blockIdx.x; u < BATCH * NH * (SEQ / 256); u += F.G) { const int qb = u & 15, bh = u >> 4;
            sb::attn_unit(bh >> 3, bh & 7, qb, Q, K, V, (bf16_t*)(ws + WS_OSB), F.lds + RING_OFF + F.wave * sb::WAVE_LDS, F.wave, F.lane); }
        p2_pool(F, (const bf16_t*)(ws + WS_U), (bf16_t*)(ws + WS_MIX)); });
    PHASE(4, {
        pg8::StaticOrder S; S.init(M, D, F.G, (int)blockIdx.x);
        { pg8::Gemm g{(const bf16_t*)(ws + WS_OSB), (const bf16_t*)(ws + WS_WSB), M, D, SBW}; pg8::EpiMerge E{(const bf16_t*)(ws + WS_GA), (bf16_t*)(ws + WS_MERGED), 0};
          pg8::gemm_phase<pg8::EpiMerge, pg8::StaticOrder, true, true>(F.lds + RING_OFF, g, S, E); }
        { pg8::Gemm g{(const bf16_t*)(ws + WS_MIX), (const bf16_t*)(ws + WS_WEFF), M, D, PW}; pg8::EpiMerge E{(const bf16_t*)(ws + WS_GB), (bf16_t*)(ws + WS_MERGED), 1};
          pg8::gemm_phase<pg8::EpiMerge, pg8::StaticOrder, true, true>(F.lds + RING_OFF, g, S, E); } });
    PHASE(5, {
        pg8::Gemm g{(const bf16_t*)(ws + WS_MERGED), (const bf16_t*)(ws + WS_WOUT), M, D, D}; pg8::StaticOrder S; S.init(M, D, F.G, (int)blockIdx.x);
        pg8::EpiX1 E{args.in[0], (const float*)(ws + WS_MOD) + 2 * D, args.out};
        pg8::gemm_phase<pg8::EpiX1, pg8::StaticOrder, true, true>(F.lds + RING_OFF, g, S, E); });
    PHASE(6, {
        if (rep_ > 0) { if (blockIdx.x == 0 && F.tid < 64) __hip_atomic_store(F.ctl + CW_CNT + 64 * F.tid, 0u, RLX_AGENT); xcd_barrier(bar); }
        p5_route(F, args); });
    PHASE(7, p6_gateup(F, args));
    PHASE(8, p7_down(F, args));
    if (IN(9)) { p8_combine(F, args); }
#undef PHASE
#undef IN
#undef SEAM
}
constexpr int N_PHASES = 10;
extern "C" void kernel_launch(void* const* d_in, const int* in_sizes, int n_in, void* d_out, int out_size, void* d_ws, size_t ws_size, hipStream_t stream) {
    static int grid = 0;
    if (grid == 0) {
        if (n_in != 22 || out_size != M * D || ws_size < WS_END) { fprintf(stderr, "kernel_launch: unexpected shapes n_in %d out %d ws %zu\n", n_in, out_size, ws_size); grid = -1; return; }
        int dev = 0, cus = 0, per_cu = 0;
        if (hipGetDevice(&dev) != hipSuccess || hipDeviceGetAttribute(&cus, hipDeviceAttributeMultiprocessorCount, dev) != hipSuccess) { grid = -1; return; }
        if (hipFuncSetAttribute((const void*)mk_fwd, hipFuncAttributeMaxDynamicSharedMemorySize, LDS_BYTES) != hipSuccess) { fprintf(stderr, "kernel_launch: hipFuncSetAttribute failed\n"); grid = -1; return; }
        if (hipOccupancyMaxActiveBlocksPerMultiprocessor(&per_cu, (const void*)mk_fwd, NWAVES * 64, LDS_BYTES) != hipSuccess || per_cu < 1) fprintf(stderr, "kernel_launch: occupancy query says %d per CU\n", per_cu);
        (void)hipGetLastError();
        grid = cus;
        if (grid * 64 < M) { fprintf(stderr, "kernel_launch: %d CUs cannot cover %d rows in the one-block-per-workgroup phases\n", cus, M); grid = -1; return; }
    }
    if (grid < 0) return;
    unsigned char* ws = (unsigned char*)d_ws;
    if (hipMemsetAsync(ws + WS_CTL, 0, CTL_ZERO_BYTES, stream) != hipSuccess) { fprintf(stderr, "kernel_launch: memset failed\n"); return; }
    Args a{};
    for (int i = 0; i < 22; ++i) a.in[i] = (const float*)d_in[i];
    a.out = (float*)d_out; a.ws = ws; a.ph_lo = 0; a.ph_hi = N_PHASES; a.use_bar = 1;
    hipLaunchKernelGGL(mk_fwd, dim3(grid), dim3(NWAVES * 64), LDS_BYTES, stream, a);
}
```

```cpp
#include <hip/hip_runtime.h>
#include <cstdint>
#include <cstdio>

typedef unsigned short bf16_t;
constexpr int D = 1024, BATCH = 4, SEQ = 4096, M = BATCH * SEQ, NH = 8, HD = 64, SBW = 512, PW = 512, INW = 4096;
constexpr int NE = 64, ED = 128, TOPK = 8, SHD = 256;
constexpr float EPS = 1e-6f, RSCALE = 2.5f;

constexpr size_t MiB = 1u << 20;
constexpr size_t WS_CTL = 0, WS_MOD = 1 * MiB, WS_PE = 2 * MiB, WS_PW = 3 * MiB, WS_LIST = 4 * MiB;
constexpr size_t WS_XN = 74 * MiB, WS_OSB = 74 * MiB, WS_MIX = 90 * MiB, WS_H2 = 74 * MiB;
constexpr size_t WS_Q = 106 * MiB, WS_K = 122 * MiB, WS_V = 138 * MiB, WS_MERGED = 106 * MiB;
constexpr size_t WS_SLOT = 190 * MiB, WS_SH = 192 * MiB, WS_HM = 200 * MiB;
constexpr size_t WS_YH = 12 * MiB, WS_YSH = 156 * MiB;
constexpr size_t WS_U = 154 * MiB, WS_GA = 170 * MiB, WS_GB = 202 * MiB, WS_END = 256 * MiB;

__device__ __forceinline__ unsigned f2bf(float f) { unsigned u = __builtin_bit_cast(unsigned, f); return (u + 0x7fffu + ((u >> 16) & 1u)) >> 16; }
__device__ __forceinline__ float bf2f(unsigned h) { return __builtin_bit_cast(float, h << 16); }
__device__ __forceinline__ float wave_sum(float v) {
#pragma unroll
    for (int o = 1; o < 64; o <<= 1) v += __shfl_xor(v, o);
    return v;
}
__device__ __forceinline__ float sigmoidf_(float v) { return 1.f / (1.f + __expf(-v)); }
__device__ __forceinline__ float siluf_(float v) { return v / (1.f + __expf(-v)); }

namespace pg8 {
#define PG8_LAS __attribute__((address_space(3)))
typedef short bf16x8 __attribute__((ext_vector_type(8)));
typedef float f32x4 __attribute__((ext_vector_type(4)));
typedef unsigned u32x4 __attribute__((ext_vector_type(4)));
constexpr int BM = 256, BK = 64, HALF = 128, HTB = HALF * BK * 2  , STAGE_BYTES = 8 * HTB, NXCD = 8, WGM = 8;

__host__ __device__ __forceinline__ int lds_byte(int r, int c) { const int st = (r >> 4) * 2 + (c >> 5), rr = r & 15, cc = c & 31, ob = rr * 64 + cc * 2; return st * 1024 + (ob ^ (((ob >> 9) & 1) << 5)); }
__host__ __device__ __forceinline__ void stage_rc(int b, int& R, int& C) { const int st = b / 1024, sb = b % 1024, swz = sb ^ (((sb >> 9) & 1) << 5); R = (st >> 1) * 16 + swz / 64; C = (st & 1) * 32 + (swz % 64) / 2; }
__host__ __device__ __forceinline__ int perm32(int rho) { const int n = rho >> 4, i = rho & 15; return 8 * (i >> 2) + 4 * n + (i & 3); }

struct Unit { int pm, pn; };
struct Gemm { const bf16_t* A; const bf16_t* Bt; int M, N, K; };

struct StaticOrder {
    int nM, nN, nwg, G, c;
    __host__ __device__ void init(int M_, int N_, int G_, int c_) { nM = M_ / BM; nN = N_ / BM; nwg = nM * nN; G = G_; c = c_; }
    __host__ __device__ bool next(int i, Unit& u) const {
        const long L = (long)i * G + c; if (L >= nwg) return false;
        int wgid = (int)L; { const int q = nwg / NXCD, r = nwg % NXCD, xcd = wgid % NXCD, off = wgid / NXCD; wgid = (xcd < r ? xcd * (q + 1) : r * (q + 1) + (xcd - r) * q) + off; }
        const int nig = WGM * nN, gid = wgid / nig, fm = gid * WGM, gsz = (nM - fm) < WGM ? (nM - fm) : WGM;
        u.pm = fm + ((wgid % nig) % gsz); u.pn = (wgid % nig) / gsz; return true;
    }
    __device__ __forceinline__ void a_ready(const Unit&) const {}
    __device__ __forceinline__ void done(const Unit&) const {}
};
typedef float f32x2_t __attribute__((ext_vector_type(2))); typedef __bf16 bf16x2_t __attribute__((ext_vector_type(2)));
__device__ __forceinline__ unsigned cvt_pk_bf16(float lo, float hi) { f32x2_t v = {lo, hi}; bf16x2_t b = __builtin_convertvector(v, bf16x2_t); return __builtin_bit_cast(unsigned, b); }
__device__ __forceinline__ float fsigmoid(float v) { return __builtin_amdgcn_rcpf(1.f + __builtin_amdgcn_exp2f(-1.4426950408889634f * v)); }
constexpr float QSCALE = 0.125f * 1.4426950408889634f;

struct EpiProj {
    static constexpr bool PERM = true, AFTER_DRAIN = false;
    bf16_t *Q, *K, *V, *U, *GA, *GB; const float* gq; const float* gk;
    __device__ __forceinline__ void operator()(const f32x4 (&acc)[2][2][4][2], const Unit& u, int wr, int wc, int fr, int fq) const {
        const int row0 = u.pm * BM + wr * 64 + fr; const int sec = u.pn;
        if (sec < 4) {
            const bool isq = sec < 2; const float* g = isq ? gq : gk; bf16_t* base = (isq ? Q : K) + ((sec & 1) * 4 + wc) * 64 + 8 * fq;
            const float qs = isq ? QSCALE : 1.f;
            f32x4 gv[2][2];
#pragma unroll
            for (int bj = 0; bj < 2; ++bj)
#pragma unroll
                for (int n = 0; n < 2; ++n) gv[bj][n] = *(const f32x4*)(g + 32 * bj + 8 * fq + 4 * n);
#pragma unroll
            for (int ai = 0; ai < 2; ++ai)
#pragma unroll
                for (int m = 0; m < 4; ++m) {
                    float ss = 0.f;
#pragma unroll
                    for (int bj = 0; bj < 2; ++bj)
#pragma unroll
                        for (int n = 0; n < 2; ++n) { const f32x4 x = acc[ai][bj][m][n]; ss += (x[0] * x[0] + x[1] * x[1]) + (x[2] * x[2] + x[3] * x[3]); }
                    ss += __shfl_xor(ss, 16); ss += __shfl_xor(ss, 32);
                    const float r = rsqrtf(ss * (1.f / 64.f) + EPS) * qs;
                    bf16_t* rowp = base + (size_t)(row0 + ai * HALF + m * 16) * 512;
#pragma unroll
                    for (int bj = 0; bj < 2; ++bj) { const f32x4 v0 = acc[ai][bj][m][0] * gv[bj][0] * r, v1 = acc[ai][bj][m][1] * gv[bj][1] * r;
                        u32x4 w; w.x = cvt_pk_bf16(v0[0], v0[1]); w.y = cvt_pk_bf16(v0[2], v0[3]); w.z = cvt_pk_bf16(v1[0], v1[1]); w.w = cvt_pk_bf16(v1[2], v1[3]);
                        *(u32x4*)(rowp + 32 * bj) = w; }
                }
        } else if (sec < 8) {
            bf16_t* base = (sec < 6 ? V : U) + (sec & 1) * 256 + wc * 32 + 8 * fq;
#pragma unroll
            for (int ai = 0; ai < 2; ++ai)
#pragma unroll
                for (int m = 0; m < 4; ++m) { bf16_t* rowp = base + (size_t)(row0 + ai * HALF + m * 16) * 512;
#pragma unroll
                    for (int bj = 0; bj < 2; ++bj) { const f32x4 v0 = acc[ai][bj][m][0], v1 = acc[ai][bj][m][1];
                        u32x4 w; w.x = cvt_pk_bf16(v0[0], v0[1]); w.y = cvt_pk_bf16(v0[2], v0[3]); w.z = cvt_pk_bf16(v1[0], v1[1]); w.w = cvt_pk_bf16(v1[2], v1[3]);
                        *(u32x4*)(rowp + bj * HALF) = w; } }
        } else {
            bf16_t* base = (sec < 12 ? GA : GB) + ((sec - 8) & 3) * 256 + wc * 32 + 8 * fq;
#pragma unroll
            for (int ai = 0; ai < 2; ++ai)
#pragma unroll
                for (int m = 0; m < 4; ++m) { bf16_t* rowp = base + (size_t)(row0 + ai * HALF + m * 16) * 1024;
#pragma unroll
                    for (int bj = 0; bj < 2; ++bj) { const f32x4 v0 = acc[ai][bj][m][0], v1 = acc[ai][bj][m][1];
                        u32x4 w; w.x = cvt_pk_bf16(fsigmoid(v0[0]), fsigmoid(v0[1])); w.y = cvt_pk_bf16(fsigmoid(v0[2]), fsigmoid(v0[3])); w.z = cvt_pk_bf16(fsigmoid(v1[0]), fsigmoid(v1[1])); w.w = cvt_pk_bf16(fsigmoid(v1[2]), fsigmoid(v1[3]));
                        *(u32x4*)(rowp + bj * HALF) = w; } }
        }
    }
};

struct EpiMerge {
    static constexpr bool PERM = true, AFTER_DRAIN = false;
    const bf16_t* G; bf16_t* MG; int add;
    __device__ __forceinline__ void operator()(const f32x4 (&acc)[2][2][4][2], const Unit& u, int wr, int wc, int fr, int fq) const {
        const int row0 = u.pm * BM + wr * 64 + fr, col0 = u.pn * BM + wc * 32 + 8 * fq;
#pragma unroll
        for (int ai = 0; ai < 2; ++ai)
#pragma unroll
            for (int m = 0; m < 4; ++m) { const size_t off = (size_t)(row0 + ai * HALF + m * 16) * 1024 + col0;
#pragma unroll
                for (int bj = 0; bj < 2; ++bj) { const u32x4 g = *(const u32x4*)(G + off + bj * HALF); const f32x4 a0 = acc[ai][bj][m][0], a1 = acc[ai][bj][m][1];
                    float v[8] = {bf2f(g.x & 0xffffu) * a0[0], bf2f(g.x >> 16) * a0[1], bf2f(g.y & 0xffffu) * a0[2], bf2f(g.y >> 16) * a0[3], bf2f(g.z & 0xffffu) * a1[0], bf2f(g.z >> 16) * a1[1], bf2f(g.w & 0xffffu) * a1[2], bf2f(g.w >> 16) * a1[3]};
                    if (add) { const u32x4 o = *(const u32x4*)(MG + off + bj * HALF);
                        v[0] += bf2f(o.x & 0xffffu); v[1] += bf2f(o.x >> 16); v[2] += bf2f(o.y & 0xffffu); v[3] += bf2f(o.y >> 16); v[4] += bf2f(o.z & 0xffffu); v[5] += bf2f(o.z >> 16); v[6] += bf2f(o.w & 0xffffu); v[7] += bf2f(o.w >> 16); }
                    u32x4 w; w.x = cvt_pk_bf16(v[0], v[1]); w.y = cvt_pk_bf16(v[2], v[3]); w.z = cvt_pk_bf16(v[4], v[5]); w.w = cvt_pk_bf16(v[6], v[7]);
                    *(u32x4*)(MG + off + bj * HALF) = w; } }
    }
};
struct EpiX1 {
    static constexpr bool PERM = false, AFTER_DRAIN = false;
    const float* x; const float* gate; float* X1;
    __device__ __forceinline__ void operator()(const f32x4 (&acc)[2][2][4][2], const Unit& u, int wr, int wc, int fr, int fq) const {
        const int row0 = u.pm * BM + wr * 64 + fr, col0 = u.pn * BM + wc * 32 + 4 * fq; const int b = (u.pm * BM) / SEQ;
        f32x4 gv[2][2];
#pragma unroll
        for (int bj = 0; bj < 2; ++bj)
#pragma unroll
            for (int n = 0; n < 2; ++n) gv[bj][n] = *(const f32x4*)(gate + (size_t)b * 6 * D + col0 + bj * HALF + n * 16);
#pragma unroll
        for (int ai = 0; ai < 2; ++ai)
#pragma unroll
            for (int m = 0; m < 4; ++m) { const size_t off = (size_t)(row0 + ai * HALF + m * 16) * D + col0;
#pragma unroll
                for (int bj = 0; bj < 2; ++bj)
#pragma unroll
                    for (int n = 0; n < 2; ++n) *(f32x4*)(X1 + off + bj * HALF + n * 16) = *(const f32x4*)(x + off + bj * HALF + n * 16) + gv[bj][n] * acc[ai][bj][m][n]; }
    }
};

template <class Epi, class Sched, bool ALIGN_EPI = false, bool SP2 = false>
__device__ __forceinline__ void gemm_phase(PG8_LAS unsigned char* lds, const Gemm g, const Sched& S, const Epi& E) {
    int tid_ = threadIdx.x; asm volatile("" : "+v"(tid_));
    const int tid = tid_, wid = __builtin_amdgcn_readfirstlane(tid >> 6), lane = tid & 63, wr = wid >> 2, wc = wid & 3, fr = lane & 15, fq = lane >> 4;
    const int K = g.K, nt = K / BK;
    unsigned voffA[2], voffB[2];
#pragma unroll
    for (int i = 0; i < 2; ++i) { int R, C; stage_rc(tid * 16 + i * 8192, R, C); const int Rb = Epi::PERM ? ((R & ~31) + perm32(R & 31)) : R;
        voffA[i] = (unsigned)(R * K + C) * 2u; voffB[i] = (unsigned)(Rb * K + C) * 2u; }
    const size_t kstep = (size_t)(BK * 2);
    const size_t hstep = (size_t)HALF * K * 2;
    const size_t tstep = 2 * hstep;
    const unsigned ldsw = (unsigned)wid * 1024u;
    const int aoff = lds_byte(wr * 64 + fr, fq * 8), boff = lds_byte(wc * 32 + fr, fq * 8);
#define PG8_SA(b, h) (((b) * 2 + (h)) * HTB)
#define PG8_SB(b, h) ((4 + (b) * 2 + (h)) * HTB)
#define PG8_STAGE(bufoff, gbase, voff) do { _Pragma("unroll") for (int _i = 0; _i < 2; ++_i) \
        __builtin_amdgcn_global_load_lds((const unsigned*)((const char*)(gbase) + (voff)[_i]), (PG8_LAS unsigned*)(lds + (bufoff) + ldsw + _i * 8192), 16, 0, 0); } while (0)
#define PG8_LDA(dst, b, h) do { _Pragma("unroll") for (int m = 0; m < 4; ++m) _Pragma("unroll") for (int k = 0; k < 2; ++k) dst[m][k] = *(const PG8_LAS bf16x8*)(lds + PG8_SA(b, h) + aoff + m * 2048 + k * 1024); } while (0)
#define PG8_LDB(dst, b, h) do { _Pragma("unroll") for (int n = 0; n < 2; ++n) _Pragma("unroll") for (int k = 0; k < 2; ++k) dst[n][k] = *(const PG8_LAS bf16x8*)(lds + PG8_SB(b, h) + boff + n * 2048 + k * 1024); } while (0)
#define PG8_MMA(ai, bj, At, Bt) do { __builtin_amdgcn_s_setprio(1); _Pragma("unroll") for (int m = 0; m < 4; ++m) _Pragma("unroll") for (int n = 0; n < 2; ++n) _Pragma("unroll") for (int k = 0; k < 2; ++k) \
        acc[ai][bj][m][n] = __builtin_amdgcn_mfma_f32_16x16x32_bf16(Bt[n][k], At[m][k], acc[ai][bj][m][n], 0, 0, 0); __builtin_amdgcn_s_setprio(0); } while (0)
#define PG8_WAIT_V(n) asm volatile("s_waitcnt vmcnt(" #n ")" ::: "memory")
#define PG8_WAIT_L(n) asm volatile("s_waitcnt lgkmcnt(" #n ")" ::: "memory")
#define PG8_BAR __builtin_amdgcn_s_barrier()
#define PG8_SCHED __builtin_amdgcn_sched_barrier(0)
    Unit cur, nxt; int ui = 0;
    if (!S.next(0, cur)) return;
    f32x4 acc[2][2][4][2];
#pragma unroll
    for (int a = 0; a < 2; ++a)
#pragma unroll
        for (int b = 0; b < 2; ++b)
#pragma unroll
            for (int m = 0; m < 4; ++m)
#pragma unroll
                for (int n = 0; n < 2; ++n) acc[a][b][m][n] = (f32x4){0.f, 0.f, 0.f, 0.f};
    bf16x8 At[4][2], B0[2][2], B1[2][2];
    const char* cA = (const char*)g.A + (size_t)cur.pm * tstep; const char* cB = (const char*)g.Bt + (size_t)cur.pn * tstep;
    S.a_ready(cur);
    if constexpr (SP2) {
        PG8_STAGE(PG8_SB(0, 0), cB, voffB); PG8_STAGE(PG8_SB(0, 1), cB + hstep, voffB); PG8_STAGE(PG8_SA(0, 0), cA, voffA); PG8_STAGE(PG8_SA(0, 1), cA + hstep, voffA);
        if (wr == 1) PG8_BAR;
        PG8_WAIT_V(2); PG8_BAR;
        PG8_STAGE(PG8_SB(1, 0), cB + kstep, voffB); PG8_STAGE(PG8_SA(1, 0), cA + kstep, voffA); PG8_STAGE(PG8_SB(1, 1), cB + hstep + kstep, voffB);
        PG8_WAIT_V(6); PG8_BAR;
    } else {
        PG8_STAGE(PG8_SB(0, 0), cB, voffB); PG8_STAGE(PG8_SA(0, 0), cA, voffA); PG8_STAGE(PG8_SB(0, 1), cB + hstep, voffB); PG8_STAGE(PG8_SA(0, 1), cA + hstep, voffA);
        if (wr == 1) PG8_BAR;
        PG8_WAIT_V(4); PG8_BAR;
        PG8_STAGE(PG8_SB(1, 0), cB + kstep, voffB); PG8_STAGE(PG8_SA(1, 0), cA + kstep, voffA); PG8_STAGE(PG8_SB(1, 1), cB + hstep + kstep, voffB);
        PG8_WAIT_V(6); PG8_BAR;
    }
    for (;;) {
        const bool has_next = S.next(ui + 1, nxt);
        const char* nA = has_next ? (const char*)g.A + (size_t)nxt.pm * tstep : cA; const char* nB = has_next ? (const char*)g.Bt + (size_t)nxt.pn * tstep : cB;
#pragma nounroll
        for (int t = 0; t < nt; t += 2) {
            const bool last = (t == nt - 2);
            const char* a1 = cA + (size_t)(t + 1) * kstep;
            const char* a2 = last ? nA : cA + (size_t)(t + 2) * kstep; const char* b2 = last ? nB : cB + (size_t)(t + 2) * kstep;
            const char* a3 = a2 + kstep; const char* b3 = b2 + kstep;
            if (last && has_next) S.a_ready(nxt);
            if constexpr (SP2) {
            PG8_LDB(B0, 0, 0); PG8_LDB(B1, 0, 1); PG8_SCHED; PG8_LDA(At, 0, 0); PG8_STAGE(PG8_SA(1, 1), a1 + hstep, voffA);
            PG8_WAIT_V(8); PG8_WAIT_L(0); PG8_BAR; PG8_MMA(0, 0, At, B0); PG8_MMA(0, 1, At, B1); PG8_BAR; PG8_SCHED;
            PG8_LDA(At, 0, 1); PG8_STAGE(PG8_SB(0, 0), b2, voffB); PG8_STAGE(PG8_SB(0, 1), b2 + hstep, voffB); PG8_STAGE(PG8_SA(0, 0), a2, voffA);
            PG8_WAIT_V(8); PG8_WAIT_L(0); PG8_BAR; PG8_MMA(1, 0, At, B0); PG8_MMA(1, 1, At, B1); PG8_BAR; PG8_SCHED;
            PG8_LDB(B0, 1, 0); PG8_LDB(B1, 1, 1); PG8_SCHED; PG8_LDA(At, 1, 0); PG8_STAGE(PG8_SA(0, 1), a2 + hstep, voffA);
            PG8_WAIT_V(8); PG8_WAIT_L(0); PG8_BAR; PG8_MMA(0, 0, At, B0); PG8_MMA(0, 1, At, B1); PG8_BAR; PG8_SCHED;
            PG8_LDA(At, 1, 1); PG8_STAGE(PG8_SB(1, 0), b3, voffB); PG8_STAGE(PG8_SB(1, 1), b3 + hstep, voffB); PG8_STAGE(PG8_SA(1, 0), a3, voffA);
            PG8_WAIT_V(8); PG8_WAIT_L(0); PG8_BAR; PG8_MMA(1, 0, At, B0); PG8_MMA(1, 1, At, B1); PG8_BAR; PG8_SCHED;
            } else {
            PG8_LDB(B0, 0, 0); PG8_SCHED; PG8_LDA(At, 0, 0); PG8_STAGE(PG8_SA(1, 1), a1 + hstep, voffA);
            PG8_WAIT_L(8); PG8_BAR; PG8_WAIT_L(0); PG8_MMA(0, 0, At, B0); PG8_BAR; PG8_SCHED;
            PG8_LDB(B1, 0, 1); PG8_STAGE(PG8_SB(0, 0), b2, voffB);
            PG8_BAR; PG8_WAIT_L(0); PG8_MMA(0, 1, At, B1); PG8_BAR;
            PG8_LDA(At, 0, 1); PG8_STAGE(PG8_SA(0, 0), a2, voffA);
            PG8_BAR; PG8_WAIT_L(0); PG8_MMA(1, 0, At, B0); PG8_BAR; PG8_SCHED;
            PG8_STAGE(PG8_SB(0, 1), b2 + hstep, voffB);
            PG8_WAIT_V(6); PG8_BAR; PG8_MMA(1, 1, At, B1); PG8_BAR;
            PG8_LDB(B0, 1, 0); PG8_SCHED; PG8_LDA(At, 1, 0); PG8_STAGE(PG8_SA(0, 1), a2 + hstep, voffA);
            PG8_WAIT_L(8); PG8_BAR; PG8_WAIT_L(0); PG8_MMA(0, 0, At, B0); PG8_BAR; PG8_SCHED;
            PG8_LDB(B1, 1, 1); PG8_STAGE(PG8_SB(1, 0), b3, voffB);
            PG8_BAR; PG8_WAIT_L(0); PG8_MMA(0, 1, At, B1); PG8_BAR;
            PG8_LDA(At, 1, 1); PG8_STAGE(PG8_SA(1, 0), a3, voffA);
            PG8_BAR; PG8_WAIT_L(0); PG8_MMA(1, 0, At, B0); PG8_BAR; PG8_SCHED;
            PG8_STAGE(PG8_SB(1, 1), b3 + hstep, voffB);
            PG8_WAIT_V(6); PG8_BAR; PG8_MMA(1, 1, At, B1); PG8_BAR;
            }
        }
        if constexpr (ALIGN_EPI) { if (wr == 0) PG8_BAR; }
        if constexpr (!Epi::AFTER_DRAIN) { E(acc, cur, wr, wc, fr, fq); S.done(cur); }
        if (!has_next) break;
#pragma unroll
        for (int a = 0; a < 2; ++a)
#pragma unroll
            for (int b = 0; b < 2; ++b)
#pragma unroll
                for (int m = 0; m < 4; ++m)
#pragma unroll
                    for (int n = 0; n < 2; ++n) acc[a][b][m][n] = (f32x4){0.f, 0.f, 0.f, 0.f};
        cur = nxt; cA = nA; cB = nB; ++ui;
        if constexpr (ALIGN_EPI) { if (wr == 1) PG8_BAR; }
    }
    PG8_WAIT_V(0);
    if constexpr (!ALIGN_EPI) { if (wr == 0) PG8_BAR; }
    PG8_BAR;
    if constexpr (Epi::AFTER_DRAIN) { E.fused(acc, cur, wr, wc, fr, fq, lds, wid, lane); S.done(cur); }
#undef PG8_SA
#undef PG8_SB
#undef PG8_STAGE
#undef PG8_LDA
#undef PG8_LDB
#undef PG8_MMA
#undef PG8_WAIT_V
#undef PG8_WAIT_L
#undef PG8_BAR
#undef PG8_SCHED
}
}
using pg8::f32x4; using pg8::bf16x8;
#define GAS __attribute__((address_space(1)))
#define LAS __attribute__((address_space(3)))
typedef unsigned v4u __attribute__((ext_vector_type(4)));
typedef GAS unsigned gu32;
typedef GAS unsigned long long gu64;
#define RLX_AGENT __ATOMIC_RELAXED, __HIP_MEMORY_SCOPE_AGENT
#define LDS_WAIT() asm volatile("s_waitcnt lgkmcnt(0)" ::: "memory")
#define VM_WAIT() asm volatile("s_waitcnt vmcnt(0)" ::: "memory")
__device__ __forceinline__ unsigned long long rt() { return __builtin_amdgcn_s_memrealtime(); }
__device__ __forceinline__ unsigned pk2(float lo, float hi) { return pg8::cvt_pk_bf16(lo, hi); }

#define XB_TMO      128
#define XB_XCNT(j)  (256  + 64 * (j))
#define XB_XSUB(j)  (1280 + 64 * (j))
#define XB_XGEN(j)  (2304 + 64 * (j))
#define XB_TOP      3328
#define XB_TOPGEN   3392
#define XCD_BAR_WORDS 3456
#define XB_SPIN_CAP (1u << 18)

__device__ __forceinline__ unsigned xb_ld(unsigned* p)              { return __hip_atomic_load(p, __ATOMIC_RELAXED, __HIP_MEMORY_SCOPE_AGENT); }
__device__ __forceinline__ unsigned xb_add(unsigned* p, unsigned v) { return __hip_atomic_fetch_add(p, v, __ATOMIC_RELAXED, __HIP_MEMORY_SCOPE_AGENT); }
__device__ __forceinline__ unsigned xb_xcc_id() { return (unsigned)__builtin_amdgcn_s_getreg((3 << 11) | 20) & 0xFu; }
#define XB_SPIN(cond, bar) do { unsigned _sp = 0; while (cond) { __builtin_amdgcn_s_sleep(1); \
    if ((++_sp & 255u) == 0u) { if (xb_ld(&(bar)[XB_TMO])) break; if (_sp > XB_SPIN_CAP) { atomicAdd(&(bar)[XB_TMO], 1u); break; } } } } while (0)

struct XcdBarrier {
    unsigned* bar; unsigned x;
    volatile LAS unsigned* st;
};

__device__ __forceinline__ XcdBarrier xcd_barrier_post(unsigned* bar, volatile LAS unsigned* st) {
    XcdBarrier b; b.bar = bar; b.x = xb_xcc_id(); b.st = st;
    if (threadIdx.x == 0) (void)xb_add(&bar[XB_XCNT(b.x)], 1u);
    return b;
}
__device__ __forceinline__ void xcd_barrier_complete(unsigned* bar, unsigned x, unsigned& nloc, unsigned& nx) {
    const unsigned G = gridDim.x * gridDim.y * gridDim.z;
    unsigned sum, cnt, mine, sp = 0u;
    for (;;) {
        sum = 0u; cnt = 0u; mine = 0u;
#pragma unroll
        for (unsigned j = 0; j < 16; ++j) { const unsigned c = xb_ld(&bar[XB_XCNT(j)]); sum += c; cnt += (c > 0u) ? 1u : 0u; mine = (j == x) ? c : mine; }
        if (sum == G) break;
        __builtin_amdgcn_s_sleep(1);
        if ((++sp & 255u) == 0u) { if (xb_ld(&bar[XB_TMO])) break; if (sp > XB_SPIN_CAP) { atomicAdd(&bar[XB_TMO], 1u); break; } }
    }
    nloc = mine > 0u ? mine : 1u; nx = cnt > 0u ? cnt : 1u;
}

__device__ __forceinline__ void xcd_barrier(const XcdBarrier& b) {
    asm volatile("s_waitcnt vmcnt(0)" ::: "memory");
    __syncthreads();
    if (threadIdx.x == 0) {
        unsigned* bar = b.bar;
        __builtin_amdgcn_s_waitcnt(0);
        unsigned nloc = b.st[0], nx = b.st[1];
        if (nloc == 0u) { xcd_barrier_complete(bar, b.x, nloc, nx); b.st[0] = nloc; b.st[1] = nx; }
        const unsigned old = xb_add(&bar[XB_XSUB(b.x)], 1u);
        const unsigned gen = old / nloc;
        if (old + 1u == (gen + 1u) * nloc) {
            __builtin_amdgcn_fence(__ATOMIC_RELEASE, "agent");
            asm volatile("s_waitcnt vmcnt(0)" ::: "memory");
            const unsigned og = xb_add(&bar[XB_TOP], 1u);
            const unsigned tg = og / nx;
            if (og + 1u == (tg + 1u) * nx) xb_add(&bar[XB_TOPGEN], 1u);
            else XB_SPIN(xb_ld(&bar[XB_TOPGEN]) == tg, bar);
            __builtin_amdgcn_fence(__ATOMIC_ACQUIRE, "agent");
            xb_add(&bar[XB_XGEN(b.x)], 1u);
            asm volatile("s_waitcnt vmcnt(0)" ::: "memory");
        } else {
            XB_SPIN(xb_ld(&bar[XB_XGEN(b.x)]) == gen, bar);
            __builtin_amdgcn_fence(__ATOMIC_ACQUIRE, "agent");
            asm volatile("s_waitcnt vmcnt(0)" ::: "memory");
        }
    }
    __syncthreads();
}

constexpr int NWAVES = 8;
#ifndef DBL_PHASE
#define DBL_PHASE -1
#endif
constexpr size_t WS_MODP = 1 * MiB + 128 * 1024;
constexpr size_t WS_WIN = 12 * MiB, WS_WSB = 20 * MiB, WS_WEFF = 21 * MiB, WS_WOUT = 22 * MiB, WS_WGU = 24 * MiB;
constexpr size_t WS_WSHGU = 237 * MiB, WS_WD = 238 * MiB, WS_WSHD = 254 * MiB, WS_WRH = 254 * MiB + 512 * 1024, WS_WRL = WS_WRH + 128 * 1024;
constexpr size_t CTL_ZERO_BYTES = 256 * 1024;
constexpr int CW_TMO = 0, CW_CODE = 1, CW_BAR = 4096, CW_CNT = 16384;
constexpr int RING_OFF = 0, RING_BYTES = 131072, AUX_OFF = RING_BYTES, LDS_BYTES = 163840, LDSCTL_OFF = LDS_BYTES - 1024, MISC_OFF = LDSCTL_OFF + 320;

struct Frame {
    LAS unsigned char* lds; volatile LAS unsigned* MISC; gu32* ctl;
    int tid, lane, wave, vcu, G;
};
struct Args { const float* in[22]; float* out; unsigned char* ws; int ph_lo, ph_hi, use_bar, pad; };

constexpr float W8SCALE = 512.f, H8SCALE = 16.f;
struct TItem { const float* W; bf16_t* dst; int ldw, ldk, k0, n0, perm, f8; };
__device__ __forceinline__ void titem_load(const TItem& t, f32x4 (&v)[8], int lane) {
    const int kr = lane >> 3, n4 = (lane & 7) * 4;
#pragma unroll
    for (int i = 0; i < 8; ++i) v[i] = *(const GAS f32x4*)(t.W + (size_t)(t.k0 + kr + 8 * i) * t.ldw + t.n0 + n4);
}
__device__ __forceinline__ void titem_store(const TItem& t, const f32x4 (&v)[8], LAS float* scr, int lane) {
    { const int kr = lane >> 3, n4 = (lane & 7) * 4;
#pragma unroll
      for (int i = 0; i < 8; ++i) { LAS float* d = scr + (kr + 8 * i) * 33 + n4; d[0] = v[i].x; d[1] = v[i].y; d[2] = v[i].z; d[3] = v[i].w; } }
    LDS_WAIT(); asm volatile("" ::: "memory");
    const int c = lane & 7;
#pragma unroll
    for (int j = 0; j < 4; ++j) { const int n = (lane >> 3) + 8 * j, drow = t.perm ? 128 * (j & 1) + 8 * (j >> 1) + (lane >> 3) : n; const LAS float* sp = scr + (8 * c) * 33 + n;
        if (t.f8) {
            unsigned lo = 0u, hi = 0u;
            lo = __builtin_amdgcn_cvt_pk_fp8_f32(sp[0 * 33] * W8SCALE, sp[1 * 33] * W8SCALE, lo, false); lo = __builtin_amdgcn_cvt_pk_fp8_f32(sp[2 * 33] * W8SCALE, sp[3 * 33] * W8SCALE, lo, true);
            hi = __builtin_amdgcn_cvt_pk_fp8_f32(sp[4 * 33] * W8SCALE, sp[5 * 33] * W8SCALE, hi, false); hi = __builtin_amdgcn_cvt_pk_fp8_f32(sp[6 * 33] * W8SCALE, sp[7 * 33] * W8SCALE, hi, true);
            *(GAS unsigned long long*)((GAS unsigned char*)t.dst + (size_t)drow * t.ldk + t.k0 + 8 * c) = (unsigned long long)lo | ((unsigned long long)hi << 32);
        } else {
        v4u o; o.x = pk2(sp[0 * 33], sp[1 * 33]); o.y = pk2(sp[2 * 33], sp[3 * 33]); o.z = pk2(sp[4 * 33], sp[5 * 33]); o.w = pk2(sp[6 * 33], sp[7 * 33]);
        *(GAS v4u*)(t.dst + (size_t)drow * t.ldk + t.k0 + 8 * c) = o; } }
    LDS_WAIT(); asm volatile("" ::: "memory");
}
__device__ __forceinline__ TItem titem_decode(int it, const Args& a, bool late) {
    unsigned char* ws = a.ws; TItem t; t.perm = 0; t.f8 = 0;
    constexpr int I_IN = 16 * 128, I_SB = 8 * 32, I_OUT = 16 * 32, I_EG = 64 * 64, I_EU = 64 * 64, I_ED = 64 * 64, I_SG = 16 * 8, I_SU = 16 * 8;
    int r = it;
    if (late) {
        if (r < I_ED) { const int e = r >> 6, q = r & 63, kb = q >> 5, nb = q & 31; t.W = a.in[18] + (size_t)e * ED * D; t.ldw = D; t.k0 = kb * 64; t.n0 = nb * 32;
            const int n0 = nb * 32, cl = n0 & 255; t.perm = 1; t.dst = (bf16_t*)(ws + WS_WD) + ((size_t)e * D + (n0 & ~255) + 32 * (cl >> 6) + 16 * ((cl >> 5) & 1)) * ED; t.ldk = ED; return t; } r -= I_ED;
        { const int kb = r >> 5, nb = r & 31; t.W = a.in[21]; t.ldw = D; t.k0 = kb * 64; t.n0 = nb * 32; t.dst = (bf16_t*)(ws + WS_WSHD) + (size_t)(nb * 32) * SHD; t.ldk = SHD; return t; } }
    if (r < I_IN) { const int kb = r >> 7, nb = r & 127, n0 = nb * 32; int d0 = n0;
        if (n0 < 1024) d0 = (n0 & ~255) + 128 * ((n0 >> 5) & 1) + 32 * ((n0 >> 6) & 3);
        t.W = a.in[5]; t.ldw = INW; t.k0 = kb * 64; t.n0 = n0; t.dst = (bf16_t*)(ws + WS_WIN) + (size_t)d0 * D; t.ldk = D; return t; } r -= I_IN;
    if (r < I_SB) { const int kb = r >> 5, nb = r & 31; t.W = a.in[8]; t.ldw = D; t.k0 = kb * 64; t.n0 = nb * 32; t.dst = (bf16_t*)(ws + WS_WSB) + (size_t)(nb * 32) * SBW; t.ldk = SBW; return t; } r -= I_SB;
    if (r < I_OUT) { const int kb = r >> 5, nb = r & 31; t.W = a.in[12]; t.ldw = D; t.k0 = kb * 64; t.n0 = nb * 32; t.dst = (bf16_t*)(ws + WS_WOUT) + (size_t)(nb * 32) * D; t.ldk = D; return t; } r -= I_OUT;
    if (r < I_EG) { const int e = r >> 6, q = r & 63, kb = q >> 2, nb = q & 3; t.W = a.in[16] + (size_t)e * D * ED; t.ldw = ED; t.k0 = kb * 64; t.n0 = nb * 32; t.f8 = 1; t.dst = (bf16_t*)(ws + WS_WGU + ((size_t)e * 256 + nb * 32) * D); t.ldk = D; return t; } r -= I_EG;
    if (r < I_EU) { const int e = r >> 6, q = r & 63, kb = q >> 2, nb = q & 3; t.W = a.in[17] + (size_t)e * D * ED; t.ldw = ED; t.k0 = kb * 64; t.n0 = nb * 32; t.f8 = 1; t.dst = (bf16_t*)(ws + WS_WGU + ((size_t)e * 256 + 128 + nb * 32) * D); t.ldk = D; return t; } r -= I_EU;
    if (r < I_SG) { const int kb = r >> 3, nb = r & 7, n0 = nb * 32; t.W = a.in[19]; t.ldw = SHD; t.k0 = kb * 64; t.n0 = n0; t.f8 = 1; t.dst = (bf16_t*)(ws + WS_WSHGU + (size_t)((n0 >> 7) * 256 + (n0 & 127)) * D); t.ldk = D; return t; } r -= I_SG;
    { const int kb = r >> 3, nb = r & 7, n0 = nb * 32; t.W = a.in[20]; t.ldw = SHD; t.k0 = kb * 64; t.n0 = n0; t.f8 = 1; t.dst = (bf16_t*)(ws + WS_WSHGU + (size_t)((n0 >> 7) * 256 + 128 + (n0 & 127)) * D); t.ldk = D; return t; }
}

__device__ __forceinline__ void titem_run(Frame& F, const Args& a, bool late, int nitems, int first, int stride) {
    LAS float* scr = (LAS float*)(F.lds + RING_OFF + F.wave * 16384); const int lane = F.lane;
    f32x4 va[8], vb[8]; TItem cur, nxt; int it = first;
    if (it < nitems) { cur = titem_decode(it, a, late); titem_load(cur, va, lane); }
    for (; it < nitems; it += 2 * stride) {
        const bool h1 = it + stride < nitems, h2 = it + 2 * stride < nitems;
        if (h1) { nxt = titem_decode(it + stride, a, late); titem_load(nxt, vb, lane); }
        titem_store(cur, va, scr, lane);
        if (h2) { cur = titem_decode(it + 2 * stride, a, late); titem_load(cur, va, lane); }
        if (h1) titem_store(nxt, vb, scr, lane);
    }
}

__device__ __forceinline__ void p0a(Frame& F, const Args& a) {
    unsigned char* ws = a.ws;
    const int gw = F.vcu * NWAVES + F.wave, NGW = F.G * NWAVES, lane = F.lane;
    LAS float* silu_t = (LAS float*)(F.lds + AUX_OFF + 1024);
    { const float* c = a.in[1]; for (int i = F.tid; i < 4 * D; i += NWAVES * 64) ((LAS float*)(F.lds + RING_OFF + 65536))[i] = siluf_(c[i]); }
    LAS float* silu = (LAS float*)(F.lds + RING_OFF + 65536);
    (void)silu_t;
    if (F.G == 256) { const float* wg = a.in[9]; const float* ps = a.in[10]; const float* wpo = a.in[11]; bf16_t* WE = (bf16_t*)(ws + WS_WEFF);
        const int g = F.vcu >> 6, nb = (F.vcu & 63) * 16; LAS float* wgt = (LAS float*)(F.lds + RING_OFF);
        for (int i = F.tid; i < 128 * 128; i += NWAVES * 64) { const int cc = i >> 7, d = i & 127; wgt[d * 128 + cc] = wg[(size_t)g * 16384 + i]; }
        __syncthreads();
        const int cc = F.tid & 127, nq = (F.tid >> 7) * 4; float acc4[4] = {0.f, 0.f, 0.f, 0.f};
        for (int d = 0; d < 128; ++d) { const float wv = wgt[d * 128 + cc] * ps[g * 128 + d]; const float* wr = wpo + (size_t)(g * 128 + d) * D + nb + nq;
#pragma unroll
            for (int j = 0; j < 4; ++j) acc4[j] += wv * wr[j]; }
#pragma unroll
        for (int j = 0; j < 4; ++j) WE[(size_t)(nb + nq + j) * PW + g * 128 + cc] = (bf16_t)f2bf(acc4[j]);
    }
    __syncthreads();
    { const float* w_ada = a.in[2]; float* MODP = (float*)(ws + WS_MODP);
      for (int it = gw; it < 96 * 8; it += NGW) { const int cg = it % 96, ks = it / 96;
          const float* w = w_ada + (size_t)(ks * 128) * (6 * D) + cg * 64 + lane;
          float a0 = 0.f, a1 = 0.f, a2 = 0.f, a3 = 0.f;
#pragma unroll 8
          for (int k = 0; k < 128; ++k) { const float wv = w[(size_t)k * (6 * D)]; const int kk = ks * 128 + k;
              a0 += silu[kk] * wv; a1 += silu[D + kk] * wv; a2 += silu[2 * D + kk] * wv; a3 += silu[3 * D + kk] * wv; }
          float* o = MODP + (size_t)ks * 4 * 6 * D + cg * 64 + lane;
          o[0] = a0; o[6 * D] = a1; o[12 * D] = a2; o[18 * D] = a3; } }
    __syncthreads();
    titem_run(F, a, false, 16 * 128 + 8 * 32 + 16 * 32 + 2 * 64 * 64 + 2 * 16 * 8, gw, NGW);
    { const float* wr = a.in[14]; bf16_t* WH = (bf16_t*)(ws + WS_WRH); bf16_t* WL = (bf16_t*)(ws + WS_WRL);
      for (int i = (F.vcu * NWAVES * 64 + F.tid); i < D * NE; i += F.G * NWAVES * 64) { const int e = i >> 10, k = i & 1023; const float v = wr[k * NE + e];
          const int pos = ((((k >> 4) * 2 + (e >> 5)) * 64) + 32 * ((k >> 3) & 1) + (e & 31)) * 8 + (k & 7);
          const unsigned h = f2bf(v); WH[pos] = (bf16_t)h; WL[pos] = (bf16_t)f2bf(v - bf2f(h)); } }
}
__device__ __forceinline__ void p0b(Frame& F, const Args& a) {
    unsigned char* ws = a.ws; const float* MODP = (const float*)(ws + WS_MODP); const float* b_ada = a.in[3];
    if (F.tid < 96) { const int idx = 96 * F.vcu + F.tid, b = idx / (6 * D), j = idx % (6 * D); float v = b_ada[j];
#pragma unroll
        for (int ks = 0; ks < 8; ++ks) v += MODP[(size_t)(ks * 4 + b) * 6 * D + j];
        ((float*)(ws + WS_MOD))[idx] = v; }
    const int rows_per = M / F.G, r0 = F.vcu * rows_per, b = r0 / SEQ;
    LAS float* gsv = (LAS float*)(F.lds + RING_OFF); LAS float* shv = gsv + D;
    for (int k = F.tid; k < D; k += NWAVES * 64) { float sh = b_ada[k], sc = b_ada[D + k];
#pragma unroll
        for (int ks = 0; ks < 8; ++ks) { sh += MODP[(size_t)(ks * 4 + b) * 6 * D + k]; sc += MODP[(size_t)(ks * 4 + b) * 6 * D + D + k]; }
        gsv[k] = a.in[4][k] * (1.f + sc); shv[k] = sh; }
    __syncthreads();
    const float* x = a.in[0]; bf16_t* XN = (bf16_t*)(ws + WS_XN);
    for (int i = F.wave; i < rows_per; i += NWAVES) { const int row = r0 + i;
        const GAS f32x4* xr = (const GAS f32x4*)(x + (size_t)row * D) + F.lane;
        f32x4 v[4]; float s = 0.f;
#pragma unroll
        for (int j = 0; j < 4; ++j) { v[j] = xr[64 * j]; s += (v[j].x * v[j].x + v[j].y * v[j].y) + (v[j].z * v[j].z + v[j].w * v[j].w); }
        const float r = rsqrtf(wave_sum(s) * (1.f / D) + EPS);
        GAS unsigned long long* o8 = (GAS unsigned long long*)(XN + (size_t)row * D) + F.lane;
#pragma unroll
        for (int j = 0; j < 4; ++j) { const f32x4 gg = *(const LAS f32x4*)(gsv + 4 * F.lane + 256 * j), ss = *(const LAS f32x4*)(shv + 4 * F.lane + 256 * j);
            const f32x4 h = v[j] * r * gg + ss;
            o8[64 * j] = (unsigned long long)pk2(h.x, h.y) | ((unsigned long long)pk2(h.z, h.w) << 32); } }
    __syncthreads();
}

namespace sb {
using pg8::bf16x8; using pg8::f32x4; typedef float f32x16 __attribute__((ext_vector_type(16))); typedef short v4i16_t __attribute__((ext_vector_type(4)));
typedef short s16x4 __attribute__((ext_vector_type(4)));
constexpr int VPITCH = 128, VBYTES = 64 * VPITCH, WAVE_LDS = 2 * VBYTES;
constexpr float EXIT_THR = -152.f;
__device__ __forceinline__ int crow(int r, int hi) { return (r & 3) + 8 * (r >> 2) + 4 * hi; }
__device__ __forceinline__ s16x4 vtr(LAS const unsigned char* p) { return __builtin_bit_cast(s16x4, __builtin_amdgcn_ds_read_tr16_b64_v4i16((LAS v4i16_t*)p)); }
__device__ __forceinline__ unsigned pkbf(float lo, float hi) { return pg8::cvt_pk_bf16(lo, hi); }

__device__ __forceinline__ void attn_unit(int b, int h, int qb, const bf16_t* Q, const bf16_t* K, const bf16_t* V, bf16_t* O, LAS unsigned char* vlds, int wid, int lane) {
    const int r32 = lane & 31, hi = lane >> 5;
    const int t0 = qb * 256 + wid * 32;
    const size_t rowbase = (size_t)b * SEQ;
    const bf16_t* Kh = K + rowbase * 512 + h * 64; const bf16_t* Vh = V + rowbase * 512 + h * 64;
    bf16x8 qr[4];
#pragma unroll
    for (int d0 = 0; d0 < 4; ++d0) qr[d0] = *(const bf16x8*)(Q + (rowbase + t0 + r32) * 512 + h * 64 + d0 * 16 + hi * 8);
    f32x16 o0 = {}, o1 = {};
    float carry = 0.f;
    int kt = t0 >> 6;
    bf16x8 kf[8];
#define SB_LOADK(KT) do { const int kb_ = (KT) * 64; \
        _Pragma("unroll") for (int d0 = 0; d0 < 4; ++d0) { kf[2 * d0] = *(const bf16x8*)(Kh + (size_t)(kb_ + r32) * 512 + d0 * 16 + hi * 8); kf[2 * d0 + 1] = *(const bf16x8*)(Kh + (size_t)(kb_ + 32 + r32) * 512 + d0 * 16 + hi * 8); } } while (0)
#define SB_DMAV(KT, BUF) do { const int kb_ = (KT) * 64; \
        _Pragma("unroll") for (int i = 0; i < 8; ++i) __builtin_amdgcn_global_load_lds((const unsigned*)(Vh + (size_t)(kb_ + 8 * i + (lane >> 3)) * 512 + (lane & 7) * 8), (LAS unsigned*)(vlds + (BUF) * VBYTES + i * 1024), 16, 0, 0); } while (0)
    int cur = 0;
    SB_DMAV(kt, 0);
    SB_LOADK(kt);
    const int trbase = (4 * hi + ((lane & 15) >> 2)) * VPITCH + (16 * ((lane >> 4) & 1) + 4 * (lane & 3)) * 2;
    bool diag = true;
    for (;; --kt) {
        const int kbase = kt * 64;
        f32x16 p0 = {}, p1 = {};
#pragma unroll
        for (int d0 = 0; d0 < 4; ++d0) { p0 = __builtin_amdgcn_mfma_f32_32x32x16_bf16(kf[2 * d0], qr[d0], p0, 0, 0, 0); p1 = __builtin_amdgcn_mfma_f32_32x32x16_bf16(kf[2 * d0 + 1], qr[d0], p1, 0, 0, 0); }
        asm volatile("" ::: "memory");
        if (kt > 0) { SB_DMAV(kt - 1, cur ^ 1); SB_LOADK(kt - 1); }
        asm volatile("" ::: "memory");
        bf16x8 pa[4]; float suf = 0.f;
        const int qrel = t0 + r32 - kbase;
#define SB_HALF(P, KOFF, PA0, PA1) do { f32x16 sp_; \
        _Pragma("unroll") for (int r = 0; r < 16; ++r) sp_[r] = __builtin_amdgcn_logf(1.f + __builtin_amdgcn_exp2f(P[r])); \
        if (diag) { _Pragma("unroll") for (int r = 0; r < 16; ++r) if (crow(r, hi) + (KOFF) >= qrel) sp_[r] = 0.f; } \
        float e_[4], og_[4], R_[4]; \
        _Pragma("unroll") for (int c = 0; c < 4; ++c) { sp_[4 * c + 2] += sp_[4 * c + 3]; sp_[4 * c + 1] += sp_[4 * c + 2]; sp_[4 * c] += sp_[4 * c + 1]; e_[c] = sp_[4 * c]; } \
        _Pragma("unroll") for (int c = 0; c < 4; ++c) og_[c] = __shfl_xor(e_[c], 32); \
        _Pragma("unroll") for (int c = 3; c >= 0; --c) { R_[c] = carry - (suf + (hi == 0 ? og_[c] : 0.f)); suf += e_[c] + og_[c]; } \
        _Pragma("unroll") for (int r = 0; r < 16; ++r) P[r] = __builtin_amdgcn_exp2f(P[r] - sp_[r] + R_[r >> 2]); \
        if (diag) { _Pragma("unroll") for (int r = 0; r < 16; ++r) if (crow(r, hi) + (KOFF) >= qrel) P[r] = 0.f; } \
        pg8::u32x4 w_; w_.x = pkbf(P[0], P[1]); w_.y = pkbf(P[2], P[3]); w_.z = pkbf(P[4], P[5]); w_.w = pkbf(P[6], P[7]); PA0 = __builtin_bit_cast(bf16x8, w_); \
        w_.x = pkbf(P[8], P[9]); w_.y = pkbf(P[10], P[11]); w_.z = pkbf(P[12], P[13]); w_.w = pkbf(P[14], P[15]); PA1 = __builtin_bit_cast(bf16x8, w_); } while (0)
        SB_HALF(p1, 32, pa[2], pa[3]);
        SB_HALF(p0, 0, pa[0], pa[1]);
#undef SB_HALF
        carry -= suf;
        diag = false;
        if (kt > 0) asm volatile("s_waitcnt vmcnt(16)" ::: "memory"); else asm volatile("s_waitcnt vmcnt(0)" ::: "memory");
        LAS const unsigned char* vb = vlds + cur * VBYTES + trbase;
#pragma unroll
        for (int s = 0; s < 4; ++s) {
            LAS const unsigned char* vp = vb + (16 * s) * VPITCH;
            const s16x4 a0 = vtr(vp), a1 = vtr(vp + 8 * VPITCH), b0 = vtr(vp + 64), b1 = vtr(vp + 8 * VPITCH + 64);
            const bf16x8 v0 = {a0[0], a0[1], a0[2], a0[3], a1[0], a1[1], a1[2], a1[3]}, v1 = {b0[0], b0[1], b0[2], b0[3], b1[0], b1[1], b1[2], b1[3]};
            o0 = __builtin_amdgcn_mfma_f32_32x32x16_bf16(pa[s], v0, o0, 0, 0, 0);
            o1 = __builtin_amdgcn_mfma_f32_32x32x16_bf16(pa[s], v1, o1, 0, 0, 0);
        }
        asm volatile("s_waitcnt lgkmcnt(0)" ::: "memory");
        cur ^= 1;
        if (kt == 0 || __all(carry < EXIT_THR)) break;
    }
    asm volatile("s_waitcnt vmcnt(0)" ::: "memory");
#undef SB_LOADK
#undef SB_DMAV
    bf16_t* Ow = O + (rowbase + t0) * 512 + h * 64 + r32;
#pragma unroll
    for (int r = 0; r < 16; ++r) { const int q = crow(r, hi); Ow[(size_t)q * 512] = (bf16_t)f2bf(o0[r]); Ow[(size_t)q * 512 + 32] = (bf16_t)f2bf(o1[r]); }
}
}

__device__ __forceinline__ void p2_pool(Frame& F, const bf16_t* U, bf16_t* MIX) {
    const int rows_per = M / F.G; const int col8 = F.lane, w = 2 << (col8 >> 4);
    for (int rb = F.wave * 8; rb < rows_per; rb += NWAVES * 8) { const int t0 = F.vcu * rows_per + rb;
        v4u ld[23];
#pragma unroll
        for (int i = 0; i < 23; ++i) ld[i] = *(const GAS v4u*)(U + ((long)(t0 - 15 + i)) * PW + col8 * 8);
#pragma unroll
        for (int r = 0; r < 8; ++r) { const int tl = (t0 + r) % SEQ; const int cnt = (tl + 1) < w ? (tl + 1) : w;
            float acc[8];
#pragma unroll
            for (int j = 0; j < 8; ++j) acc[j] = 0.f;
#pragma unroll
            for (int i = 0; i < 16; ++i) { const v4u u = ld[15 + r - i]; const float m = (i < cnt) ? 1.f : 0.f;
                acc[0] += m * bf2f(u.x & 0xffffu); acc[1] += m * bf2f(u.x >> 16); acc[2] += m * bf2f(u.y & 0xffffu); acc[3] += m * bf2f(u.y >> 16);
                acc[4] += m * bf2f(u.z & 0xffffu); acc[5] += m * bf2f(u.z >> 16); acc[6] += m * bf2f(u.w & 0xffffu); acc[7] += m * bf2f(u.w >> 16); }
            const float inv = 1.f / (float)cnt; const v4u self = ld[15 + r];
            v4u o; o.x = pk2(acc[0] * inv - bf2f(self.x & 0xffffu), acc[1] * inv - bf2f(self.x >> 16)); o.y = pk2(acc[2] * inv - bf2f(self.y & 0xffffu), acc[3] * inv - bf2f(self.y >> 16));
            o.z = pk2(acc[4] * inv - bf2f(self.z & 0xffffu), acc[5] * inv - bf2f(self.z >> 16)); o.w = pk2(acc[6] * inv - bf2f(self.w & 0xffffu), acc[7] * inv - bf2f(self.w >> 16));
            *(GAS v4u*)(MIX + (size_t)(t0 + r) * PW + col8 * 8) = o; } }
}

constexpr int P5_TAB = AUX_OFF + 2048;
constexpr int P5_CNT = AUX_OFF + 1024;
constexpr int LIST_CAP = 16384;
typedef float f32x16 __attribute__((ext_vector_type(16)));
__device__ __forceinline__ void p5_route(Frame& F, const Args& a) {
    unsigned char* ws = a.ws; const float* X1 = a.out; const float* g2 = a.in[13]; const float* mod = (const float*)(ws + WS_MOD); const float* rbias = a.in[15];
    unsigned char* H2 = ws + WS_H2; int* PE = (int*)(ws + WS_PE);
    const bf16_t* WH = (const bf16_t*)(ws + WS_WRH); const bf16_t* WL = (const bf16_t*)(ws + WS_WRL);
    unsigned long long* LIST = (unsigned long long*)(ws + WS_LIST); gu32* gcnt = F.ctl + CW_CNT;
    LAS unsigned char* Ahi = F.lds + RING_OFF; LAS unsigned char* Alo = Ahi + 65536; LAS float* part = (LAS float*)Ahi;
    LAS float* gsv = (LAS float*)(F.lds + P5_TAB); LAS float* shv = gsv + D; LAS unsigned* cnt_l = (LAS unsigned*)(F.lds + P5_CNT); LAS unsigned* base_l = cnt_l + 64; LAS float* rr = (LAS float*)(base_l + 64);
    const int lane = F.lane, wave = __builtin_amdgcn_readfirstlane(F.wave), r32 = lane & 31, hi = lane >> 5;
    const int row0 = F.vcu * 64;
    if (row0 < M) {
        const int b = row0 / SEQ;
        for (int k = F.tid; k < D; k += NWAVES * 64) { gsv[k] = g2[k] * (1.f + mod[b * 6 * D + 4 * D + k]); shv[k] = mod[b * 6 * D + 3 * D + k]; }
        if (F.tid < 64) cnt_l[F.tid] = 0u;
        { f32x4 v[8][4];
#pragma unroll
          for (int i = 0; i < 8; ++i) { const GAS f32x4* xr = (const GAS f32x4*)(X1 + (size_t)(row0 + 8 * wave + i) * D) + lane;
#pragma unroll
              for (int j = 0; j < 4; ++j) v[i][j] = xr[64 * j]; }
#pragma unroll
          for (int i = 0; i < 8; ++i) { float s = 0.f;
#pragma unroll
              for (int j = 0; j < 4; ++j) s += (v[i][j].x * v[i][j].x + v[i][j].y * v[i][j].y) + (v[i][j].z * v[i][j].z + v[i][j].w * v[i][j].w);
              s = wave_sum(s); if (lane == 0) rr[8 * wave + i] = rsqrtf(s * (1.f / D) + EPS); } }
        __syncthreads();
        f32x16 acc[2][2];
        const char* whb = (const char*)WH + wave * 8192; const char* wlb = (const char*)WL + wave * 8192;
#pragma unroll
        for (int x = 0; x < 2; ++x)
#pragma unroll
            for (int y = 0; y < 2; ++y) acc[x][y] = f32x16{};
#pragma unroll
        for (int kh = 0; kh < 2; ++kh) {
            bf16x8 bh[4][2], bl[4][2];
#pragma unroll
            for (int s4 = 0; s4 < 4; ++s4)
#pragma unroll
                for (int t = 0; t < 2; ++t) { const int fo = kh * 65536 + (s4 * 2 + t) * 1024;
                    bh[s4][t] = *(const bf16x8*)(whb + fo + lane * 16); bl[s4][t] = *(const bf16x8*)(wlb + fo + lane * 16); }
#pragma unroll
            for (int i = 0; i < 8; ++i) { const int rl = 8 * wave + i, row = row0 + rl; const float r = rr[rl];
                if ((i & 1) == 0) __builtin_amdgcn_sched_barrier(0);
                const GAS f32x4* xr = (const GAS f32x4*)(X1 + (size_t)row * D + 512 * kh) + lane;
                GAS unsigned* o4 = (GAS unsigned*)(H2 + (size_t)row * D + 512 * kh) + lane;
#pragma unroll
                for (int j = 0; j < 2; ++j) { const f32x4 xv = xr[64 * j];
                    const f32x4 gg = *(const LAS f32x4*)(gsv + 512 * kh + 4 * lane + 256 * j), ss = *(const LAS f32x4*)(shv + 512 * kh + 4 * lane + 256 * j);
                    const f32x4 h = xv * r * gg + ss;
                    const unsigned p01 = pk2(h.x, h.y), p23 = pk2(h.z, h.w);
                    const unsigned long long hh = (unsigned long long)p01 | ((unsigned long long)p23 << 32);
                    { const f32x4 h8 = h * H8SCALE; unsigned q8 = 0u;
                      q8 = __builtin_amdgcn_cvt_pk_fp8_f32(__builtin_amdgcn_fmed3f(h8.x, -448.f, 448.f), __builtin_amdgcn_fmed3f(h8.y, -448.f, 448.f), q8, false);
                      q8 = __builtin_amdgcn_cvt_pk_fp8_f32(__builtin_amdgcn_fmed3f(h8.z, -448.f, 448.f), __builtin_amdgcn_fmed3f(h8.w, -448.f, 448.f), q8, true);
                      o4[64 * j] = q8; }
                    const unsigned long long ll = (unsigned long long)pk2(h.x - __builtin_bit_cast(float, p01 << 16), h.y - __builtin_bit_cast(float, p01 & 0xffff0000u))
                                                | ((unsigned long long)pk2(h.z - __builtin_bit_cast(float, p23 << 16), h.w - __builtin_bit_cast(float, p23 & 0xffff0000u)) << 32);
                    const int chunk = (lane >> 1) + 32 * j, off = rl * 1024 + ((chunk ^ (rl & 15)) << 4) + ((lane & 1) << 3);
                    *(LAS unsigned long long*)(Ahi + off) = hh; *(LAS unsigned long long*)(Alo + off) = ll; } }
            __syncthreads();
#pragma unroll
            for (int s4 = 0; s4 < 4; ++s4) { const int chunk = 8 * wave + 2 * s4 + hi;
                const bf16x8 bh0 = bh[s4][0], bh1 = bh[s4][1], bl0 = bl[s4][0], bl1 = bl[s4][1];
#pragma unroll
                for (int x = 0; x < 2; ++x) { const int rw = 32 * x + r32, off = rw * 1024 + ((chunk ^ (rw & 15)) << 4);
                    const bf16x8 ah = *(const LAS bf16x8*)(Ahi + off), al = *(const LAS bf16x8*)(Alo + off);
                    acc[x][0] = __builtin_amdgcn_mfma_f32_32x32x16_bf16(ah, bh0, acc[x][0], 0, 0, 0); acc[x][1] = __builtin_amdgcn_mfma_f32_32x32x16_bf16(ah, bh1, acc[x][1], 0, 0, 0);
                    acc[x][0] = __builtin_amdgcn_mfma_f32_32x32x16_bf16(al, bh0, acc[x][0], 0, 0, 0); acc[x][1] = __builtin_amdgcn_mfma_f32_32x32x16_bf16(al, bh1, acc[x][1], 0, 0, 0);
                    acc[x][0] = __builtin_amdgcn_mfma_f32_32x32x16_bf16(ah, bl0, acc[x][0], 0, 0, 0); acc[x][1] = __builtin_amdgcn_mfma_f32_32x32x16_bf16(ah, bl1, acc[x][1], 0, 0, 0); } }
            __syncthreads();
        }
#pragma unroll
        for (int x = 0; x < 2; ++x)
#pragma unroll
            for (int r = 0; r < 16; ++r) { const int rw = 32 * x + (r & 3) + 8 * (r >> 2) + 4 * hi; part[wave * 4096 + rw * 64 + r32] = acc[x][0][r]; part[wave * 4096 + rw * 64 + 32 + r32] = acc[x][1][r]; }
        __syncthreads();
        float scq[8];
#pragma unroll
        for (int q = 0; q < 8; ++q) { const int rl = wave + 8 * q; float logit = 0.f;
#pragma unroll
            for (int w = 0; w < 8; ++w) logit += part[w * 4096 + rl * 64 + lane];
            scq[q] = 1.f / (1.f + expf(-logit)); }
        __syncthreads();
        LAS float* scoreT = (LAS float*)(F.lds + RING_OFF);
#pragma unroll
        for (int q = 0; q < 8; ++q) scoreT[lane * 65 + wave + 8 * q] = scq[q];
        __syncthreads();
        if (wave == 0) {
            float sel[64];
#pragma unroll
            for (int e = 0; e < 64; ++e) sel[e] = scoreT[e * 65 + lane] + rbias[e];
            float gs[8];
#pragma unroll
            for (int g = 0; g < 8; ++g) { float m1 = sel[8 * g], m2 = -INFINITY;
#pragma unroll
                for (int j = 1; j < 8; ++j) { const float v = sel[8 * g + j]; const float lo = fminf(m1, v); m1 = fmaxf(m1, v); m2 = fmaxf(m2, lo); }
                gs[g] = m1 + m2; }
            unsigned gmask = 0u;
#pragma unroll
            for (int g = 0; g < 8; ++g) { int rk = 0;
#pragma unroll
                for (int h = 0; h < 8; ++h) if (h != g) rk += (gs[h] > gs[g] || (gs[h] == gs[g] && h < g)) ? 1 : 0;
                gmask |= (rk < 4) ? (1u << g) : 0u; }
#pragma unroll
            for (int e = 0; e < 64; ++e) sel[e] = ((gmask >> (e >> 3)) & 1u) ? sel[e] : -INFINITY;
            unsigned long long taken = 0ull; int ex[8]; float ws_[8]; float wsum = 0.f;
#pragma unroll
            for (int r = 0; r < TOPK; ++r) { float best = -INFINITY; int bi = 0;
#pragma unroll
                for (int e = 0; e < 64; ++e) { const bool c = !((taken >> e) & 1ull) && sel[e] > best; best = c ? sel[e] : best; bi = c ? e : bi; }
                taken |= 1ull << bi; ex[r] = bi; ws_[r] = scoreT[bi * 65 + lane]; wsum += ws_[r]; }
            const float wn = RSCALE / wsum;
#pragma unroll
            for (int r = 0; r < TOPK; ++r) { const unsigned pos = __hip_atomic_fetch_add(cnt_l + ex[r], 1u, __ATOMIC_RELAXED, __HIP_MEMORY_SCOPE_WORKGROUP);
                LAS unsigned* pk = (LAS unsigned*)(F.lds + RING_OFF + 32768) + (lane * 8 + r) * 4; pk[0] = (unsigned)ex[r]; pk[1] = pos; pk[2] = __builtin_bit_cast(unsigned, ws_[r] * wn); }
        }
        __syncthreads();
        if (F.tid < 64) base_l[F.tid] = __hip_atomic_fetch_add(gcnt + 64 * F.tid, cnt_l[F.tid], __ATOMIC_RELAXED, __HIP_MEMORY_SCOPE_AGENT);
        __syncthreads();
        { LAS const unsigned* pk = (LAS const unsigned*)(F.lds + RING_OFF + 32768) + F.tid * 4; const unsigned e = pk[0], pos = pk[1], wb = pk[2];
          const int pair = (row0 + (F.tid >> 3)) * 8 + (F.tid & 7);
          LIST[(size_t)e * LIST_CAP + base_l[e] + pos] = (unsigned long long)(unsigned)pair | ((unsigned long long)wb << 32);
          PE[pair] = (int)e; }
        __syncthreads();
    }
}

namespace pg8 {
struct UnitG { int kind, slot, nvalid, pm, pn, row0; const char* bptr; };
constexpr int P6_PRE = AUX_OFF + 1024;
constexpr int P6_ROWS = AUX_OFF + 2048;
struct SchedG {
    const LAS int* pre; const LAS int* cnts; const LAS int* cum; const char* wgu; const char* wsh; int G, c, nr, total;
    __device__ __forceinline__ bool next(int i, UnitG& u) const {
        const int idx = i * G + c; if (idx >= total) return false;
        if (idx < nr) { int e = (int)__builtin_popcountll(__ballot(pre[1 + (threadIdx.x & 63)] <= idx));
            e = __builtin_amdgcn_readfirstlane(e); const int j = idx - __builtin_amdgcn_readfirstlane(pre[e]); const int nv = __builtin_amdgcn_readfirstlane(cnts[e]) - 256 * j;
            u.kind = 0; u.slot = i; u.nvalid = nv < 256 ? nv : 256; u.pm = e; u.pn = j; u.row0 = 256 * idx; u.bptr = wgu + (size_t)e * 256 * D; }
        else { const int s = idx - nr; u.kind = 1; u.slot = i; u.nvalid = 256; u.pm = s >> 1; u.pn = s & 1; u.row0 = (s >> 1) * 256; u.bptr = wsh + (size_t)(s & 1) * 256 * D; }
        return true; }
};
struct EpiGU {
    static constexpr bool PERM = true;
    bf16_t* HM; bf16_t* SH; int* SLOT; const LAS unsigned long long* rowinfo;
    __device__ __forceinline__ void operator()(const f32x4 (&acc)[2][2][4][2], const UnitG& u, int wr, int wc, int fr, int fq) const {
#pragma unroll
        for (int ai = 0; ai < 2; ++ai)
#pragma unroll
            for (int m = 0; m < 4; ++m) { const int r = ai * HALF + wr * 64 + m * 16 + fr;
                bf16_t* dst; float w;
                if (u.kind == 0) { const unsigned long long ri = rowinfo[u.slot * 256 + r]; dst = HM + (size_t)(u.row0 + r) * ED + wc * 32 + 8 * fq; w = __builtin_bit_cast(float, (unsigned)(ri >> 32));
                    if (wc == 0 && fq == 0) SLOT[u.row0 + r] = (r < u.nvalid) ? (int)(unsigned)ri : M * 8; }
                else { dst = SH + (size_t)(u.pm * 256 + r) * SHD + u.pn * 128 + wc * 32 + 8 * fq; w = 1.f; }
                constexpr float DQ = 1.f / (W8SCALE * H8SCALE);
                const f32x4 g0 = acc[ai][0][m][0] * DQ, g1 = acc[ai][0][m][1] * DQ, u0 = acc[ai][1][m][0] * DQ, u1 = acc[ai][1][m][1] * DQ;
                float v[8];
#pragma unroll
                for (int j = 0; j < 4; ++j) { v[j] = g0[j] * fsigmoid(g0[j]) * u0[j] * w; v[4 + j] = g1[j] * fsigmoid(g1[j]) * u1[j] * w; }
                u32x4 o; o.x = cvt_pk_bf16(v[0], v[1]); o.y = cvt_pk_bf16(v[2], v[3]); o.z = cvt_pk_bf16(v[4], v[5]); o.w = cvt_pk_bf16(v[6], v[7]);
                if (r < u.nvalid) *(u32x4*)dst = o; }
    }
};
typedef int i32x4_t __attribute__((ext_vector_type(4))); typedef int i32x8_t __attribute__((ext_vector_type(8)));
__device__ __forceinline__ i32x8_t cat8(const bf16x8& a, const bf16x8& b) { return __builtin_shufflevector(__builtin_bit_cast(i32x4_t, a), __builtin_bit_cast(i32x4_t, b), 0, 1, 2, 3, 4, 5, 6, 7); }
__device__ __forceinline__ void mfma8(f32x4& acc, const i32x8_t a, const i32x8_t b) { asm volatile("v_mfma_f32_16x16x128_f8f6f4 %0, %1, %2, %0" : "+v"(acc) : "v"(a), "v"(b)); }
__device__ __forceinline__ void mfma8_settle(f32x4 (&acc)[2][2][4][2]) {
    asm volatile("s_nop 15\n\ts_nop 15" ::: "memory");
#pragma unroll
    for (int a = 0; a < 2; ++a)
#pragma unroll
        for (int b = 0; b < 2; ++b)
#pragma unroll
            for (int m = 0; m < 4; ++m)
#pragma unroll
                for (int n = 0; n < 2; ++n) asm volatile("" : "+v"(acc[a][b][m][n]));
}
template <class Epi, class Sched, bool FP8 = false>
__device__ __forceinline__ void gemm_phase_g(PG8_LAS unsigned char* lds, const bf16_t* A, int K, const Sched& S, const Epi& E, const PG8_LAS unsigned long long* rowinfo) {
    int tid_ = threadIdx.x; asm volatile("" : "+v"(tid_));
    const int tid = tid_, wid = __builtin_amdgcn_readfirstlane(tid >> 6), lane = tid & 63, wr = wid >> 2, wc = wid & 3, fr = lane & 15, fq = lane >> 4;
    const int nt = K / BK;
    int RA[2], CA[2]; unsigned voffB[2];
#pragma unroll
    for (int i = 0; i < 2; ++i) { int R, C; stage_rc(tid * 16 + i * 8192, R, C); const int Rb = Epi::PERM ? ((R & ~31) + perm32(R & 31)) : R; RA[i] = R; CA[i] = C; voffB[i] = (unsigned)(Rb * K + C) * 2u; }
    const size_t kstep = (size_t)(BK * 2);
    const size_t hstep = (size_t)HALF * K * 2;
    const unsigned ldsw = (unsigned)wid * 1024u;
    const int aoff = lds_byte(wr * 64 + fr, fq * 8), boff = lds_byte(wc * 32 + fr, fq * 8);
#define PG8_AOFF(u, o0, o1) do { _Pragma("unroll") for (int _i = 0; _i < 2; ++_i) { unsigned r0_, r1_; \
        if ((u).kind == 0) { r0_ = (unsigned)rowinfo[(u).slot * 256 + RA[_i]] >> 3; r1_ = (unsigned)rowinfo[(u).slot * 256 + HALF + RA[_i]] >> 3; } \
        else { r0_ = (unsigned)((u).row0 + RA[_i]); r1_ = r0_ + HALF; } \
        o0[_i] = (r0_ * (unsigned)K + (unsigned)CA[_i]) * 2u; o1[_i] = (r1_ * (unsigned)K + (unsigned)CA[_i]) * 2u; } } while (0)
#define PG8_SA(b, h) (((b) * 2 + (h)) * HTB)
#define PG8_SB(b, h) ((4 + (b) * 2 + (h)) * HTB)
#define PG8_STAGE(bufoff, gbase, voff) do { _Pragma("unroll") for (int _i = 0; _i < 2; ++_i) \
        __builtin_amdgcn_global_load_lds((const unsigned*)((const char*)(gbase) + (voff)[_i]), (PG8_LAS unsigned*)(lds + (bufoff) + ldsw + _i * 8192), 16, 0, 0); } while (0)
#define PG8_LDA(dst, b, h) do { _Pragma("unroll") for (int m = 0; m < 4; ++m) _Pragma("unroll") for (int k = 0; k < 2; ++k) dst[m][k] = *(const PG8_LAS bf16x8*)(lds + PG8_SA(b, h) + aoff + m * 2048 + k * 1024); } while (0)
#define PG8_LDB(dst, b, h) do { _Pragma("unroll") for (int n = 0; n < 2; ++n) _Pragma("unroll") for (int k = 0; k < 2; ++k) dst[n][k] = *(const PG8_LAS bf16x8*)(lds + PG8_SB(b, h) + boff + n * 2048 + k * 1024); } while (0)
#define PG8_MMA(ai, bj, At, Bt) do { __builtin_amdgcn_s_setprio(1); _Pragma("unroll") for (int m = 0; m < 4; ++m) _Pragma("unroll") for (int n = 0; n < 2; ++n) { \
        if constexpr (FP8) mfma8(acc[ai][bj][m][n], cat8(Bt[n][0], Bt[n][1]), cat8(At[m][0], At[m][1])); \
        else { _Pragma("unroll") for (int k = 0; k < 2; ++k) acc[ai][bj][m][n] = __builtin_amdgcn_mfma_f32_16x16x32_bf16(Bt[n][k], At[m][k], acc[ai][bj][m][n], 0, 0, 0); } } __builtin_amdgcn_s_setprio(0); } while (0)
#define PG8_WAIT_V(n) asm volatile("s_waitcnt vmcnt(" #n ")" ::: "memory")
#define PG8_WAIT_L(n) asm volatile("s_waitcnt lgkmcnt(" #n ")" ::: "memory")
#define PG8_BAR __builtin_amdgcn_s_barrier()
#define PG8_SCHED __builtin_amdgcn_sched_barrier(0)
    UnitG cur, nxt; int ui = 0;
    if (!S.next(0, cur)) return;
    f32x4 acc[2][2][4][2];
#pragma unroll
    for (int a = 0; a < 2; ++a)
#pragma unroll
        for (int b = 0; b < 2; ++b)
#pragma unroll
            for (int m = 0; m < 4; ++m)
#pragma unroll
                for (int n = 0; n < 2; ++n) acc[a][b][m][n] = (f32x4){0.f, 0.f, 0.f, 0.f};
    bf16x8 At[4][2], B0[2][2], B1[2][2];
    const char* cA = (const char*)A; const char* cB = cur.bptr;
    unsigned vA0[2], vA1[2], nA0[2], nA1[2];
    PG8_AOFF(cur, vA0, vA1);
    PG8_STAGE(PG8_SB(0, 0), cB, voffB); PG8_STAGE(PG8_SB(0, 1), cB + hstep, voffB); PG8_STAGE(PG8_SA(0, 0), cA, vA0); PG8_STAGE(PG8_SA(0, 1), cA, vA1);
    if (wr == 1) PG8_BAR;
    PG8_WAIT_V(2); PG8_BAR;
    PG8_STAGE(PG8_SB(1, 0), cB + kstep, voffB); PG8_STAGE(PG8_SA(1, 0), cA + kstep, vA0); PG8_STAGE(PG8_SB(1, 1), cB + hstep + kstep, voffB);
    PG8_WAIT_V(6); PG8_BAR;
    for (;;) {
        const bool has_next = S.next(ui + 1, nxt);
        const char* nB = has_next ? nxt.bptr : cB;
        if (has_next) { PG8_AOFF(nxt, nA0, nA1); } else {
#pragma unroll
            for (int _i = 0; _i < 2; ++_i) { nA0[_i] = vA0[_i]; nA1[_i] = vA1[_i]; } }
#pragma nounroll
        for (int t = 0; t < nt; t += 2) {
            const bool last = (t == nt - 2);
            const char* a1 = cA + (size_t)(t + 1) * kstep;
            const char* a2 = last ? cA : cA + (size_t)(t + 2) * kstep; const char* b2 = last ? nB : cB + (size_t)(t + 2) * kstep;
            const char* a3 = a2 + kstep; const char* b3 = b2 + kstep;
            unsigned s0[2], s1[2];
#pragma unroll
            for (int _i = 0; _i < 2; ++_i) { s0[_i] = last ? nA0[_i] : vA0[_i]; s1[_i] = last ? nA1[_i] : vA1[_i]; }
            PG8_LDB(B0, 0, 0); PG8_LDB(B1, 0, 1); PG8_SCHED; PG8_LDA(At, 0, 0); PG8_STAGE(PG8_SA(1, 1), a1, vA1);
            PG8_WAIT_V(8); PG8_WAIT_L(0); PG8_BAR; PG8_MMA(0, 0, At, B0); PG8_MMA(0, 1, At, B1); PG8_BAR; PG8_SCHED;
            PG8_LDA(At, 0, 1); PG8_STAGE(PG8_SB(0, 0), b2, voffB); PG8_STAGE(PG8_SB(0, 1), b2 + hstep, voffB); PG8_STAGE(PG8_SA(0, 0), a2, s0);
            PG8_WAIT_V(8); PG8_WAIT_L(0); PG8_BAR; PG8_MMA(1, 0, At, B0); PG8_MMA(1, 1, At, B1); PG8_BAR; PG8_SCHED;
            PG8_LDB(B0, 1, 0); PG8_LDB(B1, 1, 1); PG8_SCHED; PG8_LDA(At, 1, 0); PG8_STAGE(PG8_SA(0, 1), a2, s1);
            PG8_WAIT_V(8); PG8_WAIT_L(0); PG8_BAR; PG8_MMA(0, 0, At, B0); PG8_MMA(0, 1, At, B1); PG8_BAR; PG8_SCHED;
            PG8_LDA(At, 1, 1); PG8_STAGE(PG8_SB(1, 0), b3, voffB); PG8_STAGE(PG8_SB(1, 1), b3 + hstep, voffB); PG8_STAGE(PG8_SA(1, 0), a3, s0);
            PG8_WAIT_V(8); PG8_WAIT_L(0); PG8_BAR; PG8_MMA(1, 0, At, B0); PG8_MMA(1, 1, At, B1); PG8_BAR; PG8_SCHED;
        }
        if (wr == 0) PG8_BAR;
        if constexpr (FP8) mfma8_settle(acc);
        E(acc, cur, wr, wc, fr, fq);
        if (!has_next) break;
#pragma unroll
        for (int a = 0; a < 2; ++a)
#pragma unroll
            for (int b = 0; b < 2; ++b)
#pragma unroll
                for (int m = 0; m < 4; ++m)
#pragma unroll
                    for (int n = 0; n < 2; ++n) acc[a][b][m][n] = (f32x4){0.f, 0.f, 0.f, 0.f};
        cur = nxt; cB = nB; ++ui;
#pragma unroll
        for (int _i = 0; _i < 2; ++_i) { vA0[_i] = nA0[_i]; vA1[_i] = nA1[_i]; }
        if (wr == 1) PG8_BAR;
    }
    PG8_WAIT_V(0);
    PG8_BAR;
#undef PG8_AOFF
#undef PG8_SA
#undef PG8_SB
#undef PG8_STAGE
#undef PG8_LDA
#undef PG8_LDB
#undef PG8_MMA
#undef PG8_WAIT_V
#undef PG8_WAIT_L
#undef PG8_BAR
#undef PG8_SCHED
}
}

__device__ __forceinline__ void p6_gateup(Frame& F, const Args& a) {
    unsigned char* ws = a.ws; gu32* gcnt = F.ctl + CW_CNT; const unsigned long long* LIST = (const unsigned long long*)(ws + WS_LIST);
    LAS int* pre = (LAS int*)(F.lds + pg8::P6_PRE); LAS int* cnts = pre + 65; LAS int* cum = cnts + 64; LAS unsigned long long* rowinfo = (LAS unsigned long long*)(F.lds + pg8::P6_ROWS);
    if (F.tid < 64) cnts[F.tid] = (int)__hip_atomic_load(gcnt + 64 * F.tid, RLX_AGENT);
    __syncthreads();
    if (F.tid == 0) { int s = 0, r = 0; for (int e = 0; e < 64; ++e) { pre[e] = s; cum[e] = r; s += (cnts[e] + 255) >> 8; r += cnts[e]; } pre[64] = s; cum[64] = r; }
    __syncthreads();
    pg8::SchedG S; S.pre = pre; S.cnts = cnts; S.cum = cum; S.wgu = (const char*)(ws + WS_WGU); S.wsh = (const char*)(ws + WS_WSHGU); S.G = F.G; S.c = (int)blockIdx.x; S.nr = __builtin_amdgcn_readfirstlane(pre[64]); S.total = S.nr + 2 * (M / 256);
    for (int i = 0; i < 3; ++i) { pg8::UnitG u; if (!S.next(i, u)) break;
        if (u.kind == 0 && F.tid < 256) { const int r = F.tid; rowinfo[i * 256 + r] = (r < u.nvalid) ? LIST[(size_t)u.pm * LIST_CAP + 256 * u.pn + r] : 0ull; } }
    __syncthreads();
    pg8::EpiGU E{(bf16_t*)(ws + WS_HM), (bf16_t*)(ws + WS_SH), (int*)(ws + WS_SLOT), rowinfo};
    pg8::gemm_phase_g<pg8::EpiGU, pg8::SchedG, true>(F.lds + RING_OFF, (const bf16_t*)(ws + WS_H2), D / 2, S, E, rowinfo);
    { const int rounds = (S.total + F.G - 1) / F.G, firstidle = S.total - (rounds - 1) * F.G;
      const int c = (int)blockIdx.x, nidle = F.G - firstidle;
      if (nidle > 0) { if (c >= firstidle) titem_run(F, a, true, 64 * 64 + 4 * 32, (c - firstidle) * NWAVES + F.wave, nidle * NWAVES); }
      else titem_run(F, a, true, 64 * 64 + 4 * 32, c * NWAVES + F.wave, F.G * NWAVES); }
}

namespace pg8 {
struct SchedYr {
    const LAS int* pre; int G, c, total;
    __device__ __forceinline__ bool next(int i, Unit& u) const {
        const int idx = i * G + c; if (idx >= total) return false;
        const int t = idx >> 2, pnl = idx & 3; int e = (int)__builtin_popcountll(__ballot(pre[1 + (threadIdx.x & 63)] <= t));
        e = __builtin_amdgcn_readfirstlane(e); u.pm = t; u.pn = 4 * e + pnl; return true; }
    __device__ __forceinline__ void a_ready(const Unit&) const {}
    __device__ __forceinline__ void done(const Unit&) const {}
};
constexpr float YSCALE = 8.f;
struct EpiStoreF8 {
    static constexpr bool PERM = true, AFTER_DRAIN = false;
    unsigned char* O; const PG8_LAS int* rowmap_l; int G, c;
    __device__ __forceinline__ void operator()(const f32x4 (&acc)[2][2][4][2], const Unit& u, int wr, int wc, int fr, int fq) const {
        const int slot = (4 * u.pm + (u.pn & 3) - c) / G; const PG8_LAS int* rm = rowmap_l + slot * 256 + wr * 64 + fr; const int col0 = (u.pn & 3) * BM + wc * 64 + 16 * fq;
#pragma unroll
        for (int ai = 0; ai < 2; ++ai)
#pragma unroll
            for (int m = 0; m < 4; ++m) { const int orow = rm[ai * HALF + m * 16]; u32x4 w;
#pragma unroll
                for (int bj = 0; bj < 2; ++bj) { const f32x4 v0 = acc[ai][bj][m][0] * YSCALE, v1 = acc[ai][bj][m][1] * YSCALE;
                    unsigned lo = 0u, hi = 0u;
                    lo = __builtin_amdgcn_cvt_pk_fp8_f32(v0[0], v0[1], lo, false); lo = __builtin_amdgcn_cvt_pk_fp8_f32(v0[2], v0[3], lo, true);
                    hi = __builtin_amdgcn_cvt_pk_fp8_f32(v1[0], v1[1], hi, false); hi = __builtin_amdgcn_cvt_pk_fp8_f32(v1[2], v1[3], hi, true);
                    if (bj == 0) { w.x = lo; w.y = hi; } else { w.z = lo; w.w = hi; } }
                *(u32x4*)(O + (size_t)orow * 1024 + col0) = w; }
    }
};
struct EpiStore {
    static constexpr bool PERM = true, AFTER_DRAIN = false;
    bf16_t* O; int ldc, colmask;
    __device__ __forceinline__ void operator()(const f32x4 (&acc)[2][2][4][2], const Unit& u, int wr, int wc, int fr, int fq) const {
        const int row0 = u.pm * BM + wr * 64 + fr, col0 = (u.pn & colmask) * BM + wc * 32 + 8 * fq;
#pragma unroll
        for (int ai = 0; ai < 2; ++ai)
#pragma unroll
            for (int m = 0; m < 4; ++m) { bf16_t* rowp = O + (size_t)(row0 + ai * HALF + m * 16) * ldc + col0;
#pragma unroll
                for (int bj = 0; bj < 2; ++bj) { const f32x4 v0 = acc[ai][bj][m][0], v1 = acc[ai][bj][m][1];
                    u32x4 w; w.x = cvt_pk_bf16(v0[0], v0[1]); w.y = cvt_pk_bf16(v0[2], v0[3]); w.z = cvt_pk_bf16(v1[0], v1[1]); w.w = cvt_pk_bf16(v1[2], v1[3]);
                    *(u32x4*)(rowp + bj * HALF) = w; } }
    }
};
}
__device__ __forceinline__ void p7_down(Frame& F, const Args& a) {
    unsigned char* ws = a.ws; gu32* gcnt = F.ctl + CW_CNT;
    LAS int* pre = (LAS int*)(F.lds + pg8::P6_PRE); LAS int* cnts = pre + 65;
    if (F.tid < 64) cnts[F.tid] = (int)__hip_atomic_load(gcnt + 64 * F.tid, RLX_AGENT);
    __syncthreads();
    if (F.tid == 0) { int s = 0; for (int e = 0; e < 64; ++e) { pre[e] = s; s += (cnts[e] + 255) >> 8; } pre[64] = s; }
    __syncthreads();
    { pg8::SchedYr S; S.pre = pre; S.G = F.G; S.c = (int)blockIdx.x; S.total = 4 * __builtin_amdgcn_readfirstlane(pre[64]);
      int kk = ED; asm volatile("" : "+s"(kk));
      LAS int* rml = (LAS int*)(F.lds + AUX_OFF + 2048); const int* rowmap = (const int*)(ws + WS_SLOT);
      for (int i = 0; i * F.G + S.c < S.total && i < 12; ++i) { if (F.tid < 256) rml[i * 256 + F.tid] = rowmap[256 * ((i * F.G + S.c) >> 2) + F.tid]; }
      __syncthreads();
      pg8::Gemm g{(const bf16_t*)(ws + WS_HM), (const bf16_t*)(ws + WS_WD), 0, 0, kk}; pg8::EpiStoreF8 E{ws + WS_YH, rml, F.G, S.c};
      pg8::gemm_phase<pg8::EpiStoreF8, pg8::SchedYr, true, true>(F.lds + RING_OFF, g, S, E); }
    { pg8::StaticOrder S; S.init(M, D, F.G, (int)blockIdx.x);
      int kk = SHD; asm volatile("" : "+s"(kk));
      pg8::Gemm g{(const bf16_t*)(ws + WS_SH), (const bf16_t*)(ws + WS_WSHD), M, D, kk}; pg8::EpiStore E{(bf16_t*)(ws + WS_YSH), D, 3};
      pg8::gemm_phase<pg8::EpiStore, pg8::StaticOrder, true, true>(F.lds + RING_OFF, g, S, E); }
}
__device__ __forceinline__ void p8_combine(Frame& F, const Args& a) {
    unsigned char* ws = a.ws; const unsigned char* Y8 = ws + WS_YH; const bf16_t* YSH = (const bf16_t*)(ws + WS_YSH);
    const float* mod = (const float*)(ws + WS_MOD); float* OUT = a.out; const int lane = F.lane;
    for (int tb = (F.vcu * NWAVES + F.wave) * 8; tb < M; tb += F.G * NWAVES * 8) {
        const int b = tb / SEQ; const float* gate = mod + (size_t)b * 6 * D + 5 * D + lane * 16;
        f32x4 gv[4];
#pragma unroll
        for (int i = 0; i < 4; ++i) gv[i] = *(const f32x4*)(gate + 4 * i);
#pragma nounroll
        for (int i = 0; i < 8; i += 2) {
            v4u y[2][8], ys[2][2]; f32x4 x[2][4];
#pragma unroll
            for (int q = 0; q < 2; ++q) { const int t = tb + i + q;
#pragma unroll
                for (int k = 0; k < 8; ++k) y[q][k] = *(const GAS v4u*)(Y8 + ((size_t)t * 8 + k) * 1024 + lane * 16);
                const GAS v4u* sp = (const GAS v4u*)(YSH + (size_t)t * D + lane * 16); ys[q][0] = sp[0]; ys[q][1] = sp[1];
                const GAS f32x4* o = (const GAS f32x4*)(OUT + (size_t)t * D + lane * 16);
#pragma unroll
                for (int j = 0; j < 4; ++j) x[q][j] = o[j]; }
#pragma unroll
            for (int q = 0; q < 2; ++q) { const int t = tb + i + q; float acc[16];
#pragma unroll
                for (int j = 0; j < 16; ++j) acc[j] = 0.f;
#pragma unroll
                for (int k = 0; k < 8; ++k) { const unsigned w4[4] = {y[q][k].x, y[q][k].y, y[q][k].z, y[q][k].w};
#pragma unroll
                    for (int j = 0; j < 4; ++j) { const pg8::f32x2_t lo = __builtin_amdgcn_cvt_pk_f32_fp8((int)w4[j], false), hi = __builtin_amdgcn_cvt_pk_f32_fp8((int)w4[j], true);
                        acc[4 * j] += lo.x; acc[4 * j + 1] += lo.y; acc[4 * j + 2] += hi.x; acc[4 * j + 3] += hi.y; } }
                GAS f32x4* o = (GAS f32x4*)(OUT + (size_t)t * D + lane * 16);
#pragma unroll
                for (int j = 0; j < 4; ++j) { const unsigned s0 = (j < 2 ? ys[q][0] : ys[q][1])[2 * (j & 1)], s1 = (j < 2 ? ys[q][0] : ys[q][1])[2 * (j & 1) + 1];
                    const f32x4 sh = {bf2f(s0 & 0xffffu), bf2f(s0 >> 16), bf2f(s1 & 0xffffu), bf2f(s1 >> 16)};
                    const f32x4 rt = {acc[4 * j], acc[4 * j + 1], acc[4 * j + 2], acc[4 * j + 3]};
                    o[j] = x[q][j] + gv[j] * (rt * (1.f / pg8::YSCALE) + sh); } }
        }
    }
}

__global__ void __launch_bounds__(NWAVES * 64, 2) mk_fwd(Args args) {
    extern __shared__ __attribute__((aligned(16))) unsigned char lds[];
    Frame F;
    F.lds = (LAS unsigned char*)lds; F.MISC = (volatile LAS unsigned*)(F.lds + MISC_OFF);
    F.tid = threadIdx.x; F.lane = F.tid & 63; F.wave = __builtin_amdgcn_readfirstlane(F.tid >> 6);
    F.G = gridDim.x; { const int bx = blockIdx.x; F.vcu = (F.G % 8 == 0) ? (bx % 8) * (F.G / 8) + bx / 8 : bx; }
    unsigned char* ws = args.ws; F.ctl = (gu32*)(ws + WS_CTL);
    for (int u = F.tid; u < (LDS_BYTES - LDSCTL_OFF) / 4; u += NWAVES * 64) ((LAS unsigned*)(F.lds + LDSCTL_OFF))[u] = 0u;
    __syncthreads();
    XcdBarrier bar; bar.bar = (unsigned*)(F.ctl + CW_BAR); bar.x = 0; bar.st = nullptr;
    if (args.use_bar) bar = xcd_barrier_post((unsigned*)(F.ctl + CW_BAR), F.MISC + 8);
    const int lo = args.ph_lo, hi = args.ph_hi;
#define IN(k) (lo <= (k) && (k) < hi)
#define SEAM(k) do { if (IN(k) && IN((k) + 1)) xcd_barrier(bar); } while (0)
#define REFRESH() do { int t_ = threadIdx.x; asm volatile("" : "+v"(t_)); F.tid = t_; F.lane = t_ & 63; F.wave = __builtin_amdgcn_readfirstlane(t_ >> 6); } while (0)
#define PHASE(p, ...) do { if (IN(p)) { REFRESH(); const int reps_ = (DBL_PHASE == (p)) ? 2 : 1; for (int rep_ = 0; rep_ < reps_; ++rep_) { __VA_ARGS__; if (rep_ + 1 < reps_) xcd_barrier(bar); } } SEAM(p); } while (0)
    PHASE(0, p0a(F, args));
    PHASE(1, p0b(F, args));
    PHASE(2, {
        pg8::Gemm g{(const bf16_t*)(ws + WS_XN), (const bf16_t*)(ws + WS_WIN), M, INW, D}; pg8::StaticOrder S; S.init(M, INW, F.G, (int)blockIdx.x);
        pg8::EpiProj E{(bf16_t*)(ws + WS_Q), (bf16_t*)(ws + WS_K), (bf16_t*)(ws + WS_V), (bf16_t*)(ws + WS_U), (bf16_t*)(ws + WS_GA), (bf16_t*)(ws + WS_GB), args.in[6], args.in[7]};
        pg8::gemm_phase<pg8::EpiProj, pg8::StaticOrder, true, true>(F.lds + RING_OFF, g, S, E); });
    PHASE(3, {
        const bf16_t* Q = (const bf16_t*)(ws + WS_Q); const bf16_t* K = (const bf16_t*)(ws + WS_K); const bf16_t* V = (const bf16_t*)(ws + WS_V);
        for (int u = blockIdx.x; u < BATCH * NH * (SEQ / 256); u += F.G) { const int qb = u & 15, bh = u >> 4;
            sb::attn_unit(bh >> 3, bh & 7, qb, Q, K, V, (bf16_t*)(ws + WS_OSB), F.lds + RING_OFF + F.wave * sb::WAVE_LDS, F.wave, F.lane); }
        p2_pool(F, (const bf16_t*)(ws + WS_U), (bf16_t*)(ws + WS_MIX)); });
    PHASE(4, {
        pg8::StaticOrder S; S.init(M, D, F.G, (int)blockIdx.x);
        { pg8::Gemm g{(const bf16_t*)(ws + WS_OSB), (const bf16_t*)(ws + WS_WSB), M, D, SBW}; pg8::EpiMerge E{(const bf16_t*)(ws + WS_GA), (bf16_t*)(ws + WS_MERGED), 0};
          pg8::gemm_phase<pg8::EpiMerge, pg8::StaticOrder, true, true>(F.lds + RING_OFF, g, S, E); }
        { pg8::Gemm g{(const bf16_t*)(ws + WS_MIX), (const bf16_t*)(ws + WS_WEFF), M, D, PW}; pg8::EpiMerge E{(const bf16_t*)(ws + WS_GB), (bf16_t*)(ws + WS_MERGED), 1};
          pg8::gemm_phase<pg8::EpiMerge, pg8::StaticOrder, true, true>(F.lds + RING_OFF, g, S, E); } });
    PHASE(5, {
        pg8::Gemm g{(const bf16_t*)(ws + WS_MERGED), (const bf16_t*)(ws + WS_WOUT), M, D, D}; pg8::StaticOrder S; S.init(M, D, F.G, (int)blockIdx.x);
        pg8::EpiX1 E{args.in[0], (const float*)(ws + WS_MOD) + 2 * D, args.out};
        pg8::gemm_phase<pg8::EpiX1, pg8::StaticOrder, true, true>(F.lds + RING_OFF, g, S, E); });
    PHASE(6, {
        if (rep_ > 0) { if (blockIdx.x == 0 && F.tid < 64) __hip_atomic_store(F.ctl + CW_CNT + 64 * F.tid, 0u, RLX_AGENT); xcd_barrier(bar); }
        p5_route(F, args); });
    PHASE(7, p6_gateup(F, args));
    PHASE(8, p7_down(F, args));
    if (IN(9)) { REFRESH(); p8_combine(F, args); }
#undef PHASE
#undef REFRESH
#undef IN
#undef SEAM
}
constexpr int N_PHASES = 10;
extern "C" void kernel_launch(void* const* d_in, const int* in_sizes, int n_in, void* d_out, int out_size, void* d_ws, size_t ws_size, hipStream_t stream) {
    static int grid = 0;
    if (grid == 0) {
        if (n_in != 22 || out_size != M * D || ws_size < WS_END) { fprintf(stderr, "kernel_launch: unexpected shapes n_in %d out %d ws %zu\n", n_in, out_size, ws_size); grid = -1; return; }
        int dev = 0, cus = 0, per_cu = 0;
        if (hipGetDevice(&dev) != hipSuccess || hipDeviceGetAttribute(&cus, hipDeviceAttributeMultiprocessorCount, dev) != hipSuccess) { grid = -1; return; }
        if (hipFuncSetAttribute((const void*)mk_fwd, hipFuncAttributeMaxDynamicSharedMemorySize, LDS_BYTES) != hipSuccess) { fprintf(stderr, "kernel_launch: hipFuncSetAttribute failed\n"); grid = -1; return; }
        if (hipOccupancyMaxActiveBlocksPerMultiprocessor(&per_cu, (const void*)mk_fwd, NWAVES * 64, LDS_BYTES) != hipSuccess || per_cu < 1) fprintf(stderr, "kernel_launch: occupancy query says %d per CU\n", per_cu);
        (void)hipGetLastError();
        grid = cus;
        if (grid * 64 < M) { fprintf(stderr, "kernel_launch: %d CUs cannot cover %d rows in the one-block-per-workgroup phases\n", cus, M); grid = -1; return; }
    }
    if (grid < 0) return;
    unsigned char* ws = (unsigned char*)d_ws;
    if (hipMemsetAsync(ws + WS_CTL, 0, CTL_ZERO_BYTES, stream) != hipSuccess) { fprintf(stderr, "kernel_launch: memset failed\n"); return; }
    Args a{};
    for (int i = 0; i < 22; ++i) a.in[i] = (const float*)d_in[i];
    a.out = (float*)d_out; a.ws = ws; a.ph_lo = 0; a.ph_hi = N_PHASES; a.use_bar = 1;
    hipLaunchKernelGGL(mk_fwd, dim3(grid), dim3(NWAVES * 64), LDS_BYTES, stream, a);
}
```

```cpp
#include <hip/hip_runtime.h>
#include <cstdint>
#include <cstdio>

typedef unsigned short bf16_t;
constexpr int D = 1024, BATCH = 4, SEQ = 4096, M = BATCH * SEQ, NH = 8, HD = 64, SBW = 512, PW = 512, INW = 4096;
constexpr int NE = 64, ED = 128, TOPK = 8, SHD = 256;
constexpr float EPS = 1e-6f, RSCALE = 2.5f;

constexpr size_t MiB = 1u << 20;
constexpr size_t WS_CTL = 0, WS_MOD = 1 * MiB, WS_PE = 2 * MiB, WS_PW = 3 * MiB, WS_LIST = 4 * MiB;
constexpr size_t WS_XN = 74 * MiB, WS_OSB = 74 * MiB, WS_MIX = 90 * MiB, WS_H2 = 74 * MiB;
constexpr size_t WS_Q = 106 * MiB, WS_K = 122 * MiB, WS_V = 138 * MiB, WS_MERGED = 106 * MiB;
constexpr size_t WS_SLOT = 190 * MiB, WS_SH = 192 * MiB, WS_HM = 200 * MiB;
constexpr size_t WS_YH = 12 * MiB, WS_YSH = 156 * MiB;
constexpr size_t WS_U = 154 * MiB, WS_GA = 170 * MiB, WS_GB = 202 * MiB, WS_END = 256 * MiB;

__device__ __forceinline__ unsigned f2bf(float f) { unsigned u = __builtin_bit_cast(unsigned, f); return (u + 0x7fffu + ((u >> 16) & 1u)) >> 16; }
__device__ __forceinline__ float bf2f(unsigned h) { return __builtin_bit_cast(float, h << 16); }
__device__ __forceinline__ float wave_sum(float v) {
#pragma unroll
    for (int o = 1; o < 64; o <<= 1) v += __shfl_xor(v, o);
    return v;
}
__device__ __forceinline__ float sigmoidf_(float v) { return 1.f / (1.f + __expf(-v)); }
__device__ __forceinline__ float siluf_(float v) { return v / (1.f + __expf(-v)); }

namespace pg8 {
#define PG8_LAS __attribute__((address_space(3)))
typedef short bf16x8 __attribute__((ext_vector_type(8)));
typedef float f32x4 __attribute__((ext_vector_type(4)));
typedef unsigned u32x4 __attribute__((ext_vector_type(4)));
constexpr int BM = 256, BK = 64, HALF = 128, HTB = HALF * BK * 2  , STAGE_BYTES = 8 * HTB, NXCD = 8, WGM = 8;

__host__ __device__ __forceinline__ int lds_byte(int r, int c) { const int st = (r >> 4) * 2 + (c >> 5), rr = r & 15, cc = c & 31, ob = rr * 64 + cc * 2; return st * 1024 + (ob ^ (((ob >> 9) & 1) << 5)); }
__host__ __device__ __forceinline__ void stage_rc(int b, int& R, int& C) { const int st = b / 1024, sb = b % 1024, swz = sb ^ (((sb >> 9) & 1) << 5); R = (st >> 1) * 16 + swz / 64; C = (st & 1) * 32 + (swz % 64) / 2; }
__host__ __device__ __forceinline__ int perm32(int rho) { const int n = rho >> 4, i = rho & 15; return 8 * (i >> 2) + 4 * n + (i & 3); }

struct Unit { int pm, pn; };
struct Gemm { const bf16_t* A; const bf16_t* Bt; int M, N, K; };

struct StaticOrder {
    int nM, nN, nwg, G, c;
    __host__ __device__ void init(int M_, int N_, int G_, int c_) { nM = M_ / BM; nN = N_ / BM; nwg = nM * nN; G = G_; c = c_; }
    __host__ __device__ bool next(int i, Unit& u) const {
        const long L = (long)i * G + c; if (L >= nwg) return false;
        int wgid = (int)L; { const int q = nwg / NXCD, r = nwg % NXCD, xcd = wgid % NXCD, off = wgid / NXCD; wgid = (xcd < r ? xcd * (q + 1) : r * (q + 1) + (xcd - r) * q) + off; }
        const int nig = WGM * nN, gid = wgid / nig, fm = gid * WGM, gsz = (nM - fm) < WGM ? (nM - fm) : WGM;
        u.pm = fm + ((wgid % nig) % gsz); u.pn = (wgid % nig) / gsz; return true;
    }
    __device__ __forceinline__ void a_ready(const Unit&) const {}
    __device__ __forceinline__ void done(const Unit&) const {}
};
typedef float f32x2_t __attribute__((ext_vector_type(2))); typedef __bf16 bf16x2_t __attribute__((ext_vector_type(2)));
__device__ __forceinline__ unsigned cvt_pk_bf16(float lo, float hi) { f32x2_t v = {lo, hi}; bf16x2_t b = __builtin_convertvector(v, bf16x2_t); return __builtin_bit_cast(unsigned, b); }
__device__ __forceinline__ float fsigmoid(float v) { return __builtin_amdgcn_rcpf(1.f + __builtin_amdgcn_exp2f(-1.4426950408889634f * v)); }
constexpr float QSCALE = 0.125f * 1.4426950408889634f;

struct EpiProj {
    static constexpr bool PERM = true, AFTER_DRAIN = false;
    bf16_t *Q, *K, *V, *U, *GA, *GB; const float* gq; const float* gk;
    __device__ __forceinline__ void operator()(const f32x4 (&acc)[2][2][4][2], const Unit& u, int wr, int wc, int fr, int fq) const {
        const int row0 = u.pm * BM + wr * 64 + fr; const int sec = u.pn;
        if (sec < 4) {
            const bool isq = sec < 2; const float* g = isq ? gq : gk; bf16_t* base = (isq ? Q : K) + ((sec & 1) * 4 + wc) * 64 + 8 * fq;
            const float qs = isq ? QSCALE : 1.f;
            f32x4 gv[2][2];
#pragma unroll
            for (int bj = 0; bj < 2; ++bj)
#pragma unroll
                for (int n = 0; n < 2; ++n) gv[bj][n] = *(const f32x4*)(g + 32 * bj + 8 * fq + 4 * n);
#pragma unroll
            for (int ai = 0; ai < 2; ++ai)
#pragma unroll
                for (int m = 0; m < 4; ++m) {
                    float ss = 0.f;
#pragma unroll
                    for (int bj = 0; bj < 2; ++bj)
#pragma unroll
                        for (int n = 0; n < 2; ++n) { const f32x4 x = acc[ai][bj][m][n]; ss += (x[0] * x[0] + x[1] * x[1]) + (x[2] * x[2] + x[3] * x[3]); }
                    ss += __shfl_xor(ss, 16); ss += __shfl_xor(ss, 32);
                    const float r = rsqrtf(ss * (1.f / 64.f) + EPS) * qs;
                    bf16_t* rowp = base + (size_t)(row0 + ai * HALF + m * 16) * 512;
#pragma unroll
                    for (int bj = 0; bj < 2; ++bj) { const f32x4 v0 = acc[ai][bj][m][0] * gv[bj][0] * r, v1 = acc[ai][bj][m][1] * gv[bj][1] * r;
                        u32x4 w; w.x = cvt_pk_bf16(v0[0], v0[1]); w.y = cvt_pk_bf16(v0[2], v0[3]); w.z = cvt_pk_bf16(v1[0], v1[1]); w.w = cvt_pk_bf16(v1[2], v1[3]);
                        *(u32x4*)(rowp + 32 * bj) = w; }
                }
        } else if (sec < 8) {
            bf16_t* base = (sec < 6 ? V : U) + (sec & 1) * 256 + wc * 32 + 8 * fq;
#pragma unroll
            for (int ai = 0; ai < 2; ++ai)
#pragma unroll
                for (int m = 0; m < 4; ++m) { bf16_t* rowp = base + (size_t)(row0 + ai * HALF + m * 16) * 512;
#pragma unroll
                    for (int bj = 0; bj < 2; ++bj) { const f32x4 v0 = acc[ai][bj][m][0], v1 = acc[ai][bj][m][1];
                        u32x4 w; w.x = cvt_pk_bf16(v0[0], v0[1]); w.y = cvt_pk_bf16(v0[2], v0[3]); w.z = cvt_pk_bf16(v1[0], v1[1]); w.w = cvt_pk_bf16(v1[2], v1[3]);
                        *(u32x4*)(rowp + bj * HALF) = w; } }
        } else {
            bf16_t* base = (sec < 12 ? GA : GB) + ((sec - 8) & 3) * 256 + wc * 32 + 8 * fq;
#pragma unroll
            for (int ai = 0; ai < 2; ++ai)
#pragma unroll
                for (int m = 0; m < 4; ++m) { bf16_t* rowp = base + (size_t)(row0 + ai * HALF + m * 16) * 1024;
#pragma unroll
                    for (int bj = 0; bj < 2; ++bj) { const f32x4 v0 = acc[ai][bj][m][0], v1 = acc[ai][bj][m][1];
                        u32x4 w; w.x = cvt_pk_bf16(fsigmoid(v0[0]), fsigmoid(v0[1])); w.y = cvt_pk_bf16(fsigmoid(v0[2]), fsigmoid(v0[3])); w.z = cvt_pk_bf16(fsigmoid(v1[0]), fsigmoid(v1[1])); w.w = cvt_pk_bf16(fsigmoid(v1[2]), fsigmoid(v1[3]));
                        *(u32x4*)(rowp + bj * HALF) = w; } }
        }
    }
};

struct EpiMerge {
    static constexpr bool PERM = true, AFTER_DRAIN = false;
    const bf16_t* G; bf16_t* MG; int add;
    __device__ __forceinline__ void operator()(const f32x4 (&acc)[2][2][4][2], const Unit& u, int wr, int wc, int fr, int fq) const {
        const int row0 = u.pm * BM + wr * 64 + fr, col0 = u.pn * BM + wc * 32 + 8 * fq;
#pragma unroll
        for (int ai = 0; ai < 2; ++ai)
#pragma unroll
            for (int m = 0; m < 4; ++m) { const size_t off = (size_t)(row0 + ai * HALF + m * 16) * 1024 + col0;
#pragma unroll
                for (int bj = 0; bj < 2; ++bj) { const u32x4 g = *(const u32x4*)(G + off + bj * HALF); const f32x4 a0 = acc[ai][bj][m][0], a1 = acc[ai][bj][m][1];
                    float v[8] = {bf2f(g.x & 0xffffu) * a0[0], bf2f(g.x >> 16) * a0[1], bf2f(g.y & 0xffffu) * a0[2], bf2f(g.y >> 16) * a0[3], bf2f(g.z & 0xffffu) * a1[0], bf2f(g.z >> 16) * a1[1], bf2f(g.w & 0xffffu) * a1[2], bf2f(g.w >> 16) * a1[3]};
                    if (add) { const u32x4 o = *(const u32x4*)(MG + off + bj * HALF);
                        v[0] += bf2f(o.x & 0xffffu); v[1] += bf2f(o.x >> 16); v[2] += bf2f(o.y & 0xffffu); v[3] += bf2f(o.y >> 16); v[4] += bf2f(o.z & 0xffffu); v[5] += bf2f(o.z >> 16); v[6] += bf2f(o.w & 0xffffu); v[7] += bf2f(o.w >> 16); }
                    u32x4 w; w.x = cvt_pk_bf16(v[0], v[1]); w.y = cvt_pk_bf16(v[2], v[3]); w.z = cvt_pk_bf16(v[4], v[5]); w.w = cvt_pk_bf16(v[6], v[7]);
                    *(u32x4*)(MG + off + bj * HALF) = w; } }
    }
};
struct EpiX1 {
    static constexpr bool PERM = false, AFTER_DRAIN = false;
    const float* x; const float* gate; float* X1;
    __device__ __forceinline__ void operator()(const f32x4 (&acc)[2][2][4][2], const Unit& u, int wr, int wc, int fr, int fq) const {
        const int row0 = u.pm * BM + wr * 64 + fr, col0 = u.pn * BM + wc * 32 + 4 * fq; const int b = (u.pm * BM) / SEQ;
        f32x4 gv[2][2];
#pragma unroll
        for (int bj = 0; bj < 2; ++bj)
#pragma unroll
            for (int n = 0; n < 2; ++n) gv[bj][n] = *(const f32x4*)(gate + (size_t)b * 6 * D + col0 + bj * HALF + n * 16);
#pragma unroll
        for (int ai = 0; ai < 2; ++ai)
#pragma unroll
            for (int m = 0; m < 4; ++m) { const size_t off = (size_t)(row0 + ai * HALF + m * 16) * D + col0;
#pragma unroll
                for (int bj = 0; bj < 2; ++bj)
#pragma unroll
                    for (int n = 0; n < 2; ++n) *(f32x4*)(X1 + off + bj * HALF + n * 16) = *(const f32x4*)(x + off + bj * HALF + n * 16) + gv[bj][n] * acc[ai][bj][m][n]; }
    }
};

template <class Epi, class Sched, bool ALIGN_EPI = false, bool SP2 = false>
__device__ __forceinline__ void gemm_phase(PG8_LAS unsigned char* lds, const Gemm g, const Sched& S, const Epi& E) {
    int tid_ = threadIdx.x; asm volatile("" : "+v"(tid_));
    const int tid = tid_, wid = __builtin_amdgcn_readfirstlane(tid >> 6), lane = tid & 63, wr = wid >> 2, wc = wid & 3, fr = lane & 15, fq = lane >> 4;
    const int K = g.K, nt = K / BK;
    unsigned voffA[2], voffB[2];
#pragma unroll
    for (int i = 0; i < 2; ++i) { int R, C; stage_rc(tid * 16 + i * 8192, R, C); const int Rb = Epi::PERM ? ((R & ~31) + perm32(R & 31)) : R;
        voffA[i] = (unsigned)(R * K + C) * 2u; voffB[i] = (unsigned)(Rb * K + C) * 2u; }
    const size_t kstep = (size_t)(BK * 2);
    const size_t hstep = (size_t)HALF * K * 2;
    const size_t tstep = 2 * hstep;
    const unsigned ldsw = (unsigned)wid * 1024u;
    const int aoff = lds_byte(wr * 64 + fr, fq * 8), boff = lds_byte(wc * 32 + fr, fq * 8);
#define PG8_SA(b, h) (((b) * 2 + (h)) * HTB)
#define PG8_SB(b, h) ((4 + (b) * 2 + (h)) * HTB)
#define PG8_STAGE(bufoff, gbase, voff) do { _Pragma("unroll") for (int _i = 0; _i < 2; ++_i) \
        __builtin_amdgcn_global_load_lds((const unsigned*)((const char*)(gbase) + (voff)[_i]), (PG8_LAS unsigned*)(lds + (bufoff) + ldsw + _i * 8192), 16, 0, 0); } while (0)
#define PG8_LDA(dst, b, h) do { _Pragma("unroll") for (int m = 0; m < 4; ++m) _Pragma("unroll") for (int k = 0; k < 2; ++k) dst[m][k] = *(const PG8_LAS bf16x8*)(lds + PG8_SA(b, h) + aoff + m * 2048 + k * 1024); } while (0)
#define PG8_LDB(dst, b, h) do { _Pragma("unroll") for (int n = 0; n < 2; ++n) _Pragma("unroll") for (int k = 0; k < 2; ++k) dst[n][k] = *(const PG8_LAS bf16x8*)(lds + PG8_SB(b, h) + boff + n * 2048 + k * 1024); } while (0)
#define PG8_MMA(ai, bj, At, Bt) do { __builtin_amdgcn_s_setprio(1); _Pragma("unroll") for (int m = 0; m < 4; ++m) _Pragma("unroll") for (int n = 0; n < 2; ++n) _Pragma("unroll") for (int k = 0; k < 2; ++k) \
        acc[ai][bj][m][n] = __builtin_amdgcn_mfma_f32_16x16x32_bf16(Bt[n][k], At[m][k], acc[ai][bj][m][n], 0, 0, 0); __builtin_amdgcn_s_setprio(0); } while (0)
#define PG8_WAIT_V(n) asm volatile("s_waitcnt vmcnt(" #n ")" ::: "memory")
#define PG8_WAIT_L(n) asm volatile("s_waitcnt lgkmcnt(" #n ")" ::: "memory")
#define PG8_BAR __builtin_amdgcn_s_barrier()
#define PG8_SCHED __builtin_amdgcn_sched_barrier(0)
    Unit cur, nxt; int ui = 0;
    if (!S.next(0, cur)) return;
    f32x4 acc[2][2][4][2];
#pragma unroll
    for (int a = 0; a < 2; ++a)
#pragma unroll
        for (int b = 0; b < 2; ++b)
#pragma unroll
            for (int m = 0; m < 4; ++m)
#pragma unroll
                for (int n = 0; n < 2; ++n) acc[a][b][m][n] = (f32x4){0.f, 0.f, 0.f, 0.f};
    bf16x8 At[4][2], B0[2][2], B1[2][2];
    const char* cA = (const char*)g.A + (size_t)cur.pm * tstep; const char* cB = (const char*)g.Bt + (size_t)cur.pn * tstep;
    S.a_ready(cur);
    if constexpr (SP2) {
        PG8_STAGE(PG8_SB(0, 0), cB, voffB); PG8_STAGE(PG8_SB(0, 1), cB + hstep, voffB); PG8_STAGE(PG8_SA(0, 0), cA, voffA); PG8_STAGE(PG8_SA(0, 1), cA + hstep, voffA);
        if (wr == 1) PG8_BAR;
        PG8_WAIT_V(2); PG8_BAR;
        PG8_STAGE(PG8_SB(1, 0), cB + kstep, voffB); PG8_STAGE(PG8_SA(1, 0), cA + kstep, voffA); PG8_STAGE(PG8_SB(1, 1), cB + hstep + kstep, voffB);
        PG8_WAIT_V(6); PG8_BAR;
    } else {
        PG8_STAGE(PG8_SB(0, 0), cB, voffB); PG8_STAGE(PG8_SA(0, 0), cA, voffA); PG8_STAGE(PG8_SB(0, 1), cB + hstep, voffB); PG8_STAGE(PG8_SA(0, 1), cA + hstep, voffA);
        if (wr == 1) PG8_BAR;
        PG8_WAIT_V(4); PG8_BAR;
        PG8_STAGE(PG8_SB(1, 0), cB + kstep, voffB); PG8_STAGE(PG8_SA(1, 0), cA + kstep, voffA); PG8_STAGE(PG8_SB(1, 1), cB + hstep + kstep, voffB);
        PG8_WAIT_V(6); PG8_BAR;
    }
    for (;;) {
        const bool has_next = S.next(ui + 1, nxt);
        const char* nA = has_next ? (const char*)g.A + (size_t)nxt.pm * tstep : cA; const char* nB = has_next ? (const char*)g.Bt + (size_t)nxt.pn * tstep : cB;
#pragma nounroll
        for (int t = 0; t < nt; t += 2) {
            const bool last = (t == nt - 2);
            const char* a1 = cA + (size_t)(t + 1) * kstep;
            const char* a2 = last ? nA : cA + (size_t)(t + 2) * kstep; const char* b2 = last ? nB : cB + (size_t)(t + 2) * kstep;
            const char* a3 = a2 + kstep; const char* b3 = b2 + kstep;
            if (last && has_next) S.a_ready(nxt);
            if constexpr (SP2) {
            PG8_LDB(B0, 0, 0); PG8_LDB(B1, 0, 1); PG8_SCHED; PG8_LDA(At, 0, 0); PG8_STAGE(PG8_SA(1, 1), a1 + hstep, voffA);
            PG8_WAIT_V(8); PG8_WAIT_L(0); PG8_BAR; PG8_MMA(0, 0, At, B0); PG8_MMA(0, 1, At, B1); PG8_BAR; PG8_SCHED;
            PG8_LDA(At, 0, 1); PG8_STAGE(PG8_SB(0, 0), b2, voffB); PG8_STAGE(PG8_SB(0, 1), b2 + hstep, voffB); PG8_STAGE(PG8_SA(0, 0), a2, voffA);
            PG8_WAIT_V(8); PG8_WAIT_L(0); PG8_BAR; PG8_MMA(1, 0, At, B0); PG8_MMA(1, 1, At, B1); PG8_BAR; PG8_SCHED;
            PG8_LDB(B0, 1, 0); PG8_LDB(B1, 1, 1); PG8_SCHED; PG8_LDA(At, 1, 0); PG8_STAGE(PG8_SA(0, 1), a2 + hstep, voffA);
            PG8_WAIT_V(8); PG8_WAIT_L(0); PG8_BAR; PG8_MMA(0, 0, At, B0); PG8_MMA(0, 1, At, B1); PG8_BAR; PG8_SCHED;
            PG8_LDA(At, 1, 1); PG8_STAGE(PG8_SB(1, 0), b3, voffB); PG8_STAGE(PG8_SB(1, 1), b3 + hstep, voffB); PG8_STAGE(PG8_SA(1, 0), a3, voffA);
            PG8_WAIT_V(8); PG8_WAIT_L(0); PG8_BAR; PG8_MMA(1, 0, At, B0); PG8_MMA(1, 1, At, B1); PG8_BAR; PG8_SCHED;
            } else {
            PG8_LDB(B0, 0, 0); PG8_SCHED; PG8_LDA(At, 0, 0); PG8_STAGE(PG8_SA(1, 1), a1 + hstep, voffA);
            PG8_WAIT_L(8); PG8_BAR; PG8_WAIT_L(0); PG8_MMA(0, 0, At, B0); PG8_BAR; PG8_SCHED;
            PG8_LDB(B1, 0, 1); PG8_STAGE(PG8_SB(0, 0), b2, voffB);
            PG8_BAR; PG8_WAIT_L(0); PG8_MMA(0, 1, At, B1); PG8_BAR;
            PG8_LDA(At, 0, 1); PG8_STAGE(PG8_SA(0, 0), a2, voffA);
            PG8_BAR; PG8_WAIT_L(0); PG8_MMA(1, 0, At, B0); PG8_BAR; PG8_SCHED;
            PG8_STAGE(PG8_SB(0, 1), b2 + hstep, voffB);
            PG8_WAIT_V(6); PG8_BAR; PG8_MMA(1, 1, At, B1); PG8_BAR;
            PG8_LDB(B0, 1, 0); PG8_SCHED; PG8_LDA(At, 1, 0); PG8_STAGE(PG8_SA(0, 1), a2 + hstep, voffA);
            PG8_WAIT_L(8); PG8_BAR; PG8_WAIT_L(0); PG8_MMA(0, 0, At, B0); PG8_BAR; PG8_SCHED;
            PG8_LDB(B1, 1, 1); PG8_STAGE(PG8_SB(1, 0), b3, voffB);
            PG8_BAR; PG8_WAIT_L(0); PG8_MMA(0, 1, At, B1); PG8_BAR;
            PG8_LDA(At, 1, 1); PG8_STAGE(PG8_SA(1, 0), a3, voffA);
            PG8_BAR; PG8_WAIT_L(0); PG8_MMA(1, 0, At, B0); PG8_BAR; PG8_SCHED;
            PG8_STAGE(PG8_SB(1, 1), b3 + hstep, voffB);
            PG8_WAIT_V(6); PG8_BAR; PG8_MMA(1, 1, At, B1); PG8_BAR;
            }
        }
        if constexpr (ALIGN_EPI) { if (wr == 0) PG8_BAR; }
        if constexpr (!Epi::AFTER_DRAIN) { E(acc, cur, wr, wc, fr, fq); S.done(cur); }
        if (!has_next) break;
#pragma unroll
        for (int a = 0; a < 2; ++a)
#pragma unroll
            for (int b = 0; b < 2; ++b)
#pragma unroll
                for (int m = 0; m < 4; ++m)
#pragma unroll
                    for (int n = 0; n < 2; ++n) acc[a][b][m][n] = (f32x4){0.f, 0.f, 0.f, 0.f};
        cur = nxt; cA = nA; cB = nB; ++ui;
        if constexpr (ALIGN_EPI) { if (wr == 1) PG8_BAR; }
    }
    PG8_WAIT_V(0);
    if constexpr (!ALIGN_EPI) { if (wr == 0) PG8_BAR; }
    PG8_BAR;
    if constexpr (Epi::AFTER_DRAIN) { E.fused(acc, cur, wr, wc, fr, fq, lds, wid, lane); S.done(cur); }
#undef PG8_SA
#undef PG8_SB
#undef PG8_STAGE
#undef PG8_LDA
#undef PG8_LDB
#undef PG8_MMA
#undef PG8_WAIT_V
#undef PG8_WAIT_L
#undef PG8_BAR
#undef PG8_SCHED
}
}
using pg8::f32x4; using pg8::bf16x8;
#define GAS __attribute__((address_space(1)))
#define LAS __attribute__((address_space(3)))
typedef unsigned v4u __attribute__((ext_vector_type(4)));
typedef GAS unsigned gu32;
typedef GAS unsigned long long gu64;
#define RLX_AGENT __ATOMIC_RELAXED, __HIP_MEMORY_SCOPE_AGENT
#define LDS_WAIT() asm volatile("s_waitcnt lgkmcnt(0)" ::: "memory")
#define VM_WAIT() asm volatile("s_waitcnt vmcnt(0)" ::: "memory")
__device__ __forceinline__ unsigned long long rt() { return __builtin_amdgcn_s_memrealtime(); }
__device__ __forceinline__ unsigned pk2(float lo, float hi) { return pg8::cvt_pk_bf16(lo, hi); }

#define XB_TMO      128
#define XB_XCNT(j)  (256  + 64 * (j))
#define XB_XSUB(j)  (1280 + 64 * (j))
#define XB_XGEN(j)  (2304 + 64 * (j))
#define XB_TOP      3328
#define XB_TOPGEN   3392
#define XCD_BAR_WORDS 3456
#define XB_SPIN_CAP (1u << 18)

__device__ __forceinline__ unsigned xb_ld(unsigned* p)              { return __hip_atomic_load(p, __ATOMIC_RELAXED, __HIP_MEMORY_SCOPE_AGENT); }
__device__ __forceinline__ unsigned xb_add(unsigned* p, unsigned v) { return __hip_atomic_fetch_add(p, v, __ATOMIC_RELAXED, __HIP_MEMORY_SCOPE_AGENT); }
__device__ __forceinline__ unsigned xb_xcc_id() { return (unsigned)__builtin_amdgcn_s_getreg((3 << 11) | 20) & 0xFu; }
#define XB_SPIN(cond, bar) do { unsigned _sp = 0; while (cond) { __builtin_amdgcn_s_sleep(1); \
    if ((++_sp & 255u) == 0u) { if (xb_ld(&(bar)[XB_TMO])) break; if (_sp > XB_SPIN_CAP) { atomicAdd(&(bar)[XB_TMO], 1u); break; } } } } while (0)

struct XcdBarrier {
    unsigned* bar; unsigned x;
    volatile LAS unsigned* st;
};

__device__ __forceinline__ XcdBarrier xcd_barrier_post(unsigned* bar, volatile LAS unsigned* st) {
    XcdBarrier b; b.bar = bar; b.x = xb_xcc_id(); b.st = st;
    if (threadIdx.x == 0) (void)xb_add(&bar[XB_XCNT(b.x)], 1u);
    return b;
}
__device__ __forceinline__ void xcd_barrier_complete(unsigned* bar, unsigned x, unsigned& nloc, unsigned& nx) {
    const unsigned G = gridDim.x * gridDim.y * gridDim.z;
    unsigned sum, cnt, mine, sp = 0u;
    for (;;) {
        sum = 0u; cnt = 0u; mine = 0u;
#pragma unroll
        for (unsigned j = 0; j < 16; ++j) { const unsigned c = xb_ld(&bar[XB_XCNT(j)]); sum += c; cnt += (c > 0u) ? 1u : 0u; mine = (j == x) ? c : mine; }
        if (sum == G) break;
        __builtin_amdgcn_s_sleep(1);
        if ((++sp & 255u) == 0u) { if (xb_ld(&bar[XB_TMO])) break; if (sp > XB_SPIN_CAP) { atomicAdd(&bar[XB_TMO], 1u); break; } }
    }
    nloc = mine > 0u ? mine : 1u; nx = cnt > 0u ? cnt : 1u;
}

__device__ __forceinline__ void xcd_barrier(const XcdBarrier& b) {
    asm volatile("s_waitcnt vmcnt(0)" ::: "memory");
    __syncthreads();
    if (threadIdx.x == 0) {
        unsigned* bar = b.bar;
        __builtin_amdgcn_s_waitcnt(0);
        unsigned nloc = b.st[0], nx = b.st[1];
        if (nloc == 0u) { xcd_barrier_complete(bar, b.x, nloc, nx); b.st[0] = nloc; b.st[1] = nx; }
        const unsigned old = xb_add(&bar[XB_XSUB(b.x)], 1u);
        const unsigned gen = old / nloc;
        if (old + 1u == (gen + 1u) * nloc) {
            __builtin_amdgcn_fence(__ATOMIC_RELEASE, "agent");
            asm volatile("s_waitcnt vmcnt(0)" ::: "memory");
            const unsigned og = xb_add(&bar[XB_TOP], 1u);
            const unsigned tg = og / nx;
            if (og + 1u == (tg + 1u) * nx) xb_add(&bar[XB_TOPGEN], 1u);
            else XB_SPIN(xb_ld(&bar[XB_TOPGEN]) == tg, bar);
            __builtin_amdgcn_fence(__ATOMIC_ACQUIRE, "agent");
            xb_add(&bar[XB_XGEN(b.x)], 1u);
            asm volatile("s_waitcnt vmcnt(0)" ::: "memory");
        } else {
            XB_SPIN(xb_ld(&bar[XB_XGEN(b.x)]) == gen, bar);
            __builtin_amdgcn_fence(__ATOMIC_ACQUIRE, "agent");
            asm volatile("s_waitcnt vmcnt(0)" ::: "memory");
        }
    }
    __syncthreads();
}

constexpr int NWAVES = 8;
#ifndef DBL_PHASE
#define DBL_PHASE -1
#endif
constexpr size_t WS_MODP = 1 * MiB + 128 * 1024;
constexpr size_t WS_WIN = 12 * MiB, WS_WSB = 20 * MiB, WS_WEFF = 21 * MiB, WS_WOUT = 22 * MiB, WS_WGU = 24 * MiB;
constexpr size_t WS_WSHGU = 237 * MiB, WS_WD = 238 * MiB, WS_WSHD = 254 * MiB, WS_WRH = 254 * MiB + 512 * 1024, WS_WRL = WS_WRH + 128 * 1024;
constexpr size_t CTL_ZERO_BYTES = 256 * 1024;
constexpr int CW_TMO = 0, CW_CODE = 1, CW_BAR = 4096, CW_CNT = 16384;
constexpr int RING_OFF = 0, RING_BYTES = 131072, AUX_OFF = RING_BYTES, LDS_BYTES = 163840, LDSCTL_OFF = LDS_BYTES - 1024, MISC_OFF = LDSCTL_OFF + 320;

struct Frame {
    LAS unsigned char* lds; volatile LAS unsigned* MISC; gu32* ctl;
    int tid, lane, wave, vcu, G;
};
struct Args { const float* in[22]; float* out; unsigned char* ws; int ph_lo, ph_hi, use_bar, pad; };

constexpr float W8SCALE = 512.f, H8SCALE = 16.f;
struct TItem { const float* W; bf16_t* dst; int ldw, ldk, k0, n0, perm, f8; };
__device__ __forceinline__ void titem_load(const TItem& t, f32x4 (&v)[8], int lane) {
    const int kr = lane >> 3, n4 = (lane & 7) * 4;
#pragma unroll
    for (int i = 0; i < 8; ++i) v[i] = *(const GAS f32x4*)(t.W + (size_t)(t.k0 + kr + 8 * i) * t.ldw + t.n0 + n4);
}
__device__ __forceinline__ void titem_store(const TItem& t, const f32x4 (&v)[8], LAS float* scr, int lane) {
    { const int kr = lane >> 3, n4 = (lane & 7) * 4;
#pragma unroll
      for (int i = 0; i < 8; ++i) { LAS float* d = scr + (kr + 8 * i) * 33 + n4; d[0] = v[i].x; d[1] = v[i].y; d[2] = v[i].z; d[3] = v[i].w; } }
    LDS_WAIT(); asm volatile("" ::: "memory");
    const int c = lane & 7;
#pragma unroll
    for (int j = 0; j < 4; ++j) { const int n = (lane >> 3) + 8 * j, drow = t.perm ? 128 * (j & 1) + 8 * (j >> 1) + (lane >> 3) : n; const LAS float* sp = scr + (8 * c) * 33 + n;
        if (t.f8) {
            unsigned lo = 0u, hi = 0u;
            lo = __builtin_amdgcn_cvt_pk_fp8_f32(sp[0 * 33] * W8SCALE, sp[1 * 33] * W8SCALE, lo, false); lo = __builtin_amdgcn_cvt_pk_fp8_f32(sp[2 * 33] * W8SCALE, sp[3 * 33] * W8SCALE, lo, true);
            hi = __builtin_amdgcn_cvt_pk_fp8_f32(sp[4 * 33] * W8SCALE, sp[5 * 33] * W8SCALE, hi, false); hi = __builtin_amdgcn_cvt_pk_fp8_f32(sp[6 * 33] * W8SCALE, sp[7 * 33] * W8SCALE, hi, true);
            *(GAS unsigned long long*)((GAS unsigned char*)t.dst + (size_t)drow * t.ldk + t.k0 + 8 * c) = (unsigned long long)lo | ((unsigned long long)hi << 32);
        } else {
        v4u o; o.x = pk2(sp[0 * 33], sp[1 * 33]); o.y = pk2(sp[2 * 33], sp[3 * 33]); o.z = pk2(sp[4 * 33], sp[5 * 33]); o.w = pk2(sp[6 * 33], sp[7 * 33]);
        *(GAS v4u*)(t.dst + (size_t)drow * t.ldk + t.k0 + 8 * c) = o; } }
    LDS_WAIT(); asm volatile("" ::: "memory");
}
__device__ __forceinline__ TItem titem_decode(int it, const Args& a, bool late) {
    unsigned char* ws = a.ws; TItem t; t.perm = 0; t.f8 = 0;
    constexpr int I_IN = 16 * 128, I_SB = 8 * 32, I_OUT = 16 * 32, I_EG = 64 * 64, I_EU = 64 * 64, I_ED = 64 * 64, I_SG = 16 * 8, I_SU = 16 * 8;
    int r = it;
    if (late) {
        if (r < I_ED) { const int e = r >> 6, q = r & 63, kb = q >> 5, nb = q & 31; t.W = a.in[18] + (size_t)e * ED * D; t.ldw = D; t.k0 = kb * 64; t.n0 = nb * 32;
            const int n0 = nb * 32, cl = n0 & 255; t.perm = 1; t.dst = (bf16_t*)(ws + WS_WD) + ((size_t)e * D + (n0 & ~255) + 32 * (cl >> 6) + 16 * ((cl >> 5) & 1)) * ED; t.ldk = ED; return t; } r -= I_ED;
        { const int kb = r >> 5, nb = r & 31; t.W = a.in[21]; t.ldw = D; t.k0 = kb * 64; t.n0 = nb * 32; t.dst = (bf16_t*)(ws + WS_WSHD) + (size_t)(nb * 32) * SHD; t.ldk = SHD; return t; } }
    if (r < I_IN) { const int kb = r >> 7, nb = r & 127, n0 = nb * 32; int d0 = n0;
        if (n0 < 1024) d0 = (n0 & ~255) + 128 * ((n0 >> 5) & 1) + 32 * ((n0 >> 6) & 3);
        t.W = a.in[5]; t.ldw = INW; t.k0 = kb * 64; t.n0 = n0; t.dst = (bf16_t*)(ws + WS_WIN) + (size_t)d0 * D; t.ldk = D; return t; } r -= I_IN;
    if (r < I_SB) { const int kb = r >> 5, nb = r & 31; t.W = a.in[8]; t.ldw = D; t.k0 = kb * 64; t.n0 = nb * 32; t.dst = (bf16_t*)(ws + WS_WSB) + (size_t)(nb * 32) * SBW; t.ldk = SBW; return t; } r -= I_SB;
    if (r < I_OUT) { const int kb = r >> 5, nb = r & 31; t.W = a.in[12]; t.ldw = D; t.k0 = kb * 64; t.n0 = nb * 32; t.dst = (bf16_t*)(ws + WS_WOUT) + (size_t)(nb * 32) * D; t.ldk = D; return t; } r -= I_OUT;
    if (r < I_EG) { const int e = r >> 6, q = r & 63, kb = q >> 2, nb = q & 3; t.W = a.in[16] + (size_t)e * D * ED; t.ldw = ED; t.k0 = kb * 64; t.n0 = nb * 32; t.f8 = 1; t.dst = (bf16_t*)(ws + WS_WGU + ((size_t)e * 256 + nb * 32) * D); t.ldk = D; return t; } r -= I_EG;
    if (r < I_EU) { const int e = r >> 6, q = r & 63, kb = q >> 2, nb = q & 3; t.W = a.in[17] + (size_t)e * D * ED; t.ldw = ED; t.k0 = kb * 64; t.n0 = nb * 32; t.f8 = 1; t.dst = (bf16_t*)(ws + WS_WGU + ((size_t)e * 256 + 128 + nb * 32) * D); t.ldk = D; return t; } r -= I_EU;
    if (r < I_SG) { const int kb = r >> 3, nb = r & 7, n0 = nb * 32; t.W = a.in[19]; t.ldw = SHD; t.k0 = kb * 64; t.n0 = n0; t.f8 = 1; t.dst = (bf16_t*)(ws + WS_WSHGU + (size_t)((n0 >> 7) * 256 + (n0 & 127)) * D); t.ldk = D; return t; } r -= I_SG;
    { const int kb = r >> 3, nb = r & 7, n0 = nb * 32; t.W = a.in[20]; t.ldw = SHD; t.k0 = kb * 64; t.n0 = n0; t.f8 = 1; t.dst = (bf16_t*)(ws + WS_WSHGU + (size_t)((n0 >> 7) * 256 + 128 + (n0 & 127)) * D); t.ldk = D; return t; }
}

__device__ __forceinline__ void titem_run(Frame& F, const Args& a, bool late, int nitems, int first, int stride) {
    LAS float* scr = (LAS float*)(F.lds + RING_OFF + F.wave * 16384); const int lane = F.lane;
    f32x4 va[8], vb[8]; TItem cur, nxt; int it = first;
    if (it < nitems) { cur = titem_decode(it, a, late); titem_load(cur, va, lane); }
    for (; it < nitems; it += 2 * stride) {
        const bool h1 = it + stride < nitems, h2 = it + 2 * stride < nitems;
        if (h1) { nxt = titem_decode(it + stride, a, late); titem_load(nxt, vb, lane); }
        titem_store(cur, va, scr, lane);
        if (h2) { cur = titem_decode(it + 2 * stride, a, late); titem_load(cur, va, lane); }
        if (h1) titem_store(nxt, vb, scr, lane);
    }
}

__device__ __forceinline__ void p0a(Frame& F, const Args& a) {
    unsigned char* ws = a.ws;
    const int gw = F.vcu * NWAVES + F.wave, NGW = F.G * NWAVES, lane = F.lane;
    LAS float* silu = (LAS float*)(F.lds + RING_OFF + 98304);
    { const float* c = a.in[1]; for (int i = F.tid; i < 4 * D; i += NWAVES * 64) silu[i] = siluf_(c[i]); }
    if (F.G == 256) { const float* wg = a.in[9]; const float* ps = a.in[10]; const float* wpo = a.in[11]; bf16_t* WE = (bf16_t*)(ws + WS_WEFF);
        const int g = F.vcu >> 6, nb = (F.vcu & 63) * 16;
        LAS float* wgt = (LAS float*)(F.lds + RING_OFF);
        LAS float* slab = (LAS float*)(F.lds + RING_OFF + 68 * 1024);
        for (int i = F.tid; i < 128 * 128; i += NWAVES * 64) { const int cc = i >> 7, d = i & 127; wgt[d * 129 + cc] = wg[(size_t)g * 16384 + i]; }
        { const int d = F.tid >> 2, q = (F.tid & 3) * 4; const f32x4 w4 = *(const GAS f32x4*)(wpo + (size_t)(g * 128 + d) * D + nb + q) * ps[g * 128 + d]; *(LAS f32x4*)(slab + d * 16 + q) = w4; }
        __syncthreads();
        const int cc = F.tid & 127, nq = (F.tid >> 7) * 4; f32x4 acc4 = {0.f, 0.f, 0.f, 0.f};
#pragma unroll 8
        for (int d = 0; d < 128; ++d) acc4 += wgt[d * 129 + cc] * *(const LAS f32x4*)(slab + d * 16 + nq);
#pragma unroll
        for (int j = 0; j < 4; ++j) WE[(size_t)(nb + nq + j) * PW + g * 128 + cc] = (bf16_t)f2bf(acc4[j]);
    }
    __syncthreads();
    { const float* w_ada = a.in[2]; float* MODP = (float*)(ws + WS_MODP); LAS float* red = (LAS float*)(F.lds + RING_OFF);
      for (int it = F.vcu; it < 96 * 8; it += F.G) { const int cg = it % 96, ks = it / 96, k0 = ks * 128 + F.wave * 16;
          const float* w = w_ada + (size_t)k0 * (6 * D) + cg * 64 + lane;
          float wv[16];
#pragma unroll
          for (int k = 0; k < 16; ++k) wv[k] = w[(size_t)k * (6 * D)];
          float a0 = 0.f, a1 = 0.f, a2 = 0.f, a3 = 0.f;
#pragma unroll
          for (int k = 0; k < 16; ++k) { const int kk = k0 + k; a0 += silu[kk] * wv[k]; a1 += silu[D + kk] * wv[k]; a2 += silu[2 * D + kk] * wv[k]; a3 += silu[3 * D + kk] * wv[k]; }
          LAS float* rw = red + F.wave * 256 + lane; rw[0] = a0; rw[64] = a1; rw[128] = a2; rw[192] = a3;
          __syncthreads();
          if (F.tid < 256) { float v = 0.f;
#pragma unroll
              for (int w8 = 0; w8 < 8; ++w8) v += red[w8 * 256 + F.tid];
              MODP[(size_t)(ks * 4 + (F.tid >> 6)) * 6 * D + cg * 64 + (F.tid & 63)] = v; }
          __syncthreads(); } }
    __syncthreads();
    titem_run(F, a, false, 16 * 128 + 8 * 32 + 16 * 32 + 2 * 64 * 64 + 2 * 16 * 8, gw, NGW);
    { const float* wr = a.in[14]; bf16_t* WH = (bf16_t*)(ws + WS_WRH); bf16_t* WL = (bf16_t*)(ws + WS_WRL);
      for (int i = (F.vcu * NWAVES * 64 + F.tid); i < D * NE; i += F.G * NWAVES * 64) { const int e = i >> 10, k = i & 1023; const float v = wr[k * NE + e];
          const int pos = ((((k >> 4) * 2 + (e >> 5)) * 64) + 32 * ((k >> 3) & 1) + (e & 31)) * 8 + (k & 7);
          const unsigned h = f2bf(v); WH[pos] = (bf16_t)h; WL[pos] = (bf16_t)f2bf(v - bf2f(h)); } }
}
__device__ __forceinline__ void p0b(Frame& F, const Args& a) {
    unsigned char* ws = a.ws; const float* MODP = (const float*)(ws + WS_MODP); const float* b_ada = a.in[3];
    if (F.tid < 96) { const int idx = 96 * F.vcu + F.tid, b = idx / (6 * D), j = idx % (6 * D); float v = b_ada[j];
#pragma unroll
        for (int ks = 0; ks < 8; ++ks) v += MODP[(size_t)(ks * 4 + b) * 6 * D + j];
        ((float*)(ws + WS_MOD))[idx] = v; }
    const int rows_per = M / F.G, r0 = F.vcu * rows_per, b = r0 / SEQ;
    LAS float* gsv = (LAS float*)(F.lds + RING_OFF); LAS float* shv = gsv + D;
    for (int k = F.tid; k < D; k += NWAVES * 64) { float sh = b_ada[k], sc = b_ada[D + k];
#pragma unroll
        for (int ks = 0; ks < 8; ++ks) { sh += MODP[(size_t)(ks * 4 + b) * 6 * D + k]; sc += MODP[(size_t)(ks * 4 + b) * 6 * D + D + k]; }
        gsv[k] = a.in[4][k] * (1.f + sc); shv[k] = sh; }
    __syncthreads();
    const float* x = a.in[0]; bf16_t* XN = (bf16_t*)(ws + WS_XN);
    for (int i = F.wave; i < rows_per; i += NWAVES) { const int row = r0 + i;
        const GAS f32x4* xr = (const GAS f32x4*)(x + (size_t)row * D) + F.lane;
        f32x4 v[4]; float s = 0.f;
#pragma unroll
        for (int j = 0; j < 4; ++j) { v[j] = xr[64 * j]; s += (v[j].x * v[j].x + v[j].y * v[j].y) + (v[j].z * v[j].z + v[j].w * v[j].w); }
        const float r = rsqrtf(wave_sum(s) * (1.f / D) + EPS);
        GAS unsigned long long* o8 = (GAS unsigned long long*)(XN + (size_t)row * D) + F.lane;
#pragma unroll
        for (int j = 0; j < 4; ++j) { const f32x4 gg = *(const LAS f32x4*)(gsv + 4 * F.lane + 256 * j), ss = *(const LAS f32x4*)(shv + 4 * F.lane + 256 * j);
            const f32x4 h = v[j] * r * gg + ss;
            o8[64 * j] = (unsigned long long)pk2(h.x, h.y) | ((unsigned long long)pk2(h.z, h.w) << 32); } }
    __syncthreads();
}

namespace sb {
using pg8::bf16x8; using pg8::f32x4; typedef float f32x16 __attribute__((ext_vector_type(16))); typedef short v4i16_t __attribute__((ext_vector_type(4)));
typedef short s16x4 __attribute__((ext_vector_type(4)));
constexpr int VPITCH = 128, VBYTES = 64 * VPITCH, WAVE_LDS = 2 * VBYTES;
constexpr float EXIT_THR = -152.f;
__device__ __forceinline__ int crow(int r, int hi) { return (r & 3) + 8 * (r >> 2) + 4 * hi; }
__device__ __forceinline__ s16x4 vtr(LAS const unsigned char* p) { return __builtin_bit_cast(s16x4, __builtin_amdgcn_ds_read_tr16_b64_v4i16((LAS v4i16_t*)p)); }
__device__ __forceinline__ unsigned pkbf(float lo, float hi) { return pg8::cvt_pk_bf16(lo, hi); }

__device__ __forceinline__ void attn_unit(int b, int h, int qb, const bf16_t* Q, const bf16_t* K, const bf16_t* V, bf16_t* O, LAS unsigned char* vlds, int wid, int lane) {
    const int r32 = lane & 31, hi = lane >> 5;
    const int t0 = qb * 256 + wid * 32;
    const size_t rowbase = (size_t)b * SEQ;
    const bf16_t* Kh = K + rowbase * 512 + h * 64; const bf16_t* Vh = V + rowbase * 512 + h * 64;
    bf16x8 qr[4];
#pragma unroll
    for (int d0 = 0; d0 < 4; ++d0) qr[d0] = *(const bf16x8*)(Q + (rowbase + t0 + r32) * 512 + h * 64 + d0 * 16 + hi * 8);
    f32x16 o0 = {}, o1 = {};
    float carry = 0.f;
    int kt = t0 >> 6;
    bf16x8 kf[8];
#define SB_LOADK(KT) do { const int kb_ = (KT) * 64; \
        _Pragma("unroll") for (int d0 = 0; d0 < 4; ++d0) { kf[2 * d0] = *(const bf16x8*)(Kh + (size_t)(kb_ + r32) * 512 + d0 * 16 + hi * 8); kf[2 * d0 + 1] = *(const bf16x8*)(Kh + (size_t)(kb_ + 32 + r32) * 512 + d0 * 16 + hi * 8); } } while (0)
#define SB_DMAV(KT, BUF) do { const int kb_ = (KT) * 64; \
        _Pragma("unroll") for (int i = 0; i < 8; ++i) __builtin_amdgcn_global_load_lds((const unsigned*)(Vh + (size_t)(kb_ + 8 * i + (lane >> 3)) * 512 + (lane & 7) * 8), (LAS unsigned*)(vlds + (BUF) * VBYTES + i * 1024), 16, 0, 0); } while (0)
    int cur = 0;
    SB_DMAV(kt, 0);
    SB_LOADK(kt);
    const int trbase = (4 * hi + ((lane & 15) >> 2)) * VPITCH + (16 * ((lane >> 4) & 1) + 4 * (lane & 3)) * 2;
    bool diag = true;
    for (;; --kt) {
        const int kbase = kt * 64;
        f32x16 p0 = {}, p1 = {};
#pragma unroll
        for (int d0 = 0; d0 < 4; ++d0) { p0 = __builtin_amdgcn_mfma_f32_32x32x16_bf16(kf[2 * d0], qr[d0], p0, 0, 0, 0); p1 = __builtin_amdgcn_mfma_f32_32x32x16_bf16(kf[2 * d0 + 1], qr[d0], p1, 0, 0, 0); }
        asm volatile("" ::: "memory");
        if (kt > 0) { SB_DMAV(kt - 1, cur ^ 1); SB_LOADK(kt - 1); }
        asm volatile("" ::: "memory");
        bf16x8 pa[4]; float suf = 0.f;
        const int qrel = t0 + r32 - kbase;
#define SB_HALF(P, KOFF, PA0, PA1) do { f32x16 sp_; \
        _Pragma("unroll") for (int r = 0; r < 16; ++r) sp_[r] = __builtin_amdgcn_logf(1.f + __builtin_amdgcn_exp2f(P[r])); \
        if (diag) { _Pragma("unroll") for (int r = 0; r < 16; ++r) if (crow(r, hi) + (KOFF) >= qrel) sp_[r] = 0.f; } \
        float e_[4], og_[4], R_[4]; \
        _Pragma("unroll") for (int c = 0; c < 4; ++c) { sp_[4 * c + 2] += sp_[4 * c + 3]; sp_[4 * c + 1] += sp_[4 * c + 2]; sp_[4 * c] += sp_[4 * c + 1]; e_[c] = sp_[4 * c]; } \
        _Pragma("unroll") for (int c = 0; c < 4; ++c) og_[c] = __shfl_xor(e_[c], 32); \
        _Pragma("unroll") for (int c = 3; c >= 0; --c) { R_[c] = carry - (suf + (hi == 0 ? og_[c] : 0.f)); suf += e_[c] + og_[c]; } \
        _Pragma("unroll") for (int r = 0; r < 16; ++r) P[r] = __builtin_amdgcn_exp2f(P[r] - sp_[r] + R_[r >> 2]); \
        if (diag) { _Pragma("unroll") for (int r = 0; r < 16; ++r) if (crow(r, hi) + (KOFF) >= qrel) P[r] = 0.f; } \
        pg8::u32x4 w_; w_.x = pkbf(P[0], P[1]); w_.y = pkbf(P[2], P[3]); w_.z = pkbf(P[4], P[5]); w_.w = pkbf(P[6], P[7]); PA0 = __builtin_bit_cast(bf16x8, w_); \
        w_.x = pkbf(P[8], P[9]); w_.y = pkbf(P[10], P[11]); w_.z = pkbf(P[12], P[13]); w_.w = pkbf(P[14], P[15]); PA1 = __builtin_bit_cast(bf16x8, w_); } while (0)
        SB_HALF(p1, 32, pa[2], pa[3]);
        SB_HALF(p0, 0, pa[0], pa[1]);
#undef SB_HALF
        carry -= suf;
        diag = false;
        if (kt > 0) asm volatile("s_waitcnt vmcnt(16)" ::: "memory"); else asm volatile("s_waitcnt vmcnt(0)" ::: "memory");
        LAS const unsigned char* vb = vlds + cur * VBYTES + trbase;
#pragma unroll
        for (int s = 0; s < 4; ++s) {
            LAS const unsigned char* vp = vb + (16 * s) * VPITCH;
            const s16x4 a0 = vtr(vp), a1 = vtr(vp + 8 * VPITCH), b0 = vtr(vp + 64), b1 = vtr(vp + 8 * VPITCH + 64);
            const bf16x8 v0 = {a0[0], a0[1], a0[2], a0[3], a1[0], a1[1], a1[2], a1[3]}, v1 = {b0[0], b0[1], b0[2], b0[3], b1[0], b1[1], b1[2], b1[3]};
            o0 = __builtin_amdgcn_mfma_f32_32x32x16_bf16(pa[s], v0, o0, 0, 0, 0);
            o1 = __builtin_amdgcn_mfma_f32_32x32x16_bf16(pa[s], v1, o1, 0, 0, 0);
        }
        asm volatile("s_waitcnt lgkmcnt(0)" ::: "memory");
        cur ^= 1;
        if (kt == 0 || __all(carry < EXIT_THR)) break;
    }
    asm volatile("s_waitcnt vmcnt(0)" ::: "memory");
#undef SB_LOADK
#undef SB_DMAV
    bf16_t* Ow = O + (rowbase + t0) * 512 + h * 64 + r32;
#pragma unroll
    for (int r = 0; r < 16; ++r) { const int q = crow(r, hi); Ow[(size_t)q * 512] = (bf16_t)f2bf(o0[r]); Ow[(size_t)q * 512 + 32] = (bf16_t)f2bf(o1[r]); }
}
}

__device__ __forceinline__ void p2_pool(Frame& F, const bf16_t* U, bf16_t* MIX) {
    const int rows_per = M / F.G; const int col8 = F.lane, w = 2 << (col8 >> 4);
    for (int rb = F.wave * 8; rb < rows_per; rb += NWAVES * 8) { const int t0 = F.vcu * rows_per + rb;
        v4u ld[23];
#pragma unroll
        for (int i = 0; i < 23; ++i) ld[i] = *(const GAS v4u*)(U + ((long)(t0 - 15 + i)) * PW + col8 * 8);
#pragma unroll
        for (int r = 0; r < 8; ++r) { const int tl = (t0 + r) % SEQ; const int cnt = (tl + 1) < w ? (tl + 1) : w;
            float acc[8];
#pragma unroll
            for (int j = 0; j < 8; ++j) acc[j] = 0.f;
#pragma unroll
            for (int i = 0; i < 16; ++i) { const v4u u = ld[15 + r - i]; const float m = (i < cnt) ? 1.f : 0.f;
                acc[0] += m * bf2f(u.x & 0xffffu); acc[1] += m * bf2f(u.x >> 16); acc[2] += m * bf2f(u.y & 0xffffu); acc[3] += m * bf2f(u.y >> 16);
                acc[4] += m * bf2f(u.z & 0xffffu); acc[5] += m * bf2f(u.z >> 16); acc[6] += m * bf2f(u.w & 0xffffu); acc[7] += m * bf2f(u.w >> 16); }
            const float inv = 1.f / (float)cnt; const v4u self = ld[15 + r];
            v4u o; o.x = pk2(acc[0] * inv - bf2f(self.x & 0xffffu), acc[1] * inv - bf2f(self.x >> 16)); o.y = pk2(acc[2] * inv - bf2f(self.y & 0xffffu), acc[3] * inv - bf2f(self.y >> 16));
            o.z = pk2(acc[4] * inv - bf2f(self.z & 0xffffu), acc[5] * inv - bf2f(self.z >> 16)); o.w = pk2(acc[6] * inv - bf2f(self.w & 0xffffu), acc[7] * inv - bf2f(self.w >> 16));
            *(GAS v4u*)(MIX + (size_t)(t0 + r) * PW + col8 * 8) = o; } }
}

constexpr int P5_TAB = AUX_OFF + 2048;
constexpr int P5_CNT = AUX_OFF + 1024;
constexpr int LIST_CAP = 16384;
typedef float f32x16 __attribute__((ext_vector_type(16)));
__device__ __forceinline__ void p5_route(Frame& F, const Args& a) {
    unsigned char* ws = a.ws; const float* X1 = a.out; const float* g2 = a.in[13]; const float* mod = (const float*)(ws + WS_MOD); const float* rbias = a.in[15];
    unsigned char* H2 = ws + WS_H2; int* PE = (int*)(ws + WS_PE);
    const bf16_t* WH = (const bf16_t*)(ws + WS_WRH); const bf16_t* WL = (const bf16_t*)(ws + WS_WRL);
    unsigned long long* LIST = (unsigned long long*)(ws + WS_LIST); gu32* gcnt = F.ctl + CW_CNT;
    LAS unsigned char* Ahi = F.lds + RING_OFF; LAS unsigned char* Alo = Ahi + 65536; LAS float* part = (LAS float*)Ahi;
    LAS float* gsv = (LAS float*)(F.lds + P5_TAB); LAS float* shv = gsv + D; LAS unsigned* cnt_l = (LAS unsigned*)(F.lds + P5_CNT); LAS unsigned* base_l = cnt_l + 64; LAS float* rr = (LAS float*)(base_l + 64);
    const int lane = F.lane, wave = __builtin_amdgcn_readfirstlane(F.wave), r32 = lane & 31, hi = lane >> 5;
    const int row0 = F.vcu * 64;
    if (row0 < M) {
        const int b = row0 / SEQ;
        for (int k = F.tid; k < D; k += NWAVES * 64) { gsv[k] = g2[k] * (1.f + mod[b * 6 * D + 4 * D + k]); shv[k] = mod[b * 6 * D + 3 * D + k]; }
        if (F.tid < 64) cnt_l[F.tid] = 0u;
        { f32x4 v[8][4];
#pragma unroll
          for (int i = 0; i < 8; ++i) { const GAS f32x4* xr = (const GAS f32x4*)(X1 + (size_t)(row0 + 8 * wave + i) * D) + lane;
#pragma unroll
              for (int j = 0; j < 4; ++j) v[i][j] = xr[64 * j]; }
#pragma unroll
          for (int i = 0; i < 8; ++i) { float s = 0.f;
#pragma unroll
              for (int j = 0; j < 4; ++j) s += (v[i][j].x * v[i][j].x + v[i][j].y * v[i][j].y) + (v[i][j].z * v[i][j].z + v[i][j].w * v[i][j].w);
              s = wave_sum(s); if (lane == 0) rr[8 * wave + i] = rsqrtf(s * (1.f / D) + EPS); } }
        __syncthreads();
        f32x16 acc[2][2];
        const char* whb = (const char*)WH + wave * 8192; const char* wlb = (const char*)WL + wave * 8192;
#pragma unroll
        for (int x = 0; x < 2; ++x)
#pragma unroll
            for (int y = 0; y < 2; ++y) acc[x][y] = f32x16{};
#pragma unroll
        for (int kh = 0; kh < 2; ++kh) {
            bf16x8 bh[4][2], bl[4][2];
#pragma unroll
            for (int s4 = 0; s4 < 4; ++s4)
#pragma unroll
                for (int t = 0; t < 2; ++t) { const int fo = kh * 65536 + (s4 * 2 + t) * 1024;
                    bh[s4][t] = *(const bf16x8*)(whb + fo + lane * 16); bl[s4][t] = *(const bf16x8*)(wlb + fo + lane * 16); }
#pragma unroll
            for (int i = 0; i < 8; ++i) { const int rl = 8 * wave + i, row = row0 + rl; const float r = rr[rl];
                if ((i & 1) == 0) __builtin_amdgcn_sched_barrier(0);
                const GAS f32x4* xr = (const GAS f32x4*)(X1 + (size_t)row * D + 512 * kh) + lane;
                GAS unsigned* o4 = (GAS unsigned*)(H2 + (size_t)row * D + 512 * kh) + lane;
#pragma unroll
                for (int j = 0; j < 2; ++j) { const f32x4 xv = xr[64 * j];
                    const f32x4 gg = *(const LAS f32x4*)(gsv + 512 * kh + 4 * lane + 256 * j), ss = *(const LAS f32x4*)(shv + 512 * kh + 4 * lane + 256 * j);
                    const f32x4 h = xv * r * gg + ss;
                    const unsigned p01 = pk2(h.x, h.y), p23 = pk2(h.z, h.w);
                    const unsigned long long hh = (unsigned long long)p01 | ((unsigned long long)p23 << 32);
                    { const f32x4 h8 = h * H8SCALE; unsigned q8 = 0u;
                      q8 = __builtin_amdgcn_cvt_pk_fp8_f32(__builtin_amdgcn_fmed3f(h8.x, -448.f, 448.f), __builtin_amdgcn_fmed3f(h8.y, -448.f, 448.f), q8, false);
                      q8 = __builtin_amdgcn_cvt_pk_fp8_f32(__builtin_amdgcn_fmed3f(h8.z, -448.f, 448.f), __builtin_amdgcn_fmed3f(h8.w, -448.f, 448.f), q8, true);
                      o4[64 * j] = q8; }
                    const unsigned long long ll = (unsigned long long)pk2(h.x - __builtin_bit_cast(float, p01 << 16), h.y - __builtin_bit_cast(float, p01 & 0xffff0000u))
                                                | ((unsigned long long)pk2(h.z - __builtin_bit_cast(float, p23 << 16), h.w - __builtin_bit_cast(float, p23 & 0xffff0000u)) << 32);
                    const int chunk = (lane >> 1) + 32 * j, off = rl * 1024 + ((chunk ^ (rl & 15)) << 4) + ((lane & 1) << 3);
                    *(LAS unsigned long long*)(Ahi + off) = hh; *(LAS unsigned long long*)(Alo + off) = ll; } }
            __syncthreads();
#pragma unroll
            for (int s4 = 0; s4 < 4; ++s4) { const int chunk = 8 * wave + 2 * s4 + hi;
                const bf16x8 bh0 = bh[s4][0], bh1 = bh[s4][1], bl0 = bl[s4][0], bl1 = bl[s4][1];
#pragma unroll
                for (int x = 0; x < 2; ++x) { const int rw = 32 * x + r32, off = rw * 1024 + ((chunk ^ (rw & 15)) << 4);
                    const bf16x8 ah = *(const LAS bf16x8*)(Ahi + off), al = *(const LAS bf16x8*)(Alo + off);
                    acc[x][0] = __builtin_amdgcn_mfma_f32_32x32x16_bf16(ah, bh0, acc[x][0], 0, 0, 0); acc[x][1] = __builtin_amdgcn_mfma_f32_32x32x16_bf16(ah, bh1, acc[x][1], 0, 0, 0);
                    acc[x][0] = __builtin_amdgcn_mfma_f32_32x32x16_bf16(al, bh0, acc[x][0], 0, 0, 0); acc[x][1] = __builtin_amdgcn_mfma_f32_32x32x16_bf16(al, bh1, acc[x][1], 0, 0, 0);
                    acc[x][0] = __builtin_amdgcn_mfma_f32_32x32x16_bf16(ah, bl0, acc[x][0], 0, 0, 0); acc[x][1] = __builtin_amdgcn_mfma_f32_32x32x16_bf16(ah, bl1, acc[x][1], 0, 0, 0); } }
            __syncthreads();
        }
#pragma unroll
        for (int x = 0; x < 2; ++x)
#pragma unroll
            for (int r = 0; r < 16; ++r) { const int rw = 32 * x + (r & 3) + 8 * (r >> 2) + 4 * hi; part[wave * 4096 + rw * 64 + r32] = acc[x][0][r]; part[wave * 4096 + rw * 64 + 32 + r32] = acc[x][1][r]; }
        __syncthreads();
        float scq[8];
#pragma unroll
        for (int q = 0; q < 8; ++q) { const int rl = wave + 8 * q; float logit = 0.f;
#pragma unroll
            for (int w = 0; w < 8; ++w) logit += part[w * 4096 + rl * 64 + lane];
            scq[q] = 1.f / (1.f + expf(-logit)); }
        __syncthreads();
        LAS float* scoreT = (LAS float*)(F.lds + RING_OFF);
#pragma unroll
        for (int q = 0; q < 8; ++q) scoreT[lane * 65 + wave + 8 * q] = scq[q];
        __syncthreads();
        if (wave == 0) {
            float sel[64];
#pragma unroll
            for (int e = 0; e < 64; ++e) sel[e] = scoreT[e * 65 + lane] + rbias[e];
            float gs[8];
#pragma unroll
            for (int g = 0; g < 8; ++g) { float m1 = sel[8 * g], m2 = -INFINITY;
#pragma unroll
                for (int j = 1; j < 8; ++j) { const float v = sel[8 * g + j]; const float lo = fminf(m1, v); m1 = fmaxf(m1, v); m2 = fmaxf(m2, lo); }
                gs[g] = m1 + m2; }
            unsigned gmask = 0u;
#pragma unroll
            for (int g = 0; g < 8; ++g) { int rk = 0;
#pragma unroll
                for (int h = 0; h < 8; ++h) if (h != g) rk += (gs[h] > gs[g] || (gs[h] == gs[g] && h < g)) ? 1 : 0;
                gmask |= (rk < 4) ? (1u << g) : 0u; }
#pragma unroll
            for (int e = 0; e < 64; ++e) sel[e] = ((gmask >> (e >> 3)) & 1u) ? sel[e] : -INFINITY;
            unsigned long long taken = 0ull; int ex[8]; float ws_[8]; float wsum = 0.f;
#pragma unroll
            for (int r = 0; r < TOPK; ++r) { float best = -INFINITY; int bi = 0;
#pragma unroll
                for (int e = 0; e < 64; ++e) { const bool c = !((taken >> e) & 1ull) && sel[e] > best; best = c ? sel[e] : best; bi = c ? e : bi; }
                taken |= 1ull << bi; ex[r] = bi; ws_[r] = scoreT[bi * 65 + lane]; wsum += ws_[r]; }
            const float wn = RSCALE / wsum;
#pragma unroll
            for (int r = 0; r < TOPK; ++r) { const unsigned pos = __hip_atomic_fetch_add(cnt_l + ex[r], 1u, __ATOMIC_RELAXED, __HIP_MEMORY_SCOPE_WORKGROUP);
                LAS unsigned* pk = (LAS unsigned*)(F.lds + RING_OFF + 32768) + (lane * 8 + r) * 4; pk[0] = (unsigned)ex[r]; pk[1] = pos; pk[2] = __builtin_bit_cast(unsigned, ws_[r] * wn); }
        }
        __syncthreads();
        if (F.tid < 64) base_l[F.tid] = __hip_atomic_fetch_add(gcnt + 64 * F.tid, cnt_l[F.tid], __ATOMIC_RELAXED, __HIP_MEMORY_SCOPE_AGENT);
        __syncthreads();
        { LAS const unsigned* pk = (LAS const unsigned*)(F.lds + RING_OFF + 32768) + F.tid * 4; const unsigned e = pk[0], pos = pk[1], wb = pk[2];
          const int pair = (row0 + (F.tid >> 3)) * 8 + (F.tid & 7);
          LIST[(size_t)e * LIST_CAP + base_l[e] + pos] = (unsigned long long)(unsigned)pair | ((unsigned long long)wb << 32);
          PE[pair] = (int)e; }
        __syncthreads();
    }
}

namespace pg8 {
struct UnitG { int kind, slot, nvalid, pm, pn, row0; const char* bptr; };
constexpr int P6_PRE = AUX_OFF + 1024;
constexpr int P6_ROWS = AUX_OFF + 2048;
struct SchedG {
    const LAS int* pre; const LAS int* cnts; const LAS int* cum; const char* wgu; const char* wsh; int G, c, nr, total;
    __device__ __forceinline__ bool next(int i, UnitG& u) const {
        const int idx = i * G + c; if (idx >= total) return false;
        if (idx < nr) { int e = (int)__builtin_popcountll(__ballot(pre[1 + (threadIdx.x & 63)] <= idx));
            e = __builtin_amdgcn_readfirstlane(e); const int j = idx - __builtin_amdgcn_readfirstlane(pre[e]); const int nv = __builtin_amdgcn_readfirstlane(cnts[e]) - 256 * j;
            u.kind = 0; u.slot = i; u.nvalid = nv < 256 ? nv : 256; u.pm = e; u.pn = j; u.row0 = 256 * idx; u.bptr = wgu + (size_t)e * 256 * D; }
        else { const int s = idx - nr; u.kind = 1; u.slot = i; u.nvalid = 256; u.pm = s >> 1; u.pn = s & 1; u.row0 = (s >> 1) * 256; u.bptr = wsh + (size_t)(s & 1) * 256 * D; }
        return true; }
};
struct EpiGU {
    static constexpr bool PERM = true;
    bf16_t* HM; bf16_t* SH; int* SLOT; const LAS unsigned long long* rowinfo;
    __device__ __forceinline__ void operator()(const f32x4 (&acc)[2][2][4][2], const UnitG& u, int wr, int wc, int fr, int fq) const {
#pragma unroll
        for (int ai = 0; ai < 2; ++ai)
#pragma unroll
            for (int m = 0; m < 4; ++m) { const int r = ai * HALF + wr * 64 + m * 16 + fr;
                bf16_t* dst; float w;
                if (u.kind == 0) { const unsigned long long ri = rowinfo[u.slot * 256 + r]; dst = HM + (size_t)(u.row0 + r) * ED + wc * 32 + 8 * fq; w = __builtin_bit_cast(float, (unsigned)(ri >> 32));
                    if (wc == 0 && fq == 0) SLOT[u.row0 + r] = (r < u.nvalid) ? (int)(unsigned)ri : M * 8; }
                else { dst = SH + (size_t)(u.pm * 256 + r) * SHD + u.pn * 128 + wc * 32 + 8 * fq; w = 1.f; }
                constexpr float DQ = 1.f / (W8SCALE * H8SCALE);
                const f32x4 g0 = acc[ai][0][m][0] * DQ, g1 = acc[ai][0][m][1] * DQ, u0 = acc[ai][1][m][0] * DQ, u1 = acc[ai][1][m][1] * DQ;
                float v[8];
#pragma unroll
                for (int j = 0; j < 4; ++j) { v[j] = g0[j] * fsigmoid(g0[j]) * u0[j] * w; v[4 + j] = g1[j] * fsigmoid(g1[j]) * u1[j] * w; }
                u32x4 o; o.x = cvt_pk_bf16(v[0], v[1]); o.y = cvt_pk_bf16(v[2], v[3]); o.z = cvt_pk_bf16(v[4], v[5]); o.w = cvt_pk_bf16(v[6], v[7]);
                if (r < u.nvalid) *(u32x4*)dst = o; }
    }
};
typedef int i32x4_t __attribute__((ext_vector_type(4))); typedef int i32x8_t __attribute__((ext_vector_type(8)));
__device__ __forceinline__ i32x8_t cat8(const bf16x8& a, const bf16x8& b) { return __builtin_shufflevector(__builtin_bit_cast(i32x4_t, a), __builtin_bit_cast(i32x4_t, b), 0, 1, 2, 3, 4, 5, 6, 7); }
__device__ __forceinline__ void mfma8(f32x4& acc, const i32x8_t a, const i32x8_t b) { asm volatile("v_mfma_f32_16x16x128_f8f6f4 %0, %1, %2, %0" : "+v"(acc) : "v"(a), "v"(b)); }
__device__ __forceinline__ void mfma8_settle(f32x4 (&acc)[2][2][4][2]) {
    asm volatile("s_nop 15\n\ts_nop 15" ::: "memory");
#pragma unroll
    for (int a = 0; a < 2; ++a)
#pragma unroll
        for (int b = 0; b < 2; ++b)
#pragma unroll
            for (int m = 0; m < 4; ++m)
#pragma unroll
                for (int n = 0; n < 2; ++n) asm volatile("" : "+v"(acc[a][b][m][n]));
}
template <class Epi, class Sched, bool FP8 = false>
__device__ __forceinline__ void gemm_phase_g(PG8_LAS unsigned char* lds, const bf16_t* A, int K, const Sched& S, const Epi& E, const PG8_LAS unsigned long long* rowinfo) {
    int tid_ = threadIdx.x; asm volatile("" : "+v"(tid_));
    const int tid = tid_, wid = __builtin_amdgcn_readfirstlane(tid >> 6), lane = tid & 63, wr = wid >> 2, wc = wid & 3, fr = lane & 15, fq = lane >> 4;
    const int nt = K / BK;
    int RA[2], CA[2]; unsigned voffB[2];
#pragma unroll
    for (int i = 0; i < 2; ++i) { int R, C; stage_rc(tid * 16 + i * 8192, R, C); const int Rb = Epi::PERM ? ((R & ~31) + perm32(R & 31)) : R; RA[i] = R; CA[i] = C; voffB[i] = (unsigned)(Rb * K + C) * 2u; }
    const size_t kstep = (size_t)(BK * 2);
    const size_t hstep = (size_t)HALF * K * 2;
    const unsigned ldsw = (unsigned)wid * 1024u;
    const int aoff = lds_byte(wr * 64 + fr, fq * 8), boff = lds_byte(wc * 32 + fr, fq * 8);
#define PG8_AOFF(u, o0, o1) do { _Pragma("unroll") for (int _i = 0; _i < 2; ++_i) { unsigned r0_, r1_; \
        if ((u).kind == 0) { r0_ = (unsigned)rowinfo[(u).slot * 256 + RA[_i]] >> 3; r1_ = (unsigned)rowinfo[(u).slot * 256 + HALF + RA[_i]] >> 3; } \
        else { r0_ = (unsigned)((u).row0 + RA[_i]); r1_ = r0_ + HALF; } \
        o0[_i] = (r0_ * (unsigned)K + (unsigned)CA[_i]) * 2u; o1[_i] = (r1_ * (unsigned)K + (unsigned)CA[_i]) * 2u; } } while (0)
#define PG8_SA(b, h) (((b) * 2 + (h)) * HTB)
#define PG8_SB(b, h) ((4 + (b) * 2 + (h)) * HTB)
#define PG8_STAGE(bufoff, gbase, voff) do { _Pragma("unroll") for (int _i = 0; _i < 2; ++_i) \
        __builtin_amdgcn_global_load_lds((const unsigned*)((const char*)(gbase) + (voff)[_i]), (PG8_LAS unsigned*)(lds + (bufoff) + ldsw + _i * 8192), 16, 0, 0); } while (0)
#define PG8_LDA(dst, b, h) do { _Pragma("unroll") for (int m = 0; m < 4; ++m) _Pragma("unroll") for (int k = 0; k < 2; ++k) dst[m][k] = *(const PG8_LAS bf16x8*)(lds + PG8_SA(b, h) + aoff + m * 2048 + k * 1024); } while (0)
#define PG8_LDB(dst, b, h) do { _Pragma("unroll") for (int n = 0; n < 2; ++n) _Pragma("unroll") for (int k = 0; k < 2; ++k) dst[n][k] = *(const PG8_LAS bf16x8*)(lds + PG8_SB(b, h) + boff + n * 2048 + k * 1024); } while (0)
#define PG8_MMA(ai, bj, At, Bt) do { __builtin_amdgcn_s_setprio(1); _Pragma("unroll") for (int m = 0; m < 4; ++m) _Pragma("unroll") for (int n = 0; n < 2; ++n) { \
        if constexpr (FP8) mfma8(acc[ai][bj][m][n], cat8(Bt[n][0], Bt[n][1]), cat8(At[m][0], At[m][1])); \
        else { _Pragma("unroll") for (int k = 0; k < 2; ++k) acc[ai][bj][m][n] = __builtin_amdgcn_mfma_f32_16x16x32_bf16(Bt[n][k], At[m][k], acc[ai][bj][m][n], 0, 0, 0); } } __builtin_amdgcn_s_setprio(0); } while (0)
#define PG8_WAIT_V(n) asm volatile("s_waitcnt vmcnt(" #n ")" ::: "memory")
#define PG8_WAIT_L(n) asm volatile("s_waitcnt lgkmcnt(" #n ")" ::: "memory")
#define PG8_BAR __builtin_amdgcn_s_barrier()
#define PG8_SCHED __builtin_amdgcn_sched_barrier(0)
    UnitG cur, nxt; int ui = 0;
    if (!S.next(0, cur)) return;
    f32x4 acc[2][2][4][2];
#pragma unroll
    for (int a = 0; a < 2; ++a)
#pragma unroll
        for (int b = 0; b < 2; ++b)
#pragma unroll
            for (int m = 0; m < 4; ++m)
#pragma unroll
                for (int n = 0; n < 2; ++n) acc[a][b][m][n] = (f32x4){0.f, 0.f, 0.f, 0.f};
    bf16x8 At[4][2], B0[2][2], B1[2][2];
    const char* cA = (const char*)A; const char* cB = cur.bptr;
    unsigned vA0[2], vA1[2], nA0[2], nA1[2];
    PG8_AOFF(cur, vA0, vA1);
    PG8_STAGE(PG8_SB(0, 0), cB, voffB); PG8_STAGE(PG8_SB(0, 1), cB + hstep, voffB); PG8_STAGE(PG8_SA(0, 0), cA, vA0); PG8_STAGE(PG8_SA(0, 1), cA, vA1);
    if (wr == 1) PG8_BAR;
    PG8_WAIT_V(2); PG8_BAR;
    PG8_STAGE(PG8_SB(1, 0), cB + kstep, voffB); PG8_STAGE(PG8_SA(1, 0), cA + kstep, vA0); PG8_STAGE(PG8_SB(1, 1), cB + hstep + kstep, voffB);
    PG8_WAIT_V(6); PG8_BAR;
    for (;;) {
        const bool has_next = S.next(ui + 1, nxt);
        const char* nB = has_next ? nxt.bptr : cB;
        if (has_next) { PG8_AOFF(nxt, nA0, nA1); } else {
#pragma unroll
            for (int _i = 0; _i < 2; ++_i) { nA0[_i] = vA0[_i]; nA1[_i] = vA1[_i]; } }
#pragma nounroll
        for (int t = 0; t < nt; t += 2) {
            const bool last = (t == nt - 2);
            const char* a1 = cA + (size_t)(t + 1) * kstep;
            const char* a2 = last ? cA : cA + (size_t)(t + 2) * kstep; const char* b2 = last ? nB : cB + (size_t)(t + 2) * kstep;
            const char* a3 = a2 + kstep; const char* b3 = b2 + kstep;
            unsigned s0[2], s1[2];
#pragma unroll
            for (int _i = 0; _i < 2; ++_i) { s0[_i] = last ? nA0[_i] : vA0[_i]; s1[_i] = last ? nA1[_i] : vA1[_i]; }
            PG8_LDB(B0, 0, 0); PG8_LDB(B1, 0, 1); PG8_SCHED; PG8_LDA(At, 0, 0); PG8_STAGE(PG8_SA(1, 1), a1, vA1);
            PG8_WAIT_V(8); PG8_WAIT_L(0); PG8_BAR; PG8_MMA(0, 0, At, B0); PG8_MMA(0, 1, At, B1); PG8_BAR; PG8_SCHED;
            PG8_LDA(At, 0, 1); PG8_STAGE(PG8_SB(0, 0), b2, voffB); PG8_STAGE(PG8_SB(0, 1), b2 + hstep, voffB); PG8_STAGE(PG8_SA(0, 0), a2, s0);
            PG8_WAIT_V(8); PG8_WAIT_L(0); PG8_BAR; PG8_MMA(1, 0, At, B0); PG8_MMA(1, 1, At, B1); PG8_BAR; PG8_SCHED;
            PG8_LDB(B0, 1, 0); PG8_LDB(B1, 1, 1); PG8_SCHED; PG8_LDA(At, 1, 0); PG8_STAGE(PG8_SA(0, 1), a2, s1);
            PG8_WAIT_V(8); PG8_WAIT_L(0); PG8_BAR; PG8_MMA(0, 0, At, B0); PG8_MMA(0, 1, At, B1); PG8_BAR; PG8_SCHED;
            PG8_LDA(At, 1, 1); PG8_STAGE(PG8_SB(1, 0), b3, voffB); PG8_STAGE(PG8_SB(1, 1), b3 + hstep, voffB); PG8_STAGE(PG8_SA(1, 0), a3, s0);
            PG8_WAIT_V(8); PG8_WAIT_L(0); PG8_BAR; PG8_MMA(1, 0, At, B0); PG8_MMA(1, 1, At, B1); PG8_BAR; PG8_SCHED;
        }
        if (wr == 0) PG8_BAR;
        if constexpr (FP8) mfma8_settle(acc);
        E(acc, cur, wr, wc, fr, fq);
        if (!has_next) break;
#pragma unroll
        for (int a = 0; a < 2; ++a)
#pragma unroll
            for (int b = 0; b < 2; ++b)
#pragma unroll
                for (int m = 0; m < 4; ++m)
#pragma unroll
                    for (int n = 0; n < 2; ++n) acc[a][b][m][n] = (f32x4){0.f, 0.f, 0.f, 0.f};
        cur = nxt; cB = nB; ++ui;
#pragma unroll
        for (int _i = 0; _i < 2; ++_i) { vA0[_i] = nA0[_i]; vA1[_i] = nA1[_i]; }
        if (wr == 1) PG8_BAR;
    }
    PG8_WAIT_V(0);
    PG8_BAR;
#undef PG8_AOFF
#undef PG8_SA
#undef PG8_SB
#undef PG8_STAGE
#undef PG8_LDA
#undef PG8_LDB
#undef PG8_MMA
#undef PG8_WAIT_V
#undef PG8_WAIT_L
#undef PG8_BAR
#undef PG8_SCHED
}
}

__device__ __forceinline__ void p6_gateup(Frame& F, const Args& a) {
    unsigned char* ws = a.ws; gu32* gcnt = F.ctl + CW_CNT; const unsigned long long* LIST = (const unsigned long long*)(ws + WS_LIST);
    LAS int* pre = (LAS int*)(F.lds + pg8::P6_PRE); LAS int* cnts = pre + 65; LAS int* cum = cnts + 64; LAS unsigned long long* rowinfo = (LAS unsigned long long*)(F.lds + pg8::P6_ROWS);
    if (F.tid < 64) cnts[F.tid] = (int)__hip_atomic_load(gcnt + 64 * F.tid, RLX_AGENT);
    __syncthreads();
    if (F.tid == 0) { int s = 0, r = 0; for (int e = 0; e < 64; ++e) { pre[e] = s; cum[e] = r; s += (cnts[e] + 255) >> 8; r += cnts[e]; } pre[64] = s; cum[64] = r; }
    __syncthreads();
    pg8::SchedG S; S.pre = pre; S.cnts = cnts; S.cum = cum; S.wgu = (const char*)(ws + WS_WGU); S.wsh = (const char*)(ws + WS_WSHGU); S.G = F.G; S.c = (int)blockIdx.x; S.nr = __builtin_amdgcn_readfirstlane(pre[64]); S.total = S.nr + 2 * (M / 256);
    for (int i = 0; i < 3; ++i) { pg8::UnitG u; if (!S.next(i, u)) break;
        if (u.kind == 0 && F.tid < 256) { const int r = F.tid; rowinfo[i * 256 + r] = (r < u.nvalid) ? LIST[(size_t)u.pm * LIST_CAP + 256 * u.pn + r] : 0ull; } }
    __syncthreads();
    pg8::EpiGU E{(bf16_t*)(ws + WS_HM), (bf16_t*)(ws + WS_SH), (int*)(ws + WS_SLOT), rowinfo};
    pg8::gemm_phase_g<pg8::EpiGU, pg8::SchedG, true>(F.lds + RING_OFF, (const bf16_t*)(ws + WS_H2), D / 2, S, E, rowinfo);
    { const int rounds = (S.total + F.G - 1) / F.G, firstidle = S.total - (rounds - 1) * F.G;
      const int c = (int)blockIdx.x, nidle = F.G - firstidle;
      if (nidle > 0) { if (c >= firstidle) titem_run(F, a, true, 64 * 64 + 4 * 32, (c - firstidle) * NWAVES + F.wave, nidle * NWAVES); }
      else titem_run(F, a, true, 64 * 64 + 4 * 32, c * NWAVES + F.wave, F.G * NWAVES); }
}

namespace pg8 {
struct SchedYr {
    const LAS int* pre; int G, c, total;
    __device__ __forceinline__ bool next(int i, Unit& u) const {
        const int idx = i * G + c; if (idx >= total) return false;
        const int t = idx >> 2, pnl = idx & 3; int e = (int)__builtin_popcountll(__ballot(pre[1 + (threadIdx.x & 63)] <= t));
        e = __builtin_amdgcn_readfirstlane(e); u.pm = t; u.pn = 4 * e + pnl; return true; }
    __device__ __forceinline__ void a_ready(const Unit&) const {}
    __device__ __forceinline__ void done(const Unit&) const {}
};
constexpr float YSCALE = 8.f;
struct EpiStoreF8 {
    static constexpr bool PERM = true, AFTER_DRAIN = false;
    unsigned char* O; const PG8_LAS int* rowmap_l; int G, c;
    __device__ __forceinline__ void operator()(const f32x4 (&acc)[2][2][4][2], const Unit& u, int wr, int wc, int fr, int fq) const {
        const int slot = (4 * u.pm + (u.pn & 3) - c) / G; const PG8_LAS int* rm = rowmap_l + slot * 256 + wr * 64 + fr; const int col0 = (u.pn & 3) * BM + wc * 64 + 16 * fq;
#pragma unroll
        for (int ai = 0; ai < 2; ++ai)
#pragma unroll
            for (int m = 0; m < 4; ++m) { const int orow = rm[ai * HALF + m * 16]; u32x4 w;
#pragma unroll
                for (int bj = 0; bj < 2; ++bj) { const f32x4 v0 = acc[ai][bj][m][0] * YSCALE, v1 = acc[ai][bj][m][1] * YSCALE;
                    unsigned lo = 0u, hi = 0u;
                    lo = __builtin_amdgcn_cvt_pk_fp8_f32(v0[0], v0[1], lo, false); lo = __builtin_amdgcn_cvt_pk_fp8_f32(v0[2], v0[3], lo, true);
                    hi = __builtin_amdgcn_cvt_pk_fp8_f32(v1[0], v1[1], hi, false); hi = __builtin_amdgcn_cvt_pk_fp8_f32(v1[2], v1[3], hi, true);
                    if (bj == 0) { w.x = lo; w.y = hi; } else { w.z = lo; w.w = hi; } }
                *(u32x4*)(O + (size_t)orow * 1024 + col0) = w; }
    }
};
struct EpiStore {
    static constexpr bool PERM = true, AFTER_DRAIN = false;
    bf16_t* O; int ldc, colmask;
    __device__ __forceinline__ void operator()(const f32x4 (&acc)[2][2][4][2], const Unit& u, int wr, int wc, int fr, int fq) const {
        const int row0 = u.pm * BM + wr * 64 + fr, col0 = (u.pn & colmask) * BM + wc * 32 + 8 * fq;
#pragma unroll
        for (int ai = 0; ai < 2; ++ai)
#pragma unroll
            for (int m = 0; m < 4; ++m) { bf16_t* rowp = O + (size_t)(row0 + ai * HALF + m * 16) * ldc + col0;
#pragma unroll
                for (int bj = 0; bj < 2; ++bj) { const f32x4 v0 = acc[ai][bj][m][0], v1 = acc[ai][bj][m][1];
                    u32x4 w; w.x = cvt_pk_bf16(v0[0], v0[1]); w.y = cvt_pk_bf16(v0[2], v0[3]); w.z = cvt_pk_bf16(v1[0], v1[1]); w.w = cvt_pk_bf16(v1[2], v1[3]);
                    *(u32x4*)(rowp + bj * HALF) = w; } }
    }
};
}
__device__ __forceinline__ void p7_down(Frame& F, const Args& a) {
    unsigned char* ws = a.ws; gu32* gcnt = F.ctl + CW_CNT;
    LAS int* pre = (LAS int*)(F.lds + pg8::P6_PRE); LAS int* cnts = pre + 65;
    if (F.tid < 64) cnts[F.tid] = (int)__hip_atomic_load(gcnt + 64 * F.tid, RLX_AGENT);
    __syncthreads();
    if (F.tid == 0) { int s = 0; for (int e = 0; e < 64; ++e) { pre[e] = s; s += (cnts[e] + 255) >> 8; } pre[64] = s; }
    __syncthreads();
    { pg8::SchedYr S; S.pre = pre; S.G = F.G; S.c = (int)blockIdx.x; S.total = 4 * __builtin_amdgcn_readfirstlane(pre[64]);
      int kk = ED; asm volatile("" : "+s"(kk));
      LAS int* rml = (LAS int*)(F.lds + AUX_OFF + 2048); const int* rowmap = (const int*)(ws + WS_SLOT);
      for (int i = 0; i * F.G + S.c < S.total && i < 12; ++i) { if (F.tid < 256) rml[i * 256 + F.tid] = rowmap[256 * ((i * F.G + S.c) >> 2) + F.tid]; }
      __syncthreads();
      pg8::Gemm g{(const bf16_t*)(ws + WS_HM), (const bf16_t*)(ws + WS_WD), 0, 0, kk}; pg8::EpiStoreF8 E{ws + WS_YH, rml, F.G, S.c};
      pg8::gemm_phase<pg8::EpiStoreF8, pg8::SchedYr, true, true>(F.lds + RING_OFF, g, S, E); }
    { pg8::StaticOrder S; S.init(M, D, F.G, (int)blockIdx.x);
      int kk = SHD; asm volatile("" : "+s"(kk));
      pg8::Gemm g{(const bf16_t*)(ws + WS_SH), (const bf16_t*)(ws + WS_WSHD), M, D, kk}; pg8::EpiStore E{(bf16_t*)(ws + WS_YSH), D, 3};
      pg8::gemm_phase<pg8::EpiStore, pg8::StaticOrder, true, true>(F.lds + RING_OFF, g, S, E); }
}
__device__ __forceinline__ void p8_combine(Frame& F, const Args& a) {
    unsigned char* ws = a.ws; const unsigned char* Y8 = ws + WS_YH; const bf16_t* YSH = (const bf16_t*)(ws + WS_YSH);
    const float* mod = (const float*)(ws + WS_MOD); float* OUT = a.out; const int lane = F.lane;
    for (int tb = (F.vcu * NWAVES + F.wave) * 8; tb < M; tb += F.G * NWAVES * 8) {
        const int b = tb / SEQ; const float* gate = mod + (size_t)b * 6 * D + 5 * D + lane * 16;
        f32x4 gv[4];
#pragma unroll
        for (int i = 0; i < 4; ++i) gv[i] = *(const f32x4*)(gate + 4 * i);
#pragma nounroll
        for (int i = 0; i < 8; i += 2) {
            v4u y[2][8], ys[2][2]; f32x4 x[2][4];
#pragma unroll
            for (int q = 0; q < 2; ++q) { const int t = tb + i + q;
#pragma unroll
                for (int k = 0; k < 8; ++k) y[q][k] = *(const GAS v4u*)(Y8 + ((size_t)t * 8 + k) * 1024 + lane * 16);
                const GAS v4u* sp = (const GAS v4u*)(YSH + (size_t)t * D + lane * 16); ys[q][0] = sp[0]; ys[q][1] = sp[1];
                const GAS f32x4* o = (const GAS f32x4*)(OUT + (size_t)t * D + lane * 16);
#pragma unroll
                for (int j = 0; j < 4; ++j) x[q][j] = o[j]; }
#pragma unroll
            for (int q = 0; q < 2; ++q) { const int t = tb + i + q; float acc[16];
#pragma unroll
                for (int j = 0; j < 16; ++j) acc[j] = 0.f;
#pragma unroll
                for (int k = 0; k < 8; ++k) { const unsigned w4[4] = {y[q][k].x, y[q][k].y, y[q][k].z, y[q][k].w};
#pragma unroll
                    for (int j = 0; j < 4; ++j) { const pg8::f32x2_t lo = __builtin_amdgcn_cvt_pk_f32_fp8((int)w4[j], false), hi = __builtin_amdgcn_cvt_pk_f32_fp8((int)w4[j], true);
                        acc[4 * j] += lo.x; acc[4 * j + 1] += lo.y; acc[4 * j + 2] += hi.x; acc[4 * j + 3] += hi.y; } }
                GAS f32x4* o = (GAS f32x4*)(OUT + (size_t)t * D + lane * 16);
#pragma unroll
                for (int j = 0; j < 4; ++j) { const unsigned s0 = (j < 2 ? ys[q][0] : ys[q][1])[2 * (j & 1)], s1 = (j < 2 ? ys[q][0] : ys[q][1])[2 * (j & 1) + 1];
                    const f32x4 sh = {bf2f(s0 & 0xffffu), bf2f(s0 >> 16), bf2f(s1 & 0xffffu), bf2f(s1 >> 16)};
                    const f32x4 rt = {acc[4 * j], acc[4 * j + 1], acc[4 * j + 2], acc[4 * j + 3]};
                    o[j] = x[q][j] + gv[j] * (rt * (1.f / pg8::YSCALE) + sh); } }
        }
    }
}

__global__ void __launch_bounds__(NWAVES * 64, 2) mk_fwd(Args args) {
    extern __shared__ __attribute__((aligned(16))) unsigned char lds[];
    Frame F;
    F.lds = (LAS unsigned char*)lds; F.MISC = (volatile LAS unsigned*)(F.lds + MISC_OFF);
    F.tid = threadIdx.x; F.lane = F.tid & 63; F.wave = __builtin_amdgcn_readfirstlane(F.tid >> 6);
    F.G = gridDim.x; { const int bx = blockIdx.x; F.vcu = (F.G % 8 == 0) ? (bx % 8) * (F.G / 8) + bx / 8 : bx; }
    unsigned char* ws = args.ws; F.ctl = (gu32*)(ws + WS_CTL);
    for (int u = F.tid; u < (LDS_BYTES - LDSCTL_OFF) / 4; u += NWAVES * 64) ((LAS unsigned*)(F.lds + LDSCTL_OFF))[u] = 0u;
    __syncthreads();
    XcdBarrier bar; bar.bar = (unsigned*)(F.ctl + CW_BAR); bar.x = 0; bar.st = nullptr;
    if (args.use_bar) bar = xcd_barrier_post((unsigned*)(F.ctl + CW_BAR), F.MISC + 8);
    const int lo = args.ph_lo, hi = args.ph_hi;
#define IN(k) (lo <= (k) && (k) < hi)
#define SEAM(k) do { if (IN(k) && IN((k) + 1)) xcd_barrier(bar); } while (0)
#define REFRESH() do { int t_ = threadIdx.x; asm volatile("" : "+v"(t_)); F.tid = t_; F.lane = t_ & 63; F.wave = __builtin_amdgcn_readfirstlane(t_ >> 6); } while (0)
#define PHASE(p, ...) do { if (IN(p)) { REFRESH(); const int reps_ = (DBL_PHASE == (p)) ? 2 : 1; for (int rep_ = 0; rep_ < reps_; ++rep_) { __VA_ARGS__; if (rep_ + 1 < reps_) xcd_barrier(bar); } } SEAM(p); } while (0)
    PHASE(0, p0a(F, args));
    PHASE(1, p0b(F, args));
    PHASE(2, {
        pg8::Gemm g{(const bf16_t*)(ws + WS_XN), (const bf16_t*)(ws + WS_WIN), M, INW, D}; pg8::StaticOrder S; S.init(M, INW, F.G, (int)blockIdx.x);
        pg8::EpiProj E{(bf16_t*)(ws + WS_Q), (bf16_t*)(ws + WS_K), (bf16_t*)(ws + WS_V), (bf16_t*)(ws + WS_U), (bf16_t*)(ws + WS_GA), (bf16_t*)(ws + WS_GB), args.in[6], args.in[7]};
        pg8::gemm_phase<pg8::EpiProj, pg8::StaticOrder, true, true>(F.lds + RING_OFF, g, S, E); });
    PHASE(3, {
        const bf16_t* Q = (const bf16_t*)(ws + WS_Q); const bf16_t* K = (const bf16_t*)(ws + WS_K); const bf16_t* V = (const bf16_t*)(ws + WS_V);
        for (int u = blockIdx.x; u < BATCH * NH * (SEQ / 256); u += F.G) { const int qb = u & 15, bh = u >> 4;
            sb::attn_unit(bh >> 3, bh & 7, qb, Q, K, V, (bf16_t*)(ws + WS_OSB), F.lds + RING_OFF + F.wave * sb::WAVE_LDS, F.wave, F.lane); }
        p2_pool(F, (const bf16_t*)(ws + WS_U), (bf16_t*)(ws + WS_MIX)); });
    PHASE(4, {
        pg8::StaticOrder S; S.init(M, D, F.G, (int)blockIdx.x);
        { pg8::Gemm g{(const bf16_t*)(ws + WS_OSB), (const bf16_t*)(ws + WS_WSB), M, D, SBW}; pg8::EpiMerge E{(const bf16_t*)(ws + WS_GA), (bf16_t*)(ws + WS_MERGED), 0};
          pg8::gemm_phase<pg8::EpiMerge, pg8::StaticOrder, true, true>(F.lds + RING_OFF, g, S, E); }
        { pg8::Gemm g{(const bf16_t*)(ws + WS_MIX), (const bf16_t*)(ws + WS_WEFF), M, D, PW}; pg8::EpiMerge E{(const bf16_t*)(ws + WS_GB), (bf16_t*)(ws + WS_MERGED), 1};
          pg8::gemm_phase<pg8::EpiMerge, pg8::StaticOrder, true, true>(F.lds + RING_OFF, g, S, E); } });
    PHASE(5, {
        pg8::Gemm g{(const bf16_t*)(ws + WS_MERGED), (const bf16_t*)(ws + WS_WOUT), M, D, D}; pg8::StaticOrder S; S.init(M, D, F.G, (int)blockIdx.x);
        pg8::EpiX1 E{args.in[0], (const float*)(ws + WS_MOD) + 2 * D, args.out};
        pg8::gemm_phase<pg8::EpiX1, pg8::StaticOrder, true, true>(F.lds + RING_OFF, g, S, E); });
    PHASE(6, {
        if (rep_ > 0) { if (blockIdx.x == 0 && F.tid < 64) __hip_atomic_store(F.ctl + CW_CNT + 64 * F.tid, 0u, RLX_AGENT); xcd_barrier(bar); }
        p5_route(F, args); });
    PHASE(7, p6_gateup(F, args));
    PHASE(8, p7_down(F, args));
    if (IN(9)) { REFRESH(); p8_combine(F, args); }
#undef PHASE
#undef REFRESH
#undef IN
#undef SEAM
}
constexpr int N_PHASES = 10;
extern "C" void kernel_launch(void* const* d_in, const int* in_sizes, int n_in, void* d_out, int out_size, void* d_ws, size_t ws_size, hipStream_t stream) {
    static int grid = 0;
    if (grid == 0) {
        if (n_in != 22 || out_size != M * D || ws_size < WS_END) { fprintf(stderr, "kernel_launch: unexpected shapes n_in %d out %d ws %zu\n", n_in, out_size, ws_size); grid = -1; return; }
        int dev = 0, cus = 0, per_cu = 0;
        if (hipGetDevice(&dev) != hipSuccess || hipDeviceGetAttribute(&cus, hipDeviceAttributeMultiprocessorCount, dev) != hipSuccess) { grid = -1; return; }
        if (hipFuncSetAttribute((const void*)mk_fwd, hipFuncAttributeMaxDynamicSharedMemorySize, LDS_BYTES) != hipSuccess) { fprintf(stderr, "kernel_launch: hipFuncSetAttribute failed\n"); grid = -1; return; }
        if (hipOccupancyMaxActiveBlocksPerMultiprocessor(&per_cu, (const void*)mk_fwd, NWAVES * 64, LDS_BYTES) != hipSuccess || per_cu < 1) fprintf(stderr, "kernel_launch: occupancy query says %d per CU\n", per_cu);
        (void)hipGetLastError();
        grid = cus;
        if (grid * 64 < M) { fprintf(stderr, "kernel_launch: %d CUs cannot cover %d rows in the one-block-per-workgroup phases\n", cus, M); grid = -1; return; }
    }
    if (grid < 0) return;
    unsigned char* ws = (unsigned char*)d_ws;
    if (hipMemsetAsync(ws + WS_CTL, 0, CTL_ZERO_BYTES, stream) != hipSuccess) { fprintf(stderr, "kernel_launch: memset failed\n"); return; }
    Args a{};
    for (int i = 0; i < 22; ++i) a.in[i] = (const float*)d_in[i];
    a.out = (float*)d_out; a.ws = ws; a.ph_lo = 0; a.ph_hi = N_PHASES; a.use_bar = 1;
    hipLaunchKernelGGL(mk_fwd, dim3(grid), dim3(NWAVES * 64), LDS_BYTES, stream, a);
}
```

```cpp
#include <hip/hip_runtime.h>
#include <cstdint>
#include <cstdio>

typedef unsigned short bf16_t;
constexpr int D = 1024, BATCH = 4, SEQ = 4096, M = BATCH * SEQ, NH = 8, HD = 64, SBW = 512, PW = 512, INW = 4096;
constexpr int NE = 64, ED = 128, TOPK = 8, SHD = 256;
constexpr float EPS = 1e-6f, RSCALE = 2.5f;

constexpr size_t MiB = 1u << 20;
constexpr size_t WS_CTL = 0, WS_MOD = 1 * MiB, WS_PE = 2 * MiB, WS_PW = 3 * MiB, WS_LIST = 4 * MiB;
constexpr size_t WS_XN = 74 * MiB, WS_OSB = 74 * MiB, WS_MIX = 90 * MiB, WS_H2 = 74 * MiB;
constexpr size_t WS_Q = 106 * MiB, WS_K = 122 * MiB, WS_V = 138 * MiB, WS_MERGED = 106 * MiB;
constexpr size_t WS_SLOT = 190 * MiB, WS_SH = 192 * MiB, WS_HM = 200 * MiB;
constexpr size_t WS_YH = 12 * MiB, WS_YSH = 156 * MiB;
constexpr size_t WS_U = 154 * MiB, WS_GA = 170 * MiB, WS_GB = 202 * MiB, WS_END = 256 * MiB;

__device__ __forceinline__ unsigned f2bf(float f) { unsigned u = __builtin_bit_cast(unsigned, f); return (u + 0x7fffu + ((u >> 16) & 1u)) >> 16; }
__device__ __forceinline__ float bf2f(unsigned h) { return __builtin_bit_cast(float, h << 16); }
__device__ __forceinline__ float wave_sum(float v) {
#pragma unroll
    for (int o = 1; o < 64; o <<= 1) v += __shfl_xor(v, o);
    return v;
}
__device__ __forceinline__ float sigmoidf_(float v) { return 1.f / (1.f + __expf(-v)); }
__device__ __forceinline__ float siluf_(float v) { return v / (1.f + __expf(-v)); }

namespace pg8 {
#define PG8_LAS __attribute__((address_space(3)))
typedef short bf16x8 __attribute__((ext_vector_type(8)));
typedef float f32x4 __attribute__((ext_vector_type(4)));
typedef unsigned u32x4 __attribute__((ext_vector_type(4)));
constexpr int BM = 256, BK = 64, HALF = 128, HTB = HALF * BK * 2  , STAGE_BYTES = 8 * HTB, NXCD = 8, WGM = 8;

__host__ __device__ __forceinline__ int lds_byte(int r, int c) { const int st = (r >> 4) * 2 + (c >> 5), rr = r & 15, cc = c & 31, ob = rr * 64 + cc * 2; return st * 1024 + (ob ^ (((ob >> 9) & 1) << 5)); }
__host__ __device__ __forceinline__ void stage_rc(int b, int& R, int& C) { const int st = b / 1024, sb = b % 1024, swz = sb ^ (((sb >> 9) & 1) << 5); R = (st >> 1) * 16 + swz / 64; C = (st & 1) * 32 + (swz % 64) / 2; }
__host__ __device__ __forceinline__ int perm32(int rho) { const int n = rho >> 4, i = rho & 15; return 8 * (i >> 2) + 4 * n + (i & 3); }

struct Unit { int pm, pn; };
struct Gemm { const bf16_t* A; const bf16_t* Bt; int M, N, K; };

struct StaticOrder {
    int nM, nN, nwg, G, c;
    __host__ __device__ void init(int M_, int N_, int G_, int c_) { nM = M_ / BM; nN = N_ / BM; nwg = nM * nN; G = G_; c = c_; }
    __host__ __device__ bool next(int i, Unit& u) const {
        const long L = (long)i * G + c; if (L >= nwg) return false;
        int wgid = (int)L; { const int q = nwg / NXCD, r = nwg % NXCD, xcd = wgid % NXCD, off = wgid / NXCD; wgid = (xcd < r ? xcd * (q + 1) : r * (q + 1) + (xcd - r) * q) + off; }
        const int nig = WGM * nN, gid = wgid / nig, fm = gid * WGM, gsz = (nM - fm) < WGM ? (nM - fm) : WGM;
        u.pm = fm + ((wgid % nig) % gsz); u.pn = (wgid % nig) / gsz; return true;
    }
    __device__ __forceinline__ void a_ready(const Unit&) const {}
    __device__ __forceinline__ void done(const Unit&) const {}
};
typedef float f32x2_t __attribute__((ext_vector_type(2))); typedef __bf16 bf16x2_t __attribute__((ext_vector_type(2)));
__device__ __forceinline__ unsigned cvt_pk_bf16(float lo, float hi) { f32x2_t v = {lo, hi}; bf16x2_t b = __builtin_convertvector(v, bf16x2_t); return __builtin_bit_cast(unsigned, b); }
__device__ __forceinline__ float fsigmoid(float v) { return __builtin_amdgcn_rcpf(1.f + __builtin_amdgcn_exp2f(-1.4426950408889634f * v)); }
constexpr float QSCALE = 0.125f * 1.4426950408889634f;

struct EpiProj {
    static constexpr bool PERM = true, AFTER_DRAIN = false;
    bf16_t *Q, *K, *V, *U, *GA, *GB; const float* gq; const float* gk;
    __device__ __forceinline__ void operator()(const f32x4 (&acc)[2][2][4][2], const Unit& u, int wr, int wc, int fr, int fq) const {
        const int row0 = u.pm * BM + wr * 64 + fr; const int sec = u.pn;
        if (sec < 4) {
            const bool isq = sec < 2; const float* g = isq ? gq : gk; bf16_t* base = (isq ? Q : K) + ((sec & 1) * 4 + wc) * 64 + 8 * fq;
            const float qs = isq ? QSCALE : 1.f;
            f32x4 gv[2][2];
#pragma unroll
            for (int bj = 0; bj < 2; ++bj)
#pragma unroll
                for (int n = 0; n < 2; ++n) gv[bj][n] = *(const f32x4*)(g + 32 * bj + 8 * fq + 4 * n);
#pragma unroll
            for (int ai = 0; ai < 2; ++ai)
#pragma unroll
                for (int m = 0; m < 4; ++m) {
                    float ss = 0.f;
#pragma unroll
                    for (int bj = 0; bj < 2; ++bj)
#pragma unroll
                        for (int n = 0; n < 2; ++n) { const f32x4 x = acc[ai][bj][m][n]; ss += (x[0] * x[0] + x[1] * x[1]) + (x[2] * x[2] + x[3] * x[3]); }
                    ss += __shfl_xor(ss, 16); ss += __shfl_xor(ss, 32);
                    const float r = rsqrtf(ss * (1.f / 64.f) + EPS) * qs;
                    bf16_t* rowp = base + (size_t)(row0 + ai * HALF + m * 16) * 512;
#pragma unroll
                    for (int bj = 0; bj < 2; ++bj) { const f32x4 v0 = acc[ai][bj][m][0] * gv[bj][0] * r, v1 = acc[ai][bj][m][1] * gv[bj][1] * r;
                        u32x4 w; w.x = cvt_pk_bf16(v0[0], v0[1]); w.y = cvt_pk_bf16(v0[2], v0[3]); w.z = cvt_pk_bf16(v1[0], v1[1]); w.w = cvt_pk_bf16(v1[2], v1[3]);
                        *(u32x4*)(rowp + 32 * bj) = w; }
                }
        } else if (sec < 8) {
            bf16_t* base = (sec < 6 ? V : U) + (sec & 1) * 256 + wc * 32 + 8 * fq;
#pragma unroll
            for (int ai = 0; ai < 2; ++ai)
#pragma unroll
                for (int m = 0; m < 4; ++m) { bf16_t* rowp = base + (size_t)(row0 + ai * HALF + m * 16) * 512;
#pragma unroll
                    for (int bj = 0; bj < 2; ++bj) { const f32x4 v0 = acc[ai][bj][m][0], v1 = acc[ai][bj][m][1];
                        u32x4 w; w.x = cvt_pk_bf16(v0[0], v0[1]); w.y = cvt_pk_bf16(v0[2], v0[3]); w.z = cvt_pk_bf16(v1[0], v1[1]); w.w = cvt_pk_bf16(v1[2], v1[3]);
                        *(u32x4*)(rowp + bj * HALF) = w; } }
        } else {
            bf16_t* base = (sec < 12 ? GA : GB) + ((sec - 8) & 3) * 256 + wc * 32 + 8 * fq;
#pragma unroll
            for (int ai = 0; ai < 2; ++ai)
#pragma unroll
                for (int m = 0; m < 4; ++m) { bf16_t* rowp = base + (size_t)(row0 + ai * HALF + m * 16) * 1024;
#pragma unroll
                    for (int bj = 0; bj < 2; ++bj) { const f32x4 v0 = acc[ai][bj][m][0], v1 = acc[ai][bj][m][1];
                        u32x4 w; w.x = cvt_pk_bf16(fsigmoid(v0[0]), fsigmoid(v0[1])); w.y = cvt_pk_bf16(fsigmoid(v0[2]), fsigmoid(v0[3])); w.z = cvt_pk_bf16(fsigmoid(v1[0]), fsigmoid(v1[1])); w.w = cvt_pk_bf16(fsigmoid(v1[2]), fsigmoid(v1[3]));
                        *(u32x4*)(rowp + bj * HALF) = w; } }
        }
    }
};

struct EpiMerge {
    static constexpr bool PERM = true, AFTER_DRAIN = false;
    const bf16_t* G; bf16_t* MG; int add;
    __device__ __forceinline__ void operator()(const f32x4 (&acc)[2][2][4][2], const Unit& u, int wr, int wc, int fr, int fq) const {
        const int row0 = u.pm * BM + wr * 64 + fr, col0 = u.pn * BM + wc * 32 + 8 * fq;
#pragma unroll
        for (int ai = 0; ai < 2; ++ai)
#pragma unroll
            for (int m = 0; m < 4; ++m) { const size_t off = (size_t)(row0 + ai * HALF + m * 16) * 1024 + col0;
#pragma unroll
                for (int bj = 0; bj < 2; ++bj) { const u32x4 g = *(const u32x4*)(G + off + bj * HALF); const f32x4 a0 = acc[ai][bj][m][0], a1 = acc[ai][bj][m][1];
                    float v[8] = {bf2f(g.x & 0xffffu) * a0[0], bf2f(g.x >> 16) * a0[1], bf2f(g.y & 0xffffu) * a0[2], bf2f(g.y >> 16) * a0[3], bf2f(g.z & 0xffffu) * a1[0], bf2f(g.z >> 16) * a1[1], bf2f(g.w & 0xffffu) * a1[2], bf2f(g.w >> 16) * a1[3]};
                    if (add) { const u32x4 o = *(const u32x4*)(MG + off + bj * HALF);
                        v[0] += bf2f(o.x & 0xffffu); v[1] += bf2f(o.x >> 16); v[2] += bf2f(o.y & 0xffffu); v[3] += bf2f(o.y >> 16); v[4] += bf2f(o.z & 0xffffu); v[5] += bf2f(o.z >> 16); v[6] += bf2f(o.w & 0xffffu); v[7] += bf2f(o.w >> 16); }
                    u32x4 w; w.x = cvt_pk_bf16(v[0], v[1]); w.y = cvt_pk_bf16(v[2], v[3]); w.z = cvt_pk_bf16(v[4], v[5]); w.w = cvt_pk_bf16(v[6], v[7]);
                    *(u32x4*)(MG + off + bj * HALF) = w; } }
    }
};
struct EpiX1 {
    static constexpr bool PERM = false, AFTER_DRAIN = false;
    const float* x; const float* gate; float* X1;
    __device__ __forceinline__ void operator()(const f32x4 (&acc)[2][2][4][2], const Unit& u, int wr, int wc, int fr, int fq) const {
        const int row0 = u.pm * BM + wr * 64 + fr, col0 = u.pn * BM + wc * 32 + 4 * fq; const int b = (u.pm * BM) / SEQ;
        f32x4 gv[2][2];
#pragma unroll
        for (int bj = 0; bj < 2; ++bj)
#pragma unroll
            for (int n = 0; n < 2; ++n) gv[bj][n] = *(const f32x4*)(gate + (size_t)b * 6 * D + col0 + bj * HALF + n * 16);
#pragma unroll
        for (int ai = 0; ai < 2; ++ai)
#pragma unroll
            for (int m = 0; m < 4; ++m) { const size_t off = (size_t)(row0 + ai * HALF + m * 16) * D + col0;
#pragma unroll
                for (int bj = 0; bj < 2; ++bj)
#pragma unroll
                    for (int n = 0; n < 2; ++n) *(f32x4*)(X1 + off + bj * HALF + n * 16) = *(const f32x4*)(x + off + bj * HALF + n * 16) + gv[bj][n] * acc[ai][bj][m][n]; }
    }
};

template <class Epi, class Sched, bool ALIGN_EPI = false, bool SP2 = false>
__device__ __forceinline__ void gemm_phase(PG8_LAS unsigned char* lds, const Gemm g, const Sched& S, const Epi& E) {
    int tid_ = threadIdx.x; asm volatile("" : "+v"(tid_));
    const int tid = tid_, wid = __builtin_amdgcn_readfirstlane(tid >> 6), lane = tid & 63, wr = wid >> 2, wc = wid & 3, fr = lane & 15, fq = lane >> 4;
    const int K = g.K, nt = K / BK;
    unsigned voffA[2], voffB[2];
#pragma unroll
    for (int i = 0; i < 2; ++i) { int R, C; stage_rc(tid * 16 + i * 8192, R, C); const int Rb = Epi::PERM ? ((R & ~31) + perm32(R & 31)) : R;
        voffA[i] = (unsigned)(R * K + C) * 2u; voffB[i] = (unsigned)(Rb * K + C) * 2u; }
    const size_t kstep = (size_t)(BK * 2);
    const size_t hstep = (size_t)HALF * K * 2;
    const size_t tstep = 2 * hstep;
    const unsigned ldsw = (unsigned)wid * 1024u;
    const int aoff = lds_byte(wr * 64 + fr, fq * 8), boff = lds_byte(wc * 32 + fr, fq * 8);
#define PG8_SA(b, h) (((b) * 2 + (h)) * HTB)
#define PG8_SB(b, h) ((4 + (b) * 2 + (h)) * HTB)
#define PG8_STAGE(bufoff, gbase, voff) do { _Pragma("unroll") for (int _i = 0; _i < 2; ++_i) \
        __builtin_amdgcn_global_load_lds((const unsigned*)((const char*)(gbase) + (voff)[_i]), (PG8_LAS unsigned*)(lds + (bufoff) + ldsw + _i * 8192), 16, 0, 0); } while (0)
#define PG8_LDA(dst, b, h) do { _Pragma("unroll") for (int m = 0; m < 4; ++m) _Pragma("unroll") for (int k = 0; k < 2; ++k) dst[m][k] = *(const PG8_LAS bf16x8*)(lds + PG8_SA(b, h) + aoff + m * 2048 + k * 1024); } while (0)
#define PG8_LDB(dst, b, h) do { _Pragma("unroll") for (int n = 0; n < 2; ++n) _Pragma("unroll") for (int k = 0; k < 2; ++k) dst[n][k] = *(const PG8_LAS bf16x8*)(lds + PG8_SB(b, h) + boff + n * 2048 + k * 1024); } while (0)
#define PG8_MMA(ai, bj, At, Bt) do { __builtin_amdgcn_s_setprio(1); _Pragma("unroll") for (int m = 0; m < 4; ++m) _Pragma("unroll") for (int n = 0; n < 2; ++n) _Pragma("unroll") for (int k = 0; k < 2; ++k) \
        acc[ai][bj][m][n] = __builtin_amdgcn_mfma_f32_16x16x32_bf16(Bt[n][k], At[m][k], acc[ai][bj][m][n], 0, 0, 0); __builtin_amdgcn_s_setprio(0); } while (0)
#define PG8_WAIT_V(n) asm volatile("s_waitcnt vmcnt(" #n ")" ::: "memory")
#define PG8_WAIT_L(n) asm volatile("s_waitcnt lgkmcnt(" #n ")" ::: "memory")
#define PG8_BAR __builtin_amdgcn_s_barrier()
#define PG8_SCHED __builtin_amdgcn_sched_barrier(0)
    Unit cur, nxt; int ui = 0;
    if (!S.next(0, cur)) return;
    f32x4 acc[2][2][4][2];
#pragma unroll
    for (int a = 0; a < 2; ++a)
#pragma unroll
        for (int b = 0; b < 2; ++b)
#pragma unroll
            for (int m = 0; m < 4; ++m)
#pragma unroll
                for (int n = 0; n < 2; ++n) acc[a][b][m][n] = (f32x4){0.f, 0.f, 0.f, 0.f};
    bf16x8 At[4][2], B0[2][2], B1[2][2];
    const char* cA = (const char*)g.A + (size_t)cur.pm * tstep; const char* cB = (const char*)g.Bt + (size_t)cur.pn * tstep;
    S.a_ready(cur);
    if constexpr (SP2) {
        PG8_STAGE(PG8_SB(0, 0), cB, voffB); PG8_STAGE(PG8_SB(0, 1), cB + hstep, voffB); PG8_STAGE(PG8_SA(0, 0), cA, voffA); PG8_STAGE(PG8_SA(0, 1), cA + hstep, voffA);
        if (wr == 1) PG8_BAR;
        PG8_WAIT_V(2); PG8_BAR;
        PG8_STAGE(PG8_SB(1, 0), cB + kstep, voffB); PG8_STAGE(PG8_SA(1, 0), cA + kstep, voffA); PG8_STAGE(PG8_SB(1, 1), cB + hstep + kstep, voffB);
        PG8_WAIT_V(6); PG8_BAR;
    } else {
        PG8_STAGE(PG8_SB(0, 0), cB, voffB); PG8_STAGE(PG8_SA(0, 0), cA, voffA); PG8_STAGE(PG8_SB(0, 1), cB + hstep, voffB); PG8_STAGE(PG8_SA(0, 1), cA + hstep, voffA);
        if (wr == 1) PG8_BAR;
        PG8_WAIT_V(4); PG8_BAR;
        PG8_STAGE(PG8_SB(1, 0), cB + kstep, voffB); PG8_STAGE(PG8_SA(1, 0), cA + kstep, voffA); PG8_STAGE(PG8_SB(1, 1), cB + hstep + kstep, voffB);
        PG8_WAIT_V(6); PG8_BAR;
    }
    for (;;) {
        const bool has_next = S.next(ui + 1, nxt);
        const char* nA = has_next ? (const char*)g.A + (size_t)nxt.pm * tstep : cA; const char* nB = has_next ? (const char*)g.Bt + (size_t)nxt.pn * tstep : cB;
#pragma nounroll
        for (int t = 0; t < nt; t += 2) {
            const bool last = (t == nt - 2);
            const char* a1 = cA + (size_t)(t + 1) * kstep;
            const char* a2 = last ? nA : cA + (size_t)(t + 2) * kstep; const char* b2 = last ? nB : cB + (size_t)(t + 2) * kstep;
            const char* a3 = a2 + kstep; const char* b3 = b2 + kstep;
            if (last && has_next) S.a_ready(nxt);
            if constexpr (SP2) {
            PG8_LDB(B0, 0, 0); PG8_LDB(B1, 0, 1); PG8_SCHED; PG8_LDA(At, 0, 0); PG8_STAGE(PG8_SA(1, 1), a1 + hstep, voffA);
            PG8_WAIT_V(8); PG8_WAIT_L(0); PG8_BAR; PG8_MMA(0, 0, At, B0); PG8_MMA(0, 1, At, B1); PG8_BAR; PG8_SCHED;
            PG8_LDA(At, 0, 1); PG8_STAGE(PG8_SB(0, 0), b2, voffB); PG8_STAGE(PG8_SB(0, 1), b2 + hstep, voffB); PG8_STAGE(PG8_SA(0, 0), a2, voffA);
            PG8_WAIT_V(8); PG8_WAIT_L(0); PG8_BAR; PG8_MMA(1, 0, At, B0); PG8_MMA(1, 1, At, B1); PG8_BAR; PG8_SCHED;
            PG8_LDB(B0, 1, 0); PG8_LDB(B1, 1, 1); PG8_SCHED; PG8_LDA(At, 1, 0); PG8_STAGE(PG8_SA(0, 1), a2 + hstep, voffA);
            PG8_WAIT_V(8); PG8_WAIT_L(0); PG8_BAR; PG8_MMA(0, 0, At, B0); PG8_MMA(0, 1, At, B1); PG8_BAR; PG8_SCHED;
            PG8_LDA(At, 1, 1); PG8_STAGE(PG8_SB(1, 0), b3, voffB); PG8_STAGE(PG8_SB(1, 1), b3 + hstep, voffB); PG8_STAGE(PG8_SA(1, 0), a3, voffA);
            PG8_WAIT_V(8); PG8_WAIT_L(0); PG8_BAR; PG8_MMA(1, 0, At, B0); PG8_MMA(1, 1, At, B1); PG8_BAR; PG8_SCHED;
            } else {
            PG8_LDB(B0, 0, 0); PG8_SCHED; PG8_LDA(At, 0, 0); PG8_STAGE(PG8_SA(1, 1), a1 + hstep, voffA);
            PG8_WAIT_L(8); PG8_BAR; PG8_WAIT_L(0); PG8_MMA(0, 0, At, B0); PG8_BAR; PG8_SCHED;
            PG8_LDB(B1, 0, 1); PG8_STAGE(PG8_SB(0, 0), b2, voffB);
            PG8_BAR; PG8_WAIT_L(0); PG8_MMA(0, 1, At, B1); PG8_BAR;
            PG8_LDA(At, 0, 1); PG8_STAGE(PG8_SA(0, 0), a2, voffA);
            PG8_BAR; PG8_WAIT_L(0); PG8_MMA(1, 0, At, B0); PG8_BAR; PG8_SCHED;
            PG8_STAGE(PG8_SB(0, 1), b2 + hstep, voffB);
            PG8_WAIT_V(6); PG8_BAR; PG8_MMA(1, 1, At, B1); PG8_BAR;
            PG8_LDB(B0, 1, 0); PG8_SCHED; PG8_LDA(At, 1, 0); PG8_STAGE(PG8_SA(0, 1), a2 + hstep, voffA);
            PG8_WAIT_L(8); PG8_BAR; PG8_WAIT_L(0); PG8_MMA(0, 0, At, B0); PG8_BAR; PG8_SCHED;
            PG8_LDB(B1, 1, 1); PG8_STAGE(PG8_SB(1, 0), b3, voffB);
            PG8_BAR; PG8_WAIT_L(0); PG8_MMA(0, 1, At, B1); PG8_BAR;
            PG8_LDA(At, 1, 1); PG8_STAGE(PG8_SA(1, 0), a3, voffA);
            PG8_BAR; PG8_WAIT_L(0); PG8_MMA(1, 0, At, B0); PG8_BAR; PG8_SCHED;
            PG8_STAGE(PG8_SB(1, 1), b3 + hstep, voffB);
            PG8_WAIT_V(6); PG8_BAR; PG8_MMA(1, 1, At, B1); PG8_BAR;
            }
        }
        if constexpr (ALIGN_EPI) { if (wr == 0) PG8_BAR; }
        if constexpr (!Epi::AFTER_DRAIN) { E(acc, cur, wr, wc, fr, fq); S.done(cur); }
        if (!has_next) break;
#pragma unroll
        for (int a = 0; a < 2; ++a)
#pragma unroll
            for (int b = 0; b < 2; ++b)
#pragma unroll
                for (int m = 0; m < 4; ++m)
#pragma unroll
                    for (int n = 0; n < 2; ++n) acc[a][b][m][n] = (f32x4){0.f, 0.f, 0.f, 0.f};
        cur = nxt; cA = nA; cB = nB; ++ui;
        if constexpr (ALIGN_EPI) { if (wr == 1) PG8_BAR; }
    }
    PG8_WAIT_V(0);
    if constexpr (!ALIGN_EPI) { if (wr == 0) PG8_BAR; }
    PG8_BAR;
    if constexpr (Epi::AFTER_DRAIN) { E.fused(acc, cur, wr, wc, fr, fq, lds, wid, lane); S.done(cur); }
#undef PG8_SA
#undef PG8_SB
#undef PG8_STAGE
#undef PG8_LDA
#undef PG8_LDB
#undef PG8_MMA
#undef PG8_WAIT_V
#undef PG8_WAIT_L
#undef PG8_BAR
#undef PG8_SCHED
}
}
using pg8::f32x4; using pg8::bf16x8;
#define GAS __attribute__((address_space(1)))
#define LAS __attribute__((address_space(3)))
typedef unsigned v4u __attribute__((ext_vector_type(4)));
typedef GAS unsigned gu32;
typedef GAS unsigned long long gu64;
#define RLX_AGENT __ATOMIC_RELAXED, __HIP_MEMORY_SCOPE_AGENT
#define LDS_WAIT() asm volatile("s_waitcnt lgkmcnt(0)" ::: "memory")
#define VM_WAIT() asm volatile("s_waitcnt vmcnt(0)" ::: "memory")
__device__ __forceinline__ unsigned long long rt() { return __builtin_amdgcn_s_memrealtime(); }
__device__ __forceinline__ unsigned pk2(float lo, float hi) { return pg8::cvt_pk_bf16(lo, hi); }

#define XB_TMO      128
#define XB_XCNT(j)  (256  + 64 * (j))
#define XB_XSUB(j)  (1280 + 64 * (j))
#define XB_XGEN(j)  (2304 + 64 * (j))
#define XB_TOP      3328
#define XB_TOPGEN   3392
#define XCD_BAR_WORDS 3456
#define XB_SPIN_CAP (1u << 18)

__device__ __forceinline__ unsigned xb_ld(unsigned* p)              { return __hip_atomic_load(p, __ATOMIC_RELAXED, __HIP_MEMORY_SCOPE_AGENT); }
__device__ __forceinline__ unsigned xb_add(unsigned* p, unsigned v) { return __hip_atomic_fetch_add(p, v, __ATOMIC_RELAXED, __HIP_MEMORY_SCOPE_AGENT); }
__device__ __forceinline__ unsigned xb_xcc_id() { return (unsigned)__builtin_amdgcn_s_getreg((3 << 11) | 20) & 0xFu; }
#define XB_SPIN(cond, bar) do { unsigned _sp = 0; while (cond) { __builtin_amdgcn_s_sleep(1); \
    if ((++_sp & 255u) == 0u) { if (xb_ld(&(bar)[XB_TMO])) break; if (_sp > XB_SPIN_CAP) { atomicAdd(&(bar)[XB_TMO], 1u); break; } } } } while (0)

struct XcdBarrier {
    unsigned* bar; unsigned x;
    volatile LAS unsigned* st;
};

__device__ __forceinline__ XcdBarrier xcd_barrier_post(unsigned* bar, volatile LAS unsigned* st) {
    XcdBarrier b; b.bar = bar; b.x = xb_xcc_id(); b.st = st;
    if (threadIdx.x == 0) (void)xb_add(&bar[XB_XCNT(b.x)], 1u);
    return b;
}
__device__ __forceinline__ void xcd_barrier_complete(unsigned* bar, unsigned x, unsigned& nloc, unsigned& nx) {
    const unsigned G = gridDim.x * gridDim.y * gridDim.z;
    unsigned sum, cnt, mine, sp = 0u;
    for (;;) {
        sum = 0u; cnt = 0u; mine = 0u;
#pragma unroll
        for (unsigned j = 0; j < 16; ++j) { const unsigned c = xb_ld(&bar[XB_XCNT(j)]); sum += c; cnt += (c > 0u) ? 1u : 0u; mine = (j == x) ? c : mine; }
        if (sum == G) break;
        __builtin_amdgcn_s_sleep(1);
        if ((++sp & 255u) == 0u) { if (xb_ld(&bar[XB_TMO])) break; if (sp > XB_SPIN_CAP) { atomicAdd(&bar[XB_TMO], 1u); break; } }
    }
    nloc = mine > 0u ? mine : 1u; nx = cnt > 0u ? cnt : 1u;
}

__device__ __forceinline__ void xcd_barrier(const XcdBarrier& b) {
    asm volatile("s_waitcnt vmcnt(0)" ::: "memory");
    __syncthreads();
    if (threadIdx.x == 0) {
        unsigned* bar = b.bar;
        __builtin_amdgcn_s_waitcnt(0);
        unsigned nloc = b.st[0], nx = b.st[1];
        if (nloc == 0u) { xcd_barrier_complete(bar, b.x, nloc, nx); b.st[0] = nloc; b.st[1] = nx; }
        const unsigned old = xb_add(&bar[XB_XSUB(b.x)], 1u);
        const unsigned gen = old / nloc;
        if (old + 1u == (gen + 1u) * nloc) {
            __builtin_amdgcn_fence(__ATOMIC_RELEASE, "agent");
            asm volatile("s_waitcnt vmcnt(0)" ::: "memory");
            const unsigned og = xb_add(&bar[XB_TOP], 1u);
            const unsigned tg = og / nx;
            if (og + 1u == (tg + 1u) * nx) xb_add(&bar[XB_TOPGEN], 1u);
            else XB_SPIN(xb_ld(&bar[XB_TOPGEN]) == tg, bar);
            __builtin_amdgcn_fence(__ATOMIC_ACQUIRE, "agent");
            xb_add(&bar[XB_XGEN(b.x)], 1u);
            asm volatile("s_waitcnt vmcnt(0)" ::: "memory");
        } else {
            XB_SPIN(xb_ld(&bar[XB_XGEN(b.x)]) == gen, bar);
            __builtin_amdgcn_fence(__ATOMIC_ACQUIRE, "agent");
            asm volatile("s_waitcnt vmcnt(0)" ::: "memory");
        }
    }
    __syncthreads();
}

constexpr int NWAVES = 8;
#ifndef DBL_PHASE
#define DBL_PHASE -1
#endif
constexpr size_t WS_MODP = 1 * MiB + 128 * 1024;
constexpr size_t WS_WIN = 12 * MiB, WS_WSB = 20 * MiB, WS_WEFF = 21 * MiB, WS_WOUT = 22 * MiB, WS_WGU = 24 * MiB;
constexpr size_t WS_WSHGU = 237 * MiB, WS_WD = 238 * MiB, WS_WSHD = 254 * MiB, WS_WRH = 254 * MiB + 512 * 1024, WS_WRL = WS_WRH + 128 * 1024;
constexpr size_t CTL_ZERO_BYTES = 256 * 1024;
constexpr int CW_TMO = 0, CW_CODE = 1, CW_BAR = 4096, CW_CNT = 16384, CW_ADA = 32768;
constexpr int RING_OFF = 0, RING_BYTES = 131072, AUX_OFF = RING_BYTES, LDS_BYTES = 163840, LDSCTL_OFF = LDS_BYTES - 1024, MISC_OFF = LDSCTL_OFF + 320;

struct Frame {
    LAS unsigned char* lds; volatile LAS unsigned* MISC; gu32* ctl;
    int tid, lane, wave, vcu, G;
};
struct Args { const float* in[22]; float* out; unsigned char* ws; int ph_lo, ph_hi, use_bar, pad; };

constexpr float W8SCALE = 512.f, H8SCALE = 16.f;
struct TItem { const float* W; bf16_t* dst; int ldw, ldk, k0, n0, perm, f8; };
__device__ __forceinline__ void titem_load(const TItem& t, f32x4 (&v)[8], int lane) {
    const int kr = lane >> 3, n4 = (lane & 7) * 4;
#pragma unroll
    for (int i = 0; i < 8; ++i) v[i] = *(const GAS f32x4*)(t.W + (size_t)(t.k0 + kr + 8 * i) * t.ldw + t.n0 + n4);
}
__device__ __forceinline__ void titem_store(const TItem& t, const f32x4 (&v)[8], LAS float* scr, int lane) {
    { const int kr = lane >> 3, n4 = (lane & 7) * 4;
#pragma unroll
      for (int i = 0; i < 8; ++i) { LAS float* d = scr + (kr + 8 * i) * 33 + n4; d[0] = v[i].x; d[1] = v[i].y; d[2] = v[i].z; d[3] = v[i].w; } }
    LDS_WAIT(); asm volatile("" ::: "memory");
    const int c = lane & 7;
#pragma unroll
    for (int j = 0; j < 4; ++j) { const int n = (lane >> 3) + 8 * j, drow = t.perm ? 128 * (j & 1) + 8 * (j >> 1) + (lane >> 3) : n; const LAS float* sp = scr + (8 * c) * 33 + n;
        if (t.f8) {
            unsigned lo = 0u, hi = 0u;
            lo = __builtin_amdgcn_cvt_pk_fp8_f32(sp[0 * 33] * W8SCALE, sp[1 * 33] * W8SCALE, lo, false); lo = __builtin_amdgcn_cvt_pk_fp8_f32(sp[2 * 33] * W8SCALE, sp[3 * 33] * W8SCALE, lo, true);
            hi = __builtin_amdgcn_cvt_pk_fp8_f32(sp[4 * 33] * W8SCALE, sp[5 * 33] * W8SCALE, hi, false); hi = __builtin_amdgcn_cvt_pk_fp8_f32(sp[6 * 33] * W8SCALE, sp[7 * 33] * W8SCALE, hi, true);
            *(GAS unsigned long long*)((GAS unsigned char*)t.dst + (size_t)drow * t.ldk + t.k0 + 8 * c) = (unsigned long long)lo | ((unsigned long long)hi << 32);
        } else {
        v4u o; o.x = pk2(sp[0 * 33], sp[1 * 33]); o.y = pk2(sp[2 * 33], sp[3 * 33]); o.z = pk2(sp[4 * 33], sp[5 * 33]); o.w = pk2(sp[6 * 33], sp[7 * 33]);
        *(GAS v4u*)(t.dst + (size_t)drow * t.ldk + t.k0 + 8 * c) = o; } }
    LDS_WAIT(); asm volatile("" ::: "memory");
}
__device__ __forceinline__ TItem titem_decode(int it, const Args& a, bool late) {
    unsigned char* ws = a.ws; TItem t; t.perm = 0; t.f8 = 0;
    constexpr int I_IN = 16 * 128, I_SB = 8 * 32, I_OUT = 16 * 32, I_EG = 64 * 64, I_EU = 64 * 64, I_ED = 64 * 64, I_SG = 16 * 8, I_SU = 16 * 8;
    int r = it;
    if (late) {
        if (r < I_ED) { const int e = r >> 6, q = r & 63, kb = q >> 5, nb = q & 31; t.W = a.in[18] + (size_t)e * ED * D; t.ldw = D; t.k0 = kb * 64; t.n0 = nb * 32;
            const int n0 = nb * 32, cl = n0 & 255; t.perm = 1; t.dst = (bf16_t*)(ws + WS_WD) + ((size_t)e * D + (n0 & ~255) + 32 * (cl >> 6) + 16 * ((cl >> 5) & 1)) * ED; t.ldk = ED; return t; } r -= I_ED;
        { const int kb = r >> 5, nb = r & 31; t.W = a.in[21]; t.ldw = D; t.k0 = kb * 64; t.n0 = nb * 32; t.dst = (bf16_t*)(ws + WS_WSHD) + (size_t)(nb * 32) * SHD; t.ldk = SHD; return t; } }
    if (r < I_IN) { const int kb = r >> 7, nb = r & 127, n0 = nb * 32; int d0 = n0;
        if (n0 < 1024) d0 = (n0 & ~255) + 128 * ((n0 >> 5) & 1) + 32 * ((n0 >> 6) & 3);
        t.W = a.in[5]; t.ldw = INW; t.k0 = kb * 64; t.n0 = n0; t.dst = (bf16_t*)(ws + WS_WIN) + (size_t)d0 * D; t.ldk = D; return t; } r -= I_IN;
    if (r < I_SB) { const int kb = r >> 5, nb = r & 31; t.W = a.in[8]; t.ldw = D; t.k0 = kb * 64; t.n0 = nb * 32; t.dst = (bf16_t*)(ws + WS_WSB) + (size_t)(nb * 32) * SBW; t.ldk = SBW; return t; } r -= I_SB;
    if (r < I_OUT) { const int kb = r >> 5, nb = r & 31; t.W = a.in[12]; t.ldw = D; t.k0 = kb * 64; t.n0 = nb * 32; t.dst = (bf16_t*)(ws + WS_WOUT) + (size_t)(nb * 32) * D; t.ldk = D; return t; } r -= I_OUT;
    if (r < I_EG) { const int e = r >> 6, q = r & 63, kb = q >> 2, nb = q & 3; t.W = a.in[16] + (size_t)e * D * ED; t.ldw = ED; t.k0 = kb * 64; t.n0 = nb * 32; t.f8 = 1; t.dst = (bf16_t*)(ws + WS_WGU + ((size_t)e * 256 + nb * 32) * D); t.ldk = D; return t; } r -= I_EG;
    if (r < I_EU) { const int e = r >> 6, q = r & 63, kb = q >> 2, nb = q & 3; t.W = a.in[17] + (size_t)e * D * ED; t.ldw = ED; t.k0 = kb * 64; t.n0 = nb * 32; t.f8 = 1; t.dst = (bf16_t*)(ws + WS_WGU + ((size_t)e * 256 + 128 + nb * 32) * D); t.ldk = D; return t; } r -= I_EU;
    if (r < I_SG) { const int kb = r >> 3, nb = r & 7, n0 = nb * 32; t.W = a.in[19]; t.ldw = SHD; t.k0 = kb * 64; t.n0 = n0; t.f8 = 1; t.dst = (bf16_t*)(ws + WS_WSHGU + (size_t)((n0 >> 7) * 256 + (n0 & 127)) * D); t.ldk = D; return t; } r -= I_SG;
    { const int kb = r >> 3, nb = r & 7, n0 = nb * 32; t.W = a.in[20]; t.ldw = SHD; t.k0 = kb * 64; t.n0 = n0; t.f8 = 1; t.dst = (bf16_t*)(ws + WS_WSHGU + (size_t)((n0 >> 7) * 256 + 128 + (n0 & 127)) * D); t.ldk = D; return t; }
}

__device__ __forceinline__ void titem_run(Frame& F, const Args& a, bool late, int nitems, int first, int stride) {
    LAS float* scr = (LAS float*)(F.lds + RING_OFF + F.wave * 16384); const int lane = F.lane;
    f32x4 va[8], vb[8]; TItem cur, nxt; int it = first;
    if (it < nitems) { cur = titem_decode(it, a, late); titem_load(cur, va, lane); }
    for (; it < nitems; it += 2 * stride) {
        const bool h1 = it + stride < nitems, h2 = it + 2 * stride < nitems;
        if (h1) { nxt = titem_decode(it + stride, a, late); titem_load(nxt, vb, lane); }
        titem_store(cur, va, scr, lane);
        if (h2) { cur = titem_decode(it + 2 * stride, a, late); titem_load(cur, va, lane); }
        if (h1) titem_store(nxt, vb, scr, lane);
    }
}

__device__ __forceinline__ void p0a(Frame& F, const Args& a) {
    unsigned char* ws = a.ws;
    const int gw = F.vcu * NWAVES + F.wave, NGW = F.G * NWAVES, lane = F.lane;
    LAS float* silu = (LAS float*)(F.lds + RING_OFF + 98304);
    { const float* c = a.in[1]; for (int i = F.tid; i < 4 * D; i += NWAVES * 64) silu[i] = siluf_(c[i]); }
    if (F.G == 256) { const float* wg = a.in[9]; const float* ps = a.in[10]; const float* wpo = a.in[11]; bf16_t* WE = (bf16_t*)(ws + WS_WEFF);
        const int g = F.vcu >> 6, nb = (F.vcu & 63) * 16;
        LAS float* wgt = (LAS float*)(F.lds + RING_OFF);
        LAS float* slab = (LAS float*)(F.lds + RING_OFF + 68 * 1024);
        for (int i = F.tid; i < 128 * 128; i += NWAVES * 64) { const int cc = i >> 7, d = i & 127; wgt[d * 129 + cc] = wg[(size_t)g * 16384 + i]; }
        { const int d = F.tid >> 2, q = (F.tid & 3) * 4; const f32x4 w4 = *(const GAS f32x4*)(wpo + (size_t)(g * 128 + d) * D + nb + q) * ps[g * 128 + d]; *(LAS f32x4*)(slab + d * 16 + q) = w4; }
        __syncthreads();
        const int cc = F.tid & 127, nq = (F.tid >> 7) * 4; f32x4 acc4 = {0.f, 0.f, 0.f, 0.f};
#pragma unroll 8
        for (int d = 0; d < 128; ++d) acc4 += wgt[d * 129 + cc] * *(const LAS f32x4*)(slab + d * 16 + nq);
#pragma unroll
        for (int j = 0; j < 4; ++j) WE[(size_t)(nb + nq + j) * PW + g * 128 + cc] = (bf16_t)f2bf(acc4[j]);
    }
    __syncthreads();
    { const float* w_ada = a.in[2]; float* MODP = (float*)(ws + WS_MODP); LAS float* red = (LAS float*)(F.lds + RING_OFF);
      for (int it = F.vcu; it < 96 * 8; it += F.G) { const int cg = it % 96, ks = it / 96, k0 = ks * 128 + F.wave * 16;
          const float* w = w_ada + (size_t)k0 * (6 * D) + cg * 64 + lane;
          float wv[16];
#pragma unroll
          for (int k = 0; k < 16; ++k) wv[k] = w[(size_t)k * (6 * D)];
          float a0 = 0.f, a1 = 0.f, a2 = 0.f, a3 = 0.f;
#pragma unroll
          for (int k = 0; k < 16; ++k) { const int kk = k0 + k; a0 += silu[kk] * wv[k]; a1 += silu[D + kk] * wv[k]; a2 += silu[2 * D + kk] * wv[k]; a3 += silu[3 * D + kk] * wv[k]; }
          LAS float* rw = red + F.wave * 256 + lane; rw[0] = a0; rw[64] = a1; rw[128] = a2; rw[192] = a3;
          __syncthreads();
          if (F.tid < 256) { float v = 0.f;
#pragma unroll
              for (int w8 = 0; w8 < 8; ++w8) v += red[w8 * 256 + F.tid];
              MODP[(size_t)(ks * 4 + (F.tid >> 6)) * 6 * D + cg * 64 + (F.tid & 63)] = v; }
          __syncthreads(); }
      if (F.tid == 0) { __builtin_amdgcn_fence(__ATOMIC_RELEASE, "agent"); asm volatile("s_waitcnt vmcnt(0)" ::: "memory"); (void)xb_add((unsigned*)(F.ctl + CW_ADA), 1u); } }
    __syncthreads();
    titem_run(F, a, false, 16 * 128 + 8 * 32 + 16 * 32 + 2 * 64 * 64 + 2 * 16 * 8, gw, NGW);
    { const float* wr = a.in[14]; bf16_t* WH = (bf16_t*)(ws + WS_WRH); bf16_t* WL = (bf16_t*)(ws + WS_WRL);
      for (int i = (F.vcu * NWAVES * 64 + F.tid); i < D * NE; i += F.G * NWAVES * 64) { const int e = i >> 10, k = i & 1023; const float v = wr[k * NE + e];
          const int pos = ((((k >> 4) * 2 + (e >> 5)) * 64) + 32 * ((k >> 3) & 1) + (e & 31)) * 8 + (k & 7);
          const unsigned h = f2bf(v); WH[pos] = (bf16_t)h; WL[pos] = (bf16_t)f2bf(v - bf2f(h)); } }
}
__device__ __forceinline__ void p0b(Frame& F, const Args& a) {
    unsigned char* ws = a.ws; const float* MODP = (const float*)(ws + WS_MODP); const float* b_ada = a.in[3];
    if (F.tid == 0) { unsigned* bar_ = (unsigned*)(F.ctl + CW_BAR); XB_SPIN(xb_ld((unsigned*)(F.ctl + CW_ADA)) < (unsigned)F.G, bar_);
        __builtin_amdgcn_fence(__ATOMIC_ACQUIRE, "agent"); asm volatile("s_waitcnt vmcnt(0)" ::: "memory"); }
    __syncthreads();
    if (F.tid < 96) { const int idx = 96 * F.vcu + F.tid, b = idx / (6 * D), j = idx % (6 * D); float v = b_ada[j];
#pragma unroll
        for (int ks = 0; ks < 8; ++ks) v += MODP[(size_t)(ks * 4 + b) * 6 * D + j];
        ((float*)(ws + WS_MOD))[idx] = v; }
    const int rows_per = M / F.G, r0 = F.vcu * rows_per, b = r0 / SEQ;
    LAS float* gsv = (LAS float*)(F.lds + RING_OFF); LAS float* shv = gsv + D;
    for (int k = F.tid; k < D; k += NWAVES * 64) { float sh = b_ada[k], sc = b_ada[D + k];
#pragma unroll
        for (int ks = 0; ks < 8; ++ks) { sh += MODP[(size_t)(ks * 4 + b) * 6 * D + k]; sc += MODP[(size_t)(ks * 4 + b) * 6 * D + D + k]; }
        gsv[k] = a.in[4][k] * (1.f + sc); shv[k] = sh; }
    __syncthreads();
    const float* x = a.in[0]; bf16_t* XN = (bf16_t*)(ws + WS_XN);
    for (int i = F.wave; i < rows_per; i += NWAVES) { const int row = r0 + i;
        const GAS f32x4* xr = (const GAS f32x4*)(x + (size_t)row * D) + F.lane;
        f32x4 v[4]; float s = 0.f;
#pragma unroll
        for (int j = 0; j < 4; ++j) { v[j] = xr[64 * j]; s += (v[j].x * v[j].x + v[j].y * v[j].y) + (v[j].z * v[j].z + v[j].w * v[j].w); }
        const float r = rsqrtf(wave_sum(s) * (1.f / D) + EPS);
        GAS unsigned long long* o8 = (GAS unsigned long long*)(XN + (size_t)row * D) + F.lane;
#pragma unroll
        for (int j = 0; j < 4; ++j) { const f32x4 gg = *(const LAS f32x4*)(gsv + 4 * F.lane + 256 * j), ss = *(const LAS f32x4*)(shv + 4 * F.lane + 256 * j);
            const f32x4 h = v[j] * r * gg + ss;
            o8[64 * j] = (unsigned long long)pk2(h.x, h.y) | ((unsigned long long)pk2(h.z, h.w) << 32); } }
    __syncthreads();
}

namespace sb {
using pg8::bf16x8; using pg8::f32x4; typedef float f32x16 __attribute__((ext_vector_type(16))); typedef short v4i16_t __attribute__((ext_vector_type(4)));
typedef short s16x4 __attribute__((ext_vector_type(4)));
constexpr int VPITCH = 128, VBYTES = 64 * VPITCH, WAVE_LDS = 2 * VBYTES;
constexpr float EXIT_THR = -152.f;
__device__ __forceinline__ int crow(int r, int hi) { return (r & 3) + 8 * (r >> 2) + 4 * hi; }
__device__ __forceinline__ s16x4 vtr(LAS const unsigned char* p) { return __builtin_bit_cast(s16x4, __builtin_amdgcn_ds_read_tr16_b64_v4i16((LAS v4i16_t*)p)); }
__device__ __forceinline__ unsigned pkbf(float lo, float hi) { return pg8::cvt_pk_bf16(lo, hi); }

__device__ __forceinline__ void attn_unit(int b, int h, int qb, const bf16_t* Q, const bf16_t* K, const bf16_t* V, bf16_t* O, LAS unsigned char* vlds, int wid, int lane) {
    const int r32 = lane & 31, hi = lane >> 5;
    const int t0 = qb * 256 + wid * 32;
    const size_t rowbase = (size_t)b * SEQ;
    const bf16_t* Kh = K + rowbase * 512 + h * 64; const bf16_t* Vh = V + rowbase * 512 + h * 64;
    bf16x8 qr[4];
#pragma unroll
    for (int d0 = 0; d0 < 4; ++d0) qr[d0] = *(const bf16x8*)(Q + (rowbase + t0 + r32) * 512 + h * 64 + d0 * 16 + hi * 8);
    f32x16 o0 = {}, o1 = {};
    float carry = 0.f;
    int kt = t0 >> 6;
    bf16x8 kf[8];
#define SB_LOADK(KT) do { const int kb_ = (KT) * 64; \
        _Pragma("unroll") for (int d0 = 0; d0 < 4; ++d0) { kf[2 * d0] = *(const bf16x8*)(Kh + (size_t)(kb_ + r32) * 512 + d0 * 16 + hi * 8); kf[2 * d0 + 1] = *(const bf16x8*)(Kh + (size_t)(kb_ + 32 + r32) * 512 + d0 * 16 + hi * 8); } } while (0)
#define SB_DMAV(KT, BUF) do { const int kb_ = (KT) * 64; \
        _Pragma("unroll") for (int i = 0; i < 8; ++i) __builtin_amdgcn_global_load_lds((const unsigned*)(Vh + (size_t)(kb_ + 8 * i + (lane >> 3)) * 512 + (lane & 7) * 8), (LAS unsigned*)(vlds + (BUF) * VBYTES + i * 1024), 16, 0, 0); } while (0)
    int cur = 0;
    SB_DMAV(kt, 0);
    SB_LOADK(kt);
    const int trbase = (4 * hi + ((lane & 15) >> 2)) * VPITCH + (16 * ((lane >> 4) & 1) + 4 * (lane & 3)) * 2;
    bool diag = true;
    for (;; --kt) {
        const int kbase = kt * 64;
        f32x16 p0 = {}, p1 = {};
#pragma unroll
        for (int d0 = 0; d0 < 4; ++d0) { p0 = __builtin_amdgcn_mfma_f32_32x32x16_bf16(kf[2 * d0], qr[d0], p0, 0, 0, 0); p1 = __builtin_amdgcn_mfma_f32_32x32x16_bf16(kf[2 * d0 + 1], qr[d0], p1, 0, 0, 0); }
        asm volatile("" ::: "memory");
        if (kt > 0) { SB_DMAV(kt - 1, cur ^ 1); SB_LOADK(kt - 1); }
        asm volatile("" ::: "memory");
        bf16x8 pa[4]; float suf = 0.f;
        const int qrel = t0 + r32 - kbase;
#define SB_HALF(P, KOFF, PA0, PA1) do { f32x16 sp_; \
        _Pragma("unroll") for (int r = 0; r < 16; ++r) sp_[r] = __builtin_amdgcn_logf(1.f + __builtin_amdgcn_exp2f(P[r])); \
        if (diag) { _Pragma("unroll") for (int r = 0; r < 16; ++r) if (crow(r, hi) + (KOFF) >= qrel) sp_[r] = 0.f; } \
        float e_[4], og_[4], R_[4]; \
        _Pragma("unroll") for (int c = 0; c < 4; ++c) { sp_[4 * c + 2] += sp_[4 * c + 3]; sp_[4 * c + 1] += sp_[4 * c + 2]; sp_[4 * c] += sp_[4 * c + 1]; e_[c] = sp_[4 * c]; } \
        _Pragma("unroll") for (int c = 0; c < 4; ++c) og_[c] = __shfl_xor(e_[c], 32); \
        _Pragma("unroll") for (int c = 3; c >= 0; --c) { R_[c] = carry - (suf + (hi == 0 ? og_[c] : 0.f)); suf += e_[c] + og_[c]; } \
        _Pragma("unroll") for (int r = 0; r < 16; ++r) P[r] = __builtin_amdgcn_exp2f(P[r] - sp_[r] + R_[r >> 2]); \
        if (diag) { _Pragma("unroll") for (int r = 0; r < 16; ++r) if (crow(r, hi) + (KOFF) >= qrel) P[r] = 0.f; } \
        pg8::u32x4 w_; w_.x = pkbf(P[0], P[1]); w_.y = pkbf(P[2], P[3]); w_.z = pkbf(P[4], P[5]); w_.w = pkbf(P[6], P[7]); PA0 = __builtin_bit_cast(bf16x8, w_); \
        w_.x = pkbf(P[8], P[9]); w_.y = pkbf(P[10], P[11]); w_.z = pkbf(P[12], P[13]); w_.w = pkbf(P[14], P[15]); PA1 = __builtin_bit_cast(bf16x8, w_); } while (0)
        SB_HALF(p1, 32, pa[2], pa[3]);
        SB_HALF(p0, 0, pa[0], pa[1]);
#undef SB_HALF
        carry -= suf;
        diag = false;
        if (kt > 0) asm volatile("s_waitcnt vmcnt(16)" ::: "memory"); else asm volatile("s_waitcnt vmcnt(0)" ::: "memory");
        LAS const unsigned char* vb = vlds + cur * VBYTES + trbase;
#pragma unroll
        for (int s = 0; s < 4; ++s) {
            LAS const unsigned char* vp = vb + (16 * s) * VPITCH;
            const s16x4 a0 = vtr(vp), a1 = vtr(vp + 8 * VPITCH), b0 = vtr(vp + 64), b1 = vtr(vp + 8 * VPITCH + 64);
            const bf16x8 v0 = {a0[0], a0[1], a0[2], a0[3], a1[0], a1[1], a1[2], a1[3]}, v1 = {b0[0], b0[1], b0[2], b0[3], b1[0], b1[1], b1[2], b1[3]};
            o0 = __builtin_amdgcn_mfma_f32_32x32x16_bf16(pa[s], v0, o0, 0, 0, 0);
            o1 = __builtin_amdgcn_mfma_f32_32x32x16_bf16(pa[s], v1, o1, 0, 0, 0);
        }
        asm volatile("s_waitcnt lgkmcnt(0)" ::: "memory");
        cur ^= 1;
        if (kt == 0 || __all(carry < EXIT_THR)) break;
    }
    asm volatile("s_waitcnt vmcnt(0)" ::: "memory");
#undef SB_LOADK
#undef SB_DMAV
    bf16_t* Ow = O + (rowbase + t0) * 512 + h * 64 + r32;
#pragma unroll
    for (int r = 0; r < 16; ++r) { const int q = crow(r, hi); Ow[(size_t)q * 512] = (bf16_t)f2bf(o0[r]); Ow[(size_t)q * 512 + 32] = (bf16_t)f2bf(o1[r]); }
}
}

__device__ __forceinline__ void p2_pool(Frame& F, const bf16_t* U, bf16_t* MIX) {
    const int rows_per = M / F.G; const int col8 = F.lane, w = 2 << (col8 >> 4);
    for (int rb = F.wave * 8; rb < rows_per; rb += NWAVES * 8) { const int t0 = F.vcu * rows_per + rb;
        v4u ld[23];
#pragma unroll
        for (int i = 0; i < 23; ++i) ld[i] = *(const GAS v4u*)(U + ((long)(t0 - 15 + i)) * PW + col8 * 8);
#pragma unroll
        for (int r = 0; r < 8; ++r) { const int tl = (t0 + r) % SEQ; const int cnt = (tl + 1) < w ? (tl + 1) : w;
            float acc[8];
#pragma unroll
            for (int j = 0; j < 8; ++j) acc[j] = 0.f;
#pragma unroll
            for (int i = 0; i < 16; ++i) { const v4u u = ld[15 + r - i]; const float m = (i < cnt) ? 1.f : 0.f;
                acc[0] += m * bf2f(u.x & 0xffffu); acc[1] += m * bf2f(u.x >> 16); acc[2] += m * bf2f(u.y & 0xffffu); acc[3] += m * bf2f(u.y >> 16);
                acc[4] += m * bf2f(u.z & 0xffffu); acc[5] += m * bf2f(u.z >> 16); acc[6] += m * bf2f(u.w & 0xffffu); acc[7] += m * bf2f(u.w >> 16); }
            const float inv = 1.f / (float)cnt; const v4u self = ld[15 + r];
            v4u o; o.x = pk2(acc[0] * inv - bf2f(self.x & 0xffffu), acc[1] * inv - bf2f(self.x >> 16)); o.y = pk2(acc[2] * inv - bf2f(self.y & 0xffffu), acc[3] * inv - bf2f(self.y >> 16));
            o.z = pk2(acc[4] * inv - bf2f(self.z & 0xffffu), acc[5] * inv - bf2f(self.z >> 16)); o.w = pk2(acc[6] * inv - bf2f(self.w & 0xffffu), acc[7] * inv - bf2f(self.w >> 16));
            *(GAS v4u*)(MIX + (size_t)(t0 + r) * PW + col8 * 8) = o; } }
}

constexpr int P5_TAB = AUX_OFF + 2048;
constexpr int P5_CNT = AUX_OFF + 1024;
constexpr int LIST_CAP = 16384;
typedef float f32x16 __attribute__((ext_vector_type(16)));
__device__ __forceinline__ void p5_route(Frame& F, const Args& a) {
    unsigned char* ws = a.ws; const float* X1 = a.out; const float* g2 = a.in[13]; const float* mod = (const float*)(ws + WS_MOD); const float* rbias = a.in[15];
    unsigned char* H2 = ws + WS_H2; int* PE = (int*)(ws + WS_PE);
    const bf16_t* WH = (const bf16_t*)(ws + WS_WRH); const bf16_t* WL = (const bf16_t*)(ws + WS_WRL);
    unsigned long long* LIST = (unsigned long long*)(ws + WS_LIST); gu32* gcnt = F.ctl + CW_CNT;
    LAS unsigned char* Ahi = F.lds + RING_OFF; LAS unsigned char* Alo = Ahi + 65536; LAS float* part = (LAS float*)Ahi;
    LAS float* gsv = (LAS float*)(F.lds + P5_TAB); LAS float* shv = gsv + D; LAS unsigned* cnt_l = (LAS unsigned*)(F.lds + P5_CNT); LAS unsigned* base_l = cnt_l + 64; LAS float* rr = (LAS float*)(base_l + 64);
    const int lane = F.lane, wave = __builtin_amdgcn_readfirstlane(F.wave), r32 = lane & 31, hi = lane >> 5;
    const int row0 = F.vcu * 64;
    if (row0 < M) {
        const int b = row0 / SEQ;
        for (int k = F.tid; k < D; k += NWAVES * 64) { gsv[k] = g2[k] * (1.f + mod[b * 6 * D + 4 * D + k]); shv[k] = mod[b * 6 * D + 3 * D + k]; }
        if (F.tid < 64) cnt_l[F.tid] = 0u;
        { f32x4 v[8][4];
#pragma unroll
          for (int i = 0; i < 8; ++i) { const GAS f32x4* xr = (const GAS f32x4*)(X1 + (size_t)(row0 + 8 * wave + i) * D) + lane;
#pragma unroll
              for (int j = 0; j < 4; ++j) v[i][j] = xr[64 * j]; }
#pragma unroll
          for (int i = 0; i < 8; ++i) { float s = 0.f;
#pragma unroll
              for (int j = 0; j < 4; ++j) s += (v[i][j].x * v[i][j].x + v[i][j].y * v[i][j].y) + (v[i][j].z * v[i][j].z + v[i][j].w * v[i][j].w);
              s = wave_sum(s); if (lane == 0) rr[8 * wave + i] = rsqrtf(s * (1.f / D) + EPS); } }
        __syncthreads();
        f32x16 acc[2][2];
        const char* whb = (const char*)WH + wave * 8192; const char* wlb = (const char*)WL + wave * 8192;
#pragma unroll
        for (int x = 0; x < 2; ++x)
#pragma unroll
            for (int y = 0; y < 2; ++y) acc[x][y] = f32x16{};
#pragma unroll
        for (int kh = 0; kh < 2; ++kh) {
            bf16x8 bh[4][2], bl[4][2];
#pragma unroll
            for (int s4 = 0; s4 < 4; ++s4)
#pragma unroll
                for (int t = 0; t < 2; ++t) { const int fo = kh * 65536 + (s4 * 2 + t) * 1024;
                    bh[s4][t] = *(const bf16x8*)(whb + fo + lane * 16); bl[s4][t] = *(const bf16x8*)(wlb + fo + lane * 16); }
#pragma unroll
            for (int i = 0; i < 8; ++i) { const int rl = 8 * wave + i, row = row0 + rl; const float r = rr[rl];
                if ((i & 1) == 0) __builtin_amdgcn_sched_barrier(0);
                const GAS f32x4* xr = (const GAS f32x4*)(X1 + (size_t)row * D + 512 * kh) + lane;
                GAS unsigned* o4 = (GAS unsigned*)(H2 + (size_t)row * D + 512 * kh) + lane;
#pragma unroll
                for (int j = 0; j < 2; ++j) { const f32x4 xv = xr[64 * j];
                    const f32x4 gg = *(const LAS f32x4*)(gsv + 512 * kh + 4 * lane + 256 * j), ss = *(const LAS f32x4*)(shv + 512 * kh + 4 * lane + 256 * j);
                    const f32x4 h = xv * r * gg + ss;
                    const unsigned p01 = pk2(h.x, h.y), p23 = pk2(h.z, h.w);
                    const unsigned long long hh = (unsigned long long)p01 | ((unsigned long long)p23 << 32);
                    { const f32x4 h8 = h * H8SCALE; unsigned q8 = 0u;
                      q8 = __builtin_amdgcn_cvt_pk_fp8_f32(__builtin_amdgcn_fmed3f(h8.x, -448.f, 448.f), __builtin_amdgcn_fmed3f(h8.y, -448.f, 448.f), q8, false);
                      q8 = __builtin_amdgcn_cvt_pk_fp8_f32(__builtin_amdgcn_fmed3f(h8.z, -448.f, 448.f), __builtin_amdgcn_fmed3f(h8.w, -448.f, 448.f), q8, true);
                      o4[64 * j] = q8; }
                    const unsigned long long ll = (unsigned long long)pk2(h.x - __builtin_bit_cast(float, p01 << 16), h.y - __builtin_bit_cast(float, p01 & 0xffff0000u))
                                                | ((unsigned long long)pk2(h.z - __builtin_bit_cast(float, p23 << 16), h.w - __builtin_bit_cast(float, p23 & 0xffff0000u)) << 32);
                    const int chunk = (lane >> 1) + 32 * j, off = rl * 1024 + ((chunk ^ (rl & 15)) << 4) + ((lane & 1) << 3);
                    *(LAS unsigned long long*)(Ahi + off) = hh; *(LAS unsigned long long*)(Alo + off) = ll; } }
            __syncthreads();
#pragma unroll
            for (int s4 = 0; s4 < 4; ++s4) { const int chunk = 8 * wave + 2 * s4 + hi;
                const bf16x8 bh0 = bh[s4][0], bh1 = bh[s4][1], bl0 = bl[s4][0], bl1 = bl[s4][1];
#pragma unroll
                for (int x = 0; x < 2; ++x) { const int rw = 32 * x + r32, off = rw * 1024 + ((chunk ^ (rw & 15)) << 4);
                    const bf16x8 ah = *(const LAS bf16x8*)(Ahi + off), al = *(const LAS bf16x8*)(Alo + off);
                    acc[x][0] = __builtin_amdgcn_mfma_f32_32x32x16_bf16(ah, bh0, acc[x][0], 0, 0, 0); acc[x][1] = __builtin_amdgcn_mfma_f32_32x32x16_bf16(ah, bh1, acc[x][1], 0, 0, 0);
                    acc[x][0] = __builtin_amdgcn_mfma_f32_32x32x16_bf16(al, bh0, acc[x][0], 0, 0, 0); acc[x][1] = __builtin_amdgcn_mfma_f32_32x32x16_bf16(al, bh1, acc[x][1], 0, 0, 0);
                    acc[x][0] = __builtin_amdgcn_mfma_f32_32x32x16_bf16(ah, bl0, acc[x][0], 0, 0, 0); acc[x][1] = __builtin_amdgcn_mfma_f32_32x32x16_bf16(ah, bl1, acc[x][1], 0, 0, 0); } }
            __syncthreads();
        }
#pragma unroll
        for (int x = 0; x < 2; ++x)
#pragma unroll
            for (int r = 0; r < 16; ++r) { const int rw = 32 * x + (r & 3) + 8 * (r >> 2) + 4 * hi; part[wave * 4096 + rw * 64 + r32] = acc[x][0][r]; part[wave * 4096 + rw * 64 + 32 + r32] = acc[x][1][r]; }
        __syncthreads();
        float scq[8];
#pragma unroll
        for (int q = 0; q < 8; ++q) { const int rl = wave + 8 * q; float logit = 0.f;
#pragma unroll
            for (int w = 0; w < 8; ++w) logit += part[w * 4096 + rl * 64 + lane];
            scq[q] = 1.f / (1.f + expf(-logit)); }
        __syncthreads();
        LAS float* scoreT = (LAS float*)(F.lds + RING_OFF);
#pragma unroll
        for (int q = 0; q < 8; ++q) scoreT[lane * 65 + wave + 8 * q] = scq[q];
        __syncthreads();
        if (wave == 0) {
            float sel[64];
#pragma unroll
            for (int e = 0; e < 64; ++e) sel[e] = scoreT[e * 65 + lane] + rbias[e];
            float gs[8];
#pragma unroll
            for (int g = 0; g < 8; ++g) { float m1 = sel[8 * g], m2 = -INFINITY;
#pragma unroll
                for (int j = 1; j < 8; ++j) { const float v = sel[8 * g + j]; const float lo = fminf(m1, v); m1 = fmaxf(m1, v); m2 = fmaxf(m2, lo); }
                gs[g] = m1 + m2; }
            unsigned gmask = 0u;
#pragma unroll
            for (int g = 0; g < 8; ++g) { int rk = 0;
#pragma unroll
                for (int h = 0; h < 8; ++h) if (h != g) rk += (gs[h] > gs[g] || (gs[h] == gs[g] && h < g)) ? 1 : 0;
                gmask |= (rk < 4) ? (1u << g) : 0u; }
#pragma unroll
            for (int e = 0; e < 64; ++e) sel[e] = ((gmask >> (e >> 3)) & 1u) ? sel[e] : -INFINITY;
            unsigned long long taken = 0ull; int ex[8]; float ws_[8]; float wsum = 0.f;
#pragma unroll
            for (int r = 0; r < TOPK; ++r) { float best = -INFINITY; int bi = 0;
#pragma unroll
                for (int e = 0; e < 64; ++e) { const bool c = !((taken >> e) & 1ull) && sel[e] > best; best = c ? sel[e] : best; bi = c ? e : bi; }
                taken |= 1ull << bi; ex[r] = bi; ws_[r] = scoreT[bi * 65 + lane]; wsum += ws_[r]; }
            const float wn = RSCALE / wsum;
#pragma unroll
            for (int r = 0; r < TOPK; ++r) { const unsigned pos = __hip_atomic_fetch_add(cnt_l + ex[r], 1u, __ATOMIC_RELAXED, __HIP_MEMORY_SCOPE_WORKGROUP);
                LAS unsigned* pk = (LAS unsigned*)(F.lds + RING_OFF + 32768) + (lane * 8 + r) * 4; pk[0] = (unsigned)ex[r]; pk[1] = pos; pk[2] = __builtin_bit_cast(unsigned, ws_[r] * wn); }
        }
        __syncthreads();
        if (F.tid < 64) base_l[F.tid] = __hip_atomic_fetch_add(gcnt + 64 * F.tid, cnt_l[F.tid], __ATOMIC_RELAXED, __HIP_MEMORY_SCOPE_AGENT);
        __syncthreads();
        { LAS const unsigned* pk = (LAS const unsigned*)(F.lds + RING_OFF + 32768) + F.tid * 4; const unsigned e = pk[0], pos = pk[1], wb = pk[2];
          const int pair = (row0 + (F.tid >> 3)) * 8 + (F.tid & 7);
          LIST[(size_t)e * LIST_CAP + base_l[e] + pos] = (unsigned long long)(unsigned)pair | ((unsigned long long)wb << 32);
          PE[pair] = (int)e; }
        __syncthreads();
    }
}

namespace pg8 {
struct UnitG { int kind, slot, nvalid, pm, pn, row0; const char* bptr; };
constexpr int P6_PRE = AUX_OFF + 1024;
constexpr int P6_ROWS = AUX_OFF + 2048;
struct SchedG {
    const LAS int* pre; const LAS int* cnts; const LAS int* cum; const char* wgu; const char* wsh; int G, c, nr, total;
    __device__ __forceinline__ bool next(int i, UnitG& u) const {
        const int idx = i * G + c; if (idx >= total) return false;
        if (idx < nr) { int e = (int)__builtin_popcountll(__ballot(pre[1 + (threadIdx.x & 63)] <= idx));
            e = __builtin_amdgcn_readfirstlane(e); const int j = idx - __builtin_amdgcn_readfirstlane(pre[e]); const int nv = __builtin_amdgcn_readfirstlane(cnts[e]) - 256 * j;
            u.kind = 0; u.slot = i; u.nvalid = nv < 256 ? nv : 256; u.pm = e; u.pn = j; u.row0 = 256 * idx; u.bptr = wgu + (size_t)e * 256 * D; }
        else { const int s = idx - nr; u.kind = 1; u.slot = i; u.nvalid = 256; u.pm = s >> 1; u.pn = s & 1; u.row0 = (s >> 1) * 256; u.bptr = wsh + (size_t)(s & 1) * 256 * D; }
        return true; }
};
struct EpiGU {
    static constexpr bool PERM = true;
    bf16_t* HM; bf16_t* SH; int* SLOT; const LAS unsigned long long* rowinfo;
    __device__ __forceinline__ void operator()(const f32x4 (&acc)[2][2][4][2], const UnitG& u, int wr, int wc, int fr, int fq) const {
#pragma unroll
        for (int ai = 0; ai < 2; ++ai)
#pragma unroll
            for (int m = 0; m < 4; ++m) { const int r = ai * HALF + wr * 64 + m * 16 + fr;
                bf16_t* dst; float w;
                if (u.kind == 0) { const unsigned long long ri = rowinfo[u.slot * 256 + r]; dst = HM + (size_t)(u.row0 + r) * ED + wc * 32 + 8 * fq; w = __builtin_bit_cast(float, (unsigned)(ri >> 32));
                    if (wc == 0 && fq == 0) SLOT[u.row0 + r] = (r < u.nvalid) ? (int)(unsigned)ri : M * 8; }
                else { dst = SH + (size_t)(u.pm * 256 + r) * SHD + u.pn * 128 + wc * 32 + 8 * fq; w = 1.f; }
                constexpr float DQ = 1.f / (W8SCALE * H8SCALE);
                const f32x4 g0 = acc[ai][0][m][0] * DQ, g1 = acc[ai][0][m][1] * DQ, u0 = acc[ai][1][m][0] * DQ, u1 = acc[ai][1][m][1] * DQ;
                float v[8];
#pragma unroll
                for (int j = 0; j < 4; ++j) { v[j] = g0[j] * fsigmoid(g0[j]) * u0[j] * w; v[4 + j] = g1[j] * fsigmoid(g1[j]) * u1[j] * w; }
                u32x4 o; o.x = cvt_pk_bf16(v[0], v[1]); o.y = cvt_pk_bf16(v[2], v[3]); o.z = cvt_pk_bf16(v[4], v[5]); o.w = cvt_pk_bf16(v[6], v[7]);
                if (r < u.nvalid) *(u32x4*)dst = o; }
    }
};
typedef int i32x4_t __attribute__((ext_vector_type(4))); typedef int i32x8_t __attribute__((ext_vector_type(8)));
__device__ __forceinline__ i32x8_t cat8(const bf16x8& a, const bf16x8& b) { return __builtin_shufflevector(__builtin_bit_cast(i32x4_t, a), __builtin_bit_cast(i32x4_t, b), 0, 1, 2, 3, 4, 5, 6, 7); }
__device__ __forceinline__ void mfma8(f32x4& acc, const i32x8_t a, const i32x8_t b) { asm volatile("v_mfma_f32_16x16x128_f8f6f4 %0, %1, %2, %0" : "+v"(acc) : "v"(a), "v"(b)); }
__device__ __forceinline__ void mfma8_settle(f32x4 (&acc)[2][2][4][2]) {
    asm volatile("s_nop 15\n\ts_nop 15" ::: "memory");
#pragma unroll
    for (int a = 0; a < 2; ++a)
#pragma unroll
        for (int b = 0; b < 2; ++b)
#pragma unroll
            for (int m = 0; m < 4; ++m)
#pragma unroll
                for (int n = 0; n < 2; ++n) asm volatile("" : "+v"(acc[a][b][m][n]));
}
template <class Epi, class Sched, bool FP8 = false>
__device__ __forceinline__ void gemm_phase_g(PG8_LAS unsigned char* lds, const bf16_t* A, int K, const Sched& S, const Epi& E, const PG8_LAS unsigned long long* rowinfo) {
    int tid_ = threadIdx.x; asm volatile("" : "+v"(tid_));
    const int tid = tid_, wid = __builtin_amdgcn_readfirstlane(tid >> 6), lane = tid & 63, wr = wid >> 2, wc = wid & 3, fr = lane & 15, fq = lane >> 4;
    const int nt = K / BK;
    int RA[2], CA[2]; unsigned voffB[2];
#pragma unroll
    for (int i = 0; i < 2; ++i) { int R, C; stage_rc(tid * 16 + i * 8192, R, C); const int Rb = Epi::PERM ? ((R & ~31) + perm32(R & 31)) : R; RA[i] = R; CA[i] = C; voffB[i] = (unsigned)(Rb * K + C) * 2u; }
    const size_t kstep = (size_t)(BK * 2);
    const size_t hstep = (size_t)HALF * K * 2;
    const unsigned ldsw = (unsigned)wid * 1024u;
    const int aoff = lds_byte(wr * 64 + fr, fq * 8), boff = lds_byte(wc * 32 + fr, fq * 8);
#define PG8_AOFF(u, o0, o1) do { _Pragma("unroll") for (int _i = 0; _i < 2; ++_i) { unsigned r0_, r1_; \
        if ((u).kind == 0) { r0_ = (unsigned)rowinfo[(u).slot * 256 + RA[_i]] >> 3; r1_ = (unsigned)rowinfo[(u).slot * 256 + HALF + RA[_i]] >> 3; } \
        else { r0_ = (unsigned)((u).row0 + RA[_i]); r1_ = r0_ + HALF; } \
        o0[_i] = (r0_ * (unsigned)K + (unsigned)CA[_i]) * 2u; o1[_i] = (r1_ * (unsigned)K + (unsigned)CA[_i]) * 2u; } } while (0)
#define PG8_SA(b, h) (((b) * 2 + (h)) * HTB)
#define PG8_SB(b, h) ((4 + (b) * 2 + (h)) * HTB)
#define PG8_STAGE(bufoff, gbase, voff) do { _Pragma("unroll") for (int _i = 0; _i < 2; ++_i) \
        __builtin_amdgcn_global_load_lds((const unsigned*)((const char*)(gbase) + (voff)[_i]), (PG8_LAS unsigned*)(lds + (bufoff) + ldsw + _i * 8192), 16, 0, 0); } while (0)
#define PG8_LDA(dst, b, h) do { _Pragma("unroll") for (int m = 0; m < 4; ++m) _Pragma("unroll") for (int k = 0; k < 2; ++k) dst[m][k] = *(const PG8_LAS bf16x8*)(lds + PG8_SA(b, h) + aoff + m * 2048 + k * 1024); } while (0)
#define PG8_LDB(dst, b, h) do { _Pragma("unroll") for (int n = 0; n < 2; ++n) _Pragma("unroll") for (int k = 0; k < 2; ++k) dst[n][k] = *(const PG8_LAS bf16x8*)(lds + PG8_SB(b, h) + boff + n * 2048 + k * 1024); } while (0)
#define PG8_MMA(ai, bj, At, Bt) do { __builtin_amdgcn_s_setprio(1); _Pragma("unroll") for (int m = 0; m < 4; ++m) _Pragma("unroll") for (int n = 0; n < 2; ++n) { \
        if constexpr (FP8) mfma8(acc[ai][bj][m][n], cat8(Bt[n][0], Bt[n][1]), cat8(At[m][0], At[m][1])); \
        else { _Pragma("unroll") for (int k = 0; k < 2; ++k) acc[ai][bj][m][n] = __builtin_amdgcn_mfma_f32_16x16x32_bf16(Bt[n][k], At[m][k], acc[ai][bj][m][n], 0, 0, 0); } } __builtin_amdgcn_s_setprio(0); } while (0)
#define PG8_WAIT_V(n) asm volatile("s_waitcnt vmcnt(" #n ")" ::: "memory")
#define PG8_WAIT_L(n) asm volatile("s_waitcnt lgkmcnt(" #n ")" ::: "memory")
#define PG8_BAR __builtin_amdgcn_s_barrier()
#define PG8_SCHED __builtin_amdgcn_sched_barrier(0)
    UnitG cur, nxt; int ui = 0;
    if (!S.next(0, cur)) return;
    f32x4 acc[2][2][4][2];
#pragma unroll
    for (int a = 0; a < 2; ++a)
#pragma unroll
        for (int b = 0; b < 2; ++b)
#pragma unroll
            for (int m = 0; m < 4; ++m)
#pragma unroll
                for (int n = 0; n < 2; ++n) acc[a][b][m][n] = (f32x4){0.f, 0.f, 0.f, 0.f};
    bf16x8 At[4][2], B0[2][2], B1[2][2];
    const char* cA = (const char*)A; const char* cB = cur.bptr;
    unsigned vA0[2], vA1[2], nA0[2], nA1[2];
    PG8_AOFF(cur, vA0, vA1);
    PG8_STAGE(PG8_SB(0, 0), cB, voffB); PG8_STAGE(PG8_SB(0, 1), cB + hstep, voffB); PG8_STAGE(PG8_SA(0, 0), cA, vA0); PG8_STAGE(PG8_SA(0, 1), cA, vA1);
    if (wr == 1) PG8_BAR;
    PG8_WAIT_V(2); PG8_BAR;
    PG8_STAGE(PG8_SB(1, 0), cB + kstep, voffB); PG8_STAGE(PG8_SA(1, 0), cA + kstep, vA0); PG8_STAGE(PG8_SB(1, 1), cB + hstep + kstep, voffB);
    PG8_WAIT_V(6); PG8_BAR;
    for (;;) {
        const bool has_next = S.next(ui + 1, nxt);
        const char* nB = has_next ? nxt.bptr : cB;
        if (has_next) { PG8_AOFF(nxt, nA0, nA1); } else {
#pragma unroll
            for (int _i = 0; _i < 2; ++_i) { nA0[_i] = vA0[_i]; nA1[_i] = vA1[_i]; } }
#pragma nounroll
        for (int t = 0; t < nt; t += 2) {
            const bool last = (t == nt - 2);
            const char* a1 = cA + (size_t)(t + 1) * kstep;
            const char* a2 = last ? cA : cA + (size_t)(t + 2) * kstep; const char* b2 = last ? nB : cB + (size_t)(t + 2) * kstep;
            const char* a3 = a2 + kstep; const char* b3 = b2 + kstep;
            unsigned s0[2], s1[2];
#pragma unroll
            for (int _i = 0; _i < 2; ++_i) { s0[_i] = last ? nA0[_i] : vA0[_i]; s1[_i] = last ? nA1[_i] : vA1[_i]; }
            PG8_LDB(B0, 0, 0); PG8_LDB(B1, 0, 1); PG8_SCHED; PG8_LDA(At, 0, 0); PG8_STAGE(PG8_SA(1, 1), a1, vA1);
            PG8_WAIT_V(8); PG8_WAIT_L(0); PG8_BAR; PG8_MMA(0, 0, At, B0); PG8_MMA(0, 1, At, B1); PG8_BAR; PG8_SCHED;
            PG8_LDA(At, 0, 1); PG8_STAGE(PG8_SB(0, 0), b2, voffB); PG8_STAGE(PG8_SB(0, 1), b2 + hstep, voffB); PG8_STAGE(PG8_SA(0, 0), a2, s0);
            PG8_WAIT_V(8); PG8_WAIT_L(0); PG8_BAR; PG8_MMA(1, 0, At, B0); PG8_MMA(1, 1, At, B1); PG8_BAR; PG8_SCHED;
            PG8_LDB(B0, 1, 0); PG8_LDB(B1, 1, 1); PG8_SCHED; PG8_LDA(At, 1, 0); PG8_STAGE(PG8_SA(0, 1), a2, s1);
            PG8_WAIT_V(8); PG8_WAIT_L(0); PG8_BAR; PG8_MMA(0, 0, At, B0); PG8_MMA(0, 1, At, B1); PG8_BAR; PG8_SCHED;
            PG8_LDA(At, 1, 1); PG8_STAGE(PG8_SB(1, 0), b3, voffB); PG8_STAGE(PG8_SB(1, 1), b3 + hstep, voffB); PG8_STAGE(PG8_SA(1, 0), a3, s0);
            PG8_WAIT_V(8); PG8_WAIT_L(0); PG8_BAR; PG8_MMA(1, 0, At, B0); PG8_MMA(1, 1, At, B1); PG8_BAR; PG8_SCHED;
        }
        if (wr == 0) PG8_BAR;
        if constexpr (FP8) mfma8_settle(acc);
        E(acc, cur, wr, wc, fr, fq);
        if (!has_next) break;
#pragma unroll
        for (int a = 0; a < 2; ++a)
#pragma unroll
            for (int b = 0; b < 2; ++b)
#pragma unroll
                for (int m = 0; m < 4; ++m)
#pragma unroll
                    for (int n = 0; n < 2; ++n) acc[a][b][m][n] = (f32x4){0.f, 0.f, 0.f, 0.f};
        cur = nxt; cB = nB; ++ui;
#pragma unroll
        for (int _i = 0; _i < 2; ++_i) { vA0[_i] = nA0[_i]; vA1[_i] = nA1[_i]; }
        if (wr == 1) PG8_BAR;
    }
    PG8_WAIT_V(0);
    PG8_BAR;
#undef PG8_AOFF
#undef PG8_SA
#undef PG8_SB
#undef PG8_STAGE
#undef PG8_LDA
#undef PG8_LDB
#undef PG8_MMA
#undef PG8_WAIT_V
#undef PG8_WAIT_L
#undef PG8_BAR
#undef PG8_SCHED
}
}

__device__ __forceinline__ void p6_gateup(Frame& F, const Args& a) {
    unsigned char* ws = a.ws; gu32* gcnt = F.ctl + CW_CNT; const unsigned long long* LIST = (const unsigned long long*)(ws + WS_LIST);
    LAS int* pre = (LAS int*)(F.lds + pg8::P6_PRE); LAS int* cnts = pre + 65; LAS int* cum = cnts + 64; LAS unsigned long long* rowinfo = (LAS unsigned long long*)(F.lds + pg8::P6_ROWS);
    if (F.tid < 64) cnts[F.tid] = (int)__hip_atomic_load(gcnt + 64 * F.tid, RLX_AGENT);
    __syncthreads();
    if (F.tid == 0) { int s = 0, r = 0; for (int e = 0; e < 64; ++e) { pre[e] = s; cum[e] = r; s += (cnts[e] + 255) >> 8; r += cnts[e]; } pre[64] = s; cum[64] = r; }
    __syncthreads();
    pg8::SchedG S; S.pre = pre; S.cnts = cnts; S.cum = cum; S.wgu = (const char*)(ws + WS_WGU); S.wsh = (const char*)(ws + WS_WSHGU); S.G = F.G; S.c = (int)blockIdx.x; S.nr = __builtin_amdgcn_readfirstlane(pre[64]); S.total = S.nr + 2 * (M / 256);
    for (int i = 0; i < 3; ++i) { pg8::UnitG u; if (!S.next(i, u)) break;
        if (u.kind == 0 && F.tid < 256) { const int r = F.tid; rowinfo[i * 256 + r] = (r < u.nvalid) ? LIST[(size_t)u.pm * LIST_CAP + 256 * u.pn + r] : 0ull; } }
    __syncthreads();
    pg8::EpiGU E{(bf16_t*)(ws + WS_HM), (bf16_t*)(ws + WS_SH), (int*)(ws + WS_SLOT), rowinfo};
    pg8::gemm_phase_g<pg8::EpiGU, pg8::SchedG, true>(F.lds + RING_OFF, (const bf16_t*)(ws + WS_H2), D / 2, S, E, rowinfo);
    { const int rounds = (S.total + F.G - 1) / F.G, firstidle = S.total - (rounds - 1) * F.G;
      const int c = (int)blockIdx.x, nidle = F.G - firstidle;
      if (nidle > 0) { if (c >= firstidle) titem_run(F, a, true, 64 * 64 + 4 * 32, (c - firstidle) * NWAVES + F.wave, nidle * NWAVES); }
      else titem_run(F, a, true, 64 * 64 + 4 * 32, c * NWAVES + F.wave, F.G * NWAVES); }
}

namespace pg8 {
struct SchedYr {
    const LAS int* pre; int G, c, total;
    __device__ __forceinline__ bool next(int i, Unit& u) const {
        const int idx = i * G + c; if (idx >= total) return false;
        const int t = idx >> 2, pnl = idx & 3; int e = (int)__builtin_popcountll(__ballot(pre[1 + (threadIdx.x & 63)] <= t));
        e = __builtin_amdgcn_readfirstlane(e); u.pm = t; u.pn = 4 * e + pnl; return true; }
    __device__ __forceinline__ void a_ready(const Unit&) const {}
    __device__ __forceinline__ void done(const Unit&) const {}
};
constexpr float YSCALE = 8.f;
struct EpiStoreF8 {
    static constexpr bool PERM = true, AFTER_DRAIN = false;
    unsigned char* O; const PG8_LAS int* rowmap_l; int G, c;
    __device__ __forceinline__ void operator()(const f32x4 (&acc)[2][2][4][2], const Unit& u, int wr, int wc, int fr, int fq) const {
        const int slot = (4 * u.pm + (u.pn & 3) - c) / G; const PG8_LAS int* rm = rowmap_l + slot * 256 + wr * 64 + fr; const int col0 = (u.pn & 3) * BM + wc * 64 + 16 * fq;
#pragma unroll
        for (int ai = 0; ai < 2; ++ai)
#pragma unroll
            for (int m = 0; m < 4; ++m) { const int orow = rm[ai * HALF + m * 16]; u32x4 w;
#pragma unroll
                for (int bj = 0; bj < 2; ++bj) { const f32x4 v0 = acc[ai][bj][m][0] * YSCALE, v1 = acc[ai][bj][m][1] * YSCALE;
                    unsigned lo = 0u, hi = 0u;
                    lo = __builtin_amdgcn_cvt_pk_fp8_f32(v0[0], v0[1], lo, false); lo = __builtin_amdgcn_cvt_pk_fp8_f32(v0[2], v0[3], lo, true);
                    hi = __builtin_amdgcn_cvt_pk_fp8_f32(v1[0], v1[1], hi, false); hi = __builtin_amdgcn_cvt_pk_fp8_f32(v1[2], v1[3], hi, true);
                    if (bj == 0) { w.x = lo; w.y = hi; } else { w.z = lo; w.w = hi; } }
                *(u32x4*)(O + (size_t)orow * 1024 + col0) = w; }
    }
};
struct EpiStoreF8Dense {
    static constexpr bool PERM = true, AFTER_DRAIN = false;
    unsigned char* O;
    __device__ __forceinline__ void operator()(const f32x4 (&acc)[2][2][4][2], const Unit& u, int wr, int wc, int fr, int fq) const {
        const int row0 = u.pm * BM + wr * 64 + fr, col0 = (u.pn & 3) * BM + wc * 32 + 8 * fq;
#pragma unroll
        for (int ai = 0; ai < 2; ++ai)
#pragma unroll
            for (int m = 0; m < 4; ++m) { unsigned char* rowp = O + (size_t)(row0 + ai * HALF + m * 16) * 1024 + col0;
#pragma unroll
                for (int bj = 0; bj < 2; ++bj) { const f32x4 v0 = acc[ai][bj][m][0] * YSCALE, v1 = acc[ai][bj][m][1] * YSCALE;
                    unsigned lo = 0u, hi = 0u;
                    lo = __builtin_amdgcn_cvt_pk_fp8_f32(v0[0], v0[1], lo, false); lo = __builtin_amdgcn_cvt_pk_fp8_f32(v0[2], v0[3], lo, true);
                    hi = __builtin_amdgcn_cvt_pk_fp8_f32(v1[0], v1[1], hi, false); hi = __builtin_amdgcn_cvt_pk_fp8_f32(v1[2], v1[3], hi, true);
                    *(unsigned long long*)(rowp + bj * HALF) = (unsigned long long)lo | ((unsigned long long)hi << 32); } }
    }
};
struct EpiStore {
    static constexpr bool PERM = true, AFTER_DRAIN = false;
    bf16_t* O; int ldc, colmask;
    __device__ __forceinline__ void operator()(const f32x4 (&acc)[2][2][4][2], const Unit& u, int wr, int wc, int fr, int fq) const {
        const int row0 = u.pm * BM + wr * 64 + fr, col0 = (u.pn & colmask) * BM + wc * 32 + 8 * fq;
#pragma unroll
        for (int ai = 0; ai < 2; ++ai)
#pragma unroll
            for (int m = 0; m < 4; ++m) { bf16_t* rowp = O + (size_t)(row0 + ai * HALF + m * 16) * ldc + col0;
#pragma unroll
                for (int bj = 0; bj < 2; ++bj) { const f32x4 v0 = acc[ai][bj][m][0], v1 = acc[ai][bj][m][1];
                    u32x4 w; w.x = cvt_pk_bf16(v0[0], v0[1]); w.y = cvt_pk_bf16(v0[2], v0[3]); w.z = cvt_pk_bf16(v1[0], v1[1]); w.w = cvt_pk_bf16(v1[2], v1[3]);
                    *(u32x4*)(rowp + bj * HALF) = w; } }
    }
};
}
__device__ __forceinline__ void p7_down(Frame& F, const Args& a) {
    unsigned char* ws = a.ws; gu32* gcnt = F.ctl + CW_CNT;
    LAS int* pre = (LAS int*)(F.lds + pg8::P6_PRE); LAS int* cnts = pre + 65;
    if (F.tid < 64) cnts[F.tid] = (int)__hip_atomic_load(gcnt + 64 * F.tid, RLX_AGENT);
    __syncthreads();
    if (F.tid == 0) { int s = 0; for (int e = 0; e < 64; ++e) { pre[e] = s; s += (cnts[e] + 255) >> 8; } pre[64] = s; }
    __syncthreads();
    { pg8::SchedYr S; S.pre = pre; S.G = F.G; S.c = (int)blockIdx.x; S.total = 4 * __builtin_amdgcn_readfirstlane(pre[64]);
      int kk = ED; asm volatile("" : "+s"(kk));
      LAS int* rml = (LAS int*)(F.lds + AUX_OFF + 2048); const int* rowmap = (const int*)(ws + WS_SLOT);
      for (int i = 0; i * F.G + S.c < S.total && i < 12; ++i) { if (F.tid < 256) rml[i * 256 + F.tid] = rowmap[256 * ((i * F.G + S.c) >> 2) + F.tid]; }
      __syncthreads();
      pg8::Gemm g{(const bf16_t*)(ws + WS_HM), (const bf16_t*)(ws + WS_WD), 0, 0, kk}; pg8::EpiStoreF8 E{ws + WS_YH, rml, F.G, S.c};
      pg8::gemm_phase<pg8::EpiStoreF8, pg8::SchedYr, true, true>(F.lds + RING_OFF, g, S, E); }
    { pg8::StaticOrder S; S.init(M, D, F.G, (int)blockIdx.x);
      int kk = SHD; asm volatile("" : "+s"(kk));
      pg8::Gemm g{(const bf16_t*)(ws + WS_SH), (const bf16_t*)(ws + WS_WSHD), M, D, kk}; pg8::EpiStoreF8Dense E{ws + WS_YSH};
      pg8::gemm_phase<pg8::EpiStoreF8Dense, pg8::StaticOrder, true, true>(F.lds + RING_OFF, g, S, E); }
}
__device__ __forceinline__ void p8_combine(Frame& F, const Args& a) {
    unsigned char* ws = a.ws; const unsigned char* Y8 = ws + WS_YH; const unsigned char* YSH = ws + WS_YSH;
    const float* mod = (const float*)(ws + WS_MOD); float* OUT = a.out; const int lane = F.lane;
    for (int tb = (F.vcu * NWAVES + F.wave) * 8; tb < M; tb += F.G * NWAVES * 8) {
        const int b = tb / SEQ; const float* gate = mod + (size_t)b * 6 * D + 5 * D + lane * 16;
        f32x4 gv[4];
#pragma unroll
        for (int i = 0; i < 4; ++i) gv[i] = *(const f32x4*)(gate + 4 * i);
#pragma nounroll
        for (int i = 0; i < 8; i += 2) {
            v4u y[2][9]; f32x4 x[2][4];
#pragma unroll
            for (int q = 0; q < 2; ++q) { const int t = tb + i + q;
#pragma unroll
                for (int k = 0; k < 8; ++k) y[q][k] = *(const GAS v4u*)(Y8 + ((size_t)t * 8 + k) * 1024 + lane * 16);
                y[q][8] = *(const GAS v4u*)(YSH + (size_t)t * D + lane * 16);
                const GAS f32x4* o = (const GAS f32x4*)(OUT + (size_t)t * D + lane * 16);
#pragma unroll
                for (int j = 0; j < 4; ++j) x[q][j] = o[j]; }
#pragma unroll
            for (int q = 0; q < 2; ++q) { const int t = tb + i + q; float acc[16];
#pragma unroll
                for (int j = 0; j < 16; ++j) acc[j] = 0.f;
#pragma unroll
                for (int k = 0; k < 9; ++k) { const unsigned w4[4] = {y[q][k].x, y[q][k].y, y[q][k].z, y[q][k].w};
#pragma unroll
                    for (int j = 0; j < 4; ++j) { const pg8::f32x2_t lo = __builtin_amdgcn_cvt_pk_f32_fp8((int)w4[j], false), hi = __builtin_amdgcn_cvt_pk_f32_fp8((int)w4[j], true);
                        acc[4 * j] += lo.x; acc[4 * j + 1] += lo.y; acc[4 * j + 2] += hi.x; acc[4 * j + 3] += hi.y; } }
                GAS f32x4* o = (GAS f32x4*)(OUT + (size_t)t * D + lane * 16);
#pragma unroll
                for (int j = 0; j < 4; ++j) { const f32x4 rt = {acc[4 * j], acc[4 * j + 1], acc[4 * j + 2], acc[4 * j + 3]};
                    o[j] = x[q][j] + gv[j] * (rt * (1.f / pg8::YSCALE)); } }
        }
    }
}

__global__ void __launch_bounds__(NWAVES * 64, 2) mk_fwd(Args args) {
    extern __shared__ __attribute__((aligned(16))) unsigned char lds[];
    Frame F;
    F.lds = (LAS unsigned char*)lds; F.MISC = (volatile LAS unsigned*)(F.lds + MISC_OFF);
    F.tid = threadIdx.x; F.lane = F.tid & 63; F.wave = __builtin_amdgcn_readfirstlane(F.tid >> 6);
    F.G = gridDim.x; { const int bx = blockIdx.x; F.vcu = (F.G % 8 == 0) ? (bx % 8) * (F.G / 8) + bx / 8 : bx; }
    unsigned char* ws = args.ws; F.ctl = (gu32*)(ws + WS_CTL);
    for (int u = F.tid; u < (LDS_BYTES - LDSCTL_OFF) / 4; u += NWAVES * 64) ((LAS unsigned*)(F.lds + LDSCTL_OFF))[u] = 0u;
    __syncthreads();
    XcdBarrier bar; bar.bar = (unsigned*)(F.ctl + CW_BAR); bar.x = 0; bar.st = nullptr;
    if (args.use_bar) bar = xcd_barrier_post((unsigned*)(F.ctl + CW_BAR), F.MISC + 8);
    const int lo = args.ph_lo, hi = args.ph_hi;
#define IN(k) (lo <= (k) && (k) < hi)
#define SEAM(k) do { if (IN(k) && IN((k) + 1)) xcd_barrier(bar); } while (0)
#define REFRESH() do { int t_ = threadIdx.x; asm volatile("" : "+v"(t_)); F.tid = t_; F.lane = t_ & 63; F.wave = __builtin_amdgcn_readfirstlane(t_ >> 6); } while (0)
#define PHASE(p, ...) do { if (IN(p)) { REFRESH(); const int reps_ = (DBL_PHASE == (p)) ? 2 : 1; for (int rep_ = 0; rep_ < reps_; ++rep_) { __VA_ARGS__; if (rep_ + 1 < reps_) xcd_barrier(bar); } } SEAM(p); } while (0)
    PHASE(0, { p0a(F, args); __syncthreads(); p0b(F, args); });
    PHASE(2, {
        pg8::Gemm g{(const bf16_t*)(ws + WS_XN), (const bf16_t*)(ws + WS_WIN), M, INW, D}; pg8::StaticOrder S; S.init(M, INW, F.G, (int)blockIdx.x);
        pg8::EpiProj E{(bf16_t*)(ws + WS_Q), (bf16_t*)(ws + WS_K), (bf16_t*)(ws + WS_V), (bf16_t*)(ws + WS_U), (bf16_t*)(ws + WS_GA), (bf16_t*)(ws + WS_GB), args.in[6], args.in[7]};
        pg8::gemm_phase<pg8::EpiProj, pg8::StaticOrder, true, true>(F.lds + RING_OFF, g, S, E); });
    PHASE(3, {
        const bf16_t* Q = (const bf16_t*)(ws + WS_Q); const bf16_t* K = (const bf16_t*)(ws + WS_K); const bf16_t* V = (const bf16_t*)(ws + WS_V);
        for (int u = blockIdx.x; u < BATCH * NH * (SEQ / 256); u += F.G) { const int qb = u & 15, bh = u >> 4;
            sb::attn_unit(bh >> 3, bh & 7, qb, Q, K, V, (bf16_t*)(ws + WS_OSB), F.lds + RING_OFF + F.wave * sb::WAVE_LDS, F.wave, F.lane); }
        p2_pool(F, (const bf16_t*)(ws + WS_U), (bf16_t*)(ws + WS_MIX)); });
    PHASE(4, {
        pg8::StaticOrder S; S.init(M, D, F.G, (int)blockIdx.x);
        { pg8::Gemm g{(const bf16_t*)(ws + WS_OSB), (const bf16_t*)(ws + WS_WSB), M, D, SBW}; pg8::EpiMerge E{(const bf16_t*)(ws + WS_GA), (bf16_t*)(ws + WS_MERGED), 0};
          pg8::gemm_phase<pg8::EpiMerge, pg8::StaticOrder, true, true>(F.lds + RING_OFF, g, S, E); }
        { pg8::Gemm g{(const bf16_t*)(ws + WS_MIX), (const bf16_t*)(ws + WS_WEFF), M, D, PW}; pg8::EpiMerge E{(const bf16_t*)(ws + WS_GB), (bf16_t*)(ws + WS_MERGED), 1};
          pg8::gemm_phase<pg8::EpiMerge, pg8::StaticOrder, true, true>(F.lds + RING_OFF, g, S, E); } });
    PHASE(5, {
        pg8::Gemm g{(const bf16_t*)(ws + WS_MERGED), (const bf16_t*)(ws + WS_WOUT), M, D, D}; pg8::StaticOrder S; S.init(M, D, F.G, (int)blockIdx.x);
        pg8::EpiX1 E{args.in[0], (const float*)(ws + WS_MOD) + 2 * D, args.out};
        pg8::gemm_phase<pg8::EpiX1, pg8::StaticOrder, true, true>(F.lds + RING_OFF, g, S, E); });
    PHASE(6, {
        if (rep_ > 0) { if (blockIdx.x == 0 && F.tid < 64) __hip_atomic_store(F.ctl + CW_CNT + 64 * F.tid, 0u, RLX_AGENT); xcd_barrier(bar); }
        p5_route(F, args); });
    PHASE(7, p6_gateup(F, args));
    PHASE(8, p7_down(F, args));
    if (IN(9)) { REFRESH(); p8_combine(F, args); }
#undef PHASE
#undef REFRESH
#undef IN
#undef SEAM
}
constexpr int N_PHASES = 10;
extern "C" void kernel_launch(void* const* d_in, const int* in_sizes, int n_in, void* d_out, int out_size, void* d_ws, size_t ws_size, hipStream_t stream) {
    static int grid = 0;
    if (grid == 0) {
        if (n_in != 22 || out_size != M * D || ws_size < WS_END) { fprintf(stderr, "kernel_launch: unexpected shapes n_in %d out %d ws %zu\n", n_in, out_size, ws_size); grid = -1; return; }
        int dev = 0, cus = 0, per_cu = 0;
        if (hipGetDevice(&dev) != hipSuccess || hipDeviceGetAttribute(&cus, hipDeviceAttributeMultiprocessorCount, dev) != hipSuccess) { grid = -1; return; }
        if (hipFuncSetAttribute((const void*)mk_fwd, hipFuncAttributeMaxDynamicSharedMemorySize, LDS_BYTES) != hipSuccess) { fprintf(stderr, "kernel_launch: hipFuncSetAttribute failed\n"); grid = -1; return; }
        if (hipOccupancyMaxActiveBlocksPerMultiprocessor(&per_cu, (const void*)mk_fwd, NWAVES * 64, LDS_BYTES) != hipSuccess || per_cu < 1) fprintf(stderr, "kernel_launch: occupancy query says %d per CU\n", per_cu);
        (void)hipGetLastError();
        grid = cus;
        if (grid * 64 < M) { fprintf(stderr, "kernel_launch: %d CUs cannot cover %d rows in the one-block-per-workgroup phases\n", cus, M); grid = -1; return; }
    }
    if (grid < 0) return;
    unsigned char* ws = (unsigned char*)d_ws;
    if (hipMemsetAsync(ws + WS_CTL, 0, CTL_ZERO_BYTES, stream) != hipSuccess) { fprintf(stderr, "kernel_launch: memset failed\n"); return; }
    Args a{};
    for (int i = 0; i < 22; ++i) a.in[i] = (const float*)d_in[i];
    a.out = (float*)d_out; a.ws = ws; a.ph_lo = 0; a.ph_hi = N_PHASES; a.use_bar = 1;
    hipLaunchKernelGGL(mk_fwd, dim3(grid), dim3(NWAVES * 64), LDS_BYTES, stream, a);
}
```

```cpp
#include <hip/hip_runtime.h>
#include <cstdint>
#include <cstdio>

typedef unsigned short bf16_t;
constexpr int D = 1024, BATCH = 4, SEQ = 4096, M = BATCH * SEQ, NH = 8, HD = 64, SBW = 512, PW = 512, INW = 4096;
constexpr int NE = 64, ED = 128, TOPK = 8, SHD = 256;
constexpr float EPS = 1e-6f, RSCALE = 2.5f;

constexpr size_t MiB = 1u << 20;
constexpr size_t WS_CTL = 0, WS_MOD = 1 * MiB, WS_PE = 2 * MiB, WS_PW = 3 * MiB, WS_LIST = 4 * MiB;
constexpr size_t WS_XN = 74 * MiB, WS_OSB = 74 * MiB, WS_MIX = 90 * MiB, WS_H2 = 74 * MiB;
constexpr size_t WS_Q = 106 * MiB, WS_K = 122 * MiB, WS_V = 138 * MiB, WS_MERGED = 106 * MiB;
constexpr size_t WS_SLOT = 190 * MiB, WS_SH = 192 * MiB, WS_HM = 200 * MiB;
constexpr size_t WS_YH = 12 * MiB, WS_YSH = 156 * MiB;
constexpr size_t WS_U = 154 * MiB, WS_GA = 170 * MiB, WS_GB = 202 * MiB, WS_END = 256 * MiB;

__device__ __forceinline__ unsigned f2bf(float f) { unsigned u = __builtin_bit_cast(unsigned, f); return (u + 0x7fffu + ((u >> 16) & 1u)) >> 16; }
__device__ __forceinline__ float bf2f(unsigned h) { return __builtin_bit_cast(float, h << 16); }
__device__ __forceinline__ float wave_sum(float v) {
#pragma unroll
    for (int o = 1; o < 64; o <<= 1) v += __shfl_xor(v, o);
    return v;
}
__device__ __forceinline__ float sigmoidf_(float v) { return 1.f / (1.f + __expf(-v)); }
__device__ __forceinline__ float siluf_(float v) { return v / (1.f + __expf(-v)); }

namespace pg8 {
#define PG8_LAS __attribute__((address_space(3)))
typedef short bf16x8 __attribute__((ext_vector_type(8)));
typedef float f32x4 __attribute__((ext_vector_type(4)));
typedef unsigned u32x4 __attribute__((ext_vector_type(4)));
constexpr int BM = 256, BK = 64, HALF = 128, HTB = HALF * BK * 2  , STAGE_BYTES = 8 * HTB, NXCD = 8, WGM = 8;

__host__ __device__ __forceinline__ int lds_byte(int r, int c) { const int st = (r >> 4) * 2 + (c >> 5), rr = r & 15, cc = c & 31, ob = rr * 64 + cc * 2; return st * 1024 + (ob ^ (((ob >> 9) & 1) << 5)); }
__host__ __device__ __forceinline__ void stage_rc(int b, int& R, int& C) { const int st = b / 1024, sb = b % 1024, swz = sb ^ (((sb >> 9) & 1) << 5); R = (st >> 1) * 16 + swz / 64; C = (st & 1) * 32 + (swz % 64) / 2; }
__host__ __device__ __forceinline__ int perm32(int rho) { const int n = rho >> 4, i = rho & 15; return 8 * (i >> 2) + 4 * n + (i & 3); }

struct Unit { int pm, pn; };
struct Gemm { const bf16_t* A; const bf16_t* Bt; int M, N, K; };

struct StaticOrder {
    int nM, nN, nwg, G, c;
    __host__ __device__ void init(int M_, int N_, int G_, int c_) { nM = M_ / BM; nN = N_ / BM; nwg = nM * nN; G = G_; c = c_; }
    __host__ __device__ bool next(int i, Unit& u) const {
        const long L = (long)i * G + c; if (L >= nwg) return false;
        int wgid = (int)L; { const int q = nwg / NXCD, r = nwg % NXCD, xcd = wgid % NXCD, off = wgid / NXCD; wgid = (xcd < r ? xcd * (q + 1) : r * (q + 1) + (xcd - r) * q) + off; }
        const int nig = WGM * nN, gid = wgid / nig, fm = gid * WGM, gsz = (nM - fm) < WGM ? (nM - fm) : WGM;
        u.pm = fm + ((wgid % nig) % gsz); u.pn = (wgid % nig) / gsz; return true;
    }
    __device__ __forceinline__ void a_ready(const Unit&) const {}
    __device__ __forceinline__ void done(const Unit&) const {}
};
typedef float f32x2_t __attribute__((ext_vector_type(2))); typedef __bf16 bf16x2_t __attribute__((ext_vector_type(2)));
__device__ __forceinline__ unsigned cvt_pk_bf16(float lo, float hi) { f32x2_t v = {lo, hi}; bf16x2_t b = __builtin_convertvector(v, bf16x2_t); return __builtin_bit_cast(unsigned, b); }
__device__ __forceinline__ float fsigmoid(float v) { return __builtin_amdgcn_rcpf(1.f + __builtin_amdgcn_exp2f(-1.4426950408889634f * v)); }
constexpr float QSCALE = 0.125f * 1.4426950408889634f;

struct EpiProj {
    static constexpr bool PERM = true, AFTER_DRAIN = false;
    bf16_t *Q, *K, *V, *U, *GA, *GB; const float* gq; const float* gk;
    __device__ __forceinline__ void operator()(const f32x4 (&acc)[2][2][4][2], const Unit& u, int wr, int wc, int fr, int fq) const {
        const int row0 = u.pm * BM + wr * 64 + fr; const int sec = u.pn;
        if (sec < 4) {
            const bool isq = sec < 2; const float* g = isq ? gq : gk; bf16_t* base = (isq ? Q : K) + ((sec & 1) * 4 + wc) * 64 + 8 * fq;
            const float qs = isq ? QSCALE : 1.f;
            f32x4 gv[2][2];
#pragma unroll
            for (int bj = 0; bj < 2; ++bj)
#pragma unroll
                for (int n = 0; n < 2; ++n) gv[bj][n] = *(const f32x4*)(g + 32 * bj + 8 * fq + 4 * n);
#pragma unroll
            for (int ai = 0; ai < 2; ++ai)
#pragma unroll
                for (int m = 0; m < 4; ++m) {
                    float ss = 0.f;
#pragma unroll
                    for (int bj = 0; bj < 2; ++bj)
#pragma unroll
                        for (int n = 0; n < 2; ++n) { const f32x4 x = acc[ai][bj][m][n]; ss += (x[0] * x[0] + x[1] * x[1]) + (x[2] * x[2] + x[3] * x[3]); }
                    ss += __shfl_xor(ss, 16); ss += __shfl_xor(ss, 32);
                    const float r = rsqrtf(ss * (1.f / 64.f) + EPS) * qs;
                    bf16_t* rowp = base + (size_t)(row0 + ai * HALF + m * 16) * 512;
#pragma unroll
                    for (int bj = 0; bj < 2; ++bj) { const f32x4 v0 = acc[ai][bj][m][0] * gv[bj][0] * r, v1 = acc[ai][bj][m][1] * gv[bj][1] * r;
                        u32x4 w; w.x = cvt_pk_bf16(v0[0], v0[1]); w.y = cvt_pk_bf16(v0[2], v0[3]); w.z = cvt_pk_bf16(v1[0], v1[1]); w.w = cvt_pk_bf16(v1[2], v1[3]);
                        *(u32x4*)(rowp + 32 * bj) = w; }
                }
        } else if (sec < 8) {
            bf16_t* base = (sec < 6 ? V : U) + (sec & 1) * 256 + wc * 32 + 8 * fq;
#pragma unroll
            for (int ai = 0; ai < 2; ++ai)
#pragma unroll
                for (int m = 0; m < 4; ++m) { bf16_t* rowp = base + (size_t)(row0 + ai * HALF + m * 16) * 512;
#pragma unroll
                    for (int bj = 0; bj < 2; ++bj) { const f32x4 v0 = acc[ai][bj][m][0], v1 = acc[ai][bj][m][1];
                        u32x4 w; w.x = cvt_pk_bf16(v0[0], v0[1]); w.y = cvt_pk_bf16(v0[2], v0[3]); w.z = cvt_pk_bf16(v1[0], v1[1]); w.w = cvt_pk_bf16(v1[2], v1[3]);
                        *(u32x4*)(rowp + bj * HALF) = w; } }
        } else {
            bf16_t* base = (sec < 12 ? GA : GB) + ((sec - 8) & 3) * 256 + wc * 32 + 8 * fq;
#pragma unroll
            for (int ai = 0; ai < 2; ++ai)
#pragma unroll
                for (int m = 0; m < 4; ++m) { bf16_t* rowp = base + (size_t)(row0 + ai * HALF + m * 16) * 1024;
#pragma unroll
                    for (int bj = 0; bj < 2; ++bj) { const f32x4 v0 = acc[ai][bj][m][0], v1 = acc[ai][bj][m][1];
                        u32x4 w; w.x = cvt_pk_bf16(fsigmoid(v0[0]), fsigmoid(v0[1])); w.y = cvt_pk_bf16(fsigmoid(v0[2]), fsigmoid(v0[3])); w.z = cvt_pk_bf16(fsigmoid(v1[0]), fsigmoid(v1[1])); w.w = cvt_pk_bf16(fsigmoid(v1[2]), fsigmoid(v1[3]));
                        *(u32x4*)(rowp + bj * HALF) = w; } }
        }
    }
};

struct EpiMerge {
    static constexpr bool PERM = true, AFTER_DRAIN = false;
    const bf16_t* G; bf16_t* MG; int add;
    __device__ __forceinline__ void operator()(const f32x4 (&acc)[2][2][4][2], const Unit& u, int wr, int wc, int fr, int fq) const {
        const int row0 = u.pm * BM + wr * 64 + fr, col0 = u.pn * BM + wc * 32 + 8 * fq;
#pragma unroll
        for (int ai = 0; ai < 2; ++ai)
#pragma unroll
            for (int m = 0; m < 4; ++m) { const size_t off = (size_t)(row0 + ai * HALF + m * 16) * 1024 + col0;
#pragma unroll
                for (int bj = 0; bj < 2; ++bj) { const u32x4 g = *(const u32x4*)(G + off + bj * HALF); const f32x4 a0 = acc[ai][bj][m][0], a1 = acc[ai][bj][m][1];
                    float v[8] = {bf2f(g.x & 0xffffu) * a0[0], bf2f(g.x >> 16) * a0[1], bf2f(g.y & 0xffffu) * a0[2], bf2f(g.y >> 16) * a0[3], bf2f(g.z & 0xffffu) * a1[0], bf2f(g.z >> 16) * a1[1], bf2f(g.w & 0xffffu) * a1[2], bf2f(g.w >> 16) * a1[3]};
                    if (add) { const u32x4 o = *(const u32x4*)(MG + off + bj * HALF);
                        v[0] += bf2f(o.x & 0xffffu); v[1] += bf2f(o.x >> 16); v[2] += bf2f(o.y & 0xffffu); v[3] += bf2f(o.y >> 16); v[4] += bf2f(o.z & 0xffffu); v[5] += bf2f(o.z >> 16); v[6] += bf2f(o.w & 0xffffu); v[7] += bf2f(o.w >> 16); }
                    u32x4 w; w.x = cvt_pk_bf16(v[0], v[1]); w.y = cvt_pk_bf16(v[2], v[3]); w.z = cvt_pk_bf16(v[4], v[5]); w.w = cvt_pk_bf16(v[6], v[7]);
                    *(u32x4*)(MG + off + bj * HALF) = w; } }
    }
};
struct EpiX1 {
    static constexpr bool PERM = false, AFTER_DRAIN = false;
    const float* x; const float* gate; float* X1;
    __device__ __forceinline__ void operator()(const f32x4 (&acc)[2][2][4][2], const Unit& u, int wr, int wc, int fr, int fq) const {
        const int row0 = u.pm * BM + wr * 64 + fr, col0 = u.pn * BM + wc * 32 + 4 * fq; const int b = (u.pm * BM) / SEQ;
        f32x4 gv[2][2];
#pragma unroll
        for (int bj = 0; bj < 2; ++bj)
#pragma unroll
            for (int n = 0; n < 2; ++n) gv[bj][n] = *(const f32x4*)(gate + (size_t)b * 6 * D + col0 + bj * HALF + n * 16);
#pragma unroll
        for (int ai = 0; ai < 2; ++ai)
#pragma unroll
            for (int m = 0; m < 4; ++m) { const size_t off = (size_t)(row0 + ai * HALF + m * 16) * D + col0;
#pragma unroll
                for (int bj = 0; bj < 2; ++bj)
#pragma unroll
                    for (int n = 0; n < 2; ++n) *(f32x4*)(X1 + off + bj * HALF + n * 16) = *(const f32x4*)(x + off + bj * HALF + n * 16) + gv[bj][n] * acc[ai][bj][m][n]; }
    }
};

template <class Epi, class Sched, bool ALIGN_EPI = false, bool SP2 = false>
__device__ __forceinline__ void gemm_phase(PG8_LAS unsigned char* lds, const Gemm g, const Sched& S, const Epi& E) {
    int tid_ = threadIdx.x; asm volatile("" : "+v"(tid_));
    const int tid = tid_, wid = __builtin_amdgcn_readfirstlane(tid >> 6), lane = tid & 63, wr = wid >> 2, wc = wid & 3, fr = lane & 15, fq = lane >> 4;
    const int K = g.K, nt = K / BK;
    unsigned voffA[2], voffB[2];
#pragma unroll
    for (int i = 0; i < 2; ++i) { int R, C; stage_rc(tid * 16 + i * 8192, R, C); const int Rb = Epi::PERM ? ((R & ~31) + perm32(R & 31)) : R;
        voffA[i] = (unsigned)(R * K + C) * 2u; voffB[i] = (unsigned)(Rb * K + C) * 2u; }
    const size_t kstep = (size_t)(BK * 2);
    const size_t hstep = (size_t)HALF * K * 2;
    const size_t tstep = 2 * hstep;
    const unsigned ldsw = (unsigned)wid * 1024u;
    const int aoff = lds_byte(wr * 64 + fr, fq * 8), boff = lds_byte(wc * 32 + fr, fq * 8);
#define PG8_SA(b, h) (((b) * 2 + (h)) * HTB)
#define PG8_SB(b, h) ((4 + (b) * 2 + (h)) * HTB)
#define PG8_STAGE(bufoff, gbase, voff) do { _Pragma("unroll") for (int _i = 0; _i < 2; ++_i) \
        __builtin_amdgcn_global_load_lds((const unsigned*)((const char*)(gbase) + (voff)[_i]), (PG8_LAS unsigned*)(lds + (bufoff) + ldsw + _i * 8192), 16, 0, 0); } while (0)
#define PG8_LDA(dst, b, h) do { _Pragma("unroll") for (int m = 0; m < 4; ++m) _Pragma("unroll") for (int k = 0; k < 2; ++k) dst[m][k] = *(const PG8_LAS bf16x8*)(lds + PG8_SA(b, h) + aoff + m * 2048 + k * 1024); } while (0)
#define PG8_LDB(dst, b, h) do { _Pragma("unroll") for (int n = 0; n < 2; ++n) _Pragma("unroll") for (int k = 0; k < 2; ++k) dst[n][k] = *(const PG8_LAS bf16x8*)(lds + PG8_SB(b, h) + boff + n * 2048 + k * 1024); } while (0)
#define PG8_MMA(ai, bj, At, Bt) do { __builtin_amdgcn_s_setprio(1); _Pragma("unroll") for (int m = 0; m < 4; ++m) _Pragma("unroll") for (int n = 0; n < 2; ++n) _Pragma("unroll") for (int k = 0; k < 2; ++k) \
        acc[ai][bj][m][n] = __builtin_amdgcn_mfma_f32_16x16x32_bf16(Bt[n][k], At[m][k], acc[ai][bj][m][n], 0, 0, 0); __builtin_amdgcn_s_setprio(0); } while (0)
#define PG8_WAIT_V(n) asm volatile("s_waitcnt vmcnt(" #n ")" ::: "memory")
#define PG8_WAIT_L(n) asm volatile("s_waitcnt lgkmcnt(" #n ")" ::: "memory")
#define PG8_BAR __builtin_amdgcn_s_barrier()
#define PG8_SCHED __builtin_amdgcn_sched_barrier(0)
    Unit cur, nxt; int ui = 0;
    if (!S.next(0, cur)) return;
    f32x4 acc[2][2][4][2];
#pragma unroll
    for (int a = 0; a < 2; ++a)
#pragma unroll
        for (int b = 0; b < 2; ++b)
#pragma unroll
            for (int m = 0; m < 4; ++m)
#pragma unroll
                for (int n = 0; n < 2; ++n) acc[a][b][m][n] = (f32x4){0.f, 0.f, 0.f, 0.f};
    bf16x8 At[4][2], B0[2][2], B1[2][2];
    const char* cA = (const char*)g.A + (size_t)cur.pm * tstep; const char* cB = (const char*)g.Bt + (size_t)cur.pn * tstep;
    S.a_ready(cur);
    if constexpr (SP2) {
        PG8_STAGE(PG8_SB(0, 0), cB, voffB); PG8_STAGE(PG8_SB(0, 1), cB + hstep, voffB); PG8_STAGE(PG8_SA(0, 0), cA, voffA); PG8_STAGE(PG8_SA(0, 1), cA + hstep, voffA);
        if (wr == 1) PG8_BAR;
        PG8_WAIT_V(2); PG8_BAR;
        PG8_STAGE(PG8_SB(1, 0), cB + kstep, voffB); PG8_STAGE(PG8_SA(1, 0), cA + kstep, voffA); PG8_STAGE(PG8_SB(1, 1), cB + hstep + kstep, voffB);
        PG8_WAIT_V(6); PG8_BAR;
    } else {
        PG8_STAGE(PG8_SB(0, 0), cB, voffB); PG8_STAGE(PG8_SA(0, 0), cA, voffA); PG8_STAGE(PG8_SB(0, 1), cB + hstep, voffB); PG8_STAGE(PG8_SA(0, 1), cA + hstep, voffA);
        if (wr == 1) PG8_BAR;
        PG8_WAIT_V(4); PG8_BAR;
        PG8_STAGE(PG8_SB(1, 0), cB + kstep, voffB); PG8_STAGE(PG8_SA(1, 0), cA + kstep, voffA); PG8_STAGE(PG8_SB(1, 1), cB + hstep + kstep, voffB);
        PG8_WAIT_V(6); PG8_BAR;
    }
    for (;;) {
        const bool has_next = S.next(ui + 1, nxt);
        const char* nA = has_next ? (const char*)g.A + (size_t)nxt.pm * tstep : cA; const char* nB = has_next ? (const char*)g.Bt + (size_t)nxt.pn * tstep : cB;
#pragma nounroll
        for (int t = 0; t < nt; t += 2) {
            const bool last = (t == nt - 2);
            const char* a1 = cA + (size_t)(t + 1) * kstep;
            const char* a2 = last ? nA : cA + (size_t)(t + 2) * kstep; const char* b2 = last ? nB : cB + (size_t)(t + 2) * kstep;
            const char* a3 = a2 + kstep; const char* b3 = b2 + kstep;
            if (last && has_next) S.a_ready(nxt);
            if constexpr (SP2) {
            PG8_LDB(B0, 0, 0); PG8_LDB(B1, 0, 1); PG8_SCHED; PG8_LDA(At, 0, 0); PG8_STAGE(PG8_SA(1, 1), a1 + hstep, voffA);
            PG8_WAIT_V(8); PG8_WAIT_L(0); PG8_BAR; PG8_MMA(0, 0, At, B0); PG8_MMA(0, 1, At, B1); PG8_BAR; PG8_SCHED;
            PG8_LDA(At, 0, 1); PG8_STAGE(PG8_SB(0, 0), b2, voffB); PG8_STAGE(PG8_SB(0, 1), b2 + hstep, voffB); PG8_STAGE(PG8_SA(0, 0), a2, voffA);
            PG8_WAIT_V(8); PG8_WAIT_L(0); PG8_BAR; PG8_MMA(1, 0, At, B0); PG8_MMA(1, 1, At, B1); PG8_BAR; PG8_SCHED;
            PG8_LDB(B0, 1, 0); PG8_LDB(B1, 1, 1); PG8_SCHED; PG8_LDA(At, 1, 0); PG8_STAGE(PG8_SA(0, 1), a2 + hstep, voffA);
            PG8_WAIT_V(8); PG8_WAIT_L(0); PG8_BAR; PG8_MMA(0, 0, At, B0); PG8_MMA(0, 1, At, B1); PG8_BAR; PG8_SCHED;
            PG8_LDA(At, 1, 1); PG8_STAGE(PG8_SB(1, 0), b3, voffB); PG8_STAGE(PG8_SB(1, 1), b3 + hstep, voffB); PG8_STAGE(PG8_SA(1, 0), a3, voffA);
            PG8_WAIT_V(8); PG8_WAIT_L(0); PG8_BAR; PG8_MMA(1, 0, At, B0); PG8_MMA(1, 1, At, B1); PG8_BAR; PG8_SCHED;
            } else {
            PG8_LDB(B0, 0, 0); PG8_SCHED; PG8_LDA(At, 0, 0); PG8_STAGE(PG8_SA(1, 1), a1 + hstep, voffA);
            PG8_WAIT_L(8); PG8_BAR; PG8_WAIT_L(0); PG8_MMA(0, 0, At, B0); PG8_BAR; PG8_SCHED;
            PG8_LDB(B1, 0, 1); PG8_STAGE(PG8_SB(0, 0), b2, voffB);
            PG8_BAR; PG8_WAIT_L(0); PG8_MMA(0, 1, At, B1); PG8_BAR;
            PG8_LDA(At, 0, 1); PG8_STAGE(PG8_SA(0, 0), a2, voffA);
            PG8_BAR; PG8_WAIT_L(0); PG8_MMA(1, 0, At, B0); PG8_BAR; PG8_SCHED;
            PG8_STAGE(PG8_SB(0, 1), b2 + hstep, voffB);
            PG8_WAIT_V(6); PG8_BAR; PG8_MMA(1, 1, At, B1); PG8_BAR;
            PG8_LDB(B0, 1, 0); PG8_SCHED; PG8_LDA(At, 1, 0); PG8_STAGE(PG8_SA(0, 1), a2 + hstep, voffA);
            PG8_WAIT_L(8); PG8_BAR; PG8_WAIT_L(0); PG8_MMA(0, 0, At, B0); PG8_BAR; PG8_SCHED;
            PG8_LDB(B1, 1, 1); PG8_STAGE(PG8_SB(1, 0), b3, voffB);
            PG8_BAR; PG8_WAIT_L(0); PG8_MMA(0, 1, At, B1); PG8_BAR;
            PG8_LDA(At, 1, 1); PG8_STAGE(PG8_SA(1, 0), a3, voffA);
            PG8_BAR; PG8_WAIT_L(0); PG8_MMA(1, 0, At, B0); PG8_BAR; PG8_SCHED;
            PG8_STAGE(PG8_SB(1, 1), b3 + hstep, voffB);
            PG8_WAIT_V(6); PG8_BAR; PG8_MMA(1, 1, At, B1); PG8_BAR;
            }
        }
        if constexpr (ALIGN_EPI) { if (wr == 0) PG8_BAR; }
        if constexpr (!Epi::AFTER_DRAIN) { E(acc, cur, wr, wc, fr, fq); S.done(cur); }
        if (!has_next) break;
#pragma unroll
        for (int a = 0; a < 2; ++a)
#pragma unroll
            for (int b = 0; b < 2; ++b)
#pragma unroll
                for (int m = 0; m < 4; ++m)
#pragma unroll
                    for (int n = 0; n < 2; ++n) acc[a][b][m][n] = (f32x4){0.f, 0.f, 0.f, 0.f};
        cur = nxt; cA = nA; cB = nB; ++ui;
        if constexpr (ALIGN_EPI) { if (wr == 1) PG8_BAR; }
    }
    PG8_WAIT_V(0);
    if constexpr (!ALIGN_EPI) { if (wr == 0) PG8_BAR; }
    PG8_BAR;
    if constexpr (Epi::AFTER_DRAIN) { E.fused(acc, cur, wr, wc, fr, fq, lds, wid, lane); S.done(cur); }
#undef PG8_SA
#undef PG8_SB
#undef PG8_STAGE
#undef PG8_LDA
#undef PG8_LDB
#undef PG8_MMA
#undef PG8_WAIT_V
#undef PG8_WAIT_L
#undef PG8_BAR
#undef PG8_SCHED
}
}
using pg8::f32x4; using pg8::bf16x8;
#define GAS __attribute__((address_space(1)))
#define LAS __attribute__((address_space(3)))
typedef unsigned v4u __attribute__((ext_vector_type(4)));
typedef GAS unsigned gu32;
typedef GAS unsigned long long gu64;
#define RLX_AGENT __ATOMIC_RELAXED, __HIP_MEMORY_SCOPE_AGENT
#define LDS_WAIT() asm volatile("s_waitcnt lgkmcnt(0)" ::: "memory")
#define VM_WAIT() asm volatile("s_waitcnt vmcnt(0)" ::: "memory")
__device__ __forceinline__ unsigned long long rt() { return __builtin_amdgcn_s_memrealtime(); }
__device__ __forceinline__ unsigned pk2(float lo, float hi) { return pg8::cvt_pk_bf16(lo, hi); }

#define XB_TMO      128
#define XB_XCNT(j)  (256  + 64 * (j))
#define XB_XSUB(j)  (1280 + 64 * (j))
#define XB_XGEN(j)  (2304 + 64 * (j))
#define XB_TOP      3328
#define XB_TOPGEN   3392
#define XCD_BAR_WORDS 3456
#define XB_SPIN_CAP (1u << 18)

__device__ __forceinline__ unsigned xb_ld(unsigned* p)              { return __hip_atomic_load(p, __ATOMIC_RELAXED, __HIP_MEMORY_SCOPE_AGENT); }
__device__ __forceinline__ unsigned xb_add(unsigned* p, unsigned v) { return __hip_atomic_fetch_add(p, v, __ATOMIC_RELAXED, __HIP_MEMORY_SCOPE_AGENT); }
__device__ __forceinline__ unsigned xb_xcc_id() { return (unsigned)__builtin_amdgcn_s_getreg((3 << 11) | 20) & 0xFu; }
#define XB_SPIN(cond, bar) do { unsigned _sp = 0; while (cond) { __builtin_amdgcn_s_sleep(1); \
    if ((++_sp & 255u) == 0u) { if (xb_ld(&(bar)[XB_TMO])) break; if (_sp > XB_SPIN_CAP) { atomicAdd(&(bar)[XB_TMO], 1u); break; } } } } while (0)

struct XcdBarrier {
    unsigned* bar; unsigned x;
    volatile LAS unsigned* st;
};

__device__ __forceinline__ XcdBarrier xcd_barrier_post(unsigned* bar, volatile LAS unsigned* st) {
    XcdBarrier b; b.bar = bar; b.x = xb_xcc_id(); b.st = st;
    if (threadIdx.x == 0) (void)xb_add(&bar[XB_XCNT(b.x)], 1u);
    return b;
}
__device__ __forceinline__ void xcd_barrier_complete(unsigned* bar, unsigned x, unsigned& nloc, unsigned& nx) {
    const unsigned G = gridDim.x * gridDim.y * gridDim.z;
    unsigned sum, cnt, mine, sp = 0u;
    for (;;) {
        sum = 0u; cnt = 0u; mine = 0u;
#pragma unroll
        for (unsigned j = 0; j < 16; ++j) { const unsigned c = xb_ld(&bar[XB_XCNT(j)]); sum += c; cnt += (c > 0u) ? 1u : 0u; mine = (j == x) ? c : mine; }
        if (sum == G) break;
        __builtin_amdgcn_s_sleep(1);
        if ((++sp & 255u) == 0u) { if (xb_ld(&bar[XB_TMO])) break; if (sp > XB_SPIN_CAP) { atomicAdd(&bar[XB_TMO], 1u); break; } }
    }
    nloc = mine > 0u ? mine : 1u; nx = cnt > 0u ? cnt : 1u;
}

__device__ __forceinline__ void xcd_barrier(const XcdBarrier& b) {
    asm volatile("s_waitcnt vmcnt(0)" ::: "memory");
    __syncthreads();
    if (threadIdx.x == 0) {
        unsigned* bar = b.bar;
        __builtin_amdgcn_s_waitcnt(0);
        unsigned nloc = b.st[0], nx = b.st[1];
        if (nloc == 0u) { xcd_barrier_complete(bar, b.x, nloc, nx); b.st[0] = nloc; b.st[1] = nx; }
        const unsigned old = xb_add(&bar[XB_XSUB(b.x)], 1u);
        const unsigned gen = old / nloc;
        if (old + 1u == (gen + 1u) * nloc) {
            __builtin_amdgcn_fence(__ATOMIC_RELEASE, "agent");
            asm volatile("s_waitcnt vmcnt(0)" ::: "memory");
            const unsigned og = xb_add(&bar[XB_TOP], 1u);
            const unsigned tg = og / nx;
            if (og + 1u == (tg + 1u) * nx) xb_add(&bar[XB_TOPGEN], 1u);
            else XB_SPIN(xb_ld(&bar[XB_TOPGEN]) == tg, bar);
            __builtin_amdgcn_fence(__ATOMIC_ACQUIRE, "agent");
            xb_add(&bar[XB_XGEN(b.x)], 1u);
            asm volatile("s_waitcnt vmcnt(0)" ::: "memory");
        } else {
            XB_SPIN(xb_ld(&bar[XB_XGEN(b.x)]) == gen, bar);
            __builtin_amdgcn_fence(__ATOMIC_ACQUIRE, "agent");
            asm volatile("s_waitcnt vmcnt(0)" ::: "memory");
        }
    }
    __syncthreads();
}

constexpr int NWAVES = 8;
#ifndef DBL_PHASE
#define DBL_PHASE -1
#endif
constexpr size_t WS_MODP = 1 * MiB + 128 * 1024;
constexpr size_t WS_WIN = 12 * MiB, WS_WSB = 20 * MiB, WS_WEFF = 21 * MiB, WS_WOUT = 22 * MiB, WS_WGU = 24 * MiB;
constexpr size_t WS_WSHGU = 237 * MiB, WS_WD = 238 * MiB, WS_WSHD = 254 * MiB, WS_WRH = 254 * MiB + 512 * 1024, WS_WRL = WS_WRH + 128 * 1024;
constexpr size_t CTL_ZERO_BYTES = 256 * 1024;
constexpr int CW_TMO = 0, CW_CODE = 1, CW_BAR = 4096, CW_CNT = 16384, CW_ADA = 32768;
constexpr int RING_OFF = 0, RING_BYTES = 131072, AUX_OFF = RING_BYTES, LDS_BYTES = 163840, LDSCTL_OFF = LDS_BYTES - 1024, MISC_OFF = LDSCTL_OFF + 320;

struct Frame {
    LAS unsigned char* lds; volatile LAS unsigned* MISC; gu32* ctl;
    int tid, lane, wave, vcu, G;
};
struct Args { const float* in[22]; float* out; unsigned char* ws; int ph_lo, ph_hi, use_bar, pad; };

constexpr float W8SCALE = 512.f, H8SCALE = 16.f, HM8SCALE = 32.f, SH8SCALE = 8.f;
struct TItem { const float* W; bf16_t* dst; int ldw, ldk, k0, n0, perm, f8; };
__device__ __forceinline__ void titem_load(const TItem& t, f32x4 (&v)[8], int lane) {
    const int kr = lane >> 3, n4 = (lane & 7) * 4;
#pragma unroll
    for (int i = 0; i < 8; ++i) v[i] = *(const GAS f32x4*)(t.W + (size_t)(t.k0 + kr + 8 * i) * t.ldw + t.n0 + n4);
}
__device__ __forceinline__ void titem_store(const TItem& t, const f32x4 (&v)[8], LAS float* scr, int lane) {
    { const int kr = lane >> 3, n4 = (lane & 7) * 4;
#pragma unroll
      for (int i = 0; i < 8; ++i) { LAS float* d = scr + (kr + 8 * i) * 33 + n4; d[0] = v[i].x; d[1] = v[i].y; d[2] = v[i].z; d[3] = v[i].w; } }
    LDS_WAIT(); asm volatile("" ::: "memory");
    const int c = lane & 7;
#pragma unroll
    for (int j = 0; j < 4; ++j) { const int n = (lane >> 3) + 8 * j, drow = t.perm ? 128 * (j & 1) + 8 * (j >> 1) + (lane >> 3) : n; const LAS float* sp = scr + (8 * c) * 33 + n;
        if (t.f8) {
            unsigned lo = 0u, hi = 0u;
            lo = __builtin_amdgcn_cvt_pk_fp8_f32(sp[0 * 33] * W8SCALE, sp[1 * 33] * W8SCALE, lo, false); lo = __builtin_amdgcn_cvt_pk_fp8_f32(sp[2 * 33] * W8SCALE, sp[3 * 33] * W8SCALE, lo, true);
            hi = __builtin_amdgcn_cvt_pk_fp8_f32(sp[4 * 33] * W8SCALE, sp[5 * 33] * W8SCALE, hi, false); hi = __builtin_amdgcn_cvt_pk_fp8_f32(sp[6 * 33] * W8SCALE, sp[7 * 33] * W8SCALE, hi, true);
            *(GAS unsigned long long*)((GAS unsigned char*)t.dst + (size_t)drow * t.ldk + t.k0 + 8 * c) = (unsigned long long)lo | ((unsigned long long)hi << 32);
        } else {
        v4u o; o.x = pk2(sp[0 * 33], sp[1 * 33]); o.y = pk2(sp[2 * 33], sp[3 * 33]); o.z = pk2(sp[4 * 33], sp[5 * 33]); o.w = pk2(sp[6 * 33], sp[7 * 33]);
        *(GAS v4u*)(t.dst + (size_t)drow * t.ldk + t.k0 + 8 * c) = o; } }
    LDS_WAIT(); asm volatile("" ::: "memory");
}
__device__ __forceinline__ TItem titem_decode(int it, const Args& a, bool late) {
    unsigned char* ws = a.ws; TItem t; t.perm = 0; t.f8 = 0;
    constexpr int I_IN = 16 * 128, I_SB = 8 * 32, I_OUT = 16 * 32, I_EG = 64 * 64, I_EU = 64 * 64, I_ED = 64 * 64, I_SG = 16 * 8, I_SU = 16 * 8;
    int r = it;
    if (late) {
        if (r < I_ED) { const int e = r >> 6, q = r & 63, kb = q >> 5, nb = q & 31; t.W = a.in[18] + (size_t)e * ED * D; t.ldw = D; t.k0 = kb * 64; t.n0 = nb * 32;
            const int n0 = nb * 32, cl = n0 & 255; t.perm = 1; t.f8 = 1; t.dst = (bf16_t*)(ws + WS_WD + ((size_t)e * D + (n0 & ~255) + 32 * (cl >> 6) + 16 * ((cl >> 5) & 1)) * ED); t.ldk = ED; return t; } r -= I_ED;
        { const int kb = r >> 5, nb = r & 31; t.W = a.in[21]; t.ldw = D; t.k0 = kb * 64; t.n0 = nb * 32; t.f8 = 1; t.dst = (bf16_t*)(ws + WS_WSHD + (size_t)(nb * 32) * SHD); t.ldk = SHD; return t; } }
    if (r < I_IN) { const int kb = r >> 7, nb = r & 127, n0 = nb * 32; int d0 = n0;
        if (n0 < 1024) d0 = (n0 & ~255) + 128 * ((n0 >> 5) & 1) + 32 * ((n0 >> 6) & 3);
        t.W = a.in[5]; t.ldw = INW; t.k0 = kb * 64; t.n0 = n0; t.dst = (bf16_t*)(ws + WS_WIN) + (size_t)d0 * D; t.ldk = D; return t; } r -= I_IN;
    if (r < I_SB) { const int kb = r >> 5, nb = r & 31; t.W = a.in[8]; t.ldw = D; t.k0 = kb * 64; t.n0 = nb * 32; t.dst = (bf16_t*)(ws + WS_WSB) + (size_t)(nb * 32) * SBW; t.ldk = SBW; return t; } r -= I_SB;
    if (r < I_OUT) { const int kb = r >> 5, nb = r & 31; t.W = a.in[12]; t.ldw = D; t.k0 = kb * 64; t.n0 = nb * 32; t.dst = (bf16_t*)(ws + WS_WOUT) + (size_t)(nb * 32) * D; t.ldk = D; return t; } r -= I_OUT;
    if (r < I_EG) { const int e = r >> 6, q = r & 63, kb = q >> 2, nb = q & 3; t.W = a.in[16] + (size_t)e * D * ED; t.ldw = ED; t.k0 = kb * 64; t.n0 = nb * 32; t.f8 = 1; t.dst = (bf16_t*)(ws + WS_WGU + ((size_t)e * 256 + nb * 32) * D); t.ldk = D; return t; } r -= I_EG;
    if (r < I_EU) { const int e = r >> 6, q = r & 63, kb = q >> 2, nb = q & 3; t.W = a.in[17] + (size_t)e * D * ED; t.ldw = ED; t.k0 = kb * 64; t.n0 = nb * 32; t.f8 = 1; t.dst = (bf16_t*)(ws + WS_WGU + ((size_t)e * 256 + 128 + nb * 32) * D); t.ldk = D; return t; } r -= I_EU;
    if (r < I_SG) { const int kb = r >> 3, nb = r & 7, n0 = nb * 32; t.W = a.in[19]; t.ldw = SHD; t.k0 = kb * 64; t.n0 = n0; t.f8 = 1; t.dst = (bf16_t*)(ws + WS_WSHGU + (size_t)((n0 >> 7) * 256 + (n0 & 127)) * D); t.ldk = D; return t; } r -= I_SG;
    { const int kb = r >> 3, nb = r & 7, n0 = nb * 32; t.W = a.in[20]; t.ldw = SHD; t.k0 = kb * 64; t.n0 = n0; t.f8 = 1; t.dst = (bf16_t*)(ws + WS_WSHGU + (size_t)((n0 >> 7) * 256 + 128 + (n0 & 127)) * D); t.ldk = D; return t; }
}

__device__ __forceinline__ void titem_run(Frame& F, const Args& a, bool late, int nitems, int first, int stride) {
    LAS float* scr = (LAS float*)(F.lds + RING_OFF + F.wave * 16384); const int lane = F.lane;
    f32x4 va[8], vb[8]; TItem cur, nxt; int it = first;
    if (it < nitems) { cur = titem_decode(it, a, late); titem_load(cur, va, lane); }
    for (; it < nitems; it += 2 * stride) {
        const bool h1 = it + stride < nitems, h2 = it + 2 * stride < nitems;
        if (h1) { nxt = titem_decode(it + stride, a, late); titem_load(nxt, vb, lane); }
        titem_store(cur, va, scr, lane);
        if (h2) { cur = titem_decode(it + 2 * stride, a, late); titem_load(cur, va, lane); }
        if (h1) titem_store(nxt, vb, scr, lane);
    }
}

__device__ __forceinline__ void p0a(Frame& F, const Args& a) {
    unsigned char* ws = a.ws;
    const int gw = F.vcu * NWAVES + F.wave, NGW = F.G * NWAVES, lane = F.lane;
    LAS float* silu = (LAS float*)(F.lds + RING_OFF + 98304);
    { const float* c = a.in[1]; for (int i = F.tid; i < 4 * D; i += NWAVES * 64) silu[i] = siluf_(c[i]); }
    if (F.G == 256) { const float* wg = a.in[9]; const float* ps = a.in[10]; const float* wpo = a.in[11]; bf16_t* WE = (bf16_t*)(ws + WS_WEFF);
        const int g = F.vcu >> 6, nb = (F.vcu & 63) * 16;
        LAS float* wgt = (LAS float*)(F.lds + RING_OFF);
        LAS float* slab = (LAS float*)(F.lds + RING_OFF + 68 * 1024);
        for (int i = F.tid; i < 128 * 128; i += NWAVES * 64) { const int cc = i >> 7, d = i & 127; wgt[d * 129 + cc] = wg[(size_t)g * 16384 + i]; }
        { const int d = F.tid >> 2, q = (F.tid & 3) * 4; const f32x4 w4 = *(const GAS f32x4*)(wpo + (size_t)(g * 128 + d) * D + nb + q) * ps[g * 128 + d]; *(LAS f32x4*)(slab + d * 16 + q) = w4; }
        __syncthreads();
        const int cc = F.tid & 127, nq = (F.tid >> 7) * 4; f32x4 acc4 = {0.f, 0.f, 0.f, 0.f};
#pragma unroll 8
        for (int d = 0; d < 128; ++d) acc4 += wgt[d * 129 + cc] * *(const LAS f32x4*)(slab + d * 16 + nq);
#pragma unroll
        for (int j = 0; j < 4; ++j) WE[(size_t)(nb + nq + j) * PW + g * 128 + cc] = (bf16_t)f2bf(acc4[j]);
    }
    __syncthreads();
    { const float* w_ada = a.in[2]; float* MODP = (float*)(ws + WS_MODP); LAS float* red = (LAS float*)(F.lds + RING_OFF);
      for (int it = F.vcu; it < 96 * 8; it += F.G) { const int cg = it % 96, ks = it / 96, k0 = ks * 128 + F.wave * 16;
          const float* w = w_ada + (size_t)k0 * (6 * D) + cg * 64 + lane;
          float wv[16];
#pragma unroll
          for (int k = 0; k < 16; ++k) wv[k] = w[(size_t)k * (6 * D)];
          float a0 = 0.f, a1 = 0.f, a2 = 0.f, a3 = 0.f;
#pragma unroll
          for (int k = 0; k < 16; ++k) { const int kk = k0 + k; a0 += silu[kk] * wv[k]; a1 += silu[D + kk] * wv[k]; a2 += silu[2 * D + kk] * wv[k]; a3 += silu[3 * D + kk] * wv[k]; }
          LAS float* rw = red + F.wave * 256 + lane; rw[0] = a0; rw[64] = a1; rw[128] = a2; rw[192] = a3;
          __syncthreads();
          if (F.tid < 256) { float v = 0.f;
#pragma unroll
              for (int w8 = 0; w8 < 8; ++w8) v += red[w8 * 256 + F.tid];
              MODP[(size_t)(ks * 4 + (F.tid >> 6)) * 6 * D + cg * 64 + (F.tid & 63)] = v; }
          __syncthreads(); }
      if (F.tid == 0) { __builtin_amdgcn_fence(__ATOMIC_RELEASE, "agent"); asm volatile("s_waitcnt vmcnt(0)" ::: "memory"); (void)xb_add((unsigned*)(F.ctl + CW_ADA), 1u); } }
    __syncthreads();
    titem_run(F, a, false, 16 * 128 + 8 * 32 + 16 * 32 + 2 * 64 * 64 + 2 * 16 * 8, gw, NGW);
    { const float* wr = a.in[14]; bf16_t* WH = (bf16_t*)(ws + WS_WRH); bf16_t* WL = (bf16_t*)(ws + WS_WRL);
      for (int i = (F.vcu * NWAVES * 64 + F.tid); i < D * NE; i += F.G * NWAVES * 64) { const int e = i >> 10, k = i & 1023; const float v = wr[k * NE + e];
          const int pos = ((((k >> 4) * 2 + (e >> 5)) * 64) + 32 * ((k >> 3) & 1) + (e & 31)) * 8 + (k & 7);
          const unsigned h = f2bf(v); WH[pos] = (bf16_t)h; WL[pos] = (bf16_t)f2bf(v - bf2f(h)); } }
}
__device__ __forceinline__ void p0b(Frame& F, const Args& a) {
    unsigned char* ws = a.ws; const float* MODP = (const float*)(ws + WS_MODP); const float* b_ada = a.in[3];
    if (F.tid == 0) { unsigned* bar_ = (unsigned*)(F.ctl + CW_BAR); XB_SPIN(xb_ld((unsigned*)(F.ctl + CW_ADA)) < (unsigned)F.G, bar_);
        __builtin_amdgcn_fence(__ATOMIC_ACQUIRE, "agent"); asm volatile("s_waitcnt vmcnt(0)" ::: "memory"); }
    __syncthreads();
    if (F.tid < 96) { const int idx = 96 * F.vcu + F.tid, b = idx / (6 * D), j = idx % (6 * D); float v = b_ada[j];
#pragma unroll
        for (int ks = 0; ks < 8; ++ks) v += MODP[(size_t)(ks * 4 + b) * 6 * D + j];
        ((float*)(ws + WS_MOD))[idx] = v; }
    const int rows_per = M / F.G, r0 = F.vcu * rows_per, b = r0 / SEQ;
    LAS float* gsv = (LAS float*)(F.lds + RING_OFF); LAS float* shv = gsv + D;
    for (int k = F.tid; k < D; k += NWAVES * 64) { float sh = b_ada[k], sc = b_ada[D + k];
#pragma unroll
        for (int ks = 0; ks < 8; ++ks) { sh += MODP[(size_t)(ks * 4 + b) * 6 * D + k]; sc += MODP[(size_t)(ks * 4 + b) * 6 * D + D + k]; }
        gsv[k] = a.in[4][k] * (1.f + sc); shv[k] = sh; }
    __syncthreads();
    const float* x = a.in[0]; bf16_t* XN = (bf16_t*)(ws + WS_XN);
    for (int i = F.wave; i < rows_per; i += NWAVES) { const int row = r0 + i;
        const GAS f32x4* xr = (const GAS f32x4*)(x + (size_t)row * D) + F.lane;
        f32x4 v[4]; float s = 0.f;
#pragma unroll
        for (int j = 0; j < 4; ++j) { v[j] = xr[64 * j]; s += (v[j].x * v[j].x + v[j].y * v[j].y) + (v[j].z * v[j].z + v[j].w * v[j].w); }
        const float r = rsqrtf(wave_sum(s) * (1.f / D) + EPS);
        GAS unsigned long long* o8 = (GAS unsigned long long*)(XN + (size_t)row * D) + F.lane;
#pragma unroll
        for (int j = 0; j < 4; ++j) { const f32x4 gg = *(const LAS f32x4*)(gsv + 4 * F.lane + 256 * j), ss = *(const LAS f32x4*)(shv + 4 * F.lane + 256 * j);
            const f32x4 h = v[j] * r * gg + ss;
            o8[64 * j] = (unsigned long long)pk2(h.x, h.y) | ((unsigned long long)pk2(h.z, h.w) << 32); } }
    __syncthreads();
}

namespace sb {
using pg8::bf16x8; using pg8::f32x4; typedef float f32x16 __attribute__((ext_vector_type(16))); typedef short v4i16_t __attribute__((ext_vector_type(4)));
typedef short s16x4 __attribute__((ext_vector_type(4)));
constexpr int VPITCH = 128, VBYTES = 64 * VPITCH, WAVE_LDS = 2 * VBYTES;
constexpr float EXIT_THR = -152.f;
__device__ __forceinline__ int crow(int r, int hi) { return (r & 3) + 8 * (r >> 2) + 4 * hi; }
__device__ __forceinline__ s16x4 vtr(LAS const unsigned char* p) { return __builtin_bit_cast(s16x4, __builtin_amdgcn_ds_read_tr16_b64_v4i16((LAS v4i16_t*)p)); }
__device__ __forceinline__ unsigned pkbf(float lo, float hi) { return pg8::cvt_pk_bf16(lo, hi); }

__device__ __forceinline__ void attn_unit(int b, int h, int qb, const bf16_t* Q, const bf16_t* K, const bf16_t* V, bf16_t* O, LAS unsigned char* vlds, int wid, int lane) {
    const int r32 = lane & 31, hi = lane >> 5;
    const int t0 = qb * 256 + wid * 32;
    const size_t rowbase = (size_t)b * SEQ;
    const bf16_t* Kh = K + rowbase * 512 + h * 64; const bf16_t* Vh = V + rowbase * 512 + h * 64;
    bf16x8 qr[4];
#pragma unroll
    for (int d0 = 0; d0 < 4; ++d0) qr[d0] = *(const bf16x8*)(Q + (rowbase + t0 + r32) * 512 + h * 64 + d0 * 16 + hi * 8);
    f32x16 o0 = {}, o1 = {};
    float carry = 0.f;
    int kt = t0 >> 6;
    bf16x8 kf[8];
#define SB_LOADK(KT) do { const int kb_ = (KT) * 64; \
        _Pragma("unroll") for (int d0 = 0; d0 < 4; ++d0) { kf[2 * d0] = *(const bf16x8*)(Kh + (size_t)(kb_ + r32) * 512 + d0 * 16 + hi * 8); kf[2 * d0 + 1] = *(const bf16x8*)(Kh + (size_t)(kb_ + 32 + r32) * 512 + d0 * 16 + hi * 8); } } while (0)
#define SB_DMAV(KT, BUF) do { const int kb_ = (KT) * 64; \
        _Pragma("unroll") for (int i = 0; i < 8; ++i) __builtin_amdgcn_global_load_lds((const unsigned*)(Vh + (size_t)(kb_ + 8 * i + (lane >> 3)) * 512 + (lane & 7) * 8), (LAS unsigned*)(vlds + (BUF) * VBYTES + i * 1024), 16, 0, 0); } while (0)
    int cur = 0;
    SB_DMAV(kt, 0);
    SB_LOADK(kt);
    const int trbase = (4 * hi + ((lane & 15) >> 2)) * VPITCH + (16 * ((lane >> 4) & 1) + 4 * (lane & 3)) * 2;
    bool diag = true;
    for (;; --kt) {
        const int kbase = kt * 64;
        f32x16 p0 = {}, p1 = {};
#pragma unroll
        for (int d0 = 0; d0 < 4; ++d0) { p0 = __builtin_amdgcn_mfma_f32_32x32x16_bf16(kf[2 * d0], qr[d0], p0, 0, 0, 0); p1 = __builtin_amdgcn_mfma_f32_32x32x16_bf16(kf[2 * d0 + 1], qr[d0], p1, 0, 0, 0); }
        asm volatile("" ::: "memory");
        if (kt > 0) { SB_DMAV(kt - 1, cur ^ 1); SB_LOADK(kt - 1); }
        asm volatile("" ::: "memory");
        bf16x8 pa[4]; float suf = 0.f;
        const int qrel = t0 + r32 - kbase;
#define SB_HALF(P, KOFF, PA0, PA1) do { f32x16 sp_; \
        _Pragma("unroll") for (int r = 0; r < 16; ++r) sp_[r] = __builtin_amdgcn_logf(1.f + __builtin_amdgcn_exp2f(P[r])); \
        if (diag) { _Pragma("unroll") for (int r = 0; r < 16; ++r) if (crow(r, hi) + (KOFF) >= qrel) sp_[r] = 0.f; } \
        float e_[4], og_[4], R_[4]; \
        _Pragma("unroll") for (int c = 0; c < 4; ++c) { sp_[4 * c + 2] += sp_[4 * c + 3]; sp_[4 * c + 1] += sp_[4 * c + 2]; sp_[4 * c] += sp_[4 * c + 1]; e_[c] = sp_[4 * c]; } \
        _Pragma("unroll") for (int c = 0; c < 4; ++c) og_[c] = __shfl_xor(e_[c], 32); \
        _Pragma("unroll") for (int c = 3; c >= 0; --c) { R_[c] = carry - (suf + (hi == 0 ? og_[c] : 0.f)); suf += e_[c] + og_[c]; } \
        _Pragma("unroll") for (int r = 0; r < 16; ++r) P[r] = __builtin_amdgcn_exp2f(P[r] - sp_[r] + R_[r >> 2]); \
        if (diag) { _Pragma("unroll") for (int r = 0; r < 16; ++r) if (crow(r, hi) + (KOFF) >= qrel) P[r] = 0.f; } \
        pg8::u32x4 w_; w_.x = pkbf(P[0], P[1]); w_.y = pkbf(P[2], P[3]); w_.z = pkbf(P[4], P[5]); w_.w = pkbf(P[6], P[7]); PA0 = __builtin_bit_cast(bf16x8, w_); \
        w_.x = pkbf(P[8], P[9]); w_.y = pkbf(P[10], P[11]); w_.z = pkbf(P[12], P[13]); w_.w = pkbf(P[14], P[15]); PA1 = __builtin_bit_cast(bf16x8, w_); } while (0)
        SB_HALF(p1, 32, pa[2], pa[3]);
        SB_HALF(p0, 0, pa[0], pa[1]);
#undef SB_HALF
        carry -= suf;
        diag = false;
        if (kt > 0) asm volatile("s_waitcnt vmcnt(16)" ::: "memory"); else asm volatile("s_waitcnt vmcnt(0)" ::: "memory");
        LAS const unsigned char* vb = vlds + cur * VBYTES + trbase;
#pragma unroll
        for (int s = 0; s < 4; ++s) {
            LAS const unsigned char* vp = vb + (16 * s) * VPITCH;
            const s16x4 a0 = vtr(vp), a1 = vtr(vp + 8 * VPITCH), b0 = vtr(vp + 64), b1 = vtr(vp + 8 * VPITCH + 64);
            const bf16x8 v0 = {a0[0], a0[1], a0[2], a0[3], a1[0], a1[1], a1[2], a1[3]}, v1 = {b0[0], b0[1], b0[2], b0[3], b1[0], b1[1], b1[2], b1[3]};
            o0 = __builtin_amdgcn_mfma_f32_32x32x16_bf16(pa[s], v0, o0, 0, 0, 0);
            o1 = __builtin_amdgcn_mfma_f32_32x32x16_bf16(pa[s], v1, o1, 0, 0, 0);
        }
        asm volatile("s_waitcnt lgkmcnt(0)" ::: "memory");
        cur ^= 1;
        if (kt == 0 || __all(carry < EXIT_THR)) break;
    }
    asm volatile("s_waitcnt vmcnt(0)" ::: "memory");
#undef SB_LOADK
#undef SB_DMAV
    bf16_t* Ow = O + (rowbase + t0) * 512 + h * 64 + r32;
#pragma unroll
    for (int r = 0; r < 16; ++r) { const int q = crow(r, hi); Ow[(size_t)q * 512] = (bf16_t)f2bf(o0[r]); Ow[(size_t)q * 512 + 32] = (bf16_t)f2bf(o1[r]); }
}
}

__device__ __forceinline__ void p2_pool(Frame& F, const bf16_t* U, bf16_t* MIX) {
    const int rows_per = M / F.G; const int col8 = F.lane, w = 2 << (col8 >> 4);
    for (int rb = F.wave * 8; rb < rows_per; rb += NWAVES * 8) { const int t0 = F.vcu * rows_per + rb;
        v4u ld[23];
#pragma unroll
        for (int i = 0; i < 23; ++i) ld[i] = *(const GAS v4u*)(U + ((long)(t0 - 15 + i)) * PW + col8 * 8);
#pragma unroll
        for (int r = 0; r < 8; ++r) { const int tl = (t0 + r) % SEQ; const int cnt = (tl + 1) < w ? (tl + 1) : w;
            float acc[8];
#pragma unroll
            for (int j = 0; j < 8; ++j) acc[j] = 0.f;
#pragma unroll
            for (int i = 0; i < 16; ++i) { const v4u u = ld[15 + r - i]; const float m = (i < cnt) ? 1.f : 0.f;
                acc[0] += m * bf2f(u.x & 0xffffu); acc[1] += m * bf2f(u.x >> 16); acc[2] += m * bf2f(u.y & 0xffffu); acc[3] += m * bf2f(u.y >> 16);
                acc[4] += m * bf2f(u.z & 0xffffu); acc[5] += m * bf2f(u.z >> 16); acc[6] += m * bf2f(u.w & 0xffffu); acc[7] += m * bf2f(u.w >> 16); }
            const float inv = 1.f / (float)cnt; const v4u self = ld[15 + r];
            v4u o; o.x = pk2(acc[0] * inv - bf2f(self.x & 0xffffu), acc[1] * inv - bf2f(self.x >> 16)); o.y = pk2(acc[2] * inv - bf2f(self.y & 0xffffu), acc[3] * inv - bf2f(self.y >> 16));
            o.z = pk2(acc[4] * inv - bf2f(self.z & 0xffffu), acc[5] * inv - bf2f(self.z >> 16)); o.w = pk2(acc[6] * inv - bf2f(self.w & 0xffffu), acc[7] * inv - bf2f(self.w >> 16));
            *(GAS v4u*)(MIX + (size_t)(t0 + r) * PW + col8 * 8) = o; } }
}

constexpr int P5_TAB = AUX_OFF + 2048;
constexpr int P5_CNT = AUX_OFF + 1024;
constexpr int LIST_CAP = 16384;
typedef float f32x16 __attribute__((ext_vector_type(16)));
__device__ __forceinline__ void p5_route(Frame& F, const Args& a) {
    unsigned char* ws = a.ws; const float* X1 = a.out; const float* g2 = a.in[13]; const float* mod = (const float*)(ws + WS_MOD); const float* rbias = a.in[15];
    unsigned char* H2 = ws + WS_H2; int* PE = (int*)(ws + WS_PE);
    const bf16_t* WH = (const bf16_t*)(ws + WS_WRH); const bf16_t* WL = (const bf16_t*)(ws + WS_WRL);
    unsigned long long* LIST = (unsigned long long*)(ws + WS_LIST); gu32* gcnt = F.ctl + CW_CNT;
    LAS unsigned char* Ahi = F.lds + RING_OFF; LAS unsigned char* Alo = Ahi + 65536; LAS float* part = (LAS float*)Ahi;
    LAS float* gsv = (LAS float*)(F.lds + P5_TAB); LAS float* shv = gsv + D; LAS unsigned* cnt_l = (LAS unsigned*)(F.lds + P5_CNT); LAS unsigned* base_l = cnt_l + 64; LAS float* rr = (LAS float*)(base_l + 64);
    const int lane = F.lane, wave = __builtin_amdgcn_readfirstlane(F.wave), r32 = lane & 31, hi = lane >> 5;
    const int row0 = F.vcu * 64;
    if (row0 < M) {
        const int b = row0 / SEQ;
        for (int k = F.tid; k < D; k += NWAVES * 64) { gsv[k] = g2[k] * (1.f + mod[b * 6 * D + 4 * D + k]); shv[k] = mod[b * 6 * D + 3 * D + k]; }
        if (F.tid < 64) cnt_l[F.tid] = 0u;
        { f32x4 v[8][4];
#pragma unroll
          for (int i = 0; i < 8; ++i) { const GAS f32x4* xr = (const GAS f32x4*)(X1 + (size_t)(row0 + 8 * wave + i) * D) + lane;
#pragma unroll
              for (int j = 0; j < 4; ++j) v[i][j] = xr[64 * j]; }
#pragma unroll
          for (int i = 0; i < 8; ++i) { float s = 0.f;
#pragma unroll
              for (int j = 0; j < 4; ++j) s += (v[i][j].x * v[i][j].x + v[i][j].y * v[i][j].y) + (v[i][j].z * v[i][j].z + v[i][j].w * v[i][j].w);
              s = wave_sum(s); if (lane == 0) rr[8 * wave + i] = rsqrtf(s * (1.f / D) + EPS); } }
        __syncthreads();
        f32x16 acc[2][2];
        const char* whb = (const char*)WH + wave * 8192; const char* wlb = (const char*)WL + wave * 8192;
#pragma unroll
        for (int x = 0; x < 2; ++x)
#pragma unroll
            for (int y = 0; y < 2; ++y) acc[x][y] = f32x16{};
#pragma unroll
        for (int kh = 0; kh < 2; ++kh) {
            bf16x8 bh[4][2], bl[4][2];
#pragma unroll
            for (int s4 = 0; s4 < 4; ++s4)
#pragma unroll
                for (int t = 0; t < 2; ++t) { const int fo = kh * 65536 + (s4 * 2 + t) * 1024;
                    bh[s4][t] = *(const bf16x8*)(whb + fo + lane * 16); bl[s4][t] = *(const bf16x8*)(wlb + fo + lane * 16); }
#pragma unroll
            for (int i = 0; i < 8; ++i) { const int rl = 8 * wave + i, row = row0 + rl; const float r = rr[rl];
                if ((i & 1) == 0) __builtin_amdgcn_sched_barrier(0);
                const GAS f32x4* xr = (const GAS f32x4*)(X1 + (size_t)row * D + 512 * kh) + lane;
                GAS unsigned* o4 = (GAS unsigned*)(H2 + (size_t)row * D + 512 * kh) + lane;
#pragma unroll
                for (int j = 0; j < 2; ++j) { const f32x4 xv = xr[64 * j];
                    const f32x4 gg = *(const LAS f32x4*)(gsv + 512 * kh + 4 * lane + 256 * j), ss = *(const LAS f32x4*)(shv + 512 * kh + 4 * lane + 256 * j);
                    const f32x4 h = xv * r * gg + ss;
                    const unsigned p01 = pk2(h.x, h.y), p23 = pk2(h.z, h.w);
                    const unsigned long long hh = (unsigned long long)p01 | ((unsigned long long)p23 << 32);
                    { const f32x4 h8 = h * H8SCALE; unsigned q8 = 0u;
                      q8 = __builtin_amdgcn_cvt_pk_fp8_f32(__builtin_amdgcn_fmed3f(h8.x, -448.f, 448.f), __builtin_amdgcn_fmed3f(h8.y, -448.f, 448.f), q8, false);
                      q8 = __builtin_amdgcn_cvt_pk_fp8_f32(__builtin_amdgcn_fmed3f(h8.z, -448.f, 448.f), __builtin_amdgcn_fmed3f(h8.w, -448.f, 448.f), q8, true);
                      o4[64 * j] = q8; }
                    const unsigned long long ll = (unsigned long long)pk2(h.x - __builtin_bit_cast(float, p01 << 16), h.y - __builtin_bit_cast(float, p01 & 0xffff0000u))
                                                | ((unsigned long long)pk2(h.z - __builtin_bit_cast(float, p23 << 16), h.w - __builtin_bit_cast(float, p23 & 0xffff0000u)) << 32);
                    const int chunk = (lane >> 1) + 32 * j, off = rl * 1024 + ((chunk ^ (rl & 15)) << 4) + ((lane & 1) << 3);
                    *(LAS unsigned long long*)(Ahi + off) = hh; *(LAS unsigned long long*)(Alo + off) = ll; } }
            __syncthreads();
#pragma unroll
            for (int s4 = 0; s4 < 4; ++s4) { const int chunk = 8 * wave + 2 * s4 + hi;
                const bf16x8 bh0 = bh[s4][0], bh1 = bh[s4][1], bl0 = bl[s4][0], bl1 = bl[s4][1];
#pragma unroll
                for (int x = 0; x < 2; ++x) { const int rw = 32 * x + r32, off = rw * 1024 + ((chunk ^ (rw & 15)) << 4);
                    const bf16x8 ah = *(const LAS bf16x8*)(Ahi + off), al = *(const LAS bf16x8*)(Alo + off);
                    acc[x][0] = __builtin_amdgcn_mfma_f32_32x32x16_bf16(ah, bh0, acc[x][0], 0, 0, 0); acc[x][1] = __builtin_amdgcn_mfma_f32_32x32x16_bf16(ah, bh1, acc[x][1], 0, 0, 0);
                    acc[x][0] = __builtin_amdgcn_mfma_f32_32x32x16_bf16(al, bh0, acc[x][0], 0, 0, 0); acc[x][1] = __builtin_amdgcn_mfma_f32_32x32x16_bf16(al, bh1, acc[x][1], 0, 0, 0);
                    acc[x][0] = __builtin_amdgcn_mfma_f32_32x32x16_bf16(ah, bl0, acc[x][0], 0, 0, 0); acc[x][1] = __builtin_amdgcn_mfma_f32_32x32x16_bf16(ah, bl1, acc[x][1], 0, 0, 0); } }
            __syncthreads();
        }
#pragma unroll
        for (int x = 0; x < 2; ++x)
#pragma unroll
            for (int r = 0; r < 16; ++r) { const int rw = 32 * x + (r & 3) + 8 * (r >> 2) + 4 * hi; part[wave * 4096 + rw * 64 + r32] = acc[x][0][r]; part[wave * 4096 + rw * 64 + 32 + r32] = acc[x][1][r]; }
        __syncthreads();
        float scq[8];
#pragma unroll
        for (int q = 0; q < 8; ++q) { const int rl = wave + 8 * q; float logit = 0.f;
#pragma unroll
            for (int w = 0; w < 8; ++w) logit += part[w * 4096 + rl * 64 + lane];
            scq[q] = 1.f / (1.f + expf(-logit)); }
        __syncthreads();
        LAS float* scoreT = (LAS float*)(F.lds + RING_OFF);
#pragma unroll
        for (int q = 0; q < 8; ++q) scoreT[lane * 65 + wave + 8 * q] = scq[q];
        __syncthreads();
        if (wave == 0) {
            float sel[64];
#pragma unroll
            for (int e = 0; e < 64; ++e) sel[e] = scoreT[e * 65 + lane] + rbias[e];
            float gs[8];
#pragma unroll
            for (int g = 0; g < 8; ++g) { float m1 = sel[8 * g], m2 = -INFINITY;
#pragma unroll
                for (int j = 1; j < 8; ++j) { const float v = sel[8 * g + j]; const float lo = fminf(m1, v); m1 = fmaxf(m1, v); m2 = fmaxf(m2, lo); }
                gs[g] = m1 + m2; }
            unsigned gmask = 0u;
#pragma unroll
            for (int g = 0; g < 8; ++g) { int rk = 0;
#pragma unroll
                for (int h = 0; h < 8; ++h) if (h != g) rk += (gs[h] > gs[g] || (gs[h] == gs[g] && h < g)) ? 1 : 0;
                gmask |= (rk < 4) ? (1u << g) : 0u; }
#pragma unroll
            for (int e = 0; e < 64; ++e) sel[e] = ((gmask >> (e >> 3)) & 1u) ? sel[e] : -INFINITY;
            unsigned long long taken = 0ull; int ex[8]; float ws_[8]; float wsum = 0.f;
#pragma unroll
            for (int r = 0; r < TOPK; ++r) { float best = -INFINITY; int bi = 0;
#pragma unroll
                for (int e = 0; e < 64; ++e) { const bool c = !((taken >> e) & 1ull) && sel[e] > best; best = c ? sel[e] : best; bi = c ? e : bi; }
                taken |= 1ull << bi; ex[r] = bi; ws_[r] = scoreT[bi * 65 + lane]; wsum += ws_[r]; }
            const float wn = RSCALE / wsum;
#pragma unroll
            for (int r = 0; r < TOPK; ++r) { const unsigned pos = __hip_atomic_fetch_add(cnt_l + ex[r], 1u, __ATOMIC_RELAXED, __HIP_MEMORY_SCOPE_WORKGROUP);
                LAS unsigned* pk = (LAS unsigned*)(F.lds + RING_OFF + 32768) + (lane * 8 + r) * 4; pk[0] = (unsigned)ex[r]; pk[1] = pos; pk[2] = __builtin_bit_cast(unsigned, ws_[r] * wn); }
        }
        __syncthreads();
        if (F.tid < 64) base_l[F.tid] = __hip_atomic_fetch_add(gcnt + 64 * F.tid, cnt_l[F.tid], __ATOMIC_RELAXED, __HIP_MEMORY_SCOPE_AGENT);
        __syncthreads();
        { LAS const unsigned* pk = (LAS const unsigned*)(F.lds + RING_OFF + 32768) + F.tid * 4; const unsigned e = pk[0], pos = pk[1], wb = pk[2];
          const int pair = (row0 + (F.tid >> 3)) * 8 + (F.tid & 7);
          LIST[(size_t)e * LIST_CAP + base_l[e] + pos] = (unsigned long long)(unsigned)pair | ((unsigned long long)wb << 32);
          PE[pair] = (int)e; }
        __syncthreads();
    }
}

namespace pg8 {
struct UnitG { int kind, slot, nvalid, pm, pn, row0; const char* bptr; };
constexpr int P6_PRE = AUX_OFF + 1024;
constexpr int P6_ROWS = AUX_OFF + 2048;
struct SchedG {
    const LAS int* pre; const LAS int* cnts; const LAS int* cum; const char* wgu; const char* wsh; int G, c, nr, total;
    __device__ __forceinline__ bool next(int i, UnitG& u) const {
        const int idx = i * G + c; if (idx >= total) return false;
        if (idx < nr) { int e = (int)__builtin_popcountll(__ballot(pre[1 + (threadIdx.x & 63)] <= idx));
            e = __builtin_amdgcn_readfirstlane(e); const int j = idx - __builtin_amdgcn_readfirstlane(pre[e]); const int nv = __builtin_amdgcn_readfirstlane(cnts[e]) - 256 * j;
            u.kind = 0; u.slot = i; u.nvalid = nv < 256 ? nv : 256; u.pm = e; u.pn = j; u.row0 = 256 * idx; u.bptr = wgu + (size_t)e * 256 * D; }
        else { const int s = idx - nr; u.kind = 1; u.slot = i; u.nvalid = 256; u.pm = s >> 1; u.pn = s & 1; u.row0 = (s >> 1) * 256; u.bptr = wsh + (size_t)(s & 1) * 256 * D; }
        return true; }
};
struct EpiGU {
    static constexpr bool PERM = true;
    unsigned char* HM; unsigned char* SH; int* SLOT; const LAS unsigned long long* rowinfo;
    __device__ __forceinline__ void operator()(const f32x4 (&acc)[2][2][4][2], const UnitG& u, int wr, int wc, int fr, int fq) const {
#pragma unroll
        for (int ai = 0; ai < 2; ++ai)
#pragma unroll
            for (int m = 0; m < 4; ++m) { const int r = ai * HALF + wr * 64 + m * 16 + fr;
                unsigned char* dst; float w;
                if (u.kind == 0) { const unsigned long long ri = rowinfo[u.slot * 256 + r]; dst = HM + (size_t)(u.row0 + r) * ED + wc * 32 + 8 * fq; w = __builtin_bit_cast(float, (unsigned)(ri >> 32)) * HM8SCALE;
                    if (wc == 0 && fq == 0) SLOT[u.row0 + r] = (r < u.nvalid) ? (int)(unsigned)ri : M * 8; }
                else { dst = SH + (size_t)(u.pm * 256 + r) * SHD + u.pn * 128 + wc * 32 + 8 * fq; w = SH8SCALE; }
                constexpr float DQ = 1.f / (W8SCALE * H8SCALE);
                const f32x4 g0 = acc[ai][0][m][0] * DQ, g1 = acc[ai][0][m][1] * DQ, u0 = acc[ai][1][m][0] * DQ, u1 = acc[ai][1][m][1] * DQ;
                float v[8];
#pragma unroll
                for (int j = 0; j < 4; ++j) { v[j] = __builtin_amdgcn_fmed3f(g0[j] * fsigmoid(g0[j]) * u0[j] * w, -448.f, 448.f); v[4 + j] = __builtin_amdgcn_fmed3f(g1[j] * fsigmoid(g1[j]) * u1[j] * w, -448.f, 448.f); }
                unsigned lo = 0u, hi = 0u;
                lo = __builtin_amdgcn_cvt_pk_fp8_f32(v[0], v[1], lo, false); lo = __builtin_amdgcn_cvt_pk_fp8_f32(v[2], v[3], lo, true);
                hi = __builtin_amdgcn_cvt_pk_fp8_f32(v[4], v[5], hi, false); hi = __builtin_amdgcn_cvt_pk_fp8_f32(v[6], v[7], hi, true);
                if (r < u.nvalid) *(unsigned long long*)dst = (unsigned long long)lo | ((unsigned long long)hi << 32); }
    }
};
typedef int i32x4_t __attribute__((ext_vector_type(4))); typedef int i32x8_t __attribute__((ext_vector_type(8)));
__device__ __forceinline__ i32x8_t cat8(const bf16x8& a, const bf16x8& b) { return __builtin_shufflevector(__builtin_bit_cast(i32x4_t, a), __builtin_bit_cast(i32x4_t, b), 0, 1, 2, 3, 4, 5, 6, 7); }
__device__ __forceinline__ void mfma8(f32x4& acc, const i32x8_t a, const i32x8_t b) { asm volatile("v_mfma_f32_16x16x128_f8f6f4 %0, %1, %2, %0" : "+v"(acc) : "v"(a), "v"(b)); }
__device__ __forceinline__ void mfma8_settle(f32x4 (&acc)[2][2][4][2]) {
    asm volatile("s_nop 15\n\ts_nop 15" ::: "memory");
#pragma unroll
    for (int a = 0; a < 2; ++a)
#pragma unroll
        for (int b = 0; b < 2; ++b)
#pragma unroll
            for (int m = 0; m < 4; ++m)
#pragma unroll
                for (int n = 0; n < 2; ++n) asm volatile("" : "+v"(acc[a][b][m][n]));
}
template <class Epi, class Sched, bool FP8 = false>
__device__ __forceinline__ void gemm_phase_g(PG8_LAS unsigned char* lds, const bf16_t* A, int K, const Sched& S, const Epi& E, const PG8_LAS unsigned long long* rowinfo) {
    int tid_ = threadIdx.x; asm volatile("" : "+v"(tid_));
    const int tid = tid_, wid = __builtin_amdgcn_readfirstlane(tid >> 6), lane = tid & 63, wr = wid >> 2, wc = wid & 3, fr = lane & 15, fq = lane >> 4;
    const int nt = K / BK;
    int RA[2], CA[2]; unsigned voffB[2];
#pragma unroll
    for (int i = 0; i < 2; ++i) { int R, C; stage_rc(tid * 16 + i * 8192, R, C); const int Rb = Epi::PERM ? ((R & ~31) + perm32(R & 31)) : R; RA[i] = R; CA[i] = C; voffB[i] = (unsigned)(Rb * K + C) * 2u; }
    const size_t kstep = (size_t)(BK * 2);
    const size_t hstep = (size_t)HALF * K * 2;
    const unsigned ldsw = (unsigned)wid * 1024u;
    const int aoff = lds_byte(wr * 64 + fr, fq * 8), boff = lds_byte(wc * 32 + fr, fq * 8);
#define PG8_AOFF(u, o0, o1) do { _Pragma("unroll") for (int _i = 0; _i < 2; ++_i) { unsigned r0_, r1_; \
        if ((u).kind == 0) { r0_ = (unsigned)rowinfo[(u).slot * 256 + RA[_i]] >> 3; r1_ = (unsigned)rowinfo[(u).slot * 256 + HALF + RA[_i]] >> 3; } \
        else { r0_ = (unsigned)((u).row0 + RA[_i]); r1_ = r0_ + HALF; } \
        o0[_i] = (r0_ * (unsigned)K + (unsigned)CA[_i]) * 2u; o1[_i] = (r1_ * (unsigned)K + (unsigned)CA[_i]) * 2u; } } while (0)
#define PG8_SA(b, h) (((b) * 2 + (h)) * HTB)
#define PG8_SB(b, h) ((4 + (b) * 2 + (h)) * HTB)
#define PG8_STAGE(bufoff, gbase, voff) do { _Pragma("unroll") for (int _i = 0; _i < 2; ++_i) \
        __builtin_amdgcn_global_load_lds((const unsigned*)((const char*)(gbase) + (voff)[_i]), (PG8_LAS unsigned*)(lds + (bufoff) + ldsw + _i * 8192), 16, 0, 0); } while (0)
#define PG8_LDA(dst, b, h) do { _Pragma("unroll") for (int m = 0; m < 4; ++m) _Pragma("unroll") for (int k = 0; k < 2; ++k) dst[m][k] = *(const PG8_LAS bf16x8*)(lds + PG8_SA(b, h) + aoff + m * 2048 + k * 1024); } while (0)
#define PG8_LDB(dst, b, h) do { _Pragma("unroll") for (int n = 0; n < 2; ++n) _Pragma("unroll") for (int k = 0; k < 2; ++k) dst[n][k] = *(const PG8_LAS bf16x8*)(lds + PG8_SB(b, h) + boff + n * 2048 + k * 1024); } while (0)
#define PG8_MMA(ai, bj, At, Bt) do { __builtin_amdgcn_s_setprio(1); _Pragma("unroll") for (int m = 0; m < 4; ++m) _Pragma("unroll") for (int n = 0; n < 2; ++n) { \
        if constexpr (FP8) mfma8(acc[ai][bj][m][n], cat8(Bt[n][0], Bt[n][1]), cat8(At[m][0], At[m][1])); \
        else { _Pragma("unroll") for (int k = 0; k < 2; ++k) acc[ai][bj][m][n] = __builtin_amdgcn_mfma_f32_16x16x32_bf16(Bt[n][k], At[m][k], acc[ai][bj][m][n], 0, 0, 0); } } __builtin_amdgcn_s_setprio(0); } while (0)
#define PG8_WAIT_V(n) asm volatile("s_waitcnt vmcnt(" #n ")" ::: "memory")
#define PG8_WAIT_L(n) asm volatile("s_waitcnt lgkmcnt(" #n ")" ::: "memory")
#define PG8_BAR __builtin_amdgcn_s_barrier()
#define PG8_SCHED __builtin_amdgcn_sched_barrier(0)
    UnitG cur, nxt; int ui = 0;
    if (!S.next(0, cur)) return;
    f32x4 acc[2][2][4][2];
#pragma unroll
    for (int a = 0; a < 2; ++a)
#pragma unroll
        for (int b = 0; b < 2; ++b)
#pragma unroll
            for (int m = 0; m < 4; ++m)
#pragma unroll
                for (int n = 0; n < 2; ++n) acc[a][b][m][n] = (f32x4){0.f, 0.f, 0.f, 0.f};
    bf16x8 At[4][2], B0[2][2], B1[2][2];
    const char* cA = (const char*)A; const char* cB = cur.bptr;
    unsigned vA0[2], vA1[2], nA0[2], nA1[2];
    PG8_AOFF(cur, vA0, vA1);
    PG8_STAGE(PG8_SB(0, 0), cB, voffB); PG8_STAGE(PG8_SB(0, 1), cB + hstep, voffB); PG8_STAGE(PG8_SA(0, 0), cA, vA0); PG8_STAGE(PG8_SA(0, 1), cA, vA1);
    if (wr == 1) PG8_BAR;
    PG8_WAIT_V(2); PG8_BAR;
    PG8_STAGE(PG8_SB(1, 0), cB + kstep, voffB); PG8_STAGE(PG8_SA(1, 0), cA + kstep, vA0); PG8_STAGE(PG8_SB(1, 1), cB + hstep + kstep, voffB);
    PG8_WAIT_V(6); PG8_BAR;
    for (;;) {
        const bool has_next = S.next(ui + 1, nxt);
        const char* nB = has_next ? nxt.bptr : cB;
        if (has_next) { PG8_AOFF(nxt, nA0, nA1); } else {
#pragma unroll
            for (int _i = 0; _i < 2; ++_i) { nA0[_i] = vA0[_i]; nA1[_i] = vA1[_i]; } }
#pragma nounroll
        for (int t = 0; t < nt; t += 2) {
            const bool last = (t == nt - 2);
            const char* a1 = cA + (size_t)(t + 1) * kstep;
            const char* a2 = last ? cA : cA + (size_t)(t + 2) * kstep; const char* b2 = last ? nB : cB + (size_t)(t + 2) * kstep;
            const char* a3 = a2 + kstep; const char* b3 = b2 + kstep;
            unsigned s0[2], s1[2];
#pragma unroll
            for (int _i = 0; _i < 2; ++_i) { s0[_i] = last ? nA0[_i] : vA0[_i]; s1[_i] = last ? nA1[_i] : vA1[_i]; }
            PG8_LDB(B0, 0, 0); PG8_LDB(B1, 0, 1); PG8_SCHED; PG8_LDA(At, 0, 0); PG8_STAGE(PG8_SA(1, 1), a1, vA1);
            PG8_WAIT_V(8); PG8_WAIT_L(0); PG8_BAR; PG8_MMA(0, 0, At, B0); PG8_MMA(0, 1, At, B1); PG8_BAR; PG8_SCHED;
            PG8_LDA(At, 0, 1); PG8_STAGE(PG8_SB(0, 0), b2, voffB); PG8_STAGE(PG8_SB(0, 1), b2 + hstep, voffB); PG8_STAGE(PG8_SA(0, 0), a2, s0);
            PG8_WAIT_V(8); PG8_WAIT_L(0); PG8_BAR; PG8_MMA(1, 0, At, B0); PG8_MMA(1, 1, At, B1); PG8_BAR; PG8_SCHED;
            PG8_LDB(B0, 1, 0); PG8_LDB(B1, 1, 1); PG8_SCHED; PG8_LDA(At, 1, 0); PG8_STAGE(PG8_SA(0, 1), a2, s1);
            PG8_WAIT_V(8); PG8_WAIT_L(0); PG8_BAR; PG8_MMA(0, 0, At, B0); PG8_MMA(0, 1, At, B1); PG8_BAR; PG8_SCHED;
            PG8_LDA(At, 1, 1); PG8_STAGE(PG8_SB(1, 0), b3, voffB); PG8_STAGE(PG8_SB(1, 1), b3 + hstep, voffB); PG8_STAGE(PG8_SA(1, 0), a3, s0);
            PG8_WAIT_V(8); PG8_WAIT_L(0); PG8_BAR; PG8_MMA(1, 0, At, B0); PG8_MMA(1, 1, At, B1); PG8_BAR; PG8_SCHED;
        }
        if (wr == 0) PG8_BAR;
        if constexpr (FP8) mfma8_settle(acc);
        E(acc, cur, wr, wc, fr, fq);
        if (!has_next) break;
#pragma unroll
        for (int a = 0; a < 2; ++a)
#pragma unroll
            for (int b = 0; b < 2; ++b)
#pragma unroll
                for (int m = 0; m < 4; ++m)
#pragma unroll
                    for (int n = 0; n < 2; ++n) acc[a][b][m][n] = (f32x4){0.f, 0.f, 0.f, 0.f};
        cur = nxt; cB = nB; ++ui;
#pragma unroll
        for (int _i = 0; _i < 2; ++_i) { vA0[_i] = nA0[_i]; vA1[_i] = nA1[_i]; }
        if (wr == 1) PG8_BAR;
    }
    PG8_WAIT_V(0);
    PG8_BAR;
#undef PG8_AOFF
#undef PG8_SA
#undef PG8_SB
#undef PG8_STAGE
#undef PG8_LDA
#undef PG8_LDB
#undef PG8_MMA
#undef PG8_WAIT_V
#undef PG8_WAIT_L
#undef PG8_BAR
#undef PG8_SCHED
}
}

__device__ __forceinline__ void p6_gateup(Frame& F, const Args& a) {
    unsigned char* ws = a.ws; gu32* gcnt = F.ctl + CW_CNT; const unsigned long long* LIST = (const unsigned long long*)(ws + WS_LIST);
    LAS int* pre = (LAS int*)(F.lds + pg8::P6_PRE); LAS int* cnts = pre + 65; LAS int* cum = cnts + 64; LAS unsigned long long* rowinfo = (LAS unsigned long long*)(F.lds + pg8::P6_ROWS);
    if (F.tid < 64) cnts[F.tid] = (int)__hip_atomic_load(gcnt + 64 * F.tid, RLX_AGENT);
    __syncthreads();
    if (F.tid == 0) { int s = 0, r = 0; for (int e = 0; e < 64; ++e) { pre[e] = s; cum[e] = r; s += (cnts[e] + 255) >> 8; r += cnts[e]; } pre[64] = s; cum[64] = r; }
    __syncthreads();
    pg8::SchedG S; S.pre = pre; S.cnts = cnts; S.cum = cum; S.wgu = (const char*)(ws + WS_WGU); S.wsh = (const char*)(ws + WS_WSHGU); S.G = F.G; S.c = (int)blockIdx.x; S.nr = __builtin_amdgcn_readfirstlane(pre[64]); S.total = S.nr + 2 * (M / 256);
    for (int i = 0; i < 3; ++i) { pg8::UnitG u; if (!S.next(i, u)) break;
        if (u.kind == 0 && F.tid < 256) { const int r = F.tid; rowinfo[i * 256 + r] = (r < u.nvalid) ? LIST[(size_t)u.pm * LIST_CAP + 256 * u.pn + r] : 0ull; } }
    __syncthreads();
    pg8::EpiGU E{ws + WS_HM, ws + WS_SH, (int*)(ws + WS_SLOT), rowinfo};
    pg8::gemm_phase_g<pg8::EpiGU, pg8::SchedG, true>(F.lds + RING_OFF, (const bf16_t*)(ws + WS_H2), D / 2, S, E, rowinfo);
    { const int rounds = (S.total + F.G - 1) / F.G, firstidle = S.total - (rounds - 1) * F.G;
      const int c = (int)blockIdx.x, nidle = F.G - firstidle;
      if (nidle > 0) { if (c >= firstidle) titem_run(F, a, true, 64 * 64 + 4 * 32, (c - firstidle) * NWAVES + F.wave, nidle * NWAVES); }
      else titem_run(F, a, true, 64 * 64 + 4 * 32, c * NWAVES + F.wave, F.G * NWAVES); }
}

namespace pg8 {
struct SchedYr {
    const LAS int* pre; int G, c, total;
    __device__ __forceinline__ bool next(int i, Unit& u) const {
        const int idx = i * G + c; if (idx >= total) return false;
        const int t = idx >> 2, pnl = idx & 3; int e = (int)__builtin_popcountll(__ballot(pre[1 + (threadIdx.x & 63)] <= t));
        e = __builtin_amdgcn_readfirstlane(e); u.pm = t; u.pn = 4 * e + pnl; return true; }
    __device__ __forceinline__ void a_ready(const Unit&) const {}
    __device__ __forceinline__ void done(const Unit&) const {}
};
constexpr float YSCALE = 8.f;
struct EpiStoreF8 {
    static constexpr bool PERM = true, AFTER_DRAIN = false;
    unsigned char* O; const PG8_LAS int* rowmap_l; int G, c; float scale;
    __device__ __forceinline__ void operator()(const f32x4 (&acc)[2][2][4][2], const Unit& u, int wr, int wc, int fr, int fq) const {
        const int slot = (4 * u.pm + (u.pn & 3) - c) / G; const PG8_LAS int* rm = rowmap_l + slot * 256 + wr * 64 + fr; const int col0 = (u.pn & 3) * BM + wc * 64 + 16 * fq;
#pragma unroll
        for (int ai = 0; ai < 2; ++ai)
#pragma unroll
            for (int m = 0; m < 4; ++m) { const int orow = rm[ai * HALF + m * 16]; u32x4 w;
#pragma unroll
                for (int bj = 0; bj < 2; ++bj) { const f32x4 v0 = acc[ai][bj][m][0] * scale, v1 = acc[ai][bj][m][1] * scale;
                    unsigned lo = 0u, hi = 0u;
                    lo = __builtin_amdgcn_cvt_pk_fp8_f32(v0[0], v0[1], lo, false); lo = __builtin_amdgcn_cvt_pk_fp8_f32(v0[2], v0[3], lo, true);
                    hi = __builtin_amdgcn_cvt_pk_fp8_f32(v1[0], v1[1], hi, false); hi = __builtin_amdgcn_cvt_pk_fp8_f32(v1[2], v1[3], hi, true);
                    if (bj == 0) { w.x = lo; w.y = hi; } else { w.z = lo; w.w = hi; } }
                *(u32x4*)(O + (size_t)orow * 1024 + col0) = w; }
    }
};
struct EpiStoreF8Dense {
    static constexpr bool PERM = true, AFTER_DRAIN = false;
    unsigned char* O; float scale;
    __device__ __forceinline__ void operator()(const f32x4 (&acc)[2][2][4][2], const Unit& u, int wr, int wc, int fr, int fq) const {
        const int row0 = u.pm * BM + wr * 64 + fr, col0 = (u.pn & 3) * BM + wc * 32 + 8 * fq;
#pragma unroll
        for (int ai = 0; ai < 2; ++ai)
#pragma unroll
            for (int m = 0; m < 4; ++m) { unsigned char* rowp = O + (size_t)(row0 + ai * HALF + m * 16) * 1024 + col0;
#pragma unroll
                for (int bj = 0; bj < 2; ++bj) { const f32x4 v0 = acc[ai][bj][m][0] * scale, v1 = acc[ai][bj][m][1] * scale;
                    unsigned lo = 0u, hi = 0u;
                    lo = __builtin_amdgcn_cvt_pk_fp8_f32(v0[0], v0[1], lo, false); lo = __builtin_amdgcn_cvt_pk_fp8_f32(v0[2], v0[3], lo, true);
                    hi = __builtin_amdgcn_cvt_pk_fp8_f32(v1[0], v1[1], hi, false); hi = __builtin_amdgcn_cvt_pk_fp8_f32(v1[2], v1[3], hi, true);
                    *(unsigned long long*)(rowp + bj * HALF) = (unsigned long long)lo | ((unsigned long long)hi << 32); } }
    }
};
struct EpiStore {
    static constexpr bool PERM = true, AFTER_DRAIN = false;
    bf16_t* O; int ldc, colmask;
    __device__ __forceinline__ void operator()(const f32x4 (&acc)[2][2][4][2], const Unit& u, int wr, int wc, int fr, int fq) const {
        const int row0 = u.pm * BM + wr * 64 + fr, col0 = (u.pn & colmask) * BM + wc * 32 + 8 * fq;
#pragma unroll
        for (int ai = 0; ai < 2; ++ai)
#pragma unroll
            for (int m = 0; m < 4; ++m) { bf16_t* rowp = O + (size_t)(row0 + ai * HALF + m * 16) * ldc + col0;
#pragma unroll
                for (int bj = 0; bj < 2; ++bj) { const f32x4 v0 = acc[ai][bj][m][0], v1 = acc[ai][bj][m][1];
                    u32x4 w; w.x = cvt_pk_bf16(v0[0], v0[1]); w.y = cvt_pk_bf16(v0[2], v0[3]); w.z = cvt_pk_bf16(v1[0], v1[1]); w.w = cvt_pk_bf16(v1[2], v1[3]);
                    *(u32x4*)(rowp + bj * HALF) = w; } }
    }
};
template <class Epi, class Sched, int NK>
__device__ __forceinline__ void gemm_phase_f8s(PG8_LAS unsigned char* lds, const unsigned char* A, const unsigned char* Bt, const Sched& S, const Epi& E) {
    int tid_ = threadIdx.x; asm volatile("" : "+v"(tid_));
    const int tid = tid_, wid = __builtin_amdgcn_readfirstlane(tid >> 6), lane = tid & 63, wr = wid >> 2, wc = wid & 3, fr = lane & 15, fq = lane >> 4;
    constexpr int PITCH = NK * 128;
    unsigned voffA[2], voffB[2];
#pragma unroll
    for (int i = 0; i < 2; ++i) { int R, C; stage_rc(tid * 16 + i * 8192, R, C); const int Rb = Epi::PERM ? ((R & ~31) + perm32(R & 31)) : R; voffA[i] = (unsigned)(R * PITCH + 2 * C); voffB[i] = (unsigned)(Rb * PITCH + 2 * C); }
    constexpr size_t hstep = (size_t)HALF * PITCH, tstep = 2 * hstep;
    const unsigned ldsw = (unsigned)wid * 1024u;
    const int aoff = lds_byte(wr * 64 + fr, fq * 8), boff = lds_byte(wc * 32 + fr, fq * 8);
#define F8S_SA(b, h) (((b) * 2 + (h)) * HTB)
#define F8S_SB(b, h) ((4 + (b) * 2 + (h)) * HTB)
#define F8S_STAGE(bufoff, gbase, voff) do { _Pragma("unroll") for (int _i = 0; _i < 2; ++_i) \
        __builtin_amdgcn_global_load_lds((const unsigned*)((const char*)(gbase) + (voff)[_i]), (PG8_LAS unsigned*)(lds + (bufoff) + ldsw + _i * 8192), 16, 0, 0); } while (0)
#define F8S_STAGE4(b, pa, pb) do { F8S_STAGE(F8S_SB(b, 0), pb, voffB); F8S_STAGE(F8S_SB(b, 1), (pb) + hstep, voffB); F8S_STAGE(F8S_SA(b, 0), pa, voffA); F8S_STAGE(F8S_SA(b, 1), (pa) + hstep, voffA); } while (0)
#define F8S_LDA(dst, b, h) do { _Pragma("unroll") for (int m = 0; m < 4; ++m) _Pragma("unroll") for (int k = 0; k < 2; ++k) dst[m][k] = *(const PG8_LAS bf16x8*)(lds + F8S_SA(b, h) + aoff + m * 2048 + k * 1024); } while (0)
#define F8S_LDB(dst, b, h) do { _Pragma("unroll") for (int n = 0; n < 2; ++n) _Pragma("unroll") for (int k = 0; k < 2; ++k) dst[n][k] = *(const PG8_LAS bf16x8*)(lds + F8S_SB(b, h) + boff + n * 2048 + k * 1024); } while (0)
#define F8S_MMA(ai, bj, At, Bt_) do { _Pragma("unroll") for (int m = 0; m < 4; ++m) _Pragma("unroll") for (int n = 0; n < 2; ++n) mfma8(acc[ai][bj][m][n], cat8(Bt_[n][0], Bt_[n][1]), cat8(At[m][0], At[m][1])); } while (0)
    Unit cur, nxt; int ui = 0;
    if (!S.next(0, cur)) return;
    f32x4 acc[2][2][4][2];
#pragma unroll
    for (int a = 0; a < 2; ++a)
#pragma unroll
        for (int b = 0; b < 2; ++b)
#pragma unroll
            for (int m = 0; m < 4; ++m)
#pragma unroll
                for (int n = 0; n < 2; ++n) acc[a][b][m][n] = (f32x4){0.f, 0.f, 0.f, 0.f};
    const char* cA = (const char*)A + (size_t)cur.pm * tstep; const char* cB = (const char*)Bt + (size_t)cur.pn * tstep;
    bool has_next = S.next(1, nxt);
    int b = 0, kt = 0;
    F8S_STAGE4(0, cA, cB);
    asm volatile("s_waitcnt vmcnt(0)" ::: "memory");
#pragma nounroll
    for (;;) {
        __builtin_amdgcn_s_barrier();
        bf16x8 At0[4][2], At1[4][2], B0[2][2], B1[2][2];
        F8S_LDB(B0, b, 0); F8S_LDB(B1, b, 1); F8S_LDA(At0, b, 0); F8S_LDA(At1, b, 1);
        asm volatile("s_waitcnt lgkmcnt(0)" ::: "memory");
        __builtin_amdgcn_s_barrier();
        const bool last_kt = (kt == NK - 1), more = !last_kt || has_next;
        if (more) { const char* nA = last_kt ? (const char*)A + (size_t)nxt.pm * tstep : cA + (kt + 1) * 128; const char* nB = last_kt ? (const char*)Bt + (size_t)nxt.pn * tstep : cB + (kt + 1) * 128;
            if (b == 0) F8S_STAGE4(1, nA, nB); else F8S_STAGE4(0, nA, nB); }
        __builtin_amdgcn_s_setprio(1);
        F8S_MMA(0, 0, At0, B0); F8S_MMA(0, 1, At0, B1); F8S_MMA(1, 0, At1, B0); F8S_MMA(1, 1, At1, B1);
        __builtin_amdgcn_s_setprio(0);
        asm volatile("s_waitcnt vmcnt(0)" ::: "memory");
        if (last_kt) {
            mfma8_settle(acc);
            E(acc, cur, wr, wc, fr, fq);
            if (!has_next) break;
#pragma unroll
            for (int a = 0; a < 2; ++a)
#pragma unroll
                for (int bb = 0; bb < 2; ++bb)
#pragma unroll
                    for (int m = 0; m < 4; ++m)
#pragma unroll
                        for (int n = 0; n < 2; ++n) acc[a][bb][m][n] = (f32x4){0.f, 0.f, 0.f, 0.f};
            cur = nxt; cA = (const char*)A + (size_t)cur.pm * tstep; cB = (const char*)Bt + (size_t)cur.pn * tstep; ++ui; has_next = S.next(ui + 1, nxt); kt = 0;
        } else ++kt;
        b ^= 1;
    }
    __builtin_amdgcn_s_barrier();
#undef F8S_SA
#undef F8S_SB
#undef F8S_STAGE
#undef F8S_STAGE4
#undef F8S_LDA
#undef F8S_LDB
#undef F8S_MMA
}
}
__device__ __forceinline__ void p7_down(Frame& F, const Args& a) {
    unsigned char* ws = a.ws; gu32* gcnt = F.ctl + CW_CNT;
    LAS int* pre = (LAS int*)(F.lds + pg8::P6_PRE); LAS int* cnts = pre + 65;
    if (F.tid < 64) cnts[F.tid] = (int)__hip_atomic_load(gcnt + 64 * F.tid, RLX_AGENT);
    __syncthreads();
    if (F.tid == 0) { int s = 0; for (int e = 0; e < 64; ++e) { pre[e] = s; s += (cnts[e] + 255) >> 8; } pre[64] = s; }
    __syncthreads();
    { pg8::SchedYr S; S.pre = pre; S.G = F.G; S.c = (int)blockIdx.x; S.total = 4 * __builtin_amdgcn_readfirstlane(pre[64]);
      int kk = ED; asm volatile("" : "+s"(kk));
      LAS int* rml = (LAS int*)(F.lds + AUX_OFF + 2048); const int* rowmap = (const int*)(ws + WS_SLOT);
      for (int i = 0; i * F.G + S.c < S.total && i < 12; ++i) { if (F.tid < 256) rml[i * 256 + F.tid] = rowmap[256 * ((i * F.G + S.c) >> 2) + F.tid]; }
      __syncthreads();
      pg8::EpiStoreF8 E{ws + WS_YH, rml, F.G, S.c, pg8::YSCALE / (HM8SCALE * W8SCALE)};
      pg8::gemm_phase_f8s<pg8::EpiStoreF8, pg8::SchedYr, 1>(F.lds + RING_OFF, ws + WS_HM, ws + WS_WD, S, E); }
    { pg8::StaticOrder S; S.init(M, D, F.G, (int)blockIdx.x);
      int kk = SHD; asm volatile("" : "+s"(kk));
      pg8::EpiStoreF8Dense E{ws + WS_YSH, pg8::YSCALE / (SH8SCALE * W8SCALE)};
      pg8::gemm_phase_f8s<pg8::EpiStoreF8Dense, pg8::StaticOrder, 2>(F.lds + RING_OFF, ws + WS_SH, ws + WS_WSHD, S, E); }
}
__device__ __forceinline__ void p8_combine(Frame& F, const Args& a) {
    unsigned char* ws = a.ws; const unsigned char* Y8 = ws + WS_YH; const unsigned char* YSH = ws + WS_YSH;
    const float* mod = (const float*)(ws + WS_MOD); float* OUT = a.out; const int lane = F.lane;
    for (int tb = (F.vcu * NWAVES + F.wave) * 8; tb < M; tb += F.G * NWAVES * 8) {
        const int b = tb / SEQ; const float* gate = mod + (size_t)b * 6 * D + 5 * D + lane * 16;
        f32x4 gv[4];
#pragma unroll
        for (int i = 0; i < 4; ++i) gv[i] = *(const f32x4*)(gate + 4 * i);
#pragma nounroll
        for (int i = 0; i < 8; i += 2) {
            v4u y[2][9]; f32x4 x[2][4];
#pragma unroll
            for (int q = 0; q < 2; ++q) { const int t = tb + i + q;
#pragma unroll
                for (int k = 0; k < 8; ++k) y[q][k] = *(const GAS v4u*)(Y8 + ((size_t)t * 8 + k) * 1024 + lane * 16);
                y[q][8] = *(const GAS v4u*)(YSH + (size_t)t * D + lane * 16);
                const GAS f32x4* o = (const GAS f32x4*)(OUT + (size_t)t * D + lane * 16);
#pragma unroll
                for (int j = 0; j < 4; ++j) x[q][j] = o[j]; }
#pragma unroll
            for (int q = 0; q < 2; ++q) { const int t = tb + i + q; float acc[16];
#pragma unroll
                for (int j = 0; j < 16; ++j) acc[j] = 0.f;
#pragma unroll
                for (int k = 0; k < 9; ++k) { const unsigned w4[4] = {y[q][k].x, y[q][k].y, y[q][k].z, y[q][k].w};
#pragma unroll
                    for (int j = 0; j < 4; ++j) { const pg8::f32x2_t lo = __builtin_amdgcn_cvt_pk_f32_fp8((int)w4[j], false), hi = __builtin_amdgcn_cvt_pk_f32_fp8((int)w4[j], true);
                        acc[4 * j] += lo.x; acc[4 * j + 1] += lo.y; acc[4 * j + 2] += hi.x; acc[4 * j + 3] += hi.y; } }
                GAS f32x4* o = (GAS f32x4*)(OUT + (size_t)t * D + lane * 16);
#pragma unroll
                for (int j = 0; j < 4; ++j) { const f32x4 rt = {acc[4 * j], acc[4 * j + 1], acc[4 * j + 2], acc[4 * j + 3]};
                    o[j] = x[q][j] + gv[j] * (rt * (1.f / pg8::YSCALE)); } }
        }
    }
}

__global__ void __launch_bounds__(NWAVES * 64, 2) mk_fwd(Args args) {
    extern __shared__ __attribute__((aligned(16))) unsigned char lds[];
    Frame F;
    F.lds = (LAS unsigned char*)lds; F.MISC = (volatile LAS unsigned*)(F.lds + MISC_OFF);
    F.tid = threadIdx.x; F.lane = F.tid & 63; F.wave = __builtin_amdgcn_readfirstlane(F.tid >> 6);
    F.G = gridDim.x; { const int bx = blockIdx.x; F.vcu = (F.G % 8 == 0) ? (bx % 8) * (F.G / 8) + bx / 8 : bx; }
    unsigned char* ws = args.ws; F.ctl = (gu32*)(ws + WS_CTL);
    for (int u = F.tid; u < (LDS_BYTES - LDSCTL_OFF) / 4; u += NWAVES * 64) ((LAS unsigned*)(F.lds + LDSCTL_OFF))[u] = 0u;
    __syncthreads();
    XcdBarrier bar; bar.bar = (unsigned*)(F.ctl + CW_BAR); bar.x = 0; bar.st = nullptr;
    if (args.use_bar) bar = xcd_barrier_post((unsigned*)(F.ctl + CW_BAR), F.MISC + 8);
    const int lo = args.ph_lo, hi = args.ph_hi;
#define IN(k) (lo <= (k) && (k) < hi)
#define SEAM(k) do { if (IN(k) && IN((k) + 1)) xcd_barrier(bar); } while (0)
#define REFRESH() do { int t_ = threadIdx.x; asm volatile("" : "+v"(t_)); F.tid = t_; F.lane = t_ & 63; F.wave = __builtin_amdgcn_readfirstlane(t_ >> 6); } while (0)
#define PHASE(p, ...) do { if (IN(p)) { REFRESH(); const int reps_ = (DBL_PHASE == (p)) ? 2 : 1; for (int rep_ = 0; rep_ < reps_; ++rep_) { __VA_ARGS__; if (rep_ + 1 < reps_) xcd_barrier(bar); } } SEAM(p); } while (0)
    PHASE(0, { p0a(F, args); __syncthreads(); p0b(F, args); });
    PHASE(2, {
        pg8::Gemm g{(const bf16_t*)(ws + WS_XN), (const bf16_t*)(ws + WS_WIN), M, INW, D}; pg8::StaticOrder S; S.init(M, INW, F.G, (int)blockIdx.x);
        pg8::EpiProj E{(bf16_t*)(ws + WS_Q), (bf16_t*)(ws + WS_K), (bf16_t*)(ws + WS_V), (bf16_t*)(ws + WS_U), (bf16_t*)(ws + WS_GA), (bf16_t*)(ws + WS_GB), args.in[6], args.in[7]};
        pg8::gemm_phase<pg8::EpiProj, pg8::StaticOrder, true, true>(F.lds + RING_OFF, g, S, E); });
    PHASE(3, {
        const bf16_t* Q = (const bf16_t*)(ws + WS_Q); const bf16_t* K = (const bf16_t*)(ws + WS_K); const bf16_t* V = (const bf16_t*)(ws + WS_V);
        for (int u = blockIdx.x; u < BATCH * NH * (SEQ / 256); u += F.G) { const int qb = u & 15, bh = u >> 4;
            sb::attn_unit(bh >> 3, bh & 7, qb, Q, K, V, (bf16_t*)(ws + WS_OSB), F.lds + RING_OFF + F.wave * sb::WAVE_LDS, F.wave, F.lane); }
        p2_pool(F, (const bf16_t*)(ws + WS_U), (bf16_t*)(ws + WS_MIX)); });
    PHASE(4, {
        pg8::StaticOrder S; S.init(M, D, F.G, (int)blockIdx.x);
        { pg8::Gemm g{(const bf16_t*)(ws + WS_OSB), (const bf16_t*)(ws + WS_WSB), M, D, SBW}; pg8::EpiMerge E{(const bf16_t*)(ws + WS_GA), (bf16_t*)(ws + WS_MERGED), 0};
          pg8::gemm_phase<pg8::EpiMerge, pg8::StaticOrder, true, true>(F.lds + RING_OFF, g, S, E); }
        { pg8::Gemm g{(const bf16_t*)(ws + WS_MIX), (const bf16_t*)(ws + WS_WEFF), M, D, PW}; pg8::EpiMerge E{(const bf16_t*)(ws + WS_GB), (bf16_t*)(ws + WS_MERGED), 1};
          pg8::gemm_phase<pg8::EpiMerge, pg8::StaticOrder, true, true>(F.lds + RING_OFF, g, S, E); } });
    PHASE(5, {
        pg8::Gemm g{(const bf16_t*)(ws + WS_MERGED), (const bf16_t*)(ws + WS_WOUT), M, D, D}; pg8::StaticOrder S; S.init(M, D, F.G, (int)blockIdx.x);
        pg8::EpiX1 E{args.in[0], (const float*)(ws + WS_MOD) + 2 * D, args.out};
        pg8::gemm_phase<pg8::EpiX1, pg8::StaticOrder, true, true>(F.lds + RING_OFF, g, S, E); });
    PHASE(6, {
        if (rep_ > 0) { if (blockIdx.x == 0 && F.tid < 64) __hip_atomic_store(F.ctl + CW_CNT + 64 * F.tid, 0u, RLX_AGENT); xcd_barrier(bar); }
        p5_route(F, args); });
    PHASE(7, p6_gateup(F, args));
    PHASE(8, p7_down(F, args));
    if (IN(9)) { REFRESH(); p8_combine(F, args); }
#undef PHASE
#undef REFRESH
#undef IN
#undef SEAM
}
constexpr int N_PHASES = 10;
extern "C" void kernel_launch(void* const* d_in, const int* in_sizes, int n_in, void* d_out, int out_size, void* d_ws, size_t ws_size, hipStream_t stream) {
    static int grid = 0;
    if (grid == 0) {
        if (n_in != 22 || out_size != M * D || ws_size < WS_END) { fprintf(stderr, "kernel_launch: unexpected shapes n_in %d out %d ws %zu\n", n_in, out_size, ws_size); grid = -1; return; }
        int dev = 0, cus = 0, per_cu = 0;
        if (hipGetDevice(&dev) != hipSuccess || hipDeviceGetAttribute(&cus, hipDeviceAttributeMultiprocessorCount, dev) != hipSuccess) { grid = -1; return; }
        if (hipFuncSetAttribute((const void*)mk_fwd, hipFuncAttributeMaxDynamicSharedMemorySize, LDS_BYTES) != hipSuccess) { fprintf(stderr, "kernel_launch: hipFuncSetAttribute failed\n"); grid = -1; return; }
        if (hipOccupancyMaxActiveBlocksPerMultiprocessor(&per_cu, (const void*)mk_fwd, NWAVES * 64, LDS_BYTES) != hipSuccess || per_cu < 1) fprintf(stderr, "kernel_launch: occupancy query says %d per CU\n", per_cu);
        (void)hipGetLastError();
        grid = cus;
        if (grid * 64 < M) { fprintf(stderr, "kernel_launch: %d CUs cannot cover %d rows in the one-block-per-workgroup phases\n", cus, M); grid = -1; return; }
    }
    if (grid < 0) return;
    unsigned char* ws = (unsigned char*)d_ws;
    if (hipMemsetAsync(ws + WS_CTL, 0, CTL_ZERO_BYTES, stream) != hipSuccess) { fprintf(stderr, "kernel_launch: memset failed\n"); return; }
    Args a{};
    for (int i = 0; i < 22; ++i) a.in[i] = (const float*)d_in[i];
    a.out = (float*)d_out; a.ws = ws; a.ph_lo = 0; a.ph_hi = N_PHASES; a.use_bar = 1;
    hipLaunchKernelGGL(mk_fwd, dim3(grid), dim3(NWAVES * 64), LDS_BYTES, stream, a);
}
```

```cpp
#include <hip/hip_runtime.h>
#include <cstdint>
#include <cstdio>

typedef unsigned short bf16_t;
constexpr int D = 1024, BATCH = 4, SEQ = 4096, M = BATCH * SEQ, NH = 8, HD = 64, SBW = 512, PW = 512, INW = 4096;
constexpr int NE = 64, ED = 128, TOPK = 8, SHD = 256;
constexpr float EPS = 1e-6f, RSCALE = 2.5f;

constexpr size_t MiB = 1u << 20;
constexpr size_t WS_CTL = 0, WS_MOD = 1 * MiB, WS_PE = 2 * MiB, WS_PW = 3 * MiB, WS_LIST = 4 * MiB;
constexpr size_t WS_XN = 74 * MiB, WS_OSB = 74 * MiB, WS_MIX = 90 * MiB, WS_H2 = 74 * MiB;
constexpr size_t WS_Q = 106 * MiB, WS_K = 122 * MiB, WS_V = 138 * MiB, WS_MERGED = 106 * MiB;
constexpr size_t WS_SLOT = 190 * MiB, WS_SH = 192 * MiB, WS_HM = 200 * MiB;
constexpr size_t WS_YH = 12 * MiB, WS_YSH = 156 * MiB;
constexpr size_t WS_U = 154 * MiB, WS_GA = 170 * MiB, WS_GB = 202 * MiB, WS_END = 256 * MiB;

__device__ __forceinline__ unsigned f2bf(float f) { unsigned u = __builtin_bit_cast(unsigned, f); return (u + 0x7fffu + ((u >> 16) & 1u)) >> 16; }
__device__ __forceinline__ float bf2f(unsigned h) { return __builtin_bit_cast(float, h << 16); }
__device__ __forceinline__ float wave_sum(float v) {
#pragma unroll
    for (int o = 1; o < 64; o <<= 1) v += __shfl_xor(v, o);
    return v;
}
__device__ __forceinline__ float sigmoidf_(float v) { return 1.f / (1.f + __expf(-v)); }
__device__ __forceinline__ float siluf_(float v) { return v / (1.f + __expf(-v)); }

namespace pg8 {
#define PG8_LAS __attribute__((address_space(3)))
typedef short bf16x8 __attribute__((ext_vector_type(8)));
typedef float f32x4 __attribute__((ext_vector_type(4)));
typedef unsigned u32x4 __attribute__((ext_vector_type(4)));
constexpr int BM = 256, BK = 64, HALF = 128, HTB = HALF * BK * 2  , STAGE_BYTES = 8 * HTB, NXCD = 8, WGM = 8;

__host__ __device__ __forceinline__ int lds_byte(int r, int c) { const int st = (r >> 4) * 2 + (c >> 5), rr = r & 15, cc = c & 31, ob = rr * 64 + cc * 2; return st * 1024 + (ob ^ (((ob >> 9) & 1) << 5)); }
__host__ __device__ __forceinline__ void stage_rc(int b, int& R, int& C) { const int st = b / 1024, sb = b % 1024, swz = sb ^ (((sb >> 9) & 1) << 5); R = (st >> 1) * 16 + swz / 64; C = (st & 1) * 32 + (swz % 64) / 2; }
__host__ __device__ __forceinline__ int perm32(int rho) { const int n = rho >> 4, i = rho & 15; return 8 * (i >> 2) + 4 * n + (i & 3); }

struct Unit { int pm, pn; };
struct Gemm { const bf16_t* A; const bf16_t* Bt; int M, N, K; };

struct StaticOrder {
    int nM, nN, nwg, G, c;
    __host__ __device__ void init(int M_, int N_, int G_, int c_) { nM = M_ / BM; nN = N_ / BM; nwg = nM * nN; G = G_; c = c_; }
    __host__ __device__ bool next(int i, Unit& u) const {
        const long L = (long)i * G + c; if (L >= nwg) return false;
        int wgid = (int)L; { const int q = nwg / NXCD, r = nwg % NXCD, xcd = wgid % NXCD, off = wgid / NXCD; wgid = (xcd < r ? xcd * (q + 1) : r * (q + 1) + (xcd - r) * q) + off; }
        const int nig = WGM * nN, gid = wgid / nig, fm = gid * WGM, gsz = (nM - fm) < WGM ? (nM - fm) : WGM;
        u.pm = fm + ((wgid % nig) % gsz); u.pn = (wgid % nig) / gsz; return true;
    }
    __device__ __forceinline__ void a_ready(const Unit&) const {}
    __device__ __forceinline__ void done(const Unit&) const {}
};
typedef float f32x2_t __attribute__((ext_vector_type(2))); typedef __bf16 bf16x2_t __attribute__((ext_vector_type(2)));
__device__ __forceinline__ unsigned cvt_pk_bf16(float lo, float hi) { f32x2_t v = {lo, hi}; bf16x2_t b = __builtin_convertvector(v, bf16x2_t); return __builtin_bit_cast(unsigned, b); }
__device__ __forceinline__ float fsigmoid(float v) { return __builtin_amdgcn_rcpf(1.f + __builtin_amdgcn_exp2f(-1.4426950408889634f * v)); }
constexpr float QSCALE = 0.125f * 1.4426950408889634f;

struct EpiProj {
    static constexpr bool PERM = true, AFTER_DRAIN = false;
    bf16_t *Q, *K, *V, *U, *GA, *GB; const float* gq; const float* gk; int sec0; float dq;
    __device__ __forceinline__ void operator()(const f32x4 (&acc)[2][2][4][2], const Unit& u, int wr, int wc, int fr, int fq) const {
        const int row0 = u.pm * BM + wr * 64 + fr; const int sec = u.pn + sec0;
        if (sec < 4) {
            const bool isq = sec < 2; const float* g = isq ? gq : gk; bf16_t* base = (isq ? Q : K) + ((sec & 1) * 4 + wc) * 64 + 8 * fq;
            const float qs = isq ? QSCALE : 1.f;
            f32x4 gv[2][2];
#pragma unroll
            for (int bj = 0; bj < 2; ++bj)
#pragma unroll
                for (int n = 0; n < 2; ++n) gv[bj][n] = *(const f32x4*)(g + 32 * bj + 8 * fq + 4 * n);
#pragma unroll
            for (int ai = 0; ai < 2; ++ai)
#pragma unroll
                for (int m = 0; m < 4; ++m) {
                    float ss = 0.f;
#pragma unroll
                    for (int bj = 0; bj < 2; ++bj)
#pragma unroll
                        for (int n = 0; n < 2; ++n) { const f32x4 x = acc[ai][bj][m][n]; ss += (x[0] * x[0] + x[1] * x[1]) + (x[2] * x[2] + x[3] * x[3]); }
                    ss += __shfl_xor(ss, 16); ss += __shfl_xor(ss, 32);
                    const float r = rsqrtf(ss * (1.f / 64.f) + EPS) * qs;
                    bf16_t* rowp = base + (size_t)(row0 + ai * HALF + m * 16) * 512;
#pragma unroll
                    for (int bj = 0; bj < 2; ++bj) { const f32x4 v0 = acc[ai][bj][m][0] * gv[bj][0] * r, v1 = acc[ai][bj][m][1] * gv[bj][1] * r;
                        u32x4 w; w.x = cvt_pk_bf16(v0[0], v0[1]); w.y = cvt_pk_bf16(v0[2], v0[3]); w.z = cvt_pk_bf16(v1[0], v1[1]); w.w = cvt_pk_bf16(v1[2], v1[3]);
                        *(u32x4*)(rowp + 32 * bj) = w; }
                }
        } else if (sec < 8) {
            bf16_t* base = (sec < 6 ? V : U) + (sec & 1) * 256 + wc * 32 + 8 * fq;
#pragma unroll
            for (int ai = 0; ai < 2; ++ai)
#pragma unroll
                for (int m = 0; m < 4; ++m) { bf16_t* rowp = base + (size_t)(row0 + ai * HALF + m * 16) * 512;
#pragma unroll
                    for (int bj = 0; bj < 2; ++bj) { const f32x4 v0 = acc[ai][bj][m][0], v1 = acc[ai][bj][m][1];
                        u32x4 w; w.x = cvt_pk_bf16(v0[0], v0[1]); w.y = cvt_pk_bf16(v0[2], v0[3]); w.z = cvt_pk_bf16(v1[0], v1[1]); w.w = cvt_pk_bf16(v1[2], v1[3]);
                        *(u32x4*)(rowp + bj * HALF) = w; } }
        } else {
            bf16_t* base = (sec < 12 ? GA : GB) + ((sec - 8) & 3) * 256 + wc * 32 + 8 * fq;
#pragma unroll
            for (int ai = 0; ai < 2; ++ai)
#pragma unroll
                for (int m = 0; m < 4; ++m) { bf16_t* rowp = base + (size_t)(row0 + ai * HALF + m * 16) * 1024;
#pragma unroll
                    for (int bj = 0; bj < 2; ++bj) { const f32x4 v0 = acc[ai][bj][m][0] * dq, v1 = acc[ai][bj][m][1] * dq;
                        u32x4 w; w.x = cvt_pk_bf16(fsigmoid(v0[0]), fsigmoid(v0[1])); w.y = cvt_pk_bf16(fsigmoid(v0[2]), fsigmoid(v0[3])); w.z = cvt_pk_bf16(fsigmoid(v1[0]), fsigmoid(v1[1])); w.w = cvt_pk_bf16(fsigmoid(v1[2]), fsigmoid(v1[3]));
                        *(u32x4*)(rowp + bj * HALF) = w; } }
        }
    }
};

struct EpiMerge {
    static constexpr bool PERM = true, AFTER_DRAIN = false;
    const bf16_t* G; bf16_t* MG; int add;
    __device__ __forceinline__ void operator()(const f32x4 (&acc)[2][2][4][2], const Unit& u, int wr, int wc, int fr, int fq) const {
        const int row0 = u.pm * BM + wr * 64 + fr, col0 = u.pn * BM + wc * 32 + 8 * fq;
#pragma unroll
        for (int ai = 0; ai < 2; ++ai)
#pragma unroll
            for (int m = 0; m < 4; ++m) { const size_t off = (size_t)(row0 + ai * HALF + m * 16) * 1024 + col0;
#pragma unroll
                for (int bj = 0; bj < 2; ++bj) { const u32x4 g = *(const u32x4*)(G + off + bj * HALF); const f32x4 a0 = acc[ai][bj][m][0], a1 = acc[ai][bj][m][1];
                    float v[8] = {bf2f(g.x & 0xffffu) * a0[0], bf2f(g.x >> 16) * a0[1], bf2f(g.y & 0xffffu) * a0[2], bf2f(g.y >> 16) * a0[3], bf2f(g.z & 0xffffu) * a1[0], bf2f(g.z >> 16) * a1[1], bf2f(g.w & 0xffffu) * a1[2], bf2f(g.w >> 16) * a1[3]};
                    if (add) { const u32x4 o = *(const u32x4*)(MG + off + bj * HALF);
                        v[0] += bf2f(o.x & 0xffffu); v[1] += bf2f(o.x >> 16); v[2] += bf2f(o.y & 0xffffu); v[3] += bf2f(o.y >> 16); v[4] += bf2f(o.z & 0xffffu); v[5] += bf2f(o.z >> 16); v[6] += bf2f(o.w & 0xffffu); v[7] += bf2f(o.w >> 16); }
                    u32x4 w; w.x = cvt_pk_bf16(v[0], v[1]); w.y = cvt_pk_bf16(v[2], v[3]); w.z = cvt_pk_bf16(v[4], v[5]); w.w = cvt_pk_bf16(v[6], v[7]);
                    *(u32x4*)(MG + off + bj * HALF) = w; } }
    }
};
struct EpiX1 {
    static constexpr bool PERM = false, AFTER_DRAIN = false;
    const float* x; const float* gate; float* X1;
    __device__ __forceinline__ void operator()(const f32x4 (&acc)[2][2][4][2], const Unit& u, int wr, int wc, int fr, int fq) const {
        const int row0 = u.pm * BM + wr * 64 + fr, col0 = u.pn * BM + wc * 32 + 4 * fq; const int b = (u.pm * BM) / SEQ;
        f32x4 gv[2][2];
#pragma unroll
        for (int bj = 0; bj < 2; ++bj)
#pragma unroll
            for (int n = 0; n < 2; ++n) gv[bj][n] = *(const f32x4*)(gate + (size_t)b * 6 * D + col0 + bj * HALF + n * 16);
#pragma unroll
        for (int ai = 0; ai < 2; ++ai)
#pragma unroll
            for (int m = 0; m < 4; ++m) { const size_t off = (size_t)(row0 + ai * HALF + m * 16) * D + col0;
#pragma unroll
                for (int bj = 0; bj < 2; ++bj)
#pragma unroll
                    for (int n = 0; n < 2; ++n) *(f32x4*)(X1 + off + bj * HALF + n * 16) = *(const f32x4*)(x + off + bj * HALF + n * 16) + gv[bj][n] * acc[ai][bj][m][n]; }
    }
};

typedef int i32x4_t __attribute__((ext_vector_type(4))); typedef int i32x8_t __attribute__((ext_vector_type(8)));
__device__ __forceinline__ i32x8_t cat8(const bf16x8& a, const bf16x8& b) { return __builtin_shufflevector(__builtin_bit_cast(i32x4_t, a), __builtin_bit_cast(i32x4_t, b), 0, 1, 2, 3, 4, 5, 6, 7); }
__device__ __forceinline__ void mfma8(f32x4& acc, const i32x8_t a, const i32x8_t b) { asm volatile("v_mfma_f32_16x16x128_f8f6f4 %0, %1, %2, %0" : "+v"(acc) : "v"(a), "v"(b)); }
__device__ __forceinline__ void mfma8_settle(f32x4 (&acc)[2][2][4][2]) {
    asm volatile("s_nop 15\n\ts_nop 15" ::: "memory");
#pragma unroll
    for (int a = 0; a < 2; ++a)
#pragma unroll
        for (int b = 0; b < 2; ++b)
#pragma unroll
            for (int m = 0; m < 4; ++m)
#pragma unroll
                for (int n = 0; n < 2; ++n) asm volatile("" : "+v"(acc[a][b][m][n]));
}
template <class Epi, class Sched, bool ALIGN_EPI = false, bool SP2 = false, bool FP8 = false>
__device__ __forceinline__ void gemm_phase(PG8_LAS unsigned char* lds, const Gemm g, const Sched& S, const Epi& E) {
    int tid_ = threadIdx.x; asm volatile("" : "+v"(tid_));
    const int tid = tid_, wid = __builtin_amdgcn_readfirstlane(tid >> 6), lane = tid & 63, wr = wid >> 2, wc = wid & 3, fr = lane & 15, fq = lane >> 4;
    const int K = g.K, nt = K / BK;
    unsigned voffA[2], voffB[2];
#pragma unroll
    for (int i = 0; i < 2; ++i) { int R, C; stage_rc(tid * 16 + i * 8192, R, C); const int Rb = Epi::PERM ? ((R & ~31) + perm32(R & 31)) : R;
        voffA[i] = (unsigned)(R * K + C) * 2u; voffB[i] = (unsigned)(Rb * K + C) * 2u; }
    const size_t kstep = (size_t)(BK * 2);
    const size_t hstep = (size_t)HALF * K * 2;
    const size_t tstep = 2 * hstep;
    const unsigned ldsw = (unsigned)wid * 1024u;
    const int aoff = lds_byte(wr * 64 + fr, fq * 8), boff = lds_byte(wc * 32 + fr, fq * 8);
#define PG8_SA(b, h) (((b) * 2 + (h)) * HTB)
#define PG8_SB(b, h) ((4 + (b) * 2 + (h)) * HTB)
#define PG8_STAGE(bufoff, gbase, voff) do { _Pragma("unroll") for (int _i = 0; _i < 2; ++_i) \
        __builtin_amdgcn_global_load_lds((const unsigned*)((const char*)(gbase) + (voff)[_i]), (PG8_LAS unsigned*)(lds + (bufoff) + ldsw + _i * 8192), 16, 0, 0); } while (0)
#define PG8_LDA(dst, b, h) do { _Pragma("unroll") for (int m = 0; m < 4; ++m) _Pragma("unroll") for (int k = 0; k < 2; ++k) dst[m][k] = *(const PG8_LAS bf16x8*)(lds + PG8_SA(b, h) + aoff + m * 2048 + k * 1024); } while (0)
#define PG8_LDB(dst, b, h) do { _Pragma("unroll") for (int n = 0; n < 2; ++n) _Pragma("unroll") for (int k = 0; k < 2; ++k) dst[n][k] = *(const PG8_LAS bf16x8*)(lds + PG8_SB(b, h) + boff + n * 2048 + k * 1024); } while (0)
#define PG8_MMA(ai, bj, At, Bt) do { __builtin_amdgcn_s_setprio(1); _Pragma("unroll") for (int m = 0; m < 4; ++m) _Pragma("unroll") for (int n = 0; n < 2; ++n) { \
        if constexpr (FP8) mfma8(acc[ai][bj][m][n], cat8(Bt[n][0], Bt[n][1]), cat8(At[m][0], At[m][1])); \
        else { _Pragma("unroll") for (int k = 0; k < 2; ++k) acc[ai][bj][m][n] = __builtin_amdgcn_mfma_f32_16x16x32_bf16(Bt[n][k], At[m][k], acc[ai][bj][m][n], 0, 0, 0); } } __builtin_amdgcn_s_setprio(0); } while (0)
#define PG8_WAIT_V(n) asm volatile("s_waitcnt vmcnt(" #n ")" ::: "memory")
#define PG8_WAIT_L(n) asm volatile("s_waitcnt lgkmcnt(" #n ")" ::: "memory")
#define PG8_BAR __builtin_amdgcn_s_barrier()
#define PG8_SCHED __builtin_amdgcn_sched_barrier(0)
    Unit cur, nxt; int ui = 0;
    if (!S.next(0, cur)) return;
    f32x4 acc[2][2][4][2];
#pragma unroll
    for (int a = 0; a < 2; ++a)
#pragma unroll
        for (int b = 0; b < 2; ++b)
#pragma unroll
            for (int m = 0; m < 4; ++m)
#pragma unroll
                for (int n = 0; n < 2; ++n) acc[a][b][m][n] = (f32x4){0.f, 0.f, 0.f, 0.f};
    bf16x8 At[4][2], B0[2][2], B1[2][2];
    const char* cA = (const char*)g.A + (size_t)cur.pm * tstep; const char* cB = (const char*)g.Bt + (size_t)cur.pn * tstep;
    S.a_ready(cur);
    if constexpr (SP2) {
        PG8_STAGE(PG8_SB(0, 0), cB, voffB); PG8_STAGE(PG8_SB(0, 1), cB + hstep, voffB); PG8_STAGE(PG8_SA(0, 0), cA, voffA); PG8_STAGE(PG8_SA(0, 1), cA + hstep, voffA);
        if (wr == 1) PG8_BAR;
        PG8_WAIT_V(2); PG8_BAR;
        PG8_STAGE(PG8_SB(1, 0), cB + kstep, voffB); PG8_STAGE(PG8_SA(1, 0), cA + kstep, voffA); PG8_STAGE(PG8_SB(1, 1), cB + hstep + kstep, voffB);
        PG8_WAIT_V(6); PG8_BAR;
    } else {
        PG8_STAGE(PG8_SB(0, 0), cB, voffB); PG8_STAGE(PG8_SA(0, 0), cA, voffA); PG8_STAGE(PG8_SB(0, 1), cB + hstep, voffB); PG8_STAGE(PG8_SA(0, 1), cA + hstep, voffA);
        if (wr == 1) PG8_BAR;
        PG8_WAIT_V(4); PG8_BAR;
        PG8_STAGE(PG8_SB(1, 0), cB + kstep, voffB); PG8_STAGE(PG8_SA(1, 0), cA + kstep, voffA); PG8_STAGE(PG8_SB(1, 1), cB + hstep + kstep, voffB);
        PG8_WAIT_V(6); PG8_BAR;
    }
    for (;;) {
        const bool has_next = S.next(ui + 1, nxt);
        const char* nA = has_next ? (const char*)g.A + (size_t)nxt.pm * tstep : cA; const char* nB = has_next ? (const char*)g.Bt + (size_t)nxt.pn * tstep : cB;
#pragma nounroll
        for (int t = 0; t < nt; t += 2) {
            const bool last = (t == nt - 2);
            const char* a1 = cA + (size_t)(t + 1) * kstep;
            const char* a2 = last ? nA : cA + (size_t)(t + 2) * kstep; const char* b2 = last ? nB : cB + (size_t)(t + 2) * kstep;
            const char* a3 = a2 + kstep; const char* b3 = b2 + kstep;
            if (last && has_next) S.a_ready(nxt);
            if constexpr (SP2) {
            PG8_LDB(B0, 0, 0); PG8_LDB(B1, 0, 1); PG8_SCHED; PG8_LDA(At, 0, 0); PG8_STAGE(PG8_SA(1, 1), a1 + hstep, voffA);
            PG8_WAIT_V(8); PG8_WAIT_L(0); PG8_BAR; PG8_MMA(0, 0, At, B0); PG8_MMA(0, 1, At, B1); PG8_BAR; PG8_SCHED;
            PG8_LDA(At, 0, 1); PG8_STAGE(PG8_SB(0, 0), b2, voffB); PG8_STAGE(PG8_SB(0, 1), b2 + hstep, voffB); PG8_STAGE(PG8_SA(0, 0), a2, voffA);
            PG8_WAIT_V(8); PG8_WAIT_L(0); PG8_BAR; PG8_MMA(1, 0, At, B0); PG8_MMA(1, 1, At, B1); PG8_BAR; PG8_SCHED;
            PG8_LDB(B0, 1, 0); PG8_LDB(B1, 1, 1); PG8_SCHED; PG8_LDA(At, 1, 0); PG8_STAGE(PG8_SA(0, 1), a2 + hstep, voffA);
            PG8_WAIT_V(8); PG8_WAIT_L(0); PG8_BAR; PG8_MMA(0, 0, At, B0); PG8_MMA(0, 1, At, B1); PG8_BAR; PG8_SCHED;
            PG8_LDA(At, 1, 1); PG8_STAGE(PG8_SB(1, 0), b3, voffB); PG8_STAGE(PG8_SB(1, 1), b3 + hstep, voffB); PG8_STAGE(PG8_SA(1, 0), a3, voffA);
            PG8_WAIT_V(8); PG8_WAIT_L(0); PG8_BAR; PG8_MMA(1, 0, At, B0); PG8_MMA(1, 1, At, B1); PG8_BAR; PG8_SCHED;
            } else {
            PG8_LDB(B0, 0, 0); PG8_SCHED; PG8_LDA(At, 0, 0); PG8_STAGE(PG8_SA(1, 1), a1 + hstep, voffA);
            PG8_WAIT_L(8); PG8_BAR; PG8_WAIT_L(0); PG8_MMA(0, 0, At, B0); PG8_BAR; PG8_SCHED;
            PG8_LDB(B1, 0, 1); PG8_STAGE(PG8_SB(0, 0), b2, voffB);
            PG8_BAR; PG8_WAIT_L(0); PG8_MMA(0, 1, At, B1); PG8_BAR;
            PG8_LDA(At, 0, 1); PG8_STAGE(PG8_SA(0, 0), a2, voffA);
            PG8_BAR; PG8_WAIT_L(0); PG8_MMA(1, 0, At, B0); PG8_BAR; PG8_SCHED;
            PG8_STAGE(PG8_SB(0, 1), b2 + hstep, voffB);
            PG8_WAIT_V(6); PG8_BAR; PG8_MMA(1, 1, At, B1); PG8_BAR;
            PG8_LDB(B0, 1, 0); PG8_SCHED; PG8_LDA(At, 1, 0); PG8_STAGE(PG8_SA(0, 1), a2 + hstep, voffA);
            PG8_WAIT_L(8); PG8_BAR; PG8_WAIT_L(0); PG8_MMA(0, 0, At, B0); PG8_BAR; PG8_SCHED;
            PG8_LDB(B1, 1, 1); PG8_STAGE(PG8_SB(1, 0), b3, voffB);
            PG8_BAR; PG8_WAIT_L(0); PG8_MMA(0, 1, At, B1); PG8_BAR;
            PG8_LDA(At, 1, 1); PG8_STAGE(PG8_SA(1, 0), a3, voffA);
            PG8_BAR; PG8_WAIT_L(0); PG8_MMA(1, 0, At, B0); PG8_BAR; PG8_SCHED;
            PG8_STAGE(PG8_SB(1, 1), b3 + hstep, voffB);
            PG8_WAIT_V(6); PG8_BAR; PG8_MMA(1, 1, At, B1); PG8_BAR;
            }
        }
        if constexpr (ALIGN_EPI) { if (wr == 0) PG8_BAR; }
        if constexpr (FP8) mfma8_settle(acc);
        if constexpr (!Epi::AFTER_DRAIN) { E(acc, cur, wr, wc, fr, fq); S.done(cur); }
        if (!has_next) break;
#pragma unroll
        for (int a = 0; a < 2; ++a)
#pragma unroll
            for (int b = 0; b < 2; ++b)
#pragma unroll
                for (int m = 0; m < 4; ++m)
#pragma unroll
                    for (int n = 0; n < 2; ++n) acc[a][b][m][n] = (f32x4){0.f, 0.f, 0.f, 0.f};
        cur = nxt; cA = nA; cB = nB; ++ui;
        if constexpr (ALIGN_EPI) { if (wr == 1) PG8_BAR; }
    }
    PG8_WAIT_V(0);
    if constexpr (!ALIGN_EPI) { if (wr == 0) PG8_BAR; }
    PG8_BAR;
    if constexpr (Epi::AFTER_DRAIN) { E.fused(acc, cur, wr, wc, fr, fq, lds, wid, lane); S.done(cur); }
#undef PG8_SA
#undef PG8_SB
#undef PG8_STAGE
#undef PG8_LDA
#undef PG8_LDB
#undef PG8_MMA
#undef PG8_WAIT_V
#undef PG8_WAIT_L
#undef PG8_BAR
#undef PG8_SCHED
}
}
using pg8::f32x4; using pg8::bf16x8;
#define GAS __attribute__((address_space(1)))
#define LAS __attribute__((address_space(3)))
typedef unsigned v4u __attribute__((ext_vector_type(4)));
typedef GAS unsigned gu32;
typedef GAS unsigned long long gu64;
#define RLX_AGENT __ATOMIC_RELAXED, __HIP_MEMORY_SCOPE_AGENT
#define LDS_WAIT() asm volatile("s_waitcnt lgkmcnt(0)" ::: "memory")
#define VM_WAIT() asm volatile("s_waitcnt vmcnt(0)" ::: "memory")
__device__ __forceinline__ unsigned long long rt() { return __builtin_amdgcn_s_memrealtime(); }
__device__ __forceinline__ unsigned pk2(float lo, float hi) { return pg8::cvt_pk_bf16(lo, hi); }

#define XB_TMO      128
#define XB_XCNT(j)  (256  + 64 * (j))
#define XB_XSUB(j)  (1280 + 64 * (j))
#define XB_XGEN(j)  (2304 + 64 * (j))
#define XB_TOP      3328
#define XB_TOPGEN   3392
#define XCD_BAR_WORDS 3456
#define XB_SPIN_CAP (1u << 18)

__device__ __forceinline__ unsigned xb_ld(unsigned* p)              { return __hip_atomic_load(p, __ATOMIC_RELAXED, __HIP_MEMORY_SCOPE_AGENT); }
__device__ __forceinline__ unsigned xb_add(unsigned* p, unsigned v) { return __hip_atomic_fetch_add(p, v, __ATOMIC_RELAXED, __HIP_MEMORY_SCOPE_AGENT); }
__device__ __forceinline__ unsigned xb_xcc_id() { return (unsigned)__builtin_amdgcn_s_getreg((3 << 11) | 20) & 0xFu; }
#define XB_SPIN(cond, bar) do { unsigned _sp = 0; while (cond) { __builtin_amdgcn_s_sleep(1); \
    if ((++_sp & 255u) == 0u) { if (xb_ld(&(bar)[XB_TMO])) break; if (_sp > XB_SPIN_CAP) { atomicAdd(&(bar)[XB_TMO], 1u); break; } } } } while (0)

struct XcdBarrier {
    unsigned* bar; unsigned x;
    volatile LAS unsigned* st;
};

__device__ __forceinline__ XcdBarrier xcd_barrier_post(unsigned* bar, volatile LAS unsigned* st) {
    XcdBarrier b; b.bar = bar; b.x = xb_xcc_id(); b.st = st;
    if (threadIdx.x == 0) (void)xb_add(&bar[XB_XCNT(b.x)], 1u);
    return b;
}
__device__ __forceinline__ void xcd_barrier_complete(unsigned* bar, unsigned x, unsigned& nloc, unsigned& nx) {
    const unsigned G = gridDim.x * gridDim.y * gridDim.z;
    unsigned sum, cnt, mine, sp = 0u;
    for (;;) {
        sum = 0u; cnt = 0u; mine = 0u;
#pragma unroll
        for (unsigned j = 0; j < 16; ++j) { const unsigned c = xb_ld(&bar[XB_XCNT(j)]); sum += c; cnt += (c > 0u) ? 1u : 0u; mine = (j == x) ? c : mine; }
        if (sum == G) break;
        __builtin_amdgcn_s_sleep(1);
        if ((++sp & 255u) == 0u) { if (xb_ld(&bar[XB_TMO])) break; if (sp > XB_SPIN_CAP) { atomicAdd(&bar[XB_TMO], 1u); break; } }
    }
    nloc = mine > 0u ? mine : 1u; nx = cnt > 0u ? cnt : 1u;
}

__device__ __forceinline__ void xcd_barrier(const XcdBarrier& b) {
    asm volatile("s_waitcnt vmcnt(0)" ::: "memory");
    __syncthreads();
    if (threadIdx.x == 0) {
        unsigned* bar = b.bar;
        __builtin_amdgcn_s_waitcnt(0);
        unsigned nloc = b.st[0], nx = b.st[1];
        if (nloc == 0u) { xcd_barrier_complete(bar, b.x, nloc, nx); b.st[0] = nloc; b.st[1] = nx; }
        const unsigned old = xb_add(&bar[XB_XSUB(b.x)], 1u);
        const unsigned gen = old / nloc;
        if (old + 1u == (gen + 1u) * nloc) {
            __builtin_amdgcn_fence(__ATOMIC_RELEASE, "agent");
            asm volatile("s_waitcnt vmcnt(0)" ::: "memory");
            const unsigned og = xb_add(&bar[XB_TOP], 1u);
            const unsigned tg = og / nx;
            if (og + 1u == (tg + 1u) * nx) xb_add(&bar[XB_TOPGEN], 1u);
            else XB_SPIN(xb_ld(&bar[XB_TOPGEN]) == tg, bar);
            __builtin_amdgcn_fence(__ATOMIC_ACQUIRE, "agent");
            xb_add(&bar[XB_XGEN(b.x)], 1u);
            asm volatile("s_waitcnt vmcnt(0)" ::: "memory");
        } else {
            XB_SPIN(xb_ld(&bar[XB_XGEN(b.x)]) == gen, bar);
            __builtin_amdgcn_fence(__ATOMIC_ACQUIRE, "agent");
            asm volatile("s_waitcnt vmcnt(0)" ::: "memory");
        }
    }
    __syncthreads();
}

constexpr int NWAVES = 8;
#ifndef DBL_PHASE
#define DBL_PHASE -1
#endif
constexpr size_t WS_MODP = 1 * MiB + 128 * 1024;
constexpr size_t WS_WIN8 = 16 * MiB, WS_XN8 = 40 * MiB;
constexpr size_t WS_WIN = 12 * MiB, WS_WSB = 20 * MiB, WS_WEFF = 21 * MiB, WS_WOUT = 22 * MiB, WS_WGU = 24 * MiB;
constexpr size_t WS_WSHGU = 237 * MiB, WS_WD = 238 * MiB, WS_WSHD = 254 * MiB, WS_WRH = 254 * MiB + 512 * 1024, WS_WRL = WS_WRH + 128 * 1024;
constexpr size_t CTL_ZERO_BYTES = 256 * 1024;
constexpr int CW_TMO = 0, CW_CODE = 1, CW_BAR = 4096, CW_CNT = 16384, CW_ADA = 32768;
constexpr int RING_OFF = 0, RING_BYTES = 131072, AUX_OFF = RING_BYTES, LDS_BYTES = 163840, LDSCTL_OFF = LDS_BYTES - 1024, MISC_OFF = LDSCTL_OFF + 320;

struct Frame {
    LAS unsigned char* lds; volatile LAS unsigned* MISC; gu32* ctl;
    int tid, lane, wave, vcu, G;
};
struct Args { const float* in[22]; float* out; unsigned char* ws; int ph_lo, ph_hi, use_bar, pad; };

constexpr float W8SCALE = 512.f, H8SCALE = 16.f, HM8SCALE = 32.f, SH8SCALE = 8.f;
struct TItem { const float* W; bf16_t* dst; int ldw, ldk, k0, n0, perm, f8; };
__device__ __forceinline__ void titem_load(const TItem& t, f32x4 (&v)[8], int lane) {
    const int kr = lane >> 3, n4 = (lane & 7) * 4;
#pragma unroll
    for (int i = 0; i < 8; ++i) v[i] = *(const GAS f32x4*)(t.W + (size_t)(t.k0 + kr + 8 * i) * t.ldw + t.n0 + n4);
}
__device__ __forceinline__ void titem_store(const TItem& t, const f32x4 (&v)[8], LAS float* scr, int lane) {
    { const int kr = lane >> 3, n4 = (lane & 7) * 4;
#pragma unroll
      for (int i = 0; i < 8; ++i) { LAS float* d = scr + (kr + 8 * i) * 33 + n4; d[0] = v[i].x; d[1] = v[i].y; d[2] = v[i].z; d[3] = v[i].w; } }
    LDS_WAIT(); asm volatile("" ::: "memory");
    const int c = lane & 7;
#pragma unroll
    for (int j = 0; j < 4; ++j) { const int n = (lane >> 3) + 8 * j, drow = t.perm ? 128 * (j & 1) + 8 * (j >> 1) + (lane >> 3) : n; const LAS float* sp = scr + (8 * c) * 33 + n;
        if (t.f8) {
            unsigned lo = 0u, hi = 0u;
            lo = __builtin_amdgcn_cvt_pk_fp8_f32(sp[0 * 33] * W8SCALE, sp[1 * 33] * W8SCALE, lo, false); lo = __builtin_amdgcn_cvt_pk_fp8_f32(sp[2 * 33] * W8SCALE, sp[3 * 33] * W8SCALE, lo, true);
            hi = __builtin_amdgcn_cvt_pk_fp8_f32(sp[4 * 33] * W8SCALE, sp[5 * 33] * W8SCALE, hi, false); hi = __builtin_amdgcn_cvt_pk_fp8_f32(sp[6 * 33] * W8SCALE, sp[7 * 33] * W8SCALE, hi, true);
            *(GAS unsigned long long*)((GAS unsigned char*)t.dst + (size_t)drow * t.ldk + t.k0 + 8 * c) = (unsigned long long)lo | ((unsigned long long)hi << 32);
        } else {
        v4u o; o.x = pk2(sp[0 * 33], sp[1 * 33]); o.y = pk2(sp[2 * 33], sp[3 * 33]); o.z = pk2(sp[4 * 33], sp[5 * 33]); o.w = pk2(sp[6 * 33], sp[7 * 33]);
        *(GAS v4u*)(t.dst + (size_t)drow * t.ldk + t.k0 + 8 * c) = o; } }
    LDS_WAIT(); asm volatile("" ::: "memory");
}
__device__ __forceinline__ TItem titem_decode(int it, const Args& a, bool late) {
    unsigned char* ws = a.ws; TItem t; t.perm = 0; t.f8 = 0;
    constexpr int I_IN = 16 * 128, I_SB = 8 * 32, I_OUT = 16 * 32, I_EG = 64 * 64, I_EU = 64 * 64, I_ED = 64 * 64, I_SG = 16 * 8, I_SU = 16 * 8;
    int r = it;
    if (late) {
        if (r < I_ED) { const int e = r >> 6, q = r & 63, kb = q >> 5, nb = q & 31; t.W = a.in[18] + (size_t)e * ED * D; t.ldw = D; t.k0 = kb * 64; t.n0 = nb * 32;
            const int n0 = nb * 32, cl = n0 & 255; t.perm = 1; t.f8 = 1; t.dst = (bf16_t*)(ws + WS_WD + ((size_t)e * D + (n0 & ~255) + 32 * (cl >> 6) + 16 * ((cl >> 5) & 1)) * ED); t.ldk = ED; return t; } r -= I_ED;
        { const int kb = r >> 5, nb = r & 31; t.W = a.in[21]; t.ldw = D; t.k0 = kb * 64; t.n0 = nb * 32; t.f8 = 1; t.dst = (bf16_t*)(ws + WS_WSHD + (size_t)(nb * 32) * SHD); t.ldk = SHD; return t; } }
    if (r < I_IN) { const int kb = r >> 7, nb = r & 127, n0 = nb * 32; int d0 = n0;
        if (n0 < 1024) d0 = (n0 & ~255) + 128 * ((n0 >> 5) & 1) + 32 * ((n0 >> 6) & 3);
        t.W = a.in[5]; t.ldw = INW; t.k0 = kb * 64; t.n0 = n0; t.dst = (bf16_t*)(ws + WS_WIN) + (size_t)d0 * D; t.ldk = D;
        if (n0 >= 2048) { t.f8 = 1; t.dst = (bf16_t*)(ws + WS_WIN8 + (size_t)(n0 - 2048) * D); }
        return t; } r -= I_IN;
    if (r < I_SB) { const int kb = r >> 5, nb = r & 31; t.W = a.in[8]; t.ldw = D; t.k0 = kb * 64; t.n0 = nb * 32; t.dst = (bf16_t*)(ws + WS_WSB) + (size_t)(nb * 32) * SBW; t.ldk = SBW; return t; } r -= I_SB;
    if (r < I_OUT) { const int kb = r >> 5, nb = r & 31; t.W = a.in[12]; t.ldw = D; t.k0 = kb * 64; t.n0 = nb * 32; t.dst = (bf16_t*)(ws + WS_WOUT) + (size_t)(nb * 32) * D; t.ldk = D; return t; } r -= I_OUT;
    if (r < I_EG) { const int e = r >> 6, q = r & 63, kb = q >> 2, nb = q & 3; t.W = a.in[16] + (size_t)e * D * ED; t.ldw = ED; t.k0 = kb * 64; t.n0 = nb * 32; t.f8 = 1; t.dst = (bf16_t*)(ws + WS_WGU + ((size_t)e * 256 + nb * 32) * D); t.ldk = D; return t; } r -= I_EG;
    if (r < I_EU) { const int e = r >> 6, q = r & 63, kb = q >> 2, nb = q & 3; t.W = a.in[17] + (size_t)e * D * ED; t.ldw = ED; t.k0 = kb * 64; t.n0 = nb * 32; t.f8 = 1; t.dst = (bf16_t*)(ws + WS_WGU + ((size_t)e * 256 + 128 + nb * 32) * D); t.ldk = D; return t; } r -= I_EU;
    if (r < I_SG) { const int kb = r >> 3, nb = r & 7, n0 = nb * 32; t.W = a.in[19]; t.ldw = SHD; t.k0 = kb * 64; t.n0 = n0; t.f8 = 1; t.dst = (bf16_t*)(ws + WS_WSHGU + (size_t)((n0 >> 7) * 256 + (n0 & 127)) * D); t.ldk = D; return t; } r -= I_SG;
    { const int kb = r >> 3, nb = r & 7, n0 = nb * 32; t.W = a.in[20]; t.ldw = SHD; t.k0 = kb * 64; t.n0 = n0; t.f8 = 1; t.dst = (bf16_t*)(ws + WS_WSHGU + (size_t)((n0 >> 7) * 256 + 128 + (n0 & 127)) * D); t.ldk = D; return t; }
}

__device__ __forceinline__ void titem_run(Frame& F, const Args& a, bool late, int nitems, int first, int stride) {
    LAS float* scr = (LAS float*)(F.lds + RING_OFF + F.wave * 16384); const int lane = F.lane;
    f32x4 va[8], vb[8]; TItem cur, nxt; int it = first;
    if (it < nitems) { cur = titem_decode(it, a, late); titem_load(cur, va, lane); }
    for (; it < nitems; it += 2 * stride) {
        const bool h1 = it + stride < nitems, h2 = it + 2 * stride < nitems;
        if (h1) { nxt = titem_decode(it + stride, a, late); titem_load(nxt, vb, lane); }
        titem_store(cur, va, scr, lane);
        if (h2) { cur = titem_decode(it + 2 * stride, a, late); titem_load(cur, va, lane); }
        if (h1) titem_store(nxt, vb, scr, lane);
    }
}

__device__ __forceinline__ void p0a(Frame& F, const Args& a) {
    unsigned char* ws = a.ws;
    const int gw = F.vcu * NWAVES + F.wave, NGW = F.G * NWAVES, lane = F.lane;
    LAS float* silu = (LAS float*)(F.lds + RING_OFF + 98304);
    { const float* c = a.in[1]; for (int i = F.tid; i < 4 * D; i += NWAVES * 64) silu[i] = siluf_(c[i]); }
    if (F.G == 256) { const float* wg = a.in[9]; const float* ps = a.in[10]; const float* wpo = a.in[11]; bf16_t* WE = (bf16_t*)(ws + WS_WEFF);
        const int g = F.vcu >> 6, nb = (F.vcu & 63) * 16;
        LAS float* wgt = (LAS float*)(F.lds + RING_OFF);
        LAS float* slab = (LAS float*)(F.lds + RING_OFF + 68 * 1024);
        for (int i = F.tid; i < 128 * 128; i += NWAVES * 64) { const int cc = i >> 7, d = i & 127; wgt[d * 129 + cc] = wg[(size_t)g * 16384 + i]; }
        { const int d = F.tid >> 2, q = (F.tid & 3) * 4; const f32x4 w4 = *(const GAS f32x4*)(wpo + (size_t)(g * 128 + d) * D + nb + q) * ps[g * 128 + d]; *(LAS f32x4*)(slab + d * 16 + q) = w4; }
        __syncthreads();
        const int cc = F.tid & 127, nq = (F.tid >> 7) * 4; f32x4 acc4 = {0.f, 0.f, 0.f, 0.f};
#pragma unroll 8
        for (int d = 0; d < 128; ++d) acc4 += wgt[d * 129 + cc] * *(const LAS f32x4*)(slab + d * 16 + nq);
#pragma unroll
        for (int j = 0; j < 4; ++j) WE[(size_t)(nb + nq + j) * PW + g * 128 + cc] = (bf16_t)f2bf(acc4[j]);
    }
    __syncthreads();
    { const float* w_ada = a.in[2]; float* MODP = (float*)(ws + WS_MODP); LAS float* red = (LAS float*)(F.lds + RING_OFF);
      for (int it = F.vcu; it < 96 * 8; it += F.G) { const int cg = it % 96, ks = it / 96, k0 = ks * 128 + F.wave * 16;
          const float* w = w_ada + (size_t)k0 * (6 * D) + cg * 64 + lane;
          float wv[16];
#pragma unroll
          for (int k = 0; k < 16; ++k) wv[k] = w[(size_t)k * (6 * D)];
          float a0 = 0.f, a1 = 0.f, a2 = 0.f, a3 = 0.f;
#pragma unroll
          for (int k = 0; k < 16; ++k) { const int kk = k0 + k; a0 += silu[kk] * wv[k]; a1 += silu[D + kk] * wv[k]; a2 += silu[2 * D + kk] * wv[k]; a3 += silu[3 * D + kk] * wv[k]; }
          LAS float* rw = red + F.wave * 256 + lane; rw[0] = a0; rw[64] = a1; rw[128] = a2; rw[192] = a3;
          __syncthreads();
          if (F.tid < 256) { float v = 0.f;
#pragma unroll
              for (int w8 = 0; w8 < 8; ++w8) v += red[w8 * 256 + F.tid];
              MODP[(size_t)(ks * 4 + (F.tid >> 6)) * 6 * D + cg * 64 + (F.tid & 63)] = v; }
          __syncthreads(); }
      if (F.tid == 0) { __builtin_amdgcn_fence(__ATOMIC_RELEASE, "agent"); asm volatile("s_waitcnt vmcnt(0)" ::: "memory"); (void)xb_add((unsigned*)(F.ctl + CW_ADA), 1u); } }
    __syncthreads();
    titem_run(F, a, false, 16 * 128 + 8 * 32 + 16 * 32 + 2 * 64 * 64 + 2 * 16 * 8, gw, NGW);
    { const float* wr = a.in[14]; bf16_t* WH = (bf16_t*)(ws + WS_WRH); bf16_t* WL = (bf16_t*)(ws + WS_WRL);
      for (int i = (F.vcu * NWAVES * 64 + F.tid); i < D * NE; i += F.G * NWAVES * 64) { const int e = i >> 10, k = i & 1023; const float v = wr[k * NE + e];
          const int pos = ((((k >> 4) * 2 + (e >> 5)) * 64) + 32 * ((k >> 3) & 1) + (e & 31)) * 8 + (k & 7);
          const unsigned h = f2bf(v); WH[pos] = (bf16_t)h; WL[pos] = (bf16_t)f2bf(v - bf2f(h)); } }
}
__device__ __forceinline__ void p0b(Frame& F, const Args& a) {
    unsigned char* ws = a.ws; const float* MODP = (const float*)(ws + WS_MODP); const float* b_ada = a.in[3];
    if (F.tid == 0) { unsigned* bar_ = (unsigned*)(F.ctl + CW_BAR); XB_SPIN(xb_ld((unsigned*)(F.ctl + CW_ADA)) < (unsigned)F.G, bar_);
        __builtin_amdgcn_fence(__ATOMIC_ACQUIRE, "agent"); asm volatile("s_waitcnt vmcnt(0)" ::: "memory"); }
    __syncthreads();
    if (F.tid < 96) { const int idx = 96 * F.vcu + F.tid, b = idx / (6 * D), j = idx % (6 * D); float v = b_ada[j];
#pragma unroll
        for (int ks = 0; ks < 8; ++ks) v += MODP[(size_t)(ks * 4 + b) * 6 * D + j];
        ((float*)(ws + WS_MOD))[idx] = v; }
    const int rows_per = M / F.G, r0 = F.vcu * rows_per, b = r0 / SEQ;
    LAS float* gsv = (LAS float*)(F.lds + RING_OFF); LAS float* shv = gsv + D;
    for (int k = F.tid; k < D; k += NWAVES * 64) { float sh = b_ada[k], sc = b_ada[D + k];
#pragma unroll
        for (int ks = 0; ks < 8; ++ks) { sh += MODP[(size_t)(ks * 4 + b) * 6 * D + k]; sc += MODP[(size_t)(ks * 4 + b) * 6 * D + D + k]; }
        gsv[k] = a.in[4][k] * (1.f + sc); shv[k] = sh; }
    __syncthreads();
    const float* x = a.in[0]; bf16_t* XN = (bf16_t*)(ws + WS_XN); unsigned char* XN8 = ws + WS_XN8;
    for (int i = F.wave; i < rows_per; i += NWAVES) { const int row = r0 + i;
        const GAS f32x4* xr = (const GAS f32x4*)(x + (size_t)row * D) + F.lane;
        f32x4 v[4]; float s = 0.f;
#pragma unroll
        for (int j = 0; j < 4; ++j) { v[j] = xr[64 * j]; s += (v[j].x * v[j].x + v[j].y * v[j].y) + (v[j].z * v[j].z + v[j].w * v[j].w); }
        const float r = rsqrtf(wave_sum(s) * (1.f / D) + EPS);
        GAS unsigned long long* o8 = (GAS unsigned long long*)(XN + (size_t)row * D) + F.lane; GAS unsigned* o4 = (GAS unsigned*)(XN8 + (size_t)row * D) + F.lane;
#pragma unroll
        for (int j = 0; j < 4; ++j) { const f32x4 gg = *(const LAS f32x4*)(gsv + 4 * F.lane + 256 * j), ss = *(const LAS f32x4*)(shv + 4 * F.lane + 256 * j);
            const f32x4 h = v[j] * r * gg + ss;
            o8[64 * j] = (unsigned long long)pk2(h.x, h.y) | ((unsigned long long)pk2(h.z, h.w) << 32);
            { const f32x4 h8 = h * H8SCALE; unsigned q8 = 0u;
              q8 = __builtin_amdgcn_cvt_pk_fp8_f32(__builtin_amdgcn_fmed3f(h8.x, -448.f, 448.f), __builtin_amdgcn_fmed3f(h8.y, -448.f, 448.f), q8, false);
              q8 = __builtin_amdgcn_cvt_pk_fp8_f32(__builtin_amdgcn_fmed3f(h8.z, -448.f, 448.f), __builtin_amdgcn_fmed3f(h8.w, -448.f, 448.f), q8, true);
              o4[64 * j] = q8; } } }
    __syncthreads();
}

namespace sb {
using pg8::bf16x8; using pg8::f32x4; typedef float f32x16 __attribute__((ext_vector_type(16))); typedef short v4i16_t __attribute__((ext_vector_type(4)));
typedef short s16x4 __attribute__((ext_vector_type(4)));
constexpr int VPITCH = 128, VBYTES = 64 * VPITCH, WAVE_LDS = 2 * VBYTES;
constexpr float EXIT_THR = -152.f;
__device__ __forceinline__ int crow(int r, int hi) { return (r & 3) + 8 * (r >> 2) + 4 * hi; }
__device__ __forceinline__ s16x4 vtr(LAS const unsigned char* p) { return __builtin_bit_cast(s16x4, __builtin_amdgcn_ds_read_tr16_b64_v4i16((LAS v4i16_t*)p)); }
__device__ __forceinline__ unsigned pkbf(float lo, float hi) { return pg8::cvt_pk_bf16(lo, hi); }

__device__ __forceinline__ void attn_unit(int b, int h, int qb, const bf16_t* Q, const bf16_t* K, const bf16_t* V, bf16_t* O, LAS unsigned char* vlds, int wid, int lane) {
    const int r32 = lane & 31, hi = lane >> 5;
    const int t0 = qb * 256 + wid * 32;
    const size_t rowbase = (size_t)b * SEQ;
    const bf16_t* Kh = K + rowbase * 512 + h * 64; const bf16_t* Vh = V + rowbase * 512 + h * 64;
    bf16x8 qr[4];
#pragma unroll
    for (int d0 = 0; d0 < 4; ++d0) qr[d0] = *(const bf16x8*)(Q + (rowbase + t0 + r32) * 512 + h * 64 + d0 * 16 + hi * 8);
    f32x16 o0 = {}, o1 = {};
    float carry = 0.f;
    int kt = t0 >> 6;
    bf16x8 kf[8];
#define SB_LOADK(KT) do { const int kb_ = (KT) * 64; \
        _Pragma("unroll") for (int d0 = 0; d0 < 4; ++d0) { kf[2 * d0] = *(const bf16x8*)(Kh + (size_t)(kb_ + r32) * 512 + d0 * 16 + hi * 8); kf[2 * d0 + 1] = *(const bf16x8*)(Kh + (size_t)(kb_ + 32 + r32) * 512 + d0 * 16 + hi * 8); } } while (0)
#define SB_DMAV(KT, BUF) do { const int kb_ = (KT) * 64; \
        _Pragma("unroll") for (int i = 0; i < 8; ++i) __builtin_amdgcn_global_load_lds((const unsigned*)(Vh + (size_t)(kb_ + 8 * i + (lane >> 3)) * 512 + (lane & 7) * 8), (LAS unsigned*)(vlds + (BUF) * VBYTES + i * 1024), 16, 0, 0); } while (0)
    int cur = 0;
    SB_DMAV(kt, 0);
    SB_LOADK(kt);
    const int trbase = (4 * hi + ((lane & 15) >> 2)) * VPITCH + (16 * ((lane >> 4) & 1) + 4 * (lane & 3)) * 2;
    bool diag = true;
    for (;; --kt) {
        const int kbase = kt * 64;
        f32x16 p0 = {}, p1 = {};
#pragma unroll
        for (int d0 = 0; d0 < 4; ++d0) { p0 = __builtin_amdgcn_mfma_f32_32x32x16_bf16(kf[2 * d0], qr[d0], p0, 0, 0, 0); p1 = __builtin_amdgcn_mfma_f32_32x32x16_bf16(kf[2 * d0 + 1], qr[d0], p1, 0, 0, 0); }
        asm volatile("" ::: "memory");
        if (kt > 0) { SB_DMAV(kt - 1, cur ^ 1); SB_LOADK(kt - 1); }
        asm volatile("" ::: "memory");
        bf16x8 pa[4]; float suf = 0.f;
        const int qrel = t0 + r32 - kbase;
#define SB_HALF(P, KOFF, PA0, PA1) do { f32x16 sp_; \
        _Pragma("unroll") for (int r = 0; r < 16; ++r) sp_[r] = __builtin_amdgcn_logf(1.f + __builtin_amdgcn_exp2f(P[r])); \
        if (diag) { _Pragma("unroll") for (int r = 0; r < 16; ++r) if (crow(r, hi) + (KOFF) >= qrel) sp_[r] = 0.f; } \
        float e_[4], og_[4], R_[4]; \
        _Pragma("unroll") for (int c = 0; c < 4; ++c) { sp_[4 * c + 2] += sp_[4 * c + 3]; sp_[4 * c + 1] += sp_[4 * c + 2]; sp_[4 * c] += sp_[4 * c + 1]; e_[c] = sp_[4 * c]; } \
        _Pragma("unroll") for (int c = 0; c < 4; ++c) og_[c] = __shfl_xor(e_[c], 32); \
        _Pragma("unroll") for (int c = 3; c >= 0; --c) { R_[c] = carry - (suf + (hi == 0 ? og_[c] : 0.f)); suf += e_[c] + og_[c]; } \
        _Pragma("unroll") for (int r = 0; r < 16; ++r) P[r] = __builtin_amdgcn_exp2f(P[r] - sp_[r] + R_[r >> 2]); \
        if (diag) { _Pragma("unroll") for (int r = 0; r < 16; ++r) if (crow(r, hi) + (KOFF) >= qrel) P[r] = 0.f; } \
        pg8::u32x4 w_; w_.x = pkbf(P[0], P[1]); w_.y = pkbf(P[2], P[3]); w_.z = pkbf(P[4], P[5]); w_.w = pkbf(P[6], P[7]); PA0 = __builtin_bit_cast(bf16x8, w_); \
        w_.x = pkbf(P[8], P[9]); w_.y = pkbf(P[10], P[11]); w_.z = pkbf(P[12], P[13]); w_.w = pkbf(P[14], P[15]); PA1 = __builtin_bit_cast(bf16x8, w_); } while (0)
        SB_HALF(p1, 32, pa[2], pa[3]);
        SB_HALF(p0, 0, pa[0], pa[1]);
#undef SB_HALF
        carry -= suf;
        diag = false;
        if (kt > 0) asm volatile("s_waitcnt vmcnt(16)" ::: "memory"); else asm volatile("s_waitcnt vmcnt(0)" ::: "memory");
        LAS const unsigned char* vb = vlds + cur * VBYTES + trbase;
#pragma unroll
        for (int s = 0; s < 4; ++s) {
            LAS const unsigned char* vp = vb + (16 * s) * VPITCH;
            const s16x4 a0 = vtr(vp), a1 = vtr(vp + 8 * VPITCH), b0 = vtr(vp + 64), b1 = vtr(vp + 8 * VPITCH + 64);
            const bf16x8 v0 = {a0[0], a0[1], a0[2], a0[3], a1[0], a1[1], a1[2], a1[3]}, v1 = {b0[0], b0[1], b0[2], b0[3], b1[0], b1[1], b1[2], b1[3]};
            o0 = __builtin_amdgcn_mfma_f32_32x32x16_bf16(pa[s], v0, o0, 0, 0, 0);
            o1 = __builtin_amdgcn_mfma_f32_32x32x16_bf16(pa[s], v1, o1, 0, 0, 0);
        }
        asm volatile("s_waitcnt lgkmcnt(0)" ::: "memory");
        cur ^= 1;
        if (kt == 0 || __all(carry < EXIT_THR)) break;
    }
    asm volatile("s_waitcnt vmcnt(0)" ::: "memory");
#undef SB_LOADK
#undef SB_DMAV
    bf16_t* Ow = O + (rowbase + t0) * 512 + h * 64 + r32;
#pragma unroll
    for (int r = 0; r < 16; ++r) { const int q = crow(r, hi); Ow[(size_t)q * 512] = (bf16_t)f2bf(o0[r]); Ow[(size_t)q * 512 + 32] = (bf16_t)f2bf(o1[r]); }
}
}

__device__ __forceinline__ void p2_pool(Frame& F, const bf16_t* U, bf16_t* MIX) {
    const int rows_per = M / F.G; const int col8 = F.lane, w = 2 << (col8 >> 4);
    for (int rb = F.wave * 8; rb < rows_per; rb += NWAVES * 8) { const int t0 = F.vcu * rows_per + rb;
        v4u ld[23];
#pragma unroll
        for (int i = 0; i < 23; ++i) ld[i] = *(const GAS v4u*)(U + ((long)(t0 - 15 + i)) * PW + col8 * 8);
#pragma unroll
        for (int r = 0; r < 8; ++r) { const int tl = (t0 + r) % SEQ; const int cnt = (tl + 1) < w ? (tl + 1) : w;
            float acc[8];
#pragma unroll
            for (int j = 0; j < 8; ++j) acc[j] = 0.f;
#pragma unroll
            for (int i = 0; i < 16; ++i) { const v4u u = ld[15 + r - i]; const float m = (i < cnt) ? 1.f : 0.f;
                acc[0] += m * bf2f(u.x & 0xffffu); acc[1] += m * bf2f(u.x >> 16); acc[2] += m * bf2f(u.y & 0xffffu); acc[3] += m * bf2f(u.y >> 16);
                acc[4] += m * bf2f(u.z & 0xffffu); acc[5] += m * bf2f(u.z >> 16); acc[6] += m * bf2f(u.w & 0xffffu); acc[7] += m * bf2f(u.w >> 16); }
            const float inv = 1.f / (float)cnt; const v4u self = ld[15 + r];
            v4u o; o.x = pk2(acc[0] * inv - bf2f(self.x & 0xffffu), acc[1] * inv - bf2f(self.x >> 16)); o.y = pk2(acc[2] * inv - bf2f(self.y & 0xffffu), acc[3] * inv - bf2f(self.y >> 16));
            o.z = pk2(acc[4] * inv - bf2f(self.z & 0xffffu), acc[5] * inv - bf2f(self.z >> 16)); o.w = pk2(acc[6] * inv - bf2f(self.w & 0xffffu), acc[7] * inv - bf2f(self.w >> 16));
            *(GAS v4u*)(MIX + (size_t)(t0 + r) * PW + col8 * 8) = o; } }
}

constexpr int P5_TAB = AUX_OFF + 2048;
constexpr int P5_CNT = AUX_OFF + 1024;
constexpr int LIST_CAP = 16384;
typedef float f32x16 __attribute__((ext_vector_type(16)));
__device__ __forceinline__ void p5_route(Frame& F, const Args& a) {
    unsigned char* ws = a.ws; const float* X1 = a.out; const float* g2 = a.in[13]; const float* mod = (const float*)(ws + WS_MOD); const float* rbias = a.in[15];
    unsigned char* H2 = ws + WS_H2; int* PE = (int*)(ws + WS_PE);
    const bf16_t* WH = (const bf16_t*)(ws + WS_WRH); const bf16_t* WL = (const bf16_t*)(ws + WS_WRL);
    unsigned long long* LIST = (unsigned long long*)(ws + WS_LIST); gu32* gcnt = F.ctl + CW_CNT;
    LAS unsigned char* Ahi = F.lds + RING_OFF; LAS unsigned char* Alo = Ahi + 65536; LAS float* part = (LAS float*)Ahi;
    LAS float* gsv = (LAS float*)(F.lds + P5_TAB); LAS float* shv = gsv + D; LAS unsigned* cnt_l = (LAS unsigned*)(F.lds + P5_CNT); LAS unsigned* base_l = cnt_l + 64; LAS float* rr = (LAS float*)(base_l + 64);
    const int lane = F.lane, wave = __builtin_amdgcn_readfirstlane(F.wave), r32 = lane & 31, hi = lane >> 5;
    const int row0 = F.vcu * 64;
    if (row0 < M) {
        const int b = row0 / SEQ;
        for (int k = F.tid; k < D; k += NWAVES * 64) { gsv[k] = g2[k] * (1.f + mod[b * 6 * D + 4 * D + k]); shv[k] = mod[b * 6 * D + 3 * D + k]; }
        if (F.tid < 64) cnt_l[F.tid] = 0u;
        { f32x4 v[8][4];
#pragma unroll
          for (int i = 0; i < 8; ++i) { const GAS f32x4* xr = (const GAS f32x4*)(X1 + (size_t)(row0 + 8 * wave + i) * D) + lane;
#pragma unroll
              for (int j = 0; j < 4; ++j) v[i][j] = xr[64 * j]; }
#pragma unroll
          for (int i = 0; i < 8; ++i) { float s = 0.f;
#pragma unroll
              for (int j = 0; j < 4; ++j) s += (v[i][j].x * v[i][j].x + v[i][j].y * v[i][j].y) + (v[i][j].z * v[i][j].z + v[i][j].w * v[i][j].w);
              s = wave_sum(s); if (lane == 0) rr[8 * wave + i] = rsqrtf(s * (1.f / D) + EPS); } }
        __syncthreads();
        f32x16 acc[2][2];
        const char* whb = (const char*)WH + wave * 8192; const char* wlb = (const char*)WL + wave * 8192;
#pragma unroll
        for (int x = 0; x < 2; ++x)
#pragma unroll
            for (int y = 0; y < 2; ++y) acc[x][y] = f32x16{};
#pragma unroll
        for (int kh = 0; kh < 2; ++kh) {
            bf16x8 bh[4][2], bl[4][2];
#pragma unroll
            for (int s4 = 0; s4 < 4; ++s4)
#pragma unroll
                for (int t = 0; t < 2; ++t) { const int fo = kh * 65536 + (s4 * 2 + t) * 1024;
                    bh[s4][t] = *(const bf16x8*)(whb + fo + lane * 16); bl[s4][t] = *(const bf16x8*)(wlb + fo + lane * 16); }
#pragma unroll
            for (int i = 0; i < 8; ++i) { const int rl = 8 * wave + i, row = row0 + rl; const float r = rr[rl];
                if ((i & 1) == 0) __builtin_amdgcn_sched_barrier(0);
                const GAS f32x4* xr = (const GAS f32x4*)(X1 + (size_t)row * D + 512 * kh) + lane;
                GAS unsigned* o4 = (GAS unsigned*)(H2 + (size_t)row * D + 512 * kh) + lane;
#pragma unroll
                for (int j = 0; j < 2; ++j) { const f32x4 xv = xr[64 * j];
                    const f32x4 gg = *(const LAS f32x4*)(gsv + 512 * kh + 4 * lane + 256 * j), ss = *(const LAS f32x4*)(shv + 512 * kh + 4 * lane + 256 * j);
                    const f32x4 h = xv * r * gg + ss;
                    const unsigned p01 = pk2(h.x, h.y), p23 = pk2(h.z, h.w);
                    const unsigned long long hh = (unsigned long long)p01 | ((unsigned long long)p23 << 32);
                    { const f32x4 h8 = h * H8SCALE; unsigned q8 = 0u;
                      q8 = __builtin_amdgcn_cvt_pk_fp8_f32(__builtin_amdgcn_fmed3f(h8.x, -448.f, 448.f), __builtin_amdgcn_fmed3f(h8.y, -448.f, 448.f), q8, false);
                      q8 = __builtin_amdgcn_cvt_pk_fp8_f32(__builtin_amdgcn_fmed3f(h8.z, -448.f, 448.f), __builtin_amdgcn_fmed3f(h8.w, -448.f, 448.f), q8, true);
                      o4[64 * j] = q8; }
                    const unsigned long long ll = (unsigned long long)pk2(h.x - __builtin_bit_cast(float, p01 << 16), h.y - __builtin_bit_cast(float, p01 & 0xffff0000u))
                                                | ((unsigned long long)pk2(h.z - __builtin_bit_cast(float, p23 << 16), h.w - __builtin_bit_cast(float, p23 & 0xffff0000u)) << 32);
                    const int chunk = (lane >> 1) + 32 * j, off = rl * 1024 + ((chunk ^ (rl & 15)) << 4) + ((lane & 1) << 3);
                    *(LAS unsigned long long*)(Ahi + off) = hh; *(LAS unsigned long long*)(Alo + off) = ll; } }
            __syncthreads();
#pragma unroll
            for (int s4 = 0; s4 < 4; ++s4) { const int chunk = 8 * wave + 2 * s4 + hi;
                const bf16x8 bh0 = bh[s4][0], bh1 = bh[s4][1], bl0 = bl[s4][0], bl1 = bl[s4][1];
#pragma unroll
                for (int x = 0; x < 2; ++x) { const int rw = 32 * x + r32, off = rw * 1024 + ((chunk ^ (rw & 15)) << 4);
                    const bf16x8 ah = *(const LAS bf16x8*)(Ahi + off), al = *(const LAS bf16x8*)(Alo + off);
                    acc[x][0] = __builtin_amdgcn_mfma_f32_32x32x16_bf16(ah, bh0, acc[x][0], 0, 0, 0); acc[x][1] = __builtin_amdgcn_mfma_f32_32x32x16_bf16(ah, bh1, acc[x][1], 0, 0, 0);
                    acc[x][0] = __builtin_amdgcn_mfma_f32_32x32x16_bf16(al, bh0, acc[x][0], 0, 0, 0); acc[x][1] = __builtin_amdgcn_mfma_f32_32x32x16_bf16(al, bh1, acc[x][1], 0, 0, 0);
                    acc[x][0] = __builtin_amdgcn_mfma_f32_32x32x16_bf16(ah, bl0, acc[x][0], 0, 0, 0); acc[x][1] = __builtin_amdgcn_mfma_f32_32x32x16_bf16(ah, bl1, acc[x][1], 0, 0, 0); } }
            __syncthreads();
        }
#pragma unroll
        for (int x = 0; x < 2; ++x)
#pragma unroll
            for (int r = 0; r < 16; ++r) { const int rw = 32 * x + (r & 3) + 8 * (r >> 2) + 4 * hi; part[wave * 4096 + rw * 64 + r32] = acc[x][0][r]; part[wave * 4096 + rw * 64 + 32 + r32] = acc[x][1][r]; }
        __syncthreads();
        float scq[8];
#pragma unroll
        for (int q = 0; q < 8; ++q) { const int rl = wave + 8 * q; float logit = 0.f;
#pragma unroll
            for (int w = 0; w < 8; ++w) logit += part[w * 4096 + rl * 64 + lane];
            scq[q] = 1.f / (1.f + expf(-logit)); }
        __syncthreads();
        LAS float* scoreT = (LAS float*)(F.lds + RING_OFF);
#pragma unroll
        for (int q = 0; q < 8; ++q) scoreT[lane * 65 + wave + 8 * q] = scq[q];
        __syncthreads();
        if (wave == 0) {
            float sel[64];
#pragma unroll
            for (int e = 0; e < 64; ++e) sel[e] = scoreT[e * 65 + lane] + rbias[e];
            float gs[8];
#pragma unroll
            for (int g = 0; g < 8; ++g) { float m1 = sel[8 * g], m2 = -INFINITY;
#pragma unroll
                for (int j = 1; j < 8; ++j) { const float v = sel[8 * g + j]; const float lo = fminf(m1, v); m1 = fmaxf(m1, v); m2 = fmaxf(m2, lo); }
                gs[g] = m1 + m2; }
            unsigned gmask = 0u;
#pragma unroll
            for (int g = 0; g < 8; ++g) { int rk = 0;
#pragma unroll
                for (int h = 0; h < 8; ++h) if (h != g) rk += (gs[h] > gs[g] || (gs[h] == gs[g] && h < g)) ? 1 : 0;
                gmask |= (rk < 4) ? (1u << g) : 0u; }
#pragma unroll
            for (int e = 0; e < 64; ++e) sel[e] = ((gmask >> (e >> 3)) & 1u) ? sel[e] : -INFINITY;
            unsigned long long taken = 0ull; int ex[8]; float ws_[8]; float wsum = 0.f;
#pragma unroll
            for (int r = 0; r < TOPK; ++r) { float best = -INFINITY; int bi = 0;
#pragma unroll
                for (int e = 0; e < 64; ++e) { const bool c = !((taken >> e) & 1ull) && sel[e] > best; best = c ? sel[e] : best; bi = c ? e : bi; }
                taken |= 1ull << bi; ex[r] = bi; ws_[r] = scoreT[bi * 65 + lane]; wsum += ws_[r]; }
            const float wn = RSCALE / wsum;
#pragma unroll
            for (int r = 0; r < TOPK; ++r) { const unsigned pos = __hip_atomic_fetch_add(cnt_l + ex[r], 1u, __ATOMIC_RELAXED, __HIP_MEMORY_SCOPE_WORKGROUP);
                LAS unsigned* pk = (LAS unsigned*)(F.lds + RING_OFF + 32768) + (lane * 8 + r) * 4; pk[0] = (unsigned)ex[r]; pk[1] = pos; pk[2] = __builtin_bit_cast(unsigned, ws_[r] * wn); }
        }
        __syncthreads();
        if (F.tid < 64) base_l[F.tid] = __hip_atomic_fetch_add(gcnt + 64 * F.tid, cnt_l[F.tid], __ATOMIC_RELAXED, __HIP_MEMORY_SCOPE_AGENT);
        __syncthreads();
        { LAS const unsigned* pk = (LAS const unsigned*)(F.lds + RING_OFF + 32768) + F.tid * 4; const unsigned e = pk[0], pos = pk[1], wb = pk[2];
          const int pair = (row0 + (F.tid >> 3)) * 8 + (F.tid & 7);
          LIST[(size_t)e * LIST_CAP + base_l[e] + pos] = (unsigned long long)(unsigned)pair | ((unsigned long long)wb << 32);
          PE[pair] = (int)e; }
        __syncthreads();
    }
}

namespace pg8 {
struct UnitG { int kind, slot, nvalid, pm, pn, row0; const char* bptr; };
constexpr int P6_PRE = AUX_OFF + 1024;
constexpr int P6_ROWS = AUX_OFF + 2048;
struct SchedG {
    const LAS int* pre; const LAS int* cnts; const LAS int* cum; const char* wgu; const char* wsh; int G, c, nr, total;
    __device__ __forceinline__ bool next(int i, UnitG& u) const {
        const int idx = i * G + c; if (idx >= total) return false;
        if (idx < nr) { int e = (int)__builtin_popcountll(__ballot(pre[1 + (threadIdx.x & 63)] <= idx));
            e = __builtin_amdgcn_readfirstlane(e); const int j = idx - __builtin_amdgcn_readfirstlane(pre[e]); const int nv = __builtin_amdgcn_readfirstlane(cnts[e]) - 256 * j;
            u.kind = 0; u.slot = i; u.nvalid = nv < 256 ? nv : 256; u.pm = e; u.pn = j; u.row0 = 256 * idx; u.bptr = wgu + (size_t)e * 256 * D; }
        else { const int s = idx - nr; u.kind = 1; u.slot = i; u.nvalid = 256; u.pm = s >> 1; u.pn = s & 1; u.row0 = (s >> 1) * 256; u.bptr = wsh + (size_t)(s & 1) * 256 * D; }
        return true; }
};
struct EpiGU {
    static constexpr bool PERM = true;
    unsigned char* HM; unsigned char* SH; int* SLOT; const LAS unsigned long long* rowinfo;
    __device__ __forceinline__ void operator()(const f32x4 (&acc)[2][2][4][2], const UnitG& u, int wr, int wc, int fr, int fq) const {
#pragma unroll
        for (int ai = 0; ai < 2; ++ai)
#pragma unroll
            for (int m = 0; m < 4; ++m) { const int r = ai * HALF + wr * 64 + m * 16 + fr;
                unsigned char* dst; float w;
                if (u.kind == 0) { const unsigned long long ri = rowinfo[u.slot * 256 + r]; dst = HM + (size_t)(u.row0 + r) * ED + wc * 32 + 8 * fq; w = __builtin_bit_cast(float, (unsigned)(ri >> 32)) * HM8SCALE;
                    if (wc == 0 && fq == 0) SLOT[u.row0 + r] = (r < u.nvalid) ? (int)(unsigned)ri : M * 8; }
                else { dst = SH + (size_t)(u.pm * 256 + r) * SHD + u.pn * 128 + wc * 32 + 8 * fq; w = SH8SCALE; }
                constexpr float DQ = 1.f / (W8SCALE * H8SCALE);
                const f32x4 g0 = acc[ai][0][m][0] * DQ, g1 = acc[ai][0][m][1] * DQ, u0 = acc[ai][1][m][0] * DQ, u1 = acc[ai][1][m][1] * DQ;
                float v[8];
#pragma unroll
                for (int j = 0; j < 4; ++j) { v[j] = __builtin_amdgcn_fmed3f(g0[j] * fsigmoid(g0[j]) * u0[j] * w, -448.f, 448.f); v[4 + j] = __builtin_amdgcn_fmed3f(g1[j] * fsigmoid(g1[j]) * u1[j] * w, -448.f, 448.f); }
                unsigned lo = 0u, hi = 0u;
                lo = __builtin_amdgcn_cvt_pk_fp8_f32(v[0], v[1], lo, false); lo = __builtin_amdgcn_cvt_pk_fp8_f32(v[2], v[3], lo, true);
                hi = __builtin_amdgcn_cvt_pk_fp8_f32(v[4], v[5], hi, false); hi = __builtin_amdgcn_cvt_pk_fp8_f32(v[6], v[7], hi, true);
                if (r < u.nvalid) *(unsigned long long*)dst = (unsigned long long)lo | ((unsigned long long)hi << 32); }
    }
};
template <class Epi, class Sched, bool FP8 = false>
__device__ __forceinline__ void gemm_phase_g(PG8_LAS unsigned char* lds, const bf16_t* A, int K, const Sched& S, const Epi& E, const PG8_LAS unsigned long long* rowinfo) {
    int tid_ = threadIdx.x; asm volatile("" : "+v"(tid_));
    const int tid = tid_, wid = __builtin_amdgcn_readfirstlane(tid >> 6), lane = tid & 63, wr = wid >> 2, wc = wid & 3, fr = lane & 15, fq = lane >> 4;
    const int nt = K / BK;
    int RA[2], CA[2]; unsigned voffB[2];
#pragma unroll
    for (int i = 0; i < 2; ++i) { int R, C; stage_rc(tid * 16 + i * 8192, R, C); const int Rb = Epi::PERM ? ((R & ~31) + perm32(R & 31)) : R; RA[i] = R; CA[i] = C; voffB[i] = (unsigned)(Rb * K + C) * 2u; }
    const size_t kstep = (size_t)(BK * 2);
    const size_t hstep = (size_t)HALF * K * 2;
    const unsigned ldsw = (unsigned)wid * 1024u;
    const int aoff = lds_byte(wr * 64 + fr, fq * 8), boff = lds_byte(wc * 32 + fr, fq * 8);
#define PG8_AOFF(u, o0, o1) do { _Pragma("unroll") for (int _i = 0; _i < 2; ++_i) { unsigned r0_, r1_; \
        if ((u).kind == 0) { r0_ = (unsigned)rowinfo[(u).slot * 256 + RA[_i]] >> 3; r1_ = (unsigned)rowinfo[(u).slot * 256 + HALF + RA[_i]] >> 3; } \
        else { r0_ = (unsigned)((u).row0 + RA[_i]); r1_ = r0_ + HALF; } \
        o0[_i] = (r0_ * (unsigned)K + (unsigned)CA[_i]) * 2u; o1[_i] = (r1_ * (unsigned)K + (unsigned)CA[_i]) * 2u; } } while (0)
#define PG8_SA(b, h) (((b) * 2 + (h)) * HTB)
#define PG8_SB(b, h) ((4 + (b) * 2 + (h)) * HTB)
#define PG8_STAGE(bufoff, gbase, voff) do { _Pragma("unroll") for (int _i = 0; _i < 2; ++_i) \
        __builtin_amdgcn_global_load_lds((const unsigned*)((const char*)(gbase) + (voff)[_i]), (PG8_LAS unsigned*)(lds + (bufoff) + ldsw + _i * 8192), 16, 0, 0); } while (0)
#define PG8_LDA(dst, b, h) do { _Pragma("unroll") for (int m = 0; m < 4; ++m) _Pragma("unroll") for (int k = 0; k < 2; ++k) dst[m][k] = *(const PG8_LAS bf16x8*)(lds + PG8_SA(b, h) + aoff + m * 2048 + k * 1024); } while (0)
#define PG8_LDB(dst, b, h) do { _Pragma("unroll") for (int n = 0; n < 2; ++n) _Pragma("unroll") for (int k = 0; k < 2; ++k) dst[n][k] = *(const PG8_LAS bf16x8*)(lds + PG8_SB(b, h) + boff + n * 2048 + k * 1024); } while (0)
#define PG8_MMA(ai, bj, At, Bt) do { __builtin_amdgcn_s_setprio(1); _Pragma("unroll") for (int m = 0; m < 4; ++m) _Pragma("unroll") for (int n = 0; n < 2; ++n) { \
        if constexpr (FP8) mfma8(acc[ai][bj][m][n], cat8(Bt[n][0], Bt[n][1]), cat8(At[m][0], At[m][1])); \
        else { _Pragma("unroll") for (int k = 0; k < 2; ++k) acc[ai][bj][m][n] = __builtin_amdgcn_mfma_f32_16x16x32_bf16(Bt[n][k], At[m][k], acc[ai][bj][m][n], 0, 0, 0); } } __builtin_amdgcn_s_setprio(0); } while (0)
#define PG8_WAIT_V(n) asm volatile("s_waitcnt vmcnt(" #n ")" ::: "memory")
#define PG8_WAIT_L(n) asm volatile("s_waitcnt lgkmcnt(" #n ")" ::: "memory")
#define PG8_BAR __builtin_amdgcn_s_barrier()
#define PG8_SCHED __builtin_amdgcn_sched_barrier(0)
    UnitG cur, nxt; int ui = 0;
    if (!S.next(0, cur)) return;
    f32x4 acc[2][2][4][2];
#pragma unroll
    for (int a = 0; a < 2; ++a)
#pragma unroll
        for (int b = 0; b < 2; ++b)
#pragma unroll
            for (int m = 0; m < 4; ++m)
#pragma unroll
                for (int n = 0; n < 2; ++n) acc[a][b][m][n] = (f32x4){0.f, 0.f, 0.f, 0.f};
    bf16x8 At[4][2], B0[2][2], B1[2][2];
    const char* cA = (const char*)A; const char* cB = cur.bptr;
    unsigned vA0[2], vA1[2], nA0[2], nA1[2];
    PG8_AOFF(cur, vA0, vA1);
    PG8_STAGE(PG8_SB(0, 0), cB, voffB); PG8_STAGE(PG8_SB(0, 1), cB + hstep, voffB); PG8_STAGE(PG8_SA(0, 0), cA, vA0); PG8_STAGE(PG8_SA(0, 1), cA, vA1);
    if (wr == 1) PG8_BAR;
    PG8_WAIT_V(2); PG8_BAR;
    PG8_STAGE(PG8_SB(1, 0), cB + kstep, voffB); PG8_STAGE(PG8_SA(1, 0), cA + kstep, vA0); PG8_STAGE(PG8_SB(1, 1), cB + hstep + kstep, voffB);
    PG8_WAIT_V(6); PG8_BAR;
    for (;;) {
        const bool has_next = S.next(ui + 1, nxt);
        const char* nB = has_next ? nxt.bptr : cB;
        if (has_next) { PG8_AOFF(nxt, nA0, nA1); } else {
#pragma unroll
            for (int _i = 0; _i < 2; ++_i) { nA0[_i] = vA0[_i]; nA1[_i] = vA1[_i]; } }
#pragma nounroll
        for (int t = 0; t < nt; t += 2) {
            const bool last = (t == nt - 2);
            const char* a1 = cA + (size_t)(t + 1) * kstep;
            const char* a2 = last ? cA : cA + (size_t)(t + 2) * kstep; const char* b2 = last ? nB : cB + (size_t)(t + 2) * kstep;
            const char* a3 = a2 + kstep; const char* b3 = b2 + kstep;
            unsigned s0[2], s1[2];
#pragma unroll
            for (int _i = 0; _i < 2; ++_i) { s0[_i] = last ? nA0[_i] : vA0[_i]; s1[_i] = last ? nA1[_i] : vA1[_i]; }
            PG8_LDB(B0, 0, 0); PG8_LDB(B1, 0, 1); PG8_SCHED; PG8_LDA(At, 0, 0); PG8_STAGE(PG8_SA(1, 1), a1, vA1);
            PG8_WAIT_V(8); PG8_WAIT_L(0); PG8_BAR; PG8_MMA(0, 0, At, B0); PG8_MMA(0, 1, At, B1); PG8_BAR; PG8_SCHED;
            PG8_LDA(At, 0, 1); PG8_STAGE(PG8_SB(0, 0), b2, voffB); PG8_STAGE(PG8_SB(0, 1), b2 + hstep, voffB); PG8_STAGE(PG8_SA(0, 0), a2, s0);
            PG8_WAIT_V(8); PG8_WAIT_L(0); PG8_BAR; PG8_MMA(1, 0, At, B0); PG8_MMA(1, 1, At, B1); PG8_BAR; PG8_SCHED;
            PG8_LDB(B0, 1, 0); PG8_LDB(B1, 1, 1); PG8_SCHED; PG8_LDA(At, 1, 0); PG8_STAGE(PG8_SA(0, 1), a2, s1);
            PG8_WAIT_V(8); PG8_WAIT_L(0); PG8_BAR; PG8_MMA(0, 0, At, B0); PG8_MMA(0, 1, At, B1); PG8_BAR; PG8_SCHED;
            PG8_LDA(At, 1, 1); PG8_STAGE(PG8_SB(1, 0), b3, voffB); PG8_STAGE(PG8_SB(1, 1), b3 + hstep, voffB); PG8_STAGE(PG8_SA(1, 0), a3, s0);
            PG8_WAIT_V(8); PG8_WAIT_L(0); PG8_BAR; PG8_MMA(1, 0, At, B0); PG8_MMA(1, 1, At, B1); PG8_BAR; PG8_SCHED;
        }
        if (wr == 0) PG8_BAR;
        if constexpr (FP8) mfma8_settle(acc);
        E(acc, cur, wr, wc, fr, fq);
        if (!has_next) break;
#pragma unroll
        for (int a = 0; a < 2; ++a)
#pragma unroll
            for (int b = 0; b < 2; ++b)
#pragma unroll
                for (int m = 0; m < 4; ++m)
#pragma unroll
                    for (int n = 0; n < 2; ++n) acc[a][b][m][n] = (f32x4){0.f, 0.f, 0.f, 0.f};
        cur = nxt; cB = nB; ++ui;
#pragma unroll
        for (int _i = 0; _i < 2; ++_i) { vA0[_i] = nA0[_i]; vA1[_i] = nA1[_i]; }
        if (wr == 1) PG8_BAR;
    }
    PG8_WAIT_V(0);
    PG8_BAR;
#undef PG8_AOFF
#undef PG8_SA
#undef PG8_SB
#undef PG8_STAGE
#undef PG8_LDA
#undef PG8_LDB
#undef PG8_MMA
#undef PG8_WAIT_V
#undef PG8_WAIT_L
#undef PG8_BAR
#undef PG8_SCHED
}
}

__device__ __forceinline__ void p6_gateup(Frame& F, const Args& a) {
    unsigned char* ws = a.ws; gu32* gcnt = F.ctl + CW_CNT; const unsigned long long* LIST = (const unsigned long long*)(ws + WS_LIST);
    LAS int* pre = (LAS int*)(F.lds + pg8::P6_PRE); LAS int* cnts = pre + 65; LAS int* cum = cnts + 64; LAS unsigned long long* rowinfo = (LAS unsigned long long*)(F.lds + pg8::P6_ROWS);
    if (F.tid < 64) cnts[F.tid] = (int)__hip_atomic_load(gcnt + 64 * F.tid, RLX_AGENT);
    __syncthreads();
    if (F.tid == 0) { int s = 0, r = 0; for (int e = 0; e < 64; ++e) { pre[e] = s; cum[e] = r; s += (cnts[e] + 255) >> 8; r += cnts[e]; } pre[64] = s; cum[64] = r; }
    __syncthreads();
    pg8::SchedG S; S.pre = pre; S.cnts = cnts; S.cum = cum; S.wgu = (const char*)(ws + WS_WGU); S.wsh = (const char*)(ws + WS_WSHGU); S.G = F.G; S.c = (int)blockIdx.x; S.nr = __builtin_amdgcn_readfirstlane(pre[64]); S.total = S.nr + 2 * (M / 256);
    for (int i = 0; i < 3; ++i) { pg8::UnitG u; if (!S.next(i, u)) break;
        if (u.kind == 0 && F.tid < 256) { const int r = F.tid; rowinfo[i * 256 + r] = (r < u.nvalid) ? LIST[(size_t)u.pm * LIST_CAP + 256 * u.pn + r] : 0ull; } }
    __syncthreads();
    pg8::EpiGU E{ws + WS_HM, ws + WS_SH, (int*)(ws + WS_SLOT), rowinfo};
    pg8::gemm_phase_g<pg8::EpiGU, pg8::SchedG, true>(F.lds + RING_OFF, (const bf16_t*)(ws + WS_H2), D / 2, S, E, rowinfo);
    { const int rounds = (S.total + F.G - 1) / F.G, firstidle = S.total - (rounds - 1) * F.G;
      const int c = (int)blockIdx.x, nidle = F.G - firstidle;
      if (nidle > 0) { if (c >= firstidle) titem_run(F, a, true, 64 * 64 + 4 * 32, (c - firstidle) * NWAVES + F.wave, nidle * NWAVES); }
      else titem_run(F, a, true, 64 * 64 + 4 * 32, c * NWAVES + F.wave, F.G * NWAVES); }
}

namespace pg8 {
struct SchedYr {
    const LAS int* pre; int G, c, total;
    __device__ __forceinline__ bool next(int i, Unit& u) const {
        const int idx = i * G + c; if (idx >= total) return false;
        const int t = idx >> 2, pnl = idx & 3; int e = (int)__builtin_popcountll(__ballot(pre[1 + (threadIdx.x & 63)] <= t));
        e = __builtin_amdgcn_readfirstlane(e); u.pm = t; u.pn = 4 * e + pnl; return true; }
    __device__ __forceinline__ void a_ready(const Unit&) const {}
    __device__ __forceinline__ void done(const Unit&) const {}
};
constexpr float YSCALE = 8.f;
struct EpiStoreF8 {
    static constexpr bool PERM = true, AFTER_DRAIN = false;
    unsigned char* O; const PG8_LAS int* rowmap_l; int G, c; float scale;
    __device__ __forceinline__ void operator()(const f32x4 (&acc)[2][2][4][2], const Unit& u, int wr, int wc, int fr, int fq) const {
        const int slot = (4 * u.pm + (u.pn & 3) - c) / G; const PG8_LAS int* rm = rowmap_l + slot * 256 + wr * 64 + fr; const int col0 = (u.pn & 3) * BM + wc * 64 + 16 * fq;
#pragma unroll
        for (int ai = 0; ai < 2; ++ai)
#pragma unroll
            for (int m = 0; m < 4; ++m) { const int orow = rm[ai * HALF + m * 16]; u32x4 w;
#pragma unroll
                for (int bj = 0; bj < 2; ++bj) { const f32x4 v0 = acc[ai][bj][m][0] * scale, v1 = acc[ai][bj][m][1] * scale;
                    unsigned lo = 0u, hi = 0u;
                    lo = __builtin_amdgcn_cvt_pk_fp8_f32(v0[0], v0[1], lo, false); lo = __builtin_amdgcn_cvt_pk_fp8_f32(v0[2], v0[3], lo, true);
                    hi = __builtin_amdgcn_cvt_pk_fp8_f32(v1[0], v1[1], hi, false); hi = __builtin_amdgcn_cvt_pk_fp8_f32(v1[2], v1[3], hi, true);
                    if (bj == 0) { w.x = lo; w.y = hi; } else { w.z = lo; w.w = hi; } }
                *(u32x4*)(O + (size_t)orow * 1024 + col0) = w; }
    }
};
struct EpiStoreF8Dense {
    static constexpr bool PERM = true, AFTER_DRAIN = false;
    unsigned char* O; float scale;
    __device__ __forceinline__ void operator()(const f32x4 (&acc)[2][2][4][2], const Unit& u, int wr, int wc, int fr, int fq) const {
        const int row0 = u.pm * BM + wr * 64 + fr, col0 = (u.pn & 3) * BM + wc * 32 + 8 * fq;
#pragma unroll
        for (int ai = 0; ai < 2; ++ai)
#pragma unroll
            for (int m = 0; m < 4; ++m) { unsigned char* rowp = O + (size_t)(row0 + ai * HALF + m * 16) * 1024 + col0;
#pragma unroll
                for (int bj = 0; bj < 2; ++bj) { const f32x4 v0 = acc[ai][bj][m][0] * scale, v1 = acc[ai][bj][m][1] * scale;
                    unsigned lo = 0u, hi = 0u;
                    lo = __builtin_amdgcn_cvt_pk_fp8_f32(v0[0], v0[1], lo, false); lo = __builtin_amdgcn_cvt_pk_fp8_f32(v0[2], v0[3], lo, true);
                    hi = __builtin_amdgcn_cvt_pk_fp8_f32(v1[0], v1[1], hi, false); hi = __builtin_amdgcn_cvt_pk_fp8_f32(v1[2], v1[3], hi, true);
                    *(unsigned long long*)(rowp + bj * HALF) = (unsigned long long)lo | ((unsigned long long)hi << 32); } }
    }
};
struct EpiStore {
    static constexpr bool PERM = true, AFTER_DRAIN = false;
    bf16_t* O; int ldc, colmask;
    __device__ __forceinline__ void operator()(const f32x4 (&acc)[2][2][4][2], const Unit& u, int wr, int wc, int fr, int fq) const {
        const int row0 = u.pm * BM + wr * 64 + fr, col0 = (u.pn & colmask) * BM + wc * 32 + 8 * fq;
#pragma unroll
        for (int ai = 0; ai < 2; ++ai)
#pragma unroll
            for (int m = 0; m < 4; ++m) { bf16_t* rowp = O + (size_t)(row0 + ai * HALF + m * 16) * ldc + col0;
#pragma unroll
                for (int bj = 0; bj < 2; ++bj) { const f32x4 v0 = acc[ai][bj][m][0], v1 = acc[ai][bj][m][1];
                    u32x4 w; w.x = cvt_pk_bf16(v0[0], v0[1]); w.y = cvt_pk_bf16(v0[2], v0[3]); w.z = cvt_pk_bf16(v1[0], v1[1]); w.w = cvt_pk_bf16(v1[2], v1[3]);
                    *(u32x4*)(rowp + bj * HALF) = w; } }
    }
};
template <class Epi, class Sched, int NK>
__device__ __forceinline__ void gemm_phase_f8s(PG8_LAS unsigned char* lds, const unsigned char* A, const unsigned char* Bt, const Sched& S, const Epi& E) {
    int tid_ = threadIdx.x; asm volatile("" : "+v"(tid_));
    const int tid = tid_, wid = __builtin_amdgcn_readfirstlane(tid >> 6), lane = tid & 63, wr = wid >> 2, wc = wid & 3, fr = lane & 15, fq = lane >> 4;
    constexpr int PITCH = NK * 128;
    unsigned voffA[2], voffB[2];
#pragma unroll
    for (int i = 0; i < 2; ++i) { int R, C; stage_rc(tid * 16 + i * 8192, R, C); const int Rb = Epi::PERM ? ((R & ~31) + perm32(R & 31)) : R; voffA[i] = (unsigned)(R * PITCH + 2 * C); voffB[i] = (unsigned)(Rb * PITCH + 2 * C); }
    constexpr size_t hstep = (size_t)HALF * PITCH, tstep = 2 * hstep;
    const unsigned ldsw = (unsigned)wid * 1024u;
    const int aoff = lds_byte(wr * 64 + fr, fq * 8), boff = lds_byte(wc * 32 + fr, fq * 8);
#define F8S_SA(b, h) (((b) * 2 + (h)) * HTB)
#define F8S_SB(b, h) ((4 + (b) * 2 + (h)) * HTB)
#define F8S_STAGE(bufoff, gbase, voff) do { _Pragma("unroll") for (int _i = 0; _i < 2; ++_i) \
        __builtin_amdgcn_global_load_lds((const unsigned*)((const char*)(gbase) + (voff)[_i]), (PG8_LAS unsigned*)(lds + (bufoff) + ldsw + _i * 8192), 16, 0, 0); } while (0)
#define F8S_STAGE4(b, pa, pb) do { F8S_STAGE(F8S_SB(b, 0), pb, voffB); F8S_STAGE(F8S_SB(b, 1), (pb) + hstep, voffB); F8S_STAGE(F8S_SA(b, 0), pa, voffA); F8S_STAGE(F8S_SA(b, 1), (pa) + hstep, voffA); } while (0)
#define F8S_LDA(dst, b, h) do { _Pragma("unroll") for (int m = 0; m < 4; ++m) _Pragma("unroll") for (int k = 0; k < 2; ++k) dst[m][k] = *(const PG8_LAS bf16x8*)(lds + F8S_SA(b, h) + aoff + m * 2048 + k * 1024); } while (0)
#define F8S_LDB(dst, b, h) do { _Pragma("unroll") for (int n = 0; n < 2; ++n) _Pragma("unroll") for (int k = 0; k < 2; ++k) dst[n][k] = *(const PG8_LAS bf16x8*)(lds + F8S_SB(b, h) + boff + n * 2048 + k * 1024); } while (0)
#define F8S_MMA(ai, bj, At, Bt_) do { _Pragma("unroll") for (int m = 0; m < 4; ++m) _Pragma("unroll") for (int n = 0; n < 2; ++n) mfma8(acc[ai][bj][m][n], cat8(Bt_[n][0], Bt_[n][1]), cat8(At[m][0], At[m][1])); } while (0)
    Unit cur, nxt; int ui = 0;
    if (!S.next(0, cur)) return;
    f32x4 acc[2][2][4][2];
#pragma unroll
    for (int a = 0; a < 2; ++a)
#pragma unroll
        for (int b = 0; b < 2; ++b)
#pragma unroll
            for (int m = 0; m < 4; ++m)
#pragma unroll
                for (int n = 0; n < 2; ++n) acc[a][b][m][n] = (f32x4){0.f, 0.f, 0.f, 0.f};
    const char* cA = (const char*)A + (size_t)cur.pm * tstep; const char* cB = (const char*)Bt + (size_t)cur.pn * tstep;
    bool has_next = S.next(1, nxt);
    int b = 0, kt = 0;
    F8S_STAGE4(0, cA, cB);
    asm volatile("s_waitcnt vmcnt(0)" ::: "memory");
#pragma nounroll
    for (;;) {
        __builtin_amdgcn_s_barrier();
        bf16x8 At0[4][2], At1[4][2], B0[2][2], B1[2][2];
        F8S_LDB(B0, b, 0); F8S_LDB(B1, b, 1); F8S_LDA(At0, b, 0); F8S_LDA(At1, b, 1);
        asm volatile("s_waitcnt lgkmcnt(0)" ::: "memory");
        __builtin_amdgcn_s_barrier();
        const bool last_kt = (kt == NK - 1), more = !last_kt || has_next;
        if (more) { const char* nA = last_kt ? (const char*)A + (size_t)nxt.pm * tstep : cA + (kt + 1) * 128; const char* nB = last_kt ? (const char*)Bt + (size_t)nxt.pn * tstep : cB + (kt + 1) * 128;
            if (b == 0) F8S_STAGE4(1, nA, nB); else F8S_STAGE4(0, nA, nB); }
        __builtin_amdgcn_s_setprio(1);
        F8S_MMA(0, 0, At0, B0); F8S_MMA(0, 1, At0, B1); F8S_MMA(1, 0, At1, B0); F8S_MMA(1, 1, At1, B1);
        __builtin_amdgcn_s_setprio(0);
        asm volatile("s_waitcnt vmcnt(0)" ::: "memory");
        if (last_kt) {
            mfma8_settle(acc);
            E(acc, cur, wr, wc, fr, fq);
            if (!has_next) break;
#pragma unroll
            for (int a = 0; a < 2; ++a)
#pragma unroll
                for (int bb = 0; bb < 2; ++bb)
#pragma unroll
                    for (int m = 0; m < 4; ++m)
#pragma unroll
                        for (int n = 0; n < 2; ++n) acc[a][bb][m][n] = (f32x4){0.f, 0.f, 0.f, 0.f};
            cur = nxt; cA = (const char*)A + (size_t)cur.pm * tstep; cB = (const char*)Bt + (size_t)cur.pn * tstep; ++ui; has_next = S.next(ui + 1, nxt); kt = 0;
        } else ++kt;
        b ^= 1;
    }
    __builtin_amdgcn_s_barrier();
#undef F8S_SA
#undef F8S_SB
#undef F8S_STAGE
#undef F8S_STAGE4
#undef F8S_LDA
#undef F8S_LDB
#undef F8S_MMA
}
}
__device__ __forceinline__ void p7_down(Frame& F, const Args& a) {
    unsigned char* ws = a.ws; gu32* gcnt = F.ctl + CW_CNT;
    LAS int* pre = (LAS int*)(F.lds + pg8::P6_PRE); LAS int* cnts = pre + 65;
    if (F.tid < 64) cnts[F.tid] = (int)__hip_atomic_load(gcnt + 64 * F.tid, RLX_AGENT);
    __syncthreads();
    if (F.tid == 0) { int s = 0; for (int e = 0; e < 64; ++e) { pre[e] = s; s += (cnts[e] + 255) >> 8; } pre[64] = s; }
    __syncthreads();
    { pg8::SchedYr S; S.pre = pre; S.G = F.G; S.c = (int)blockIdx.x; S.total = 4 * __builtin_amdgcn_readfirstlane(pre[64]);
      int kk = ED; asm volatile("" : "+s"(kk));
      LAS int* rml = (LAS int*)(F.lds + AUX_OFF + 2048); const int* rowmap = (const int*)(ws + WS_SLOT);
      for (int i = 0; i * F.G + S.c < S.total && i < 12; ++i) { if (F.tid < 256) rml[i * 256 + F.tid] = rowmap[256 * ((i * F.G + S.c) >> 2) + F.tid]; }
      __syncthreads();
      pg8::EpiStoreF8 E{ws + WS_YH, rml, F.G, S.c, pg8::YSCALE / (HM8SCALE * W8SCALE)};
      pg8::gemm_phase_f8s<pg8::EpiStoreF8, pg8::SchedYr, 1>(F.lds + RING_OFF, ws + WS_HM, ws + WS_WD, S, E); }
    { pg8::StaticOrder S; S.init(M, D, F.G, (int)blockIdx.x);
      int kk = SHD; asm volatile("" : "+s"(kk));
      pg8::EpiStoreF8Dense E{ws + WS_YSH, pg8::YSCALE / (SH8SCALE * W8SCALE)};
      pg8::gemm_phase_f8s<pg8::EpiStoreF8Dense, pg8::StaticOrder, 2>(F.lds + RING_OFF, ws + WS_SH, ws + WS_WSHD, S, E); }
}
__device__ __forceinline__ void p8_combine(Frame& F, const Args& a) {
    unsigned char* ws = a.ws; const unsigned char* Y8 = ws + WS_YH; const unsigned char* YSH = ws + WS_YSH;
    const float* mod = (const float*)(ws + WS_MOD); float* OUT = a.out; const int lane = F.lane;
    for (int tb = (F.vcu * NWAVES + F.wave) * 8; tb < M; tb += F.G * NWAVES * 8) {
        const int b = tb / SEQ; const float* gate = mod + (size_t)b * 6 * D + 5 * D + lane * 16;
        f32x4 gv[4];
#pragma unroll
        for (int i = 0; i < 4; ++i) gv[i] = *(const f32x4*)(gate + 4 * i);
#pragma nounroll
        for (int i = 0; i < 8; i += 2) {
            v4u y[2][9]; f32x4 x[2][4];
#pragma unroll
            for (int q = 0; q < 2; ++q) { const int t = tb + i + q;
#pragma unroll
                for (int k = 0; k < 8; ++k) y[q][k] = *(const GAS v4u*)(Y8 + ((size_t)t * 8 + k) * 1024 + lane * 16);
                y[q][8] = *(const GAS v4u*)(YSH + (size_t)t * D + lane * 16);
                const GAS f32x4* o = (const GAS f32x4*)(OUT + (size_t)t * D + lane * 16);
#pragma unroll
                for (int j = 0; j < 4; ++j) x[q][j] = o[j]; }
#pragma unroll
            for (int q = 0; q < 2; ++q) { const int t = tb + i + q; float acc[16];
#pragma unroll
                for (int j = 0; j < 16; ++j) acc[j] = 0.f;
#pragma unroll
                for (int k = 0; k < 9; ++k) { const unsigned w4[4] = {y[q][k].x, y[q][k].y, y[q][k].z, y[q][k].w};
#pragma unroll
                    for (int j = 0; j < 4; ++j) { const pg8::f32x2_t lo = __builtin_amdgcn_cvt_pk_f32_fp8((int)w4[j], false), hi = __builtin_amdgcn_cvt_pk_f32_fp8((int)w4[j], true);
                        acc[4 * j] += lo.x; acc[4 * j + 1] += lo.y; acc[4 * j + 2] += hi.x; acc[4 * j + 3] += hi.y; } }
                GAS f32x4* o = (GAS f32x4*)(OUT + (size_t)t * D + lane * 16);
#pragma unroll
                for (int j = 0; j < 4; ++j) { const f32x4 rt = {acc[4 * j], acc[4 * j + 1], acc[4 * j + 2], acc[4 * j + 3]};
                    o[j] = x[q][j] + gv[j] * (rt * (1.f / pg8::YSCALE)); } }
        }
    }
}

__global__ void __launch_bounds__(NWAVES * 64, 2) mk_fwd(Args args) {
    extern __shared__ __attribute__((aligned(16))) unsigned char lds[];
    Frame F;
    F.lds = (LAS unsigned char*)lds; F.MISC = (volatile LAS unsigned*)(F.lds + MISC_OFF);
    F.tid = threadIdx.x; F.lane = F.tid & 63; F.wave = __builtin_amdgcn_readfirstlane(F.tid >> 6);
    F.G = gridDim.x; { const int bx = blockIdx.x; F.vcu = (F.G % 8 == 0) ? (bx % 8) * (F.G / 8) + bx / 8 : bx; }
    unsigned char* ws = args.ws; F.ctl = (gu32*)(ws + WS_CTL);
    for (int u = F.tid; u < (LDS_BYTES - LDSCTL_OFF) / 4; u += NWAVES * 64) ((LAS unsigned*)(F.lds + LDSCTL_OFF))[u] = 0u;
    __syncthreads();
    XcdBarrier bar; bar.bar = (unsigned*)(F.ctl + CW_BAR); bar.x = 0; bar.st = nullptr;
    if (args.use_bar) bar = xcd_barrier_post((unsigned*)(F.ctl + CW_BAR), F.MISC + 8);
    const int lo = args.ph_lo, hi = args.ph_hi;
#define IN(k) (lo <= (k) && (k) < hi)
#define SEAM(k) do { if (IN(k) && IN((k) + 1)) xcd_barrier(bar); } while (0)
#define REFRESH() do { int t_ = threadIdx.x; asm volatile("" : "+v"(t_)); F.tid = t_; F.lane = t_ & 63; F.wave = __builtin_amdgcn_readfirstlane(t_ >> 6); } while (0)
#define PHASE(p, ...) do { if (IN(p)) { REFRESH(); const int reps_ = (DBL_PHASE == (p)) ? 2 : 1; for (int rep_ = 0; rep_ < reps_; ++rep_) { __VA_ARGS__; if (rep_ + 1 < reps_) xcd_barrier(bar); } } SEAM(p); } while (0)
    PHASE(0, { p0a(F, args); __syncthreads(); p0b(F, args); });
    PHASE(2, {
        pg8::StaticOrder S; S.init(M, INW / 2, F.G, (int)blockIdx.x);
        { pg8::Gemm g{(const bf16_t*)(ws + WS_XN), (const bf16_t*)(ws + WS_WIN), M, INW / 2, D};
          pg8::EpiProj E{(bf16_t*)(ws + WS_Q), (bf16_t*)(ws + WS_K), (bf16_t*)(ws + WS_V), (bf16_t*)(ws + WS_U), (bf16_t*)(ws + WS_GA), (bf16_t*)(ws + WS_GB), args.in[6], args.in[7], 0, 1.f};
          pg8::gemm_phase<pg8::EpiProj, pg8::StaticOrder, true, true>(F.lds + RING_OFF, g, S, E); }
        { pg8::Gemm g{(const bf16_t*)(ws + WS_XN8), (const bf16_t*)(ws + WS_WIN8), M, INW / 2, D / 2};
          pg8::EpiProj E{(bf16_t*)(ws + WS_Q), (bf16_t*)(ws + WS_K), (bf16_t*)(ws + WS_V), (bf16_t*)(ws + WS_U), (bf16_t*)(ws + WS_GA), (bf16_t*)(ws + WS_GB), args.in[6], args.in[7], 8, 1.f / (W8SCALE * H8SCALE)};
          pg8::gemm_phase<pg8::EpiProj, pg8::StaticOrder, true, true, true>(F.lds + RING_OFF, g, S, E); } });
    PHASE(3, {
        const bf16_t* Q = (const bf16_t*)(ws + WS_Q); const bf16_t* K = (const bf16_t*)(ws + WS_K); const bf16_t* V = (const bf16_t*)(ws + WS_V);
        for (int u = blockIdx.x; u < BATCH * NH * (SEQ / 256); u += F.G) { const int qb = u & 15, bh = u >> 4;
            sb::attn_unit(bh >> 3, bh & 7, qb, Q, K, V, (bf16_t*)(ws + WS_OSB), F.lds + RING_OFF + F.wave * sb::WAVE_LDS, F.wave, F.lane); }
        p2_pool(F, (const bf16_t*)(ws + WS_U), (bf16_t*)(ws + WS_MIX)); });
    PHASE(4, {
        pg8::StaticOrder S; S.init(M, D, F.G, (int)blockIdx.x);
        { pg8::Gemm g{(const bf16_t*)(ws + WS_OSB), (const bf16_t*)(ws + WS_WSB), M, D, SBW}; pg8::EpiMerge E{(const bf16_t*)(ws + WS_GA), (bf16_t*)(ws + WS_MERGED), 0};
          pg8::gemm_phase<pg8::EpiMerge, pg8::StaticOrder, true, true>(F.lds + RING_OFF, g, S, E); }
        { pg8::Gemm g{(const bf16_t*)(ws + WS_MIX), (const bf16_t*)(ws + WS_WEFF), M, D, PW}; pg8::EpiMerge E{(const bf16_t*)(ws + WS_GB), (bf16_t*)(ws + WS_MERGED), 1};
          pg8::gemm_phase<pg8::EpiMerge, pg8::StaticOrder, true, true>(F.lds + RING_OFF, g, S, E); } });
    PHASE(5, {
        pg8::Gemm g{(const bf16_t*)(ws + WS_MERGED), (const bf16_t*)(ws + WS_WOUT), M, D, D}; pg8::StaticOrder S; S.init(M, D, F.G, (int)blockIdx.x);
        pg8::EpiX1 E{args.in[0], (const float*)(ws + WS_MOD) + 2 * D, args.out};
        pg8::gemm_phase<pg8::EpiX1, pg8::StaticOrder, true, true>(F.lds + RING_OFF, g, S, E); });
    PHASE(6, {
        if (rep_ > 0) { if (blockIdx.x == 0 && F.tid < 64) __hip_atomic_store(F.ctl + CW_CNT + 64 * F.tid, 0u, RLX_AGENT); xcd_barrier(bar); }
        p5_route(F, args); });
    PHASE(7, p6_gateup(F, args));
    PHASE(8, p7_down(F, args));
    if (IN(9)) { REFRESH(); p8_combine(F, args); }
#undef PHASE
#undef REFRESH
#undef IN
#undef SEAM
}
constexpr int N_PHASES = 10;
extern "C" void kernel_launch(void* const* d_in, const int* in_sizes, int n_in, void* d_out, int out_size, void* d_ws, size_t ws_size, hipStream_t stream) {
    static int grid = 0;
    if (grid == 0) {
        if (n_in != 22 || out_size != M * D || ws_size < WS_END) { fprintf(stderr, "kernel_launch: unexpected shapes n_in %d out %d ws %zu\n", n_in, out_size, ws_size); grid = -1; return; }
        int dev = 0, cus = 0, per_cu = 0;
        if (hipGetDevice(&dev) != hipSuccess || hipDeviceGetAttribute(&cus, hipDeviceAttributeMultiprocessorCount, dev) != hipSuccess) { grid = -1; return; }
        if (hipFuncSetAttribute((const void*)mk_fwd, hipFuncAttributeMaxDynamicSharedMemorySize, LDS_BYTES) != hipSuccess) { fprintf(stderr, "kernel_launch: hipFuncSetAttribute failed\n"); grid = -1; return; }
        if (hipOccupancyMaxActiveBlocksPerMultiprocessor(&per_cu, (const void*)mk_fwd, NWAVES * 64, LDS_BYTES) != hipSuccess || per_cu < 1) fprintf(stderr, "kernel_launch: occupancy query says %d per CU\n", per_cu);
        (void)hipGetLastError();
        grid = cus;
        if (grid * 64 < M) { fprintf(stderr, "kernel_launch: %d CUs cannot cover %d rows in the one-block-per-workgroup phases\n", cus, M); grid = -1; return; }
    }
    if (grid < 0) return;
    unsigned char* ws = (unsigned char*)d_ws;
    if (hipMemsetAsync(ws + WS_CTL, 0, CTL_ZERO_BYTES, stream) != hipSuccess) { fprintf(stderr, "kernel_launch: memset failed\n"); return; }
    Args a{};
    for (int i = 0; i < 22; ++i) a.in[i] = (const float*)d_in[i];
    a.out = (float*)d_out; a.ws = ws; a.ph_lo = 0; a.ph_hi = N_PHASES; a.use_bar = 1;
    hipLaunchKernelGGL(mk_fwd, dim3(grid), dim3(NWAVES * 64), LDS_BYTES, stream, a);
}
```

```cpp
#include <hip/hip_runtime.h>
#include <cstdint>
#include <type_traits>
#include <cstdio>

typedef unsigned short bf16_t;
constexpr int D = 1024, BATCH = 4, SEQ = 4096, M = BATCH * SEQ, NH = 8, HD = 64, SBW = 512, PW = 512, INW = 4096;
constexpr int NE = 64, ED = 128, TOPK = 8, SHD = 256;
constexpr float EPS = 1e-6f, RSCALE = 2.5f;

constexpr size_t MiB = 1u << 20;
constexpr size_t WS_X1B0 = 172 * MiB, WS_X1B1 = 219 * MiB;
__host__ __device__ __forceinline__ unsigned short* x1b_row(unsigned char* ws, int row) { return (unsigned short*)(ws + (row < 8192 ? WS_X1B0 : WS_X1B1 - (size_t)8192 * 2048) + (size_t)row * 2048); }
constexpr size_t WS_CTL = 0, WS_MOD = 1 * MiB, WS_PE = 2 * MiB, WS_PW = 3 * MiB, WS_LIST = 4 * MiB;
constexpr size_t WS_XN = 74 * MiB, WS_OSB = 74 * MiB, WS_MIX = 90 * MiB, WS_H2 = 74 * MiB;
constexpr size_t WS_Q = 106 * MiB, WS_K = 122 * MiB, WS_V = 138 * MiB, WS_MERGED = 106 * MiB;
constexpr size_t WS_SLOT = 190 * MiB, WS_SH = 192 * MiB, WS_HM = 200 * MiB;
constexpr size_t WS_YH = 12 * MiB, WS_YSH = 156 * MiB;
constexpr size_t WS_U = 154 * MiB, WS_GA = 170 * MiB, WS_GB = 202 * MiB, WS_END = 256 * MiB;

__device__ __forceinline__ unsigned f2bf(float f) { unsigned u = __builtin_bit_cast(unsigned, f); return (u + 0x7fffu + ((u >> 16) & 1u)) >> 16; }
__device__ __forceinline__ float bf2f(unsigned h) { return __builtin_bit_cast(float, h << 16); }
struct HalfSwap { float keep_lo, keep_hi; };
__device__ __forceinline__ HalfSwap half_swap(float v) {
    const unsigned a = __builtin_bit_cast(unsigned, v);
    const auto sw = __builtin_amdgcn_permlane32_swap(a, a, false, false);
    const unsigned r0 = sw[0], r1 = sw[1];
    return HalfSwap{__builtin_bit_cast(float, r0), __builtin_bit_cast(float, r1)};
}
__device__ __forceinline__ float wave_sum(float v) {
#pragma unroll
    for (int o = 1; o < 32; o <<= 1) v += __shfl_xor(v, o);
    { const HalfSwap h = half_swap(v); v = h.keep_lo + h.keep_hi; }
    return v;
}
__device__ __forceinline__ int wave_excl_scan(int v, int lane) {
    int x = v;
#pragma unroll
    for (int o = 1; o < 64; o <<= 1) { const int y = __shfl_up(x, o); x += (lane >= o) ? y : 0; }
    return x - v;
}
__device__ __forceinline__ float sigmoidf_(float v) { return 1.f / (1.f + __expf(-v)); }
__device__ __forceinline__ float siluf_(float v) { return v / (1.f + __expf(-v)); }

namespace pg8 {
#define PG8_LAS __attribute__((address_space(3)))
typedef short bf16x8 __attribute__((ext_vector_type(8)));
typedef float f32x4 __attribute__((ext_vector_type(4)));
typedef unsigned u32x4 __attribute__((ext_vector_type(4)));
constexpr int M_ROWS = 16384;
constexpr int BM = 256, BK = 64, HALF = 128, HTB = HALF * BK * 2  , STAGE_BYTES = 8 * HTB, NXCD = 8, WGM = 8;

__host__ __device__ __forceinline__ int lds_byte(int r, int c) { const int st = (r >> 4) * 2 + (c >> 5), rr = r & 15, cc = c & 31, ob = rr * 64 + cc * 2; return st * 1024 + (ob ^ (((ob >> 9) & 1) << 5)); }
__host__ __device__ __forceinline__ void stage_rc(int b, int& R, int& C) { const int st = b / 1024, sb = b % 1024, swz = sb ^ (((sb >> 9) & 1) << 5); R = (st >> 1) * 16 + swz / 64; C = (st & 1) * 32 + (swz % 64) / 2; }
__host__ __device__ __forceinline__ int perm32(int rho) { const int n = rho >> 4, i = rho & 15; return 8 * (i >> 2) + 4 * n + (i & 3); }

struct Unit { int pm, pn; };
template <class E, class = void> struct epi_carry : std::false_type {};
template <class E> struct epi_carry<E, std::void_t<decltype(E::CARRY)>> : std::bool_constant<E::CARRY> {};
struct Gemm { const bf16_t* A; const bf16_t* Bt; int M, N, K; };

struct StaticOrder {
    int nM, nN, nwg, G, c;
    __host__ __device__ void init(int M_, int N_, int G_, int c_) { nM = M_ / BM; nN = N_ / BM; nwg = nM * nN; G = G_; c = c_; }
    __host__ __device__ bool next(int i, Unit& u) const {
        const long L = (long)i * G + c; if (L >= nwg) return false;
        int wgid = (int)L; { const int q = nwg / NXCD, r = nwg % NXCD, xcd = wgid % NXCD, off = wgid / NXCD; wgid = (xcd < r ? xcd * (q + 1) : r * (q + 1) + (xcd - r) * q) + off; }
        const int nig = WGM * nN, gid = wgid / nig, fm = gid * WGM, gsz = (nM - fm) < WGM ? (nM - fm) : WGM;
        u.pm = fm + ((wgid % nig) % gsz); u.pn = (wgid % nig) / gsz; return true;
    }
    __device__ __forceinline__ void a_ready(const Unit&) const {}
    __device__ __forceinline__ void done(const Unit&) const {}
};
typedef float f32x2_t __attribute__((ext_vector_type(2))); typedef __bf16 bf16x2_t __attribute__((ext_vector_type(2)));
__device__ __forceinline__ unsigned cvt_pk_bf16(float lo, float hi) { f32x2_t v = {lo, hi}; bf16x2_t b = __builtin_convertvector(v, bf16x2_t); return __builtin_bit_cast(unsigned, b); }
__device__ __forceinline__ float fsigmoid(float v) { return __builtin_amdgcn_rcpf(1.f + __builtin_amdgcn_exp2f(-1.4426950408889634f * v)); }
constexpr float QSCALE = 0.125f * 1.4426950408889634f;

struct EpiProj {
    static constexpr bool PERM = true, AFTER_DRAIN = false;
    bf16_t *Q, *K, *V, *U, *GA, *GB; const float* gq; const float* gk; int sec0; float dq;
    __device__ __forceinline__ void operator()(const f32x4 (&acc)[2][2][4][2], const Unit& u, int wr, int wc, int fr, int fq) const {
        const int row0 = u.pm * BM + wr * 64 + fr; const int sec = u.pn + sec0;
        if (sec < 4) {
            const bool isq = sec < 2; const float* g = isq ? gq : gk; bf16_t* base = (isq ? Q : K) + ((sec & 1) * 4 + wc) * 64 + 8 * fq;
            const float qs = isq ? QSCALE : 1.f;
            f32x4 gv[2][2];
#pragma unroll
            for (int bj = 0; bj < 2; ++bj)
#pragma unroll
                for (int n = 0; n < 2; ++n) gv[bj][n] = *(const f32x4*)(g + 32 * bj + 8 * fq + 4 * n);
#pragma unroll
            for (int ai = 0; ai < 2; ++ai)
#pragma unroll
                for (int m = 0; m < 4; ++m) {
                    float ss = 0.f;
#pragma unroll
                    for (int bj = 0; bj < 2; ++bj)
#pragma unroll
                        for (int n = 0; n < 2; ++n) { const f32x4 x = acc[ai][bj][m][n]; ss += (x[0] * x[0] + x[1] * x[1]) + (x[2] * x[2] + x[3] * x[3]); }
                    ss += __shfl_xor(ss, 16); { const HalfSwap h_ = half_swap(ss); ss = h_.keep_lo + h_.keep_hi; }
                    const float r = rsqrtf(ss * (1.f / 64.f) + EPS) * qs;
                    bf16_t* rowp = base + (size_t)(row0 + ai * HALF + m * 16) * 512;
#pragma unroll
                    for (int bj = 0; bj < 2; ++bj) { const f32x4 v0 = acc[ai][bj][m][0] * gv[bj][0] * r, v1 = acc[ai][bj][m][1] * gv[bj][1] * r;
                        u32x4 w; w.x = cvt_pk_bf16(v0[0], v0[1]); w.y = cvt_pk_bf16(v0[2], v0[3]); w.z = cvt_pk_bf16(v1[0], v1[1]); w.w = cvt_pk_bf16(v1[2], v1[3]);
                        *(u32x4*)(rowp + 32 * bj) = w; }
                }
        } else if (sec < 8) {
            bf16_t* base = (sec < 6 ? V : U) + (sec & 1) * 256 + wc * 32 + 8 * fq;
#pragma unroll
            for (int ai = 0; ai < 2; ++ai)
#pragma unroll
                for (int m = 0; m < 4; ++m) { bf16_t* rowp = base + (size_t)(row0 + ai * HALF + m * 16) * 512;
#pragma unroll
                    for (int bj = 0; bj < 2; ++bj) { const f32x4 v0 = acc[ai][bj][m][0], v1 = acc[ai][bj][m][1];
                        u32x4 w; w.x = cvt_pk_bf16(v0[0], v0[1]); w.y = cvt_pk_bf16(v0[2], v0[3]); w.z = cvt_pk_bf16(v1[0], v1[1]); w.w = cvt_pk_bf16(v1[2], v1[3]);
                        *(u32x4*)(rowp + bj * HALF) = w; } }
        } else {
            unsigned char* base = (unsigned char*)(sec < 12 ? GA : GB) + ((sec - 8) & 3) * 256 + wc * 32 + 8 * fq;
            const float gmin = (sec < 12) ? 0.f : 1.f;
#define GQ8(x) fmaxf(__builtin_rintf(fsigmoid(x) * 255.f), gmin)
#pragma unroll
            for (int ai = 0; ai < 2; ++ai)
#pragma unroll
                for (int m = 0; m < 4; ++m) { unsigned char* rowp = base + (size_t)(row0 + ai * HALF + m * 16) * 1024;
#pragma unroll
                    for (int bj = 0; bj < 2; ++bj) { const f32x4 v0 = acc[ai][bj][m][0] * dq, v1 = acc[ai][bj][m][1] * dq;
                        unsigned lo = 0u, hi = 0u;
                        lo = __builtin_amdgcn_cvt_pk_u8_f32(GQ8(v0[0]), 0, lo); lo = __builtin_amdgcn_cvt_pk_u8_f32(GQ8(v0[1]), 1, lo); lo = __builtin_amdgcn_cvt_pk_u8_f32(GQ8(v0[2]), 2, lo); lo = __builtin_amdgcn_cvt_pk_u8_f32(GQ8(v0[3]), 3, lo);
                        hi = __builtin_amdgcn_cvt_pk_u8_f32(GQ8(v1[0]), 0, hi); hi = __builtin_amdgcn_cvt_pk_u8_f32(GQ8(v1[1]), 1, hi); hi = __builtin_amdgcn_cvt_pk_u8_f32(GQ8(v1[2]), 2, hi); hi = __builtin_amdgcn_cvt_pk_u8_f32(GQ8(v1[3]), 3, hi);
                        *(unsigned long long*)(rowp + bj * HALF) = (unsigned long long)lo | ((unsigned long long)hi << 32); } }
#undef GQ8
        }
    }
};

struct SchedMerge {
    StaticOrder so;
    __device__ __forceinline__ bool next(int i, Unit& u) const { if (!so.next(i >> 1, u)) return false; if (i & 1) { u.pm += M_ROWS / BM; u.pn += 1024 / BM; } return true; }
    __device__ __forceinline__ void a_ready(const Unit&) const {}
    __device__ __forceinline__ void done(const Unit&) const {}
};
struct EpiMerge2 {
    static constexpr bool PERM = true, AFTER_DRAIN = false, CARRY = true;
    const unsigned char* GA; const unsigned char* GB; unsigned char* MG8;
    __device__ __forceinline__ bool carry(const Unit& u) const { return u.pm < M_ROWS / BM; }
    __device__ __forceinline__ void mid(f32x4 (&acc)[2][2][4][2], const Unit& u, int wr, int wc, int fr, int fq) const {
        const int row0 = u.pm * BM + wr * 64 + fr, col0 = u.pn * BM + wc * 32 + 8 * fq;
#pragma unroll
        for (int ai = 0; ai < 2; ++ai)
#pragma unroll
            for (int m = 0; m < 4; ++m) { const size_t off = (size_t)(row0 + ai * HALF + m * 16) * 1024 + col0;
#pragma unroll
                for (int bj = 0; bj < 2; ++bj) { const unsigned long long a8 = *(const unsigned long long*)(GA + off + bj * HALF), b8 = *(const unsigned long long*)(GB + off + bj * HALF);
                    const unsigned al = (unsigned)a8, ah = (unsigned)(a8 >> 32), bl = (unsigned)b8, bh = (unsigned)(b8 >> 32);
#define RQ(av, bv, sh) ((float)(((av) >> (sh)) & 0xffu) * __builtin_amdgcn_rcpf((float)(((bv) >> (sh)) & 0xffu)))
                    f32x4& a0 = acc[ai][bj][m][0]; f32x4& a1 = acc[ai][bj][m][1];
                    a0[0] *= RQ(al, bl, 0); a0[1] *= RQ(al, bl, 8); a0[2] *= RQ(al, bl, 16); a0[3] *= RQ(al, bl, 24);
                    a1[0] *= RQ(ah, bh, 0); a1[1] *= RQ(ah, bh, 8); a1[2] *= RQ(ah, bh, 16); a1[3] *= RQ(ah, bh, 24); } }
#undef RQ
    }
    __device__ __forceinline__ void operator()(const f32x4 (&acc)[2][2][4][2], const Unit& u, int wr, int wc, int fr, int fq) const {
        const int row0 = (u.pm - M_ROWS / BM) * BM + wr * 64 + fr, col0 = (u.pn - 1024 / BM) * BM + wc * 32 + 8 * fq;
#pragma unroll
        for (int ai = 0; ai < 2; ++ai)
#pragma unroll
            for (int m = 0; m < 4; ++m) { const size_t off = (size_t)(row0 + ai * HALF + m * 16) * 1024 + col0;
#pragma unroll
                for (int bj = 0; bj < 2; ++bj) { const unsigned long long g8 = *(const unsigned long long*)(GB + off + bj * HALF); const unsigned gl = (unsigned)g8, gh = (unsigned)(g8 >> 32);
                    const f32x4 a0 = acc[ai][bj][m][0] * (32.f / 255.f), a1 = acc[ai][bj][m][1] * (32.f / 255.f);
#define M8Q(gv, sh, x) __builtin_amdgcn_fmed3f((float)(((gv) >> (sh)) & 0xffu) * (x), -448.f, 448.f)
                    unsigned lo = 0u, hi = 0u;
                    lo = __builtin_amdgcn_cvt_pk_fp8_f32(M8Q(gl, 0, a0[0]), M8Q(gl, 8, a0[1]), lo, false); lo = __builtin_amdgcn_cvt_pk_fp8_f32(M8Q(gl, 16, a0[2]), M8Q(gl, 24, a0[3]), lo, true);
                    hi = __builtin_amdgcn_cvt_pk_fp8_f32(M8Q(gh, 0, a1[0]), M8Q(gh, 8, a1[1]), hi, false); hi = __builtin_amdgcn_cvt_pk_fp8_f32(M8Q(gh, 16, a1[2]), M8Q(gh, 24, a1[3]), hi, true);
#undef M8Q
                    *(unsigned long long*)(MG8 + off + bj * HALF) = (unsigned long long)lo | ((unsigned long long)hi << 32); } }
    }
};
struct EpiX1 {
    static constexpr bool PERM = true, AFTER_DRAIN = false;
    const float* x; const float* gate; unsigned char* ws; float* SS; float dq;
    __device__ __forceinline__ void operator()(const f32x4 (&acc)[2][2][4][2], const Unit& u, int wr, int wc, int fr, int fq) const {
        const int row0 = u.pm * BM + wr * 64 + fr, col0 = u.pn * BM + wc * 32 + 8 * fq; const int b = (u.pm * BM) / 4096;
        f32x4 gv[2][2];
#pragma unroll
        for (int bj = 0; bj < 2; ++bj)
#pragma unroll
            for (int n = 0; n < 2; ++n) gv[bj][n] = *(const f32x4*)(gate + (size_t)b * 6 * 1024 + col0 + bj * HALF + n * 4) * dq;
#pragma unroll
        for (int ai = 0; ai < 2; ++ai)
#pragma unroll
            for (int m = 0; m < 4; ++m) { const int row = row0 + ai * HALF + m * 16; const float* xrow = x + (size_t)row * 1024 + col0; unsigned short* orow = x1b_row(ws, row) + col0; float ss = 0.f;
#pragma unroll
                for (int bj = 0; bj < 2; ++bj) { const f32x4 v0 = *(const f32x4*)(xrow + bj * HALF) + gv[bj][0] * acc[ai][bj][m][0], v1 = *(const f32x4*)(xrow + bj * HALF + 4) + gv[bj][1] * acc[ai][bj][m][1];
                    ss += (v0[0] * v0[0] + v0[1] * v0[1]) + (v0[2] * v0[2] + v0[3] * v0[3]) + (v1[0] * v1[0] + v1[1] * v1[1]) + (v1[2] * v1[2] + v1[3] * v1[3]);
                    u32x4 w; w.x = cvt_pk_bf16(v0[0], v0[1]); w.y = cvt_pk_bf16(v0[2], v0[3]); w.z = cvt_pk_bf16(v1[0], v1[1]); w.w = cvt_pk_bf16(v1[2], v1[3]);
                    *(u32x4*)(orow + bj * HALF) = w; }
                ss += __shfl_xor(ss, 16); ss += __shfl_xor(ss, 32);
                if (fq == 0) SS[(size_t)row * 16 + (u.pn & 3) * 4 + wc] = ss; }
    }
};

typedef int i32x4_t __attribute__((ext_vector_type(4))); typedef int i32x8_t __attribute__((ext_vector_type(8)));
__device__ __forceinline__ i32x8_t cat8(const bf16x8& a, const bf16x8& b) { return __builtin_shufflevector(__builtin_bit_cast(i32x4_t, a), __builtin_bit_cast(i32x4_t, b), 0, 1, 2, 3, 4, 5, 6, 7); }
__device__ __forceinline__ void mfma8(f32x4& acc, const i32x8_t a, const i32x8_t b) { asm volatile("v_mfma_f32_16x16x128_f8f6f4 %0, %1, %2, %0" : "+v"(acc) : "v"(a), "v"(b)); }
__device__ __forceinline__ void mfma8_settle(f32x4 (&acc)[2][2][4][2]) {
    asm volatile("s_nop 15\n\ts_nop 15" ::: "memory");
#pragma unroll
    for (int a = 0; a < 2; ++a)
#pragma unroll
        for (int b = 0; b < 2; ++b)
#pragma unroll
            for (int m = 0; m < 4; ++m)
#pragma unroll
                for (int n = 0; n < 2; ++n) asm volatile("" : "+v"(acc[a][b][m][n]));
}
template <class Epi, class Sched, bool ALIGN_EPI = false, bool SP2 = false, bool FP8 = false>
__device__ __forceinline__ void gemm_phase(PG8_LAS unsigned char* lds, const Gemm g, const Sched& S, const Epi& E) {
    int tid_ = threadIdx.x; asm volatile("" : "+v"(tid_));
    const int tid = tid_, wid = __builtin_amdgcn_readfirstlane(tid >> 6), lane = tid & 63, wr = wid >> 2, wc = wid & 3, fr = lane & 15, fq = lane >> 4;
    const int K = g.K, nt = K / BK;
    unsigned voffA[2], voffB[2];
#pragma unroll
    for (int i = 0; i < 2; ++i) { int R, C; stage_rc(tid * 16 + i * 8192, R, C); const int Rb = Epi::PERM ? ((R & ~31) + perm32(R & 31)) : R;
        voffA[i] = (unsigned)(R * K + C) * 2u; voffB[i] = (unsigned)(Rb * K + C) * 2u; }
    const size_t kstep = (size_t)(BK * 2);
    const size_t hstep = (size_t)HALF * K * 2;
    const size_t tstep = 2 * hstep;
    const unsigned ldsw = (unsigned)wid * 1024u;
    const int aoff = lds_byte(wr * 64 + fr, fq * 8), boff = lds_byte(wc * 32 + fr, fq * 8);
#define PG8_SA(b, h) (((b) * 2 + (h)) * HTB)
#define PG8_SB(b, h) ((4 + (b) * 2 + (h)) * HTB)
#define PG8_STAGE(bufoff, gbase, voff) do { _Pragma("unroll") for (int _i = 0; _i < 2; ++_i) \
        __builtin_amdgcn_global_load_lds((const unsigned*)((const char*)(gbase) + (voff)[_i]), (PG8_LAS unsigned*)(lds + (bufoff) + ldsw + _i * 8192), 16, 0, 0); } while (0)
#define PG8_LDA(dst, b, h) do { _Pragma("unroll") for (int m = 0; m < 4; ++m) _Pragma("unroll") for (int k = 0; k < 2; ++k) dst[m][k] = *(const PG8_LAS bf16x8*)(lds + PG8_SA(b, h) + aoff + m * 2048 + k * 1024); } while (0)
#define PG8_LDB(dst, b, h) do { _Pragma("unroll") for (int n = 0; n < 2; ++n) _Pragma("unroll") for (int k = 0; k < 2; ++k) dst[n][k] = *(const PG8_LAS bf16x8*)(lds + PG8_SB(b, h) + boff + n * 2048 + k * 1024); } while (0)
#define PG8_MMA(ai, bj, At, Bt) do { __builtin_amdgcn_s_setprio(1); _Pragma("unroll") for (int m = 0; m < 4; ++m) _Pragma("unroll") for (int n = 0; n < 2; ++n) { \
        if constexpr (FP8) mfma8(acc[ai][bj][m][n], cat8(Bt[n][0], Bt[n][1]), cat8(At[m][0], At[m][1])); \
        else { _Pragma("unroll") for (int k = 0; k < 2; ++k) acc[ai][bj][m][n] = __builtin_amdgcn_mfma_f32_16x16x32_bf16(Bt[n][k], At[m][k], acc[ai][bj][m][n], 0, 0, 0); } } __builtin_amdgcn_s_setprio(0); } while (0)
#define PG8_WAIT_V(n) asm volatile("s_waitcnt vmcnt(" #n ")" ::: "memory")
#define PG8_WAIT_L(n) asm volatile("s_waitcnt lgkmcnt(" #n ")" ::: "memory")
#define PG8_BAR __builtin_amdgcn_s_barrier()
#define PG8_SCHED __builtin_amdgcn_sched_barrier(0)
    Unit cur, nxt; int ui = 0;
    if (!S.next(0, cur)) return;
    f32x4 acc[2][2][4][2];
#pragma unroll
    for (int a = 0; a < 2; ++a)
#pragma unroll
        for (int b = 0; b < 2; ++b)
#pragma unroll
            for (int m = 0; m < 4; ++m)
#pragma unroll
                for (int n = 0; n < 2; ++n) acc[a][b][m][n] = (f32x4){0.f, 0.f, 0.f, 0.f};
    bf16x8 At[4][2], B0[2][2], B1[2][2];
    const char* cA = (const char*)g.A + (size_t)cur.pm * tstep; const char* cB = (const char*)g.Bt + (size_t)cur.pn * tstep;
    S.a_ready(cur);
    if constexpr (SP2) {
        PG8_STAGE(PG8_SB(0, 0), cB, voffB); PG8_STAGE(PG8_SB(0, 1), cB + hstep, voffB); PG8_STAGE(PG8_SA(0, 0), cA, voffA); PG8_STAGE(PG8_SA(0, 1), cA + hstep, voffA);
        if (wr == 1) PG8_BAR;
        PG8_WAIT_V(2); PG8_BAR;
        PG8_STAGE(PG8_SB(1, 0), cB + kstep, voffB); PG8_STAGE(PG8_SA(1, 0), cA + kstep, voffA); PG8_STAGE(PG8_SB(1, 1), cB + hstep + kstep, voffB);
        PG8_WAIT_V(6); PG8_BAR;
    } else {
        PG8_STAGE(PG8_SB(0, 0), cB, voffB); PG8_STAGE(PG8_SA(0, 0), cA, voffA); PG8_STAGE(PG8_SB(0, 1), cB + hstep, voffB); PG8_STAGE(PG8_SA(0, 1), cA + hstep, voffA);
        if (wr == 1) PG8_BAR;
        PG8_WAIT_V(4); PG8_BAR;
        PG8_STAGE(PG8_SB(1, 0), cB + kstep, voffB); PG8_STAGE(PG8_SA(1, 0), cA + kstep, voffA); PG8_STAGE(PG8_SB(1, 1), cB + hstep + kstep, voffB);
        PG8_WAIT_V(6); PG8_BAR;
    }
    for (;;) {
        const bool has_next = S.next(ui + 1, nxt);
        const char* nA = has_next ? (const char*)g.A + (size_t)nxt.pm * tstep : cA; const char* nB = has_next ? (const char*)g.Bt + (size_t)nxt.pn * tstep : cB;
#pragma nounroll
        for (int t = 0; t < nt; t += 2) {
            const bool last = (t == nt - 2);
            const char* a1 = cA + (size_t)(t + 1) * kstep;
            const char* a2 = last ? nA : cA + (size_t)(t + 2) * kstep; const char* b2 = last ? nB : cB + (size_t)(t + 2) * kstep;
            const char* a3 = a2 + kstep; const char* b3 = b2 + kstep;
            if (last && has_next) S.a_ready(nxt);
            if constexpr (SP2) {
            PG8_LDB(B0, 0, 0); PG8_LDB(B1, 0, 1); PG8_SCHED; PG8_LDA(At, 0, 0); PG8_STAGE(PG8_SA(1, 1), a1 + hstep, voffA);
            PG8_WAIT_V(8); PG8_WAIT_L(0); PG8_BAR; PG8_MMA(0, 0, At, B0); PG8_MMA(0, 1, At, B1); PG8_BAR; PG8_SCHED;
            PG8_LDA(At, 0, 1); PG8_STAGE(PG8_SB(0, 0), b2, voffB); PG8_STAGE(PG8_SB(0, 1), b2 + hstep, voffB); PG8_STAGE(PG8_SA(0, 0), a2, voffA);
            PG8_WAIT_V(8); PG8_WAIT_L(0); PG8_BAR; PG8_MMA(1, 0, At, B0); PG8_MMA(1, 1, At, B1); PG8_BAR; PG8_SCHED;
            PG8_LDB(B0, 1, 0); PG8_LDB(B1, 1, 1); PG8_SCHED; PG8_LDA(At, 1, 0); PG8_STAGE(PG8_SA(0, 1), a2 + hstep, voffA);
            PG8_WAIT_V(8); PG8_WAIT_L(0); PG8_BAR; PG8_MMA(0, 0, At, B0); PG8_MMA(0, 1, At, B1); PG8_BAR; PG8_SCHED;
            PG8_LDA(At, 1, 1); PG8_STAGE(PG8_SB(1, 0), b3, voffB); PG8_STAGE(PG8_SB(1, 1), b3 + hstep, voffB); PG8_STAGE(PG8_SA(1, 0), a3, voffA);
            PG8_WAIT_V(8); PG8_WAIT_L(0); PG8_BAR; PG8_MMA(1, 0, At, B0); PG8_MMA(1, 1, At, B1); PG8_BAR; PG8_SCHED;
            } else {
            PG8_LDB(B0, 0, 0); PG8_SCHED; PG8_LDA(At, 0, 0); PG8_STAGE(PG8_SA(1, 1), a1 + hstep, voffA);
            PG8_WAIT_L(8); PG8_BAR; PG8_WAIT_L(0); PG8_MMA(0, 0, At, B0); PG8_BAR; PG8_SCHED;
            PG8_LDB(B1, 0, 1); PG8_STAGE(PG8_SB(0, 0), b2, voffB);
            PG8_BAR; PG8_WAIT_L(0); PG8_MMA(0, 1, At, B1); PG8_BAR;
            PG8_LDA(At, 0, 1); PG8_STAGE(PG8_SA(0, 0), a2, voffA);
            PG8_BAR; PG8_WAIT_L(0); PG8_MMA(1, 0, At, B0); PG8_BAR; PG8_SCHED;
            PG8_STAGE(PG8_SB(0, 1), b2 + hstep, voffB);
            PG8_WAIT_V(6); PG8_BAR; PG8_MMA(1, 1, At, B1); PG8_BAR;
            PG8_LDB(B0, 1, 0); PG8_SCHED; PG8_LDA(At, 1, 0); PG8_STAGE(PG8_SA(0, 1), a2 + hstep, voffA);
            PG8_WAIT_L(8); PG8_BAR; PG8_WAIT_L(0); PG8_MMA(0, 0, At, B0); PG8_BAR; PG8_SCHED;
            PG8_LDB(B1, 1, 1); PG8_STAGE(PG8_SB(1, 0), b3, voffB);
            PG8_BAR; PG8_WAIT_L(0); PG8_MMA(0, 1, At, B1); PG8_BAR;
            PG8_LDA(At, 1, 1); PG8_STAGE(PG8_SA(1, 0), a3, voffA);
            PG8_BAR; PG8_WAIT_L(0); PG8_MMA(1, 0, At, B0); PG8_BAR; PG8_SCHED;
            PG8_STAGE(PG8_SB(1, 1), b3 + hstep, voffB);
            PG8_WAIT_V(6); PG8_BAR; PG8_MMA(1, 1, At, B1); PG8_BAR;
            }
        }
        if constexpr (ALIGN_EPI) { if (wr == 0) PG8_BAR; }
        if constexpr (FP8) mfma8_settle(acc);
        bool carried = false;
        if constexpr (epi_carry<Epi>::value) { if (E.carry(cur)) { E.mid(acc, cur, wr, wc, fr, fq); carried = true; } }
        if (!carried) { if constexpr (!Epi::AFTER_DRAIN) { E(acc, cur, wr, wc, fr, fq); S.done(cur); } }
        if (!has_next) break;
        if (!carried) {
#pragma unroll
        for (int a = 0; a < 2; ++a)
#pragma unroll
            for (int b = 0; b < 2; ++b)
#pragma unroll
                for (int m = 0; m < 4; ++m)
#pragma unroll
                    for (int n = 0; n < 2; ++n) acc[a][b][m][n] = (f32x4){0.f, 0.f, 0.f, 0.f}; }
        cur = nxt; cA = nA; cB = nB; ++ui;
        if constexpr (ALIGN_EPI) { if (wr == 1) PG8_BAR; }
    }
    PG8_WAIT_V(0);
    if constexpr (!ALIGN_EPI) { if (wr == 0) PG8_BAR; }
    PG8_BAR;
    if constexpr (Epi::AFTER_DRAIN) { E.fused(acc, cur, wr, wc, fr, fq, lds, wid, lane); S.done(cur); }
#undef PG8_SA
#undef PG8_SB
#undef PG8_STAGE
#undef PG8_LDA
#undef PG8_LDB
#undef PG8_MMA
#undef PG8_WAIT_V
#undef PG8_WAIT_L
#undef PG8_BAR
#undef PG8_SCHED
}
}
using pg8::f32x4; using pg8::bf16x8;
#define GAS __attribute__((address_space(1)))
#define LAS __attribute__((address_space(3)))
typedef unsigned v4u __attribute__((ext_vector_type(4)));
typedef GAS unsigned gu32;
typedef GAS unsigned long long gu64;
#define RLX_AGENT __ATOMIC_RELAXED, __HIP_MEMORY_SCOPE_AGENT
#define LDS_WAIT() asm volatile("s_waitcnt lgkmcnt(0)" ::: "memory")
#define VM_WAIT() asm volatile("s_waitcnt vmcnt(0)" ::: "memory")
__device__ __forceinline__ unsigned long long rt() { return __builtin_amdgcn_s_memrealtime(); }
__device__ __forceinline__ unsigned pk2(float lo, float hi) { return pg8::cvt_pk_bf16(lo, hi); }

#define XB_TMO      128
#define XB_XCNT(j)  (256  + 64 * (j))
#define XB_XSUB(j)  (1280 + 64 * (j))
#define XB_XGEN(j)  (2304 + 64 * (j))
#define XB_TOP      3328
#define XB_TOPGEN   3392
#define XCD_BAR_WORDS 3456
#define XB_SPIN_CAP (1u << 18)

__device__ __forceinline__ unsigned xb_ld(unsigned* p)              { return __hip_atomic_load(p, __ATOMIC_RELAXED, __HIP_MEMORY_SCOPE_AGENT); }
__device__ __forceinline__ unsigned xb_add(unsigned* p, unsigned v) { return __hip_atomic_fetch_add(p, v, __ATOMIC_RELAXED, __HIP_MEMORY_SCOPE_AGENT); }
__device__ __forceinline__ unsigned xb_xcc_id() { return (unsigned)__builtin_amdgcn_s_getreg((3 << 11) | 20) & 0xFu; }
#define XB_SPIN(cond, bar) do { unsigned _sp = 0; while (cond) { __builtin_amdgcn_s_sleep(1); \
    if ((++_sp & 255u) == 0u) { if (xb_ld(&(bar)[XB_TMO])) break; if (_sp > XB_SPIN_CAP) { atomicAdd(&(bar)[XB_TMO], 1u); break; } } } } while (0)

struct XcdBarrier {
    unsigned* bar; unsigned x;
    volatile LAS unsigned* st;
};

__device__ __forceinline__ XcdBarrier xcd_barrier_post(unsigned* bar, volatile LAS unsigned* st) {
    XcdBarrier b; b.bar = bar; b.x = xb_xcc_id(); b.st = st;
    if (threadIdx.x == 0) (void)xb_add(&bar[XB_XCNT(b.x)], 1u);
    return b;
}
__device__ __forceinline__ void xcd_barrier_complete(unsigned* bar, unsigned x, unsigned& nloc, unsigned& nx, unsigned& xmask) {
    const unsigned G = gridDim.x * gridDim.y * gridDim.z;
    unsigned sum, cnt, mine, msk, sp = 0u;
    for (;;) {
        sum = 0u; cnt = 0u; mine = 0u; msk = 0u;
#pragma unroll
        for (unsigned j = 0; j < 16; ++j) { const unsigned c = xb_ld(&bar[XB_XCNT(j)]); sum += c; cnt += (c > 0u) ? 1u : 0u; msk |= (c > 0u) ? (1u << j) : 0u; mine = (j == x) ? c : mine; }
        if (sum == G) break;
        __builtin_amdgcn_s_sleep(1);
        if ((++sp & 255u) == 0u) { if (xb_ld(&bar[XB_TMO])) break; if (sp > XB_SPIN_CAP) { atomicAdd(&bar[XB_TMO], 1u); break; } }
    }
    nloc = mine > 0u ? mine : 1u; nx = cnt > 0u ? cnt : 1u; xmask = msk | (1u << x);
}

__device__ __forceinline__ void xcd_barrier(const XcdBarrier& b) {
    asm volatile("s_waitcnt vmcnt(0)" ::: "memory");
    __syncthreads();
    if (threadIdx.x == 0) {
        unsigned* bar = b.bar;
        __builtin_amdgcn_s_waitcnt(0);
        unsigned nloc = b.st[0], nx = b.st[1];
        if (nloc == 0u) { unsigned xm_; xcd_barrier_complete(bar, b.x, nloc, nx, xm_); b.st[0] = nloc; b.st[1] = nx; b.st[2] = xm_; }
        const unsigned old = xb_add(&bar[XB_XSUB(b.x)], 1u);
        const unsigned gen = old / nloc;
        if (old + 1u == (gen + 1u) * nloc) {
            __builtin_amdgcn_fence(__ATOMIC_RELEASE, "agent");
            asm volatile("s_waitcnt vmcnt(0)" ::: "memory");
            const unsigned og = xb_add(&bar[XB_TOP], 1u);
            const unsigned tg = og / nx;
            if (og + 1u == (tg + 1u) * nx) { const unsigned xm = b.st[2];
#pragma unroll
                for (unsigned j = 0; j < 16; ++j) if ((xm >> j) & 1u) xb_add(&bar[XB_XGEN(j)], 1u); }
            else XB_SPIN(xb_ld(&bar[XB_XGEN(b.x)]) == gen, bar);
            __builtin_amdgcn_fence(__ATOMIC_ACQUIRE, "agent");
            asm volatile("s_waitcnt vmcnt(0)" ::: "memory");
        } else {
            XB_SPIN(xb_ld(&bar[XB_XGEN(b.x)]) == gen, bar);
            __builtin_amdgcn_fence(__ATOMIC_ACQUIRE, "agent");
            asm volatile("s_waitcnt vmcnt(0)" ::: "memory");
        }
    }
    __syncthreads();
}

constexpr int NWAVES = 8;
#ifndef DBL_PHASE
#define DBL_PHASE -1
#endif
constexpr size_t WS_MODP = 1 * MiB + 128 * 1024;
constexpr size_t WS_MERGED8 = 138 * MiB;
constexpr size_t WS_WIN8 = 16 * MiB, WS_XN8 = 40 * MiB;
constexpr size_t WS_WIN = 12 * MiB, WS_WSB = 20 * MiB, WS_WEFF = 21 * MiB, WS_WOUT = 22 * MiB, WS_WGU = 24 * MiB;
constexpr size_t WS_WSHGU = 237 * MiB, WS_WD = 238 * MiB, WS_WSHD = 254 * MiB, WS_WRH = 254 * MiB + 512 * 1024, WS_WRL = WS_WRH + 128 * 1024;
constexpr size_t CTL_ZERO_BYTES = 256 * 1024;
constexpr int CW_TMO = 0, CW_CODE = 1, CW_BAR = 4096, CW_CNT = 16384, CW_ADA = 32768;
constexpr int RING_OFF = 0, RING_BYTES = 131072, AUX_OFF = RING_BYTES, LDS_BYTES = 163840, LDSCTL_OFF = LDS_BYTES - 1024, MISC_OFF = LDSCTL_OFF + 320;

struct Frame {
    LAS unsigned char* lds; volatile LAS unsigned* MISC; gu32* ctl;
    int tid, lane, wave, vcu, G;
};
struct Args { const float* in[22]; float* out; unsigned char* ws; int ph_lo, ph_hi, use_bar, pad; };

constexpr float W8SCALE = 512.f, H8SCALE = 16.f, HM8SCALE = 32.f, SH8SCALE = 8.f;
struct TItem { const float* W; bf16_t* dst; int ldw, ldk, k0, n0, perm, f8; };
__device__ __forceinline__ void titem_load(const TItem& t, f32x4 (&v)[8], int lane) {
    const int kr = lane >> 3, n4 = (lane & 7) * 4;
#pragma unroll
    for (int i = 0; i < 8; ++i) v[i] = *(const GAS f32x4*)(t.W + (size_t)(t.k0 + kr + 8 * i) * t.ldw + t.n0 + n4);
}
__device__ __forceinline__ void titem_store(const TItem& t, const f32x4 (&v)[8], LAS float* scr, int lane) {
    { const int kr = lane >> 3, n4 = (lane & 7) * 4;
#pragma unroll
      for (int i = 0; i < 8; ++i) { LAS float* d = scr + (kr + 8 * i) * 33 + n4; d[0] = v[i].x; d[1] = v[i].y; d[2] = v[i].z; d[3] = v[i].w; } }
    LDS_WAIT(); asm volatile("" ::: "memory");
    const int c = lane & 7;
#pragma unroll
    for (int j = 0; j < 4; ++j) { const int n = (lane >> 3) + 8 * j, drow = t.perm ? 128 * (j & 1) + 8 * (j >> 1) + (lane >> 3) : n; const LAS float* sp = scr + (8 * c) * 33 + n;
        if (t.f8) {
            unsigned lo = 0u, hi = 0u;
#define W8Q(i) __builtin_amdgcn_fmed3f(sp[(i) * 33] * W8SCALE, -448.f, 448.f)
            lo = __builtin_amdgcn_cvt_pk_fp8_f32(W8Q(0), W8Q(1), lo, false); lo = __builtin_amdgcn_cvt_pk_fp8_f32(W8Q(2), W8Q(3), lo, true);
            hi = __builtin_amdgcn_cvt_pk_fp8_f32(W8Q(4), W8Q(5), hi, false); hi = __builtin_amdgcn_cvt_pk_fp8_f32(W8Q(6), W8Q(7), hi, true);
#undef W8Q
            *(GAS unsigned long long*)((GAS unsigned char*)t.dst + (size_t)drow * t.ldk + t.k0 + 8 * c) = (unsigned long long)lo | ((unsigned long long)hi << 32);
        } else {
        v4u o; o.x = pk2(sp[0 * 33], sp[1 * 33]); o.y = pk2(sp[2 * 33], sp[3 * 33]); o.z = pk2(sp[4 * 33], sp[5 * 33]); o.w = pk2(sp[6 * 33], sp[7 * 33]);
        *(GAS v4u*)(t.dst + (size_t)drow * t.ldk + t.k0 + 8 * c) = o; } }
    LDS_WAIT(); asm volatile("" ::: "memory");
}
__device__ __forceinline__ TItem titem_decode(int it, const Args& a, bool late) {
    unsigned char* ws = a.ws; TItem t; t.perm = 0; t.f8 = 0;
    constexpr int I_IN = 16 * 128, I_SB = 8 * 32, I_OUT = 16 * 32, I_EG = 64 * 64, I_EU = 64 * 64, I_ED = 64 * 64, I_SG = 16 * 8, I_SU = 16 * 8;
    int r = it;
    if (late) {
        if (r < I_ED) { const int e = r >> 6, q = r & 63, kb = q >> 5, nb = q & 31; t.W = a.in[18] + (size_t)e * ED * D; t.ldw = D; t.k0 = kb * 64; t.n0 = nb * 32;
            const int n0 = nb * 32, cl = n0 & 255; t.perm = 1; t.f8 = 1; t.dst = (bf16_t*)(ws + WS_WD + ((size_t)e * D + (n0 & ~255) + 32 * (cl >> 6) + 16 * ((cl >> 5) & 1)) * ED); t.ldk = ED; return t; } r -= I_ED;
        { const int kb = r >> 5, nb = r & 31; t.W = a.in[21]; t.ldw = D; t.k0 = kb * 64; t.n0 = nb * 32; t.f8 = 1; t.dst = (bf16_t*)(ws + WS_WSHD + (size_t)(nb * 32) * SHD); t.ldk = SHD; return t; } }
    if (r < I_IN) { const int kb = r >> 7, nb = r & 127, n0 = nb * 32; int d0 = n0;
        if (n0 < 1024) d0 = (n0 & ~255) + 128 * ((n0 >> 5) & 1) + 32 * ((n0 >> 6) & 3);
        t.W = a.in[5]; t.ldw = INW; t.k0 = kb * 64; t.n0 = n0; t.dst = (bf16_t*)(ws + WS_WIN) + (size_t)d0 * D; t.ldk = D;
        if (n0 >= 2048) { t.f8 = 1; t.dst = (bf16_t*)(ws + WS_WIN8 + (size_t)(n0 - 2048) * D); }
        return t; } r -= I_IN;
    if (r < I_SB) { const int kb = r >> 5, nb = r & 31; t.W = a.in[8]; t.ldw = D; t.k0 = kb * 64; t.n0 = nb * 32; t.dst = (bf16_t*)(ws + WS_WSB) + (size_t)(nb * 32) * SBW; t.ldk = SBW; return t; } r -= I_SB;
    if (r < I_OUT) { const int kb = r >> 5, nb = r & 31; t.W = a.in[12]; t.ldw = D; t.k0 = kb * 64; t.n0 = nb * 32; t.f8 = 1; t.dst = (bf16_t*)(ws + WS_WOUT + (size_t)(nb * 32) * D); t.ldk = D; return t; } r -= I_OUT;
    if (r < I_EG) { const int e = r >> 6, q = r & 63, kb = q >> 2, nb = q & 3; t.W = a.in[16] + (size_t)e * D * ED; t.ldw = ED; t.k0 = kb * 64; t.n0 = nb * 32; t.f8 = 1; t.dst = (bf16_t*)(ws + WS_WGU + ((size_t)e * 256 + nb * 32) * D); t.ldk = D; return t; } r -= I_EG;
    if (r < I_EU) { const int e = r >> 6, q = r & 63, kb = q >> 2, nb = q & 3; t.W = a.in[17] + (size_t)e * D * ED; t.ldw = ED; t.k0 = kb * 64; t.n0 = nb * 32; t.f8 = 1; t.dst = (bf16_t*)(ws + WS_WGU + ((size_t)e * 256 + 128 + nb * 32) * D); t.ldk = D; return t; } r -= I_EU;
    if (r < I_SG) { const int kb = r >> 3, nb = r & 7, n0 = nb * 32; t.W = a.in[19]; t.ldw = SHD; t.k0 = kb * 64; t.n0 = n0; t.f8 = 1; t.dst = (bf16_t*)(ws + WS_WSHGU + (size_t)((n0 >> 7) * 256 + (n0 & 127)) * D); t.ldk = D; return t; } r -= I_SG;
    { const int kb = r >> 3, nb = r & 7, n0 = nb * 32; t.W = a.in[20]; t.ldw = SHD; t.k0 = kb * 64; t.n0 = n0; t.f8 = 1; t.dst = (bf16_t*)(ws + WS_WSHGU + (size_t)((n0 >> 7) * 256 + 128 + (n0 & 127)) * D); t.ldk = D; return t; }
}

__device__ __forceinline__ void titem_run(Frame& F, const Args& a, bool late, int nitems, int first, int stride) {
    LAS float* scr = (LAS float*)(F.lds + RING_OFF + F.wave * 16384); const int lane = F.lane;
    f32x4 va[8], vb[8]; TItem cur, nxt; int it = first;
    if (it < nitems) { cur = titem_decode(it, a, late); titem_load(cur, va, lane); }
    for (; it < nitems; it += 2 * stride) {
        const bool h1 = it + stride < nitems, h2 = it + 2 * stride < nitems;
        if (h1) { nxt = titem_decode(it + stride, a, late); titem_load(nxt, vb, lane); }
        titem_store(cur, va, scr, lane);
        if (h2) { cur = titem_decode(it + 2 * stride, a, late); titem_load(cur, va, lane); }
        if (h1) titem_store(nxt, vb, scr, lane);
    }
}

constexpr int BW_FIRST = 16 * 128 + 8 * 32;
__device__ __forceinline__ void xcd_barrier_work(const XcdBarrier& b, Frame& F, const Args& a, int seam) {
    asm volatile("s_waitcnt vmcnt(0)" ::: "memory");
    __syncthreads();
    if (F.wave == 0) {
      if (threadIdx.x == 0) {
        unsigned* bar = b.bar;
        __builtin_amdgcn_s_waitcnt(0);
        unsigned nloc = b.st[0], nx = b.st[1];
        if (nloc == 0u) { unsigned xm_; xcd_barrier_complete(bar, b.x, nloc, nx, xm_); b.st[0] = nloc; b.st[1] = nx; b.st[2] = xm_; }
        const unsigned old = xb_add(&bar[XB_XSUB(b.x)], 1u);
        const unsigned gen = old / nloc;
        if (old + 1u == (gen + 1u) * nloc) {
            __builtin_amdgcn_fence(__ATOMIC_RELEASE, "agent");
            asm volatile("s_waitcnt vmcnt(0)" ::: "memory");
            const unsigned og = xb_add(&bar[XB_TOP], 1u);
            const unsigned tg = og / nx;
            if (og + 1u == (tg + 1u) * nx) { const unsigned xm = b.st[2];
#pragma unroll
                for (unsigned j = 0; j < 16; ++j) if ((xm >> j) & 1u) xb_add(&bar[XB_XGEN(j)], 1u); }
            else XB_SPIN(xb_ld(&bar[XB_XGEN(b.x)]) == gen, bar);
            __builtin_amdgcn_fence(__ATOMIC_ACQUIRE, "agent");
            asm volatile("s_waitcnt vmcnt(0)" ::: "memory");
        } else {
            XB_SPIN(xb_ld(&bar[XB_XGEN(b.x)]) == gen, bar);
            __builtin_amdgcn_fence(__ATOMIC_ACQUIRE, "agent");
            asm volatile("s_waitcnt vmcnt(0)" ::: "memory");
        }
      }
    } else {
        const int ri = (F.vcu * 7 + (F.wave - 1)) * 64 + F.lane; const bool rdo = (seam == 1) && ri < D * NE; float rv = 0.f;
        if (rdo) rv = a.in[14][(ri & 1023) * NE + (ri >> 10)];
        const int it = BW_FIRST + seam * 7 * F.G + F.vcu * 7 + (F.wave - 1);
        if (it < 16 * 128 + 8 * 32 + 16 * 32 + 2 * 64 * 64 + 2 * 16 * 8) { const TItem t = titem_decode(it, a, false); f32x4 v[8]; titem_load(t, v, F.lane); titem_store(t, v, (LAS float*)(F.lds + RING_OFF + F.wave * 16384), F.lane); }
        if (rdo) { const int e = ri >> 10, k = ri & 1023; bf16_t* WH = (bf16_t*)(a.ws + WS_WRH); bf16_t* WL = (bf16_t*)(a.ws + WS_WRL);
            const int pos = ((((k >> 4) * 2 + (e >> 5)) * 64) + 32 * ((k >> 3) & 1) + (e & 31)) * 8 + (k & 7);
            const unsigned h = f2bf(rv); WH[pos] = (bf16_t)h; WL[pos] = (bf16_t)f2bf(rv - bf2f(h)); }
    }
    __syncthreads();
}
constexpr int P0_ITEMS = 16 * 128 + 8 * 32 + 16 * 32 + 2 * 64 * 64 + 2 * 16 * 8, P0_ITEMS_EARLY = BW_FIRST;
__device__ __forceinline__ void p0a(Frame& F, const Args& a) {
    unsigned char* ws = a.ws;
    const int gw = F.vcu * NWAVES + F.wave, NGW = F.G * NWAVES, lane = F.lane;
    TItem t0; f32x4 v0[8]; const bool h0 = gw < P0_ITEMS_EARLY;
    if (h0) { t0 = titem_decode(gw, a, false); titem_load(t0, v0, lane); }
    LAS float* silu = (LAS float*)(F.lds + RING_OFF + 98304);
    { const float* c = a.in[1]; for (int i = F.tid; i < 4 * D; i += NWAVES * 64) silu[i] = siluf_(c[i]); }
    const bool weff = (F.G == 256); const int g = F.vcu >> 6, nb = (F.vcu & 63) * 16;
    LAS float* wgt = (LAS float*)(F.lds + RING_OFF);
    LAS float* slab = (LAS float*)(F.lds + RING_OFF + 68 * 1024);
    float wgv[32]; f32x4 w4 = {0.f, 0.f, 0.f, 0.f}; float psv = 0.f;
    if (weff) {
#pragma unroll
        for (int q = 0; q < 32; ++q) wgv[q] = a.in[9][(size_t)g * 16384 + F.tid + 512 * q];
        const int d = F.tid >> 2, q4 = (F.tid & 3) * 4; w4 = *(const GAS f32x4*)(a.in[11] + (size_t)(g * 128 + d) * D + nb + q4); psv = a.in[10][g * 128 + d]; }
    const float* w_ada = a.in[2]; float wv[3][16];
#pragma unroll
    for (int q = 0; q < 3; ++q) { const int it = F.vcu + q * F.G, cg = it % 96, ks = it / 96, k0 = ks * 128 + F.wave * 16; const float* w = w_ada + (size_t)k0 * (6 * D) + cg * 64 + lane;
#pragma unroll
        for (int k = 0; k < 16; ++k) wv[q][k] = (it < 96 * 8) ? w[(size_t)k * (6 * D)] : 0.f; }
    if (weff) {
#pragma unroll
        for (int q = 0; q < 32; ++q) { const int i = F.tid + 512 * q, cc = i >> 7, d = i & 127; wgt[d * 129 + cc] = wgv[q]; }
        const int d = F.tid >> 2, q4 = (F.tid & 3) * 4; *(LAS f32x4*)(slab + d * 16 + q4) = w4 * psv; }
    asm volatile("s_waitcnt lgkmcnt(0)" ::: "memory");
    __builtin_amdgcn_s_barrier();
    if (weff) { bf16_t* WE = (bf16_t*)(ws + WS_WEFF);
        const int cc = F.tid & 127, nq = (F.tid >> 7) * 4; f32x4 acc4 = {0.f, 0.f, 0.f, 0.f};
#pragma unroll 8
        for (int d = 0; d < 128; ++d) acc4 += wgt[d * 129 + cc] * *(const LAS f32x4*)(slab + d * 16 + nq);
#pragma unroll
        for (int j = 0; j < 4; ++j) WE[(size_t)(nb + nq + j) * PW + g * 128 + cc] = (bf16_t)f2bf(acc4[j]); }
    asm volatile("s_waitcnt lgkmcnt(0)" ::: "memory");
    __builtin_amdgcn_s_barrier();
    { float* MODP = (float*)(ws + WS_MODP); LAS float* red = (LAS float*)(F.lds + RING_OFF);
#pragma unroll
      for (int q = 0; q < 3; ++q) { const int it = F.vcu + q * F.G, ks = it / 96, k0 = ks * 128 + F.wave * 16;
          float a0 = 0.f, a1 = 0.f, a2 = 0.f, a3 = 0.f;
          if (it < 96 * 8) {
#pragma unroll
              for (int k = 0; k < 16; ++k) { const int kk = k0 + k; a0 += silu[kk] * wv[q][k]; a1 += silu[D + kk] * wv[q][k]; a2 += silu[2 * D + kk] * wv[q][k]; a3 += silu[3 * D + kk] * wv[q][k]; } }
          LAS float* rw = red + q * 2048 + F.wave * 256 + lane; rw[0] = a0; rw[64] = a1; rw[128] = a2; rw[192] = a3; }
      __syncthreads();
      for (int o = F.tid; o < 3 * 256; o += NWAVES * 64) { const int q = o >> 8, t = o & 255, it = F.vcu + q * F.G, cg = it % 96, ks = it / 96;
          if (it < 96 * 8) { float vsum = 0.f;
#pragma unroll
              for (int w8 = 0; w8 < 8; ++w8) vsum += red[q * 2048 + w8 * 256 + t];
              MODP[(size_t)(ks * 4 + (t >> 6)) * 6 * D + cg * 64 + (t & 63)] = vsum; } }
      __syncthreads();
      if (F.tid == 0) { __builtin_amdgcn_fence(__ATOMIC_RELEASE, "agent"); asm volatile("s_waitcnt vmcnt(0)" ::: "memory"); (void)xb_add((unsigned*)(F.ctl + CW_ADA), 1u); } }
    __syncthreads();
    if (h0) titem_store(t0, v0, (LAS float*)(F.lds + RING_OFF + F.wave * 16384), lane);
    titem_run(F, a, false, P0_ITEMS_EARLY, gw + NGW, NGW);
}
__device__ __forceinline__ void p0b(Frame& F, const Args& a) {
    unsigned char* ws = a.ws; const float* MODP = (const float*)(ws + WS_MODP); const float* b_ada = a.in[3];
    if (F.tid == 0) { unsigned* bar_ = (unsigned*)(F.ctl + CW_BAR); XB_SPIN(xb_ld((unsigned*)(F.ctl + CW_ADA)) < (unsigned)F.G, bar_);
        __builtin_amdgcn_fence(__ATOMIC_ACQUIRE, "agent"); asm volatile("s_waitcnt vmcnt(0)" ::: "memory"); }
    __syncthreads();
    if (F.tid < 96) { const int idx = 96 * F.vcu + F.tid, b = idx / (6 * D), j = idx % (6 * D); float v = b_ada[j];
#pragma unroll
        for (int ks = 0; ks < 8; ++ks) v += MODP[(size_t)(ks * 4 + b) * 6 * D + j];
        ((float*)(ws + WS_MOD))[idx] = v; }
    const int rows_per = M / F.G, r0 = F.vcu * rows_per, b = r0 / SEQ;
    LAS float* gsv = (LAS float*)(F.lds + RING_OFF); LAS float* shv = gsv + D;
    for (int k = F.tid; k < D; k += NWAVES * 64) { float sh = b_ada[k], sc = b_ada[D + k];
#pragma unroll
        for (int ks = 0; ks < 8; ++ks) { sh += MODP[(size_t)(ks * 4 + b) * 6 * D + k]; sc += MODP[(size_t)(ks * 4 + b) * 6 * D + D + k]; }
        gsv[k] = a.in[4][k] * (1.f + sc); shv[k] = sh; }
    __syncthreads();
    const float* x = a.in[0]; bf16_t* XN = (bf16_t*)(ws + WS_XN); unsigned char* XN8 = ws + WS_XN8;
    for (int i = F.wave; i < rows_per; i += NWAVES) { const int row = r0 + i;
        const GAS f32x4* xr = (const GAS f32x4*)(x + (size_t)row * D) + F.lane;
        f32x4 v[4]; float s = 0.f;
#pragma unroll
        for (int j = 0; j < 4; ++j) { v[j] = xr[64 * j]; s += (v[j].x * v[j].x + v[j].y * v[j].y) + (v[j].z * v[j].z + v[j].w * v[j].w); }
        const float r = rsqrtf(wave_sum(s) * (1.f / D) + EPS);
        GAS unsigned long long* o8 = (GAS unsigned long long*)(XN + (size_t)row * D) + F.lane; GAS unsigned* o4 = (GAS unsigned*)(XN8 + (size_t)row * D) + F.lane;
#pragma unroll
        for (int j = 0; j < 4; ++j) { const f32x4 gg = *(const LAS f32x4*)(gsv + 4 * F.lane + 256 * j), ss = *(const LAS f32x4*)(shv + 4 * F.lane + 256 * j);
            const f32x4 h = v[j] * r * gg + ss;
            o8[64 * j] = (unsigned long long)pk2(h.x, h.y) | ((unsigned long long)pk2(h.z, h.w) << 32);
            { const f32x4 h8 = h * H8SCALE; unsigned q8 = 0u;
              q8 = __builtin_amdgcn_cvt_pk_fp8_f32(__builtin_amdgcn_fmed3f(h8.x, -448.f, 448.f), __builtin_amdgcn_fmed3f(h8.y, -448.f, 448.f), q8, false);
              q8 = __builtin_amdgcn_cvt_pk_fp8_f32(__builtin_amdgcn_fmed3f(h8.z, -448.f, 448.f), __builtin_amdgcn_fmed3f(h8.w, -448.f, 448.f), q8, true);
              o4[64 * j] = q8; } } }
    __syncthreads();
}

namespace sb {
using pg8::bf16x8; using pg8::f32x4; typedef float f32x16 __attribute__((ext_vector_type(16))); typedef short v4i16_t __attribute__((ext_vector_type(4)));
typedef short s16x4 __attribute__((ext_vector_type(4))); typedef float f32x2 __attribute__((ext_vector_type(2)));
constexpr int VPITCH = 128, VBYTES = 64 * VPITCH, WAVE_LDS = 2 * VBYTES;
constexpr float EXIT_THR = 1.17549435e-38f;
__device__ __forceinline__ int crow(int r, int hi) { return (r & 3) + 8 * (r >> 2) + 4 * hi; }
__device__ __forceinline__ s16x4 vtr(LAS const unsigned char* p) { return __builtin_bit_cast(s16x4, __builtin_amdgcn_ds_read_tr16_b64_v4i16((LAS v4i16_t*)p)); }
__device__ __forceinline__ unsigned pkbf(float lo, float hi) { return pg8::cvt_pk_bf16(lo, hi); }

struct AttnPre { bf16x8 qr[4]; bf16x8 kf[8]; };
__device__ __forceinline__ void attn_preload(AttnPre& P, int b, int h, int qb, const bf16_t* Q, const bf16_t* K, int wid, int lane) {
    const int r32 = lane & 31, hi = lane >> 5, t0 = qb * 256 + wid * 32, kb = (t0 >> 6) * 64; const size_t rowbase = (size_t)b * SEQ; const bf16_t* Kh = K + rowbase * 512 + h * 64;
#pragma unroll
    for (int d0 = 0; d0 < 4; ++d0) { P.qr[d0] = *(const bf16x8*)(Q + (rowbase + t0 + r32) * 512 + h * 64 + d0 * 16 + hi * 8);
        P.kf[2 * d0] = *(const bf16x8*)(Kh + (size_t)(kb + r32) * 512 + d0 * 16 + hi * 8); P.kf[2 * d0 + 1] = *(const bf16x8*)(Kh + (size_t)(kb + 32 + r32) * 512 + d0 * 16 + hi * 8); }
}
__device__ __forceinline__ void attn_unit(int b, int h, int qb, const AttnPre& P, const bf16_t* K, const bf16_t* V, bf16_t* O, LAS unsigned char* vlds, int wid, int lane) {
    const int r32 = lane & 31, hi = lane >> 5;
    const int t0 = qb * 256 + wid * 32;
    const size_t rowbase = (size_t)b * SEQ;
    const bf16_t* Kh = K + rowbase * 512 + h * 64; const bf16_t* Vh = V + rowbase * 512 + h * 64;
    bf16x8 qr[4];
#pragma unroll
    for (int d0 = 0; d0 < 4; ++d0) qr[d0] = P.qr[d0];
    f32x16 o0 = {}, o1 = {};
    float carryD = 1.f;
    int kt = t0 >> 6;
    bf16x8 kf[8];
    const unsigned klo = (unsigned)r32 * 1024u + (unsigned)hi * 16u, vlo = (unsigned)(lane >> 3) * 1024u + (unsigned)(lane & 7) * 16u;
#define SB_LOADK(KT) do { const unsigned char* kb_ = (const unsigned char*)Kh + (size_t)(KT) * 65536; \
        _Pragma("unroll") for (int d0 = 0; d0 < 4; ++d0) { kf[2 * d0] = *(const bf16x8*)(kb_ + d0 * 32 + klo); kf[2 * d0 + 1] = *(const bf16x8*)(kb_ + 32768 + d0 * 32 + klo); } } while (0)
#define SB_DMAV(KT, BUF) do { const unsigned char* vb_ = (const unsigned char*)Vh + (size_t)(KT) * 65536; \
        _Pragma("unroll") for (int i = 0; i < 8; ++i) __builtin_amdgcn_global_load_lds((const unsigned*)(vb_ + i * 8192 + vlo), (LAS unsigned*)(vlds + (BUF) * VBYTES + i * 1024), 16, 0, 0); } while (0)
    int cur = 0;
    SB_DMAV(kt, 0);
#pragma unroll
    for (int i = 0; i < 8; ++i) kf[i] = P.kf[i];
    const int trbase = (4 * hi + ((lane & 15) >> 2)) * VPITCH + (16 * ((lane >> 4) & 1) + 4 * (lane & 3)) * 2;
    bool diag = true;
    for (;; --kt) {
        const int kbase = kt * 64;
        f32x16 p0 = {}, p1 = {};
        __builtin_amdgcn_s_setprio(1);
#pragma unroll
        for (int d0 = 0; d0 < 4; ++d0) { p0 = __builtin_amdgcn_mfma_f32_32x32x16_bf16(kf[2 * d0], qr[d0], p0, 0, 0, 0); p1 = __builtin_amdgcn_mfma_f32_32x32x16_bf16(kf[2 * d0 + 1], qr[d0], p1, 0, 0, 0); }
        __builtin_amdgcn_s_setprio(0);
        asm volatile("" ::: "memory");
        if (kt > 0) { SB_DMAV(kt - 1, cur ^ 1); SB_LOADK(kt - 1); }
        asm volatile("" ::: "memory");
        bf16x8 pa[4]; float cs_ = carryD;
        const int qrel = t0 + r32 - kbase;
#define SB_HALF(P, KOFF, PA0, PA1) do { f32x2 E_[8], T_[8]; \
          \
          \
          \
        _Pragma("unroll") for (int r = 0; r < 8; ++r) { E_[r].x = fminf(__builtin_amdgcn_exp2f(P[2 * r]), 0x1p30f); E_[r].y = fminf(__builtin_amdgcn_exp2f(P[2 * r + 1]), 0x1p30f); } \
        if (diag) { _Pragma("unroll") for (int r = 0; r < 16; ++r) if (crow(r, hi) + (KOFF) >= qrel) E_[r >> 1][r & 1] = 0.f; } \
        _Pragma("unroll") for (int r = 0; r < 8; ++r) T_[r] = E_[r] + 1.f; \
        float g_[4], pt_[4]; \
        _Pragma("unroll") for (int c = 0; c < 4; ++c) { const f32x2 u_ = T_[2 * c] * T_[2 * c + 1]; g_[c] = u_.x * u_.y; } \
          \
          \
        _Pragma("unroll") for (int c = 0; c < 4; ++c) { const HalfSwap h_ = half_swap(g_[c]); pt_[c] = h_.keep_lo * h_.keep_hi; } \
        _Pragma("unroll") for (int c = 3; c >= 0; --c) { const float i0_ = __builtin_amdgcn_rcpf(cs_ * (hi == 0 ? pt_[c] : g_[c])); cs_ *= pt_[c]; \
            f32x2 A_, B_; A_.x = i0_; A_.y = i0_ * T_[2 * c].x; B_.x = A_.y * T_[2 * c].y; B_.y = B_.x * T_[2 * c + 1].x; \
            const f32x2 p01_ = E_[2 * c] * A_, p23_ = E_[2 * c + 1] * B_; P[4 * c] = p01_.x; P[4 * c + 1] = p01_.y; P[4 * c + 2] = p23_.x; P[4 * c + 3] = p23_.y; } \
        pg8::u32x4 w_; w_.x = pkbf(P[0], P[1]); w_.y = pkbf(P[2], P[3]); w_.z = pkbf(P[4], P[5]); w_.w = pkbf(P[6], P[7]); PA0 = __builtin_bit_cast(bf16x8, w_); \
        w_.x = pkbf(P[8], P[9]); w_.y = pkbf(P[10], P[11]); w_.z = pkbf(P[12], P[13]); w_.w = pkbf(P[14], P[15]); PA1 = __builtin_bit_cast(bf16x8, w_); } while (0)
        SB_HALF(p1, 32, pa[2], pa[3]);
        SB_HALF(p0, 0, pa[0], pa[1]);
#undef SB_HALF
        carryD = cs_;
        diag = false;
        if (kt > 0) asm volatile("s_waitcnt vmcnt(16)" ::: "memory"); else asm volatile("s_waitcnt vmcnt(0)" ::: "memory");
        LAS const unsigned char* vb = vlds + cur * VBYTES + trbase;
        __builtin_amdgcn_s_setprio(1);
#pragma unroll
        for (int s = 0; s < 4; ++s) {
            LAS const unsigned char* vp = vb + (16 * s) * VPITCH;
            const s16x4 a0 = vtr(vp), a1 = vtr(vp + 8 * VPITCH), b0 = vtr(vp + 64), b1 = vtr(vp + 8 * VPITCH + 64);
            const bf16x8 v0 = {a0[0], a0[1], a0[2], a0[3], a1[0], a1[1], a1[2], a1[3]}, v1 = {b0[0], b0[1], b0[2], b0[3], b1[0], b1[1], b1[2], b1[3]};
            o0 = __builtin_amdgcn_mfma_f32_32x32x16_bf16(v0, pa[s], o0, 0, 0, 0);
            o1 = __builtin_amdgcn_mfma_f32_32x32x16_bf16(v1, pa[s], o1, 0, 0, 0);
        }
        __builtin_amdgcn_s_setprio(0);
        asm volatile("s_waitcnt lgkmcnt(0)" ::: "memory");
        cur ^= 1;
        if (kt == 0 || __all(carryD > 1.f / EXIT_THR)) break;
    }
    asm volatile("s_waitcnt vmcnt(0)" ::: "memory");
#undef SB_LOADK
#undef SB_DMAV
    bf16_t* Orow = O + (rowbase + t0 + r32) * 512 + h * 64 + (hi ? 8 : 0);
#define SB_OST(OV, DOFF) do { _Pragma("unroll") for (int pr = 0; pr < 2; ++pr) { const int g0_ = 2 * pr, g1_ = 2 * pr + 1; \
        unsigned ax_ = pkbf(OV[4 * g0_], OV[4 * g0_ + 1]), ay_ = pkbf(OV[4 * g0_ + 2], OV[4 * g0_ + 3]), bx_ = pkbf(OV[4 * g1_], OV[4 * g1_ + 1]), by_ = pkbf(OV[4 * g1_ + 2], OV[4 * g1_ + 3]); \
        { const auto sw_ = __builtin_amdgcn_permlane32_swap(ax_, bx_, false, false); const unsigned r0_ = sw_[0], r1_ = sw_[1]; ax_ = r0_; bx_ = r1_; } \
        { const auto sw_ = __builtin_amdgcn_permlane32_swap(ay_, by_, false, false); const unsigned r0_ = sw_[0], r1_ = sw_[1]; ay_ = r0_; by_ = r1_; } \
        pg8::u32x4 w_; w_.x = ax_; w_.y = ay_; w_.z = bx_; w_.w = by_; *(pg8::u32x4*)(Orow + (DOFF) + 16 * pr) = w_; } } while (0)
    SB_OST(o0, 0);
    SB_OST(o1, 32);
#undef SB_OST
}
}

__device__ __forceinline__ void p2_pool(Frame& F, const bf16_t* U, bf16_t* MIX) {
    const int col8 = F.lane, w = 2 << (col8 >> 4), T0 = F.vcu * 64;
    if (T0 >= M) return;
    LAS unsigned char* st = F.lds + RING_OFF;
    for (int r = F.wave; r < 79; r += NWAVES)
        __builtin_amdgcn_global_load_lds((const unsigned*)(U + ((long)(T0 - 15 + r)) * PW + col8 * 8), (LAS unsigned*)(st + r * 1024), 16, 0, 0);
    asm volatile("s_waitcnt vmcnt(0)" ::: "memory");
    __builtin_amdgcn_s_barrier();
    { const int rb = F.wave * 8, t0 = T0 + rb;
        v4u ld[23];
#pragma unroll
        for (int i = 0; i < 23; ++i) ld[i] = *(const LAS v4u*)(st + (rb + i) * 1024 + col8 * 16);
#pragma unroll
        for (int r = 0; r < 8; ++r) { const int tl = (t0 + r) % SEQ; int cnt = (tl + 1) < w ? (tl + 1) : w;
            asm volatile("" : "+v"(cnt));
            float acc[8];
#pragma unroll
            for (int j = 0; j < 8; ++j) acc[j] = 0.f;
#pragma unroll
            for (int i = 0; i < 16; ++i) { const v4u u = ld[15 + r - i]; const float m = (i < cnt) ? 1.f : 0.f;
                acc[0] += m * bf2f(u.x & 0xffffu); acc[1] += m * bf2f(u.x >> 16); acc[2] += m * bf2f(u.y & 0xffffu); acc[3] += m * bf2f(u.y >> 16);
                acc[4] += m * bf2f(u.z & 0xffffu); acc[5] += m * bf2f(u.z >> 16); acc[6] += m * bf2f(u.w & 0xffffu); acc[7] += m * bf2f(u.w >> 16); }
            const float inv = __builtin_amdgcn_rcpf((float)cnt); const v4u self = ld[15 + r];
            v4u o; o.x = pk2(acc[0] * inv - bf2f(self.x & 0xffffu), acc[1] * inv - bf2f(self.x >> 16)); o.y = pk2(acc[2] * inv - bf2f(self.y & 0xffffu), acc[3] * inv - bf2f(self.y >> 16));
            o.z = pk2(acc[4] * inv - bf2f(self.z & 0xffffu), acc[5] * inv - bf2f(self.z >> 16)); o.w = pk2(acc[6] * inv - bf2f(self.w & 0xffffu), acc[7] * inv - bf2f(self.w >> 16));
            *(GAS v4u*)(MIX + (size_t)(t0 + r) * PW + col8 * 8) = o; } }
    asm volatile("s_waitcnt lgkmcnt(0)" ::: "memory");
    __builtin_amdgcn_s_barrier();
}

constexpr int P5_TAB = AUX_OFF + 2048;
constexpr int P5_CNT = AUX_OFF + 1024;
constexpr int LIST_CAP = 16384;
typedef float f32x16 __attribute__((ext_vector_type(16)));
__device__ __forceinline__ void p5_route(Frame& F, const Args& a) {
    unsigned char* ws = a.ws; const float* g2 = a.in[13]; const float* mod = (const float*)(ws + WS_MOD); const float* rbias = a.in[15];
    unsigned char* H2 = ws + WS_H2;
    const bf16_t* WH = (const bf16_t*)(ws + WS_WRH); const bf16_t* WL = (const bf16_t*)(ws + WS_WRL);
    unsigned long long* LIST = (unsigned long long*)(ws + WS_LIST); gu32* gcnt = F.ctl + CW_CNT;
    LAS unsigned char* Ahi = F.lds + RING_OFF; LAS unsigned char* Alo = Ahi + 65536; LAS float* part = (LAS float*)Ahi;
    LAS float* gsv = (LAS float*)(F.lds + P5_TAB); LAS float* shv = gsv + D; LAS unsigned* cnt_l = (LAS unsigned*)(F.lds + P5_CNT); LAS unsigned* base_l = cnt_l + 64; LAS float* rr = (LAS float*)(base_l + 64);
    const int lane = F.lane, wave = __builtin_amdgcn_readfirstlane(F.wave), r32 = lane & 31, hi = lane >> 5;
    const int row0 = F.vcu * 64;
    if (row0 < M) {
        const int b = row0 / SEQ;
        { const float* SS = (const float*)(ws + WS_PE);
          if (F.tid < 64) { const GAS f32x4* sp = (const GAS f32x4*)(SS + (size_t)(row0 + F.tid) * 16); const f32x4 s0 = sp[0], s1 = sp[1], s2 = sp[2], s3 = sp[3];
              const float sm = ((s0.x + s0.y) + (s0.z + s0.w)) + ((s1.x + s1.y) + (s1.z + s1.w)) + ((s2.x + s2.y) + (s2.z + s2.w)) + ((s3.x + s3.y) + (s3.z + s3.w));
              rr[F.tid] = rsqrtf(sm * (1.f / D) + EPS); cnt_l[F.tid] = 0u; }
          { float gq[2], sq[2], mq[2];
#pragma unroll
            for (int q = 0; q < 2; ++q) { const int k = F.tid + q * NWAVES * 64; gq[q] = g2[k]; mq[q] = mod[b * 6 * D + 4 * D + k]; sq[q] = mod[b * 6 * D + 3 * D + k]; }
#pragma unroll
            for (int q = 0; q < 2; ++q) { const int k = F.tid + q * NWAVES * 64; gsv[k] = gq[q] * (1.f + mq[q]); shv[k] = sq[q]; } } }
        __syncthreads();
        f32x16 acc[2][2];
        const char* whb = (const char*)WH + wave * 8192; const char* wlb = (const char*)WL + wave * 8192;
#pragma unroll
        for (int x = 0; x < 2; ++x)
#pragma unroll
            for (int y = 0; y < 2; ++y) acc[x][y] = f32x16{};
        unsigned long long xqv[8][2];
#pragma unroll
        for (int kh = 0; kh < 2; ++kh) {
            bf16x8 bh[4][2], bl[4][2];
#pragma unroll
            for (int s4 = 0; s4 < 4; ++s4)
#pragma unroll
                for (int t = 0; t < 2; ++t) { const int fo = kh * 65536 + (s4 * 2 + t) * 1024;
                    bh[s4][t] = *(const bf16x8*)(whb + fo + lane * 16); bl[s4][t] = *(const bf16x8*)(wlb + fo + lane * 16); }
            if (kh == 0) {
#pragma unroll
                for (int i = 0; i < 8; ++i) { const GAS unsigned long long* xr = (const GAS unsigned long long*)(x1b_row(ws, row0 + 8 * wave + i)) + lane; xqv[i][0] = xr[0]; xqv[i][1] = xr[64]; } }
            __builtin_amdgcn_sched_barrier(0);
#pragma unroll
            for (int i = 0; i < 8; ++i) { const int rl = 8 * wave + i, row = row0 + rl; const float r = rr[rl];
                GAS unsigned* o4 = (GAS unsigned*)(H2 + (size_t)row * D + 512 * kh) + lane;
#pragma unroll
                for (int j = 0; j < 2; ++j) { const unsigned long long xq = xqv[i][j]; const unsigned xl = (unsigned)xq, xh = (unsigned)(xq >> 32);
                    const f32x4 xv = {__builtin_bit_cast(float, xl << 16), __builtin_bit_cast(float, xl & 0xffff0000u), __builtin_bit_cast(float, xh << 16), __builtin_bit_cast(float, xh & 0xffff0000u)};
                    const f32x4 gg = *(const LAS f32x4*)(gsv + 512 * kh + 4 * lane + 256 * j), ss = *(const LAS f32x4*)(shv + 512 * kh + 4 * lane + 256 * j);
                    const f32x4 h = xv * r * gg + ss;
                    const unsigned p01 = pk2(h.x, h.y), p23 = pk2(h.z, h.w);
                    const unsigned long long hh = (unsigned long long)p01 | ((unsigned long long)p23 << 32);
                    { const f32x4 h8 = h * H8SCALE; unsigned q8 = 0u;
                      q8 = __builtin_amdgcn_cvt_pk_fp8_f32(__builtin_amdgcn_fmed3f(h8.x, -448.f, 448.f), __builtin_amdgcn_fmed3f(h8.y, -448.f, 448.f), q8, false);
                      q8 = __builtin_amdgcn_cvt_pk_fp8_f32(__builtin_amdgcn_fmed3f(h8.z, -448.f, 448.f), __builtin_amdgcn_fmed3f(h8.w, -448.f, 448.f), q8, true);
                      o4[64 * j] = q8; }
                    const unsigned long long ll = (unsigned long long)pk2(h.x - __builtin_bit_cast(float, p01 << 16), h.y - __builtin_bit_cast(float, p01 & 0xffff0000u))
                                                | ((unsigned long long)pk2(h.z - __builtin_bit_cast(float, p23 << 16), h.w - __builtin_bit_cast(float, p23 & 0xffff0000u)) << 32);
                    const int chunk = (lane >> 1) + 32 * j, off = rl * 1024 + ((chunk ^ (rl & 15)) << 4) + ((lane & 1) << 3);
                    *(LAS unsigned long long*)(Ahi + off) = hh; *(LAS unsigned long long*)(Alo + off) = ll; } }
            if (kh == 0) { __builtin_amdgcn_sched_barrier(0);
#pragma unroll
                for (int i = 0; i < 8; ++i) { const GAS unsigned long long* xr = (const GAS unsigned long long*)(x1b_row(ws, row0 + 8 * wave + i) + 512) + lane; xqv[i][0] = xr[0]; xqv[i][1] = xr[64]; } }
            asm volatile("s_waitcnt lgkmcnt(0)\n\ts_barrier" ::: "memory");
#pragma unroll
            for (int s4 = 0; s4 < 4; ++s4) { const int chunk = 8 * wave + 2 * s4 + hi;
                const bf16x8 bh0 = bh[s4][0], bh1 = bh[s4][1], bl0 = bl[s4][0], bl1 = bl[s4][1];
#pragma unroll
                for (int x = 0; x < 2; ++x) { const int rw = 32 * x + r32, off = rw * 1024 + ((chunk ^ (rw & 15)) << 4);
                    const bf16x8 ah = *(const LAS bf16x8*)(Ahi + off), al = *(const LAS bf16x8*)(Alo + off);
                    acc[x][0] = __builtin_amdgcn_mfma_f32_32x32x16_bf16(ah, bh0, acc[x][0], 0, 0, 0); acc[x][1] = __builtin_amdgcn_mfma_f32_32x32x16_bf16(ah, bh1, acc[x][1], 0, 0, 0);
                    acc[x][0] = __builtin_amdgcn_mfma_f32_32x32x16_bf16(al, bh0, acc[x][0], 0, 0, 0); acc[x][1] = __builtin_amdgcn_mfma_f32_32x32x16_bf16(al, bh1, acc[x][1], 0, 0, 0);
                    acc[x][0] = __builtin_amdgcn_mfma_f32_32x32x16_bf16(ah, bl0, acc[x][0], 0, 0, 0); acc[x][1] = __builtin_amdgcn_mfma_f32_32x32x16_bf16(ah, bl1, acc[x][1], 0, 0, 0); } }
            asm volatile("s_waitcnt lgkmcnt(0)\n\ts_barrier" ::: "memory");
        }
#pragma unroll
        for (int x = 0; x < 2; ++x)
#pragma unroll
            for (int r = 0; r < 16; ++r) { const int rw = 32 * x + (r & 3) + 8 * (r >> 2) + 4 * hi; part[wave * 4096 + rw * 64 + r32] = acc[x][0][r]; part[wave * 4096 + rw * 64 + 32 + r32] = acc[x][1][r]; }
        const f32x4 rb0 = *(const GAS f32x4*)(rbias + 8 * (F.tid & 7)), rb1 = *(const GAS f32x4*)(rbias + 8 * (F.tid & 7) + 4);
        asm volatile("s_waitcnt lgkmcnt(0)\n\ts_barrier" ::: "memory");
        LAS unsigned* park = (LAS unsigned*)(F.lds + P5_TAB);
        float wn;
        { const int row = F.tid >> 3, g = F.tid & 7;
#define P5_XOR1(v) __builtin_amdgcn_update_dpp(0, (v), 0xB1, 0xF, 0xF, false)
#define P5_XOR2(v) __builtin_amdgcn_update_dpp(0, (v), 0x4E, 0xF, 0xF, false)
#define P5_XOR3(v) __builtin_amdgcn_update_dpp(0, (v), 0x1B, 0xF, 0xF, false)
#define P5_MIR8(v) __builtin_amdgcn_update_dpp(0, (v), 0x141, 0xF, 0xF, false)
#define P5_F(x) __builtin_bit_cast(float, (x))
#define P5_I(x) __builtin_bit_cast(int, (x))
          f32x4 l0 = {0.f, 0.f, 0.f, 0.f}, l1 = {0.f, 0.f, 0.f, 0.f};
#pragma unroll
          for (int w8 = 0; w8 < 8; ++w8) { const LAS f32x4* pp = (const LAS f32x4*)(part + w8 * 4096 + row * 64 + 8 * g); l0 += pp[0]; l1 += pp[1]; }
          float sc[8], sel[8];
#pragma unroll
          for (int j = 0; j < 4; ++j) { sc[j] = 1.f / (1.f + expf(-l0[j])); sc[4 + j] = 1.f / (1.f + expf(-l1[j])); sel[j] = sc[j] + rb0[j]; sel[4 + j] = sc[4 + j] + rb1[j]; }
          float m1 = sel[0], m2 = -INFINITY;
#pragma unroll
          for (int j = 1; j < 8; ++j) { const float v = sel[j]; const float lo = fminf(m1, v); m1 = fmaxf(m1, v); m2 = fmaxf(m2, lo); }
          const float gs = m1 + m2;
          int rk = 0; { const int gi = P5_I(gs); const int m7 = P5_MIR8(gi);
            const float v1 = P5_F(P5_XOR1(gi)), v2 = P5_F(P5_XOR2(gi)), v3 = P5_F(P5_XOR3(gi)), v7 = P5_F(m7), v6 = P5_F(P5_XOR1(m7)), v5 = P5_F(P5_XOR2(m7)), v4 = P5_F(P5_XOR3(m7));
            rk += (v1 > gs || (v1 == gs && (g ^ 1) < g)) ? 1 : 0; rk += (v2 > gs || (v2 == gs && (g ^ 2) < g)) ? 1 : 0; rk += (v3 > gs || (v3 == gs && (g ^ 3) < g)) ? 1 : 0; rk += (v4 > gs || (v4 == gs && (g ^ 4) < g)) ? 1 : 0;
            rk += (v5 > gs || (v5 == gs && (g ^ 5) < g)) ? 1 : 0; rk += (v6 > gs || (v6 == gs && (g ^ 6) < g)) ? 1 : 0; rk += (v7 > gs || (v7 == gs && (g ^ 7) < g)) ? 1 : 0; }
          if (rk >= 4) {
#pragma unroll
              for (int j = 0; j < 8; ++j) sel[j] = -INFINITY; }
          float wpart = 0.f;
#pragma unroll
          for (int r = 0; r < TOPK; ++r) { float bv = sel[0], br = sc[0]; int bi = 0;
#pragma unroll
              for (int j = 1; j < 8; ++j) { const bool c = sel[j] > bv; bv = c ? sel[j] : bv; br = c ? sc[j] : br; bi = c ? j : bi; }
              float gv = bv; int gidx = 8 * g + bi;
              { const float ov = P5_F(P5_XOR1(P5_I(gv))); const int oi = P5_XOR1(gidx); const bool t = ov > gv || (ov == gv && oi < gidx); gv = t ? ov : gv; gidx = t ? oi : gidx; }
              { const float ov = P5_F(P5_XOR2(P5_I(gv))); const int oi = P5_XOR2(gidx); const bool t = ov > gv || (ov == gv && oi < gidx); gv = t ? ov : gv; gidx = t ? oi : gidx; }
              { const float ov = P5_F(P5_MIR8(P5_I(gv))); const int oi = P5_MIR8(gidx); const bool t = ov > gv || (ov == gv && oi < gidx); gv = t ? ov : gv; gidx = t ? oi : gidx; }
              const bool own = (gidx >> 3) == g;
              if (own) { const unsigned pos = __hip_atomic_fetch_add(cnt_l + gidx, 1u, __ATOMIC_RELAXED, __HIP_MEMORY_SCOPE_WORKGROUP);
                  LAS unsigned* pk = park + (row * 8 + r) * 4; pk[0] = (unsigned)gidx; pk[1] = pos; pk[2] = __builtin_bit_cast(unsigned, br); wpart += br; }
#pragma unroll
              for (int j = 0; j < 8; ++j) sel[j] = (own && j == (gidx & 7)) ? -INFINITY : sel[j]; }
          { float t = wpart; t += P5_F(P5_XOR1(P5_I(t))); t += P5_F(P5_XOR2(P5_I(t))); t += P5_F(P5_MIR8(P5_I(t))); wn = RSCALE / t; }
#undef P5_XOR1
#undef P5_XOR2
#undef P5_XOR3
#undef P5_MIR8
#undef P5_F
#undef P5_I
        }
        asm volatile("s_waitcnt lgkmcnt(0)\n\ts_barrier" ::: "memory");
        if (F.tid < 64) base_l[F.tid] = __hip_atomic_fetch_add(gcnt + 64 * F.tid, cnt_l[F.tid], __ATOMIC_RELAXED, __HIP_MEMORY_SCOPE_AGENT);
        asm volatile("s_waitcnt lgkmcnt(0)\n\ts_barrier" ::: "memory");
        { LAS const unsigned* pk = park + F.tid * 4; const unsigned e = pk[0], pos = pk[1], wb = __builtin_bit_cast(unsigned, __builtin_bit_cast(float, pk[2]) * wn);
          const int pair = (row0 + (F.tid >> 3)) * 8 + (F.tid & 7);
          LIST[(size_t)e * LIST_CAP + base_l[e] + pos] = (unsigned long long)(unsigned)pair | ((unsigned long long)wb << 32);
          }
        __syncthreads();
    }
}

namespace pg8 {
struct UnitG { int kind, slot, nvalid, pm, pn, row0; const char* bptr; };
constexpr int P6_PRE = AUX_OFF + 1024;
constexpr int P6_ROWS = AUX_OFF + 2048;
struct SchedG {
    const LAS int* pre; const LAS int* cnts; const LAS int* cum; const char* wgu; const char* wsh; int G, c, nr, total;
    __device__ __forceinline__ bool next(int i, UnitG& u) const {
        const int idx = i * G + c; if (idx >= total) return false;
        if (idx < nr) { int e = (int)__builtin_popcountll(__ballot(pre[1 + (threadIdx.x & 63)] <= idx));
            e = __builtin_amdgcn_readfirstlane(e); const int j = idx - __builtin_amdgcn_readfirstlane(pre[e]); const int nv = __builtin_amdgcn_readfirstlane(cnts[e]) - 256 * j;
            u.kind = 0; u.slot = i; u.nvalid = nv < 256 ? nv : 256; u.pm = e; u.pn = j; u.row0 = 256 * idx; u.bptr = wgu + (size_t)e * 256 * D; }
        else { const int s = idx - nr; u.kind = 1; u.slot = i; u.nvalid = 256; u.pm = s >> 1; u.pn = s & 1; u.row0 = (s >> 1) * 256; u.bptr = wsh + (size_t)(s & 1) * 256 * D; }
        return true; }
};
struct EpiGU {
    static constexpr bool PERM = true;
    unsigned char* HM; unsigned char* SH; int* SLOT; const LAS unsigned long long* rowinfo;
    __device__ __forceinline__ void operator()(const f32x4 (&acc)[2][2][4][2], const UnitG& u, int wr, int wc, int fr, int fq) const {
#pragma unroll
        for (int ai = 0; ai < 2; ++ai)
#pragma unroll
            for (int m = 0; m < 4; ++m) { const int r = ai * HALF + wr * 64 + m * 16 + fr;
                unsigned char* dst; float w;
                if (u.kind == 0) { const unsigned long long ri = rowinfo[u.slot * 256 + r]; dst = HM + (size_t)(u.row0 + r) * ED + wc * 32 + 8 * fq; w = __builtin_bit_cast(float, (unsigned)(ri >> 32)) * HM8SCALE;
                    }
                else { dst = SH + (size_t)(u.pm * 256 + r) * SHD + u.pn * 128 + wc * 32 + 8 * fq; w = SH8SCALE; }
                constexpr float DQ = 1.f / (W8SCALE * H8SCALE);
                const f32x4 g0 = acc[ai][0][m][0] * DQ, g1 = acc[ai][0][m][1] * DQ, u0 = acc[ai][1][m][0] * DQ, u1 = acc[ai][1][m][1] * DQ;
                float v[8];
#pragma unroll
                for (int j = 0; j < 4; ++j) { v[j] = __builtin_amdgcn_fmed3f(g0[j] * fsigmoid(g0[j]) * u0[j] * w, -448.f, 448.f); v[4 + j] = __builtin_amdgcn_fmed3f(g1[j] * fsigmoid(g1[j]) * u1[j] * w, -448.f, 448.f); }
                unsigned lo = 0u, hi = 0u;
                lo = __builtin_amdgcn_cvt_pk_fp8_f32(v[0], v[1], lo, false); lo = __builtin_amdgcn_cvt_pk_fp8_f32(v[2], v[3], lo, true);
                hi = __builtin_amdgcn_cvt_pk_fp8_f32(v[4], v[5], hi, false); hi = __builtin_amdgcn_cvt_pk_fp8_f32(v[6], v[7], hi, true);
                if (r < u.nvalid) *(unsigned long long*)dst = (unsigned long long)lo | ((unsigned long long)hi << 32); }
    }
};
template <class Epi, class Sched, bool FP8 = false>
__device__ __forceinline__ void gemm_phase_g(PG8_LAS unsigned char* lds, const bf16_t* A, int K, const Sched& S, const Epi& E, const PG8_LAS unsigned long long* rowinfo) {
    int tid_ = threadIdx.x; asm volatile("" : "+v"(tid_));
    const int tid = tid_, wid = __builtin_amdgcn_readfirstlane(tid >> 6), lane = tid & 63, wr = wid >> 2, wc = wid & 3, fr = lane & 15, fq = lane >> 4;
    const int nt = K / BK;
    int RA[2], CA[2]; unsigned voffB[2];
#pragma unroll
    for (int i = 0; i < 2; ++i) { int R, C; stage_rc(tid * 16 + i * 8192, R, C); const int Rb = Epi::PERM ? ((R & ~31) + perm32(R & 31)) : R; RA[i] = R; CA[i] = C; voffB[i] = (unsigned)(Rb * K + C) * 2u; }
    const size_t kstep = (size_t)(BK * 2);
    const size_t hstep = (size_t)HALF * K * 2;
    const unsigned ldsw = (unsigned)wid * 1024u;
    const int aoff = lds_byte(wr * 64 + fr, fq * 8), boff = lds_byte(wc * 32 + fr, fq * 8);
#define PG8_AOFF(u, o0, o1) do { _Pragma("unroll") for (int _i = 0; _i < 2; ++_i) { unsigned r0_, r1_; \
        if ((u).kind == 0) { r0_ = (unsigned)rowinfo[(u).slot * 256 + RA[_i]] >> 3; r1_ = (unsigned)rowinfo[(u).slot * 256 + HALF + RA[_i]] >> 3; } \
        else { r0_ = (unsigned)((u).row0 + RA[_i]); r1_ = r0_ + HALF; } \
        o0[_i] = (r0_ * (unsigned)K + (unsigned)CA[_i]) * 2u; o1[_i] = (r1_ * (unsigned)K + (unsigned)CA[_i]) * 2u; } } while (0)
#define PG8_SA(b, h) (((b) * 2 + (h)) * HTB)
#define PG8_SB(b, h) ((4 + (b) * 2 + (h)) * HTB)
#define PG8_STAGE(bufoff, gbase, voff) do { _Pragma("unroll") for (int _i = 0; _i < 2; ++_i) \
        __builtin_amdgcn_global_load_lds((const unsigned*)((const char*)(gbase) + (voff)[_i]), (PG8_LAS unsigned*)(lds + (bufoff) + ldsw + _i * 8192), 16, 0, 0); } while (0)
#define PG8_LDA(dst, b, h) do { _Pragma("unroll") for (int m = 0; m < 4; ++m) _Pragma("unroll") for (int k = 0; k < 2; ++k) dst[m][k] = *(const PG8_LAS bf16x8*)(lds + PG8_SA(b, h) + aoff + m * 2048 + k * 1024); } while (0)
#define PG8_LDB(dst, b, h) do { _Pragma("unroll") for (int n = 0; n < 2; ++n) _Pragma("unroll") for (int k = 0; k < 2; ++k) dst[n][k] = *(const PG8_LAS bf16x8*)(lds + PG8_SB(b, h) + boff + n * 2048 + k * 1024); } while (0)
#define PG8_MMA(ai, bj, At, Bt) do { __builtin_amdgcn_s_setprio(1); _Pragma("unroll") for (int m = 0; m < 4; ++m) _Pragma("unroll") for (int n = 0; n < 2; ++n) { \
        if constexpr (FP8) mfma8(acc[ai][bj][m][n], cat8(Bt[n][0], Bt[n][1]), cat8(At[m][0], At[m][1])); \
        else { _Pragma("unroll") for (int k = 0; k < 2; ++k) acc[ai][bj][m][n] = __builtin_amdgcn_mfma_f32_16x16x32_bf16(Bt[n][k], At[m][k], acc[ai][bj][m][n], 0, 0, 0); } } __builtin_amdgcn_s_setprio(0); } while (0)
#define PG8_WAIT_V(n) asm volatile("s_waitcnt vmcnt(" #n ")" ::: "memory")
#define PG8_WAIT_L(n) asm volatile("s_waitcnt lgkmcnt(" #n ")" ::: "memory")
#define PG8_BAR __builtin_amdgcn_s_barrier()
#define PG8_SCHED __builtin_amdgcn_sched_barrier(0)
    UnitG cur, nxt; int ui = 0;
    if (!S.next(0, cur)) return;
    f32x4 acc[2][2][4][2];
#pragma unroll
    for (int a = 0; a < 2; ++a)
#pragma unroll
        for (int b = 0; b < 2; ++b)
#pragma unroll
            for (int m = 0; m < 4; ++m)
#pragma unroll
                for (int n = 0; n < 2; ++n) acc[a][b][m][n] = (f32x4){0.f, 0.f, 0.f, 0.f};
    bf16x8 At[4][2], B0[2][2], B1[2][2];
    const char* cA = (const char*)A; const char* cB = cur.bptr;
    unsigned vA0[2], vA1[2], nA0[2], nA1[2];
    PG8_AOFF(cur, vA0, vA1);
    PG8_STAGE(PG8_SB(0, 0), cB, voffB); PG8_STAGE(PG8_SB(0, 1), cB + hstep, voffB); PG8_STAGE(PG8_SA(0, 0), cA, vA0); PG8_STAGE(PG8_SA(0, 1), cA, vA1);
    if (wr == 1) PG8_BAR;
    PG8_WAIT_V(2); PG8_BAR;
    PG8_STAGE(PG8_SB(1, 0), cB + kstep, voffB); PG8_STAGE(PG8_SA(1, 0), cA + kstep, vA0); PG8_STAGE(PG8_SB(1, 1), cB + hstep + kstep, voffB);
    PG8_WAIT_V(6); PG8_BAR;
    for (;;) {
        const bool has_next = S.next(ui + 1, nxt);
        const char* nB = has_next ? nxt.bptr : cB;
        if (has_next) { PG8_AOFF(nxt, nA0, nA1); } else {
#pragma unroll
            for (int _i = 0; _i < 2; ++_i) { nA0[_i] = vA0[_i]; nA1[_i] = vA1[_i]; } }
#pragma nounroll
        for (int t = 0; t < nt; t += 2) {
            const bool last = (t == nt - 2);
            const char* a1 = cA + (size_t)(t + 1) * kstep;
            const char* a2 = last ? cA : cA + (size_t)(t + 2) * kstep; const char* b2 = last ? nB : cB + (size_t)(t + 2) * kstep;
            const char* a3 = a2 + kstep; const char* b3 = b2 + kstep;
            unsigned s0[2], s1[2];
#pragma unroll
            for (int _i = 0; _i < 2; ++_i) { s0[_i] = last ? nA0[_i] : vA0[_i]; s1[_i] = last ? nA1[_i] : vA1[_i]; }
            PG8_LDB(B0, 0, 0); PG8_LDB(B1, 0, 1); PG8_SCHED; PG8_LDA(At, 0, 0); PG8_STAGE(PG8_SA(1, 1), a1, vA1);
            PG8_WAIT_V(8); PG8_WAIT_L(0); PG8_BAR; PG8_MMA(0, 0, At, B0); PG8_MMA(0, 1, At, B1); PG8_BAR; PG8_SCHED;
            PG8_LDA(At, 0, 1); PG8_STAGE(PG8_SB(0, 0), b2, voffB); PG8_STAGE(PG8_SB(0, 1), b2 + hstep, voffB); PG8_STAGE(PG8_SA(0, 0), a2, s0);
            PG8_WAIT_V(8); PG8_WAIT_L(0); PG8_BAR; PG8_MMA(1, 0, At, B0); PG8_MMA(1, 1, At, B1); PG8_BAR; PG8_SCHED;
            PG8_LDB(B0, 1, 0); PG8_LDB(B1, 1, 1); PG8_SCHED; PG8_LDA(At, 1, 0); PG8_STAGE(PG8_SA(0, 1), a2, s1);
            PG8_WAIT_V(8); PG8_WAIT_L(0); PG8_BAR; PG8_MMA(0, 0, At, B0); PG8_MMA(0, 1, At, B1); PG8_BAR; PG8_SCHED;
            PG8_LDA(At, 1, 1); PG8_STAGE(PG8_SB(1, 0), b3, voffB); PG8_STAGE(PG8_SB(1, 1), b3 + hstep, voffB); PG8_STAGE(PG8_SA(1, 0), a3, s0);
            PG8_WAIT_V(8); PG8_WAIT_L(0); PG8_BAR; PG8_MMA(1, 0, At, B0); PG8_MMA(1, 1, At, B1); PG8_BAR; PG8_SCHED;
        }
        if (wr == 0) PG8_BAR;
        if constexpr (FP8) mfma8_settle(acc);
        E(acc, cur, wr, wc, fr, fq);
        if (!has_next) break;
#pragma unroll
        for (int a = 0; a < 2; ++a)
#pragma unroll
            for (int b = 0; b < 2; ++b)
#pragma unroll
                for (int m = 0; m < 4; ++m)
#pragma unroll
                    for (int n = 0; n < 2; ++n) acc[a][b][m][n] = (f32x4){0.f, 0.f, 0.f, 0.f};
        cur = nxt; cB = nB; ++ui;
#pragma unroll
        for (int _i = 0; _i < 2; ++_i) { vA0[_i] = nA0[_i]; vA1[_i] = nA1[_i]; }
        if (wr == 1) PG8_BAR;
    }
    PG8_WAIT_V(0);
    PG8_BAR;
#undef PG8_AOFF
#undef PG8_SA
#undef PG8_SB
#undef PG8_STAGE
#undef PG8_LDA
#undef PG8_LDB
#undef PG8_MMA
#undef PG8_WAIT_V
#undef PG8_WAIT_L
#undef PG8_BAR
#undef PG8_SCHED
}
}

__device__ __forceinline__ void p6_gateup(Frame& F, const Args& a) {
    unsigned char* ws = a.ws; gu32* gcnt = F.ctl + CW_CNT; const unsigned long long* LIST = (const unsigned long long*)(ws + WS_LIST);
    LAS int* pre = (LAS int*)(F.lds + pg8::P6_PRE); LAS int* cnts = pre + 65; LAS int* cum = cnts + 64; LAS unsigned long long* rowinfo = (LAS unsigned long long*)(F.lds + pg8::P6_ROWS);
    if (F.tid < 64) { const int cn = (int)__hip_atomic_load(gcnt + 64 * F.tid, RLX_AGENT), t = (cn + 255) >> 8;
        const int ps = wave_excl_scan(t, F.tid), pr = wave_excl_scan(cn, F.tid);
        cnts[F.tid] = cn; pre[F.tid] = ps; cum[F.tid] = pr; if (F.tid == 63) { pre[64] = ps + t; cum[64] = pr + cn; } }
    __syncthreads();
    pg8::SchedG S; S.pre = pre; S.cnts = cnts; S.cum = cum; S.wgu = (const char*)(ws + WS_WGU); S.wsh = (const char*)(ws + WS_WSHGU); S.G = F.G; S.c = F.vcu  ; S.nr = __builtin_amdgcn_readfirstlane(pre[64]); S.total = S.nr + 2 * (M / 256);
    { unsigned long long rv[3]; bool wr[3];
#pragma unroll
      for (int i = 0; i < 3; ++i) { pg8::UnitG u; rv[i] = 0ull; wr[i] = false;
          if (S.next(i, u) && u.kind == 0) { wr[i] = true; if (F.tid < 256 && F.tid < u.nvalid) rv[i] = LIST[(size_t)u.pm * LIST_CAP + 256 * u.pn + F.tid]; } }
#pragma unroll
      for (int i = 0; i < 3; ++i) if (wr[i] && F.tid < 256) rowinfo[i * 256 + F.tid] = rv[i]; }
    __syncthreads();
    pg8::EpiGU E{ws + WS_HM, ws + WS_SH, (int*)(ws + WS_SLOT), rowinfo};
    pg8::gemm_phase_g<pg8::EpiGU, pg8::SchedG, true>(F.lds + RING_OFF, (const bf16_t*)(ws + WS_H2), D / 2, S, E, rowinfo);
    { const int rounds = (S.total + F.G - 1) / F.G, firstidle = S.total - (rounds - 1) * F.G;
      const int c = F.vcu, nidle = F.G - firstidle;
      if (nidle > 0) { if (c >= firstidle) titem_run(F, a, true, 64 * 64 + 4 * 32, (c - firstidle) * NWAVES + F.wave, nidle * NWAVES); }
      else titem_run(F, a, true, 64 * 64 + 4 * 32, c * NWAVES + F.wave, F.G * NWAVES); }
}

namespace pg8 {
struct SchedYr {
    const LAS int* pre; int G, c, total;
    __device__ __forceinline__ bool next(int i, Unit& u) const {
        const int idx = i * G + c; if (idx >= total) return false;
        const int t = idx >> 2, pnl = idx & 3; int e = (int)__builtin_popcountll(__ballot(pre[1 + (threadIdx.x & 63)] <= t));
        e = __builtin_amdgcn_readfirstlane(e); u.pm = t; u.pn = 4 * e + pnl; return true; }
    __device__ __forceinline__ void a_ready(const Unit&) const {}
    __device__ __forceinline__ void done(const Unit&) const {}
};
constexpr float YSCALE = 8.f;
struct EpiStoreF8 {
    static constexpr bool PERM = true, AFTER_DRAIN = false;
    unsigned char* O; const PG8_LAS int* rowmap_l; int G, c; float scale;
    __device__ __forceinline__ void operator()(const f32x4 (&acc)[2][2][4][2], const Unit& u, int wr, int wc, int fr, int fq) const {
        const int slot = (4 * u.pm + (u.pn & 3) - c) / G; const PG8_LAS int* rm = rowmap_l + slot * 256 + wr * 64 + fr; const int col0 = (u.pn & 3) * BM + wc * 64 + 16 * fq;
#pragma unroll
        for (int ai = 0; ai < 2; ++ai)
#pragma unroll
            for (int m = 0; m < 4; ++m) { const int orow = rm[ai * HALF + m * 16]; u32x4 w;
#pragma unroll
                for (int bj = 0; bj < 2; ++bj) { const f32x4 v0 = acc[ai][bj][m][0] * scale, v1 = acc[ai][bj][m][1] * scale;
                    unsigned lo = 0u, hi = 0u;
                    lo = __builtin_amdgcn_cvt_pk_fp8_f32(v0[0], v0[1], lo, false); lo = __builtin_amdgcn_cvt_pk_fp8_f32(v0[2], v0[3], lo, true);
                    hi = __builtin_amdgcn_cvt_pk_fp8_f32(v1[0], v1[1], hi, false); hi = __builtin_amdgcn_cvt_pk_fp8_f32(v1[2], v1[3], hi, true);
                    if (bj == 0) { w.x = lo; w.y = hi; } else { w.z = lo; w.w = hi; } }
                *(u32x4*)(O + (size_t)orow * 1024 + col0) = w; }
    }
};
struct EpiStoreF8Dense {
    static constexpr bool PERM = true, AFTER_DRAIN = false;
    unsigned char* O; float scale;
    __device__ __forceinline__ void operator()(const f32x4 (&acc)[2][2][4][2], const Unit& u, int wr, int wc, int fr, int fq) const {
        const int row0 = u.pm * BM + wr * 64 + fr, col0 = (u.pn & 3) * BM + wc * 32 + 8 * fq;
#pragma unroll
        for (int ai = 0; ai < 2; ++ai)
#pragma unroll
            for (int m = 0; m < 4; ++m) { unsigned char* rowp = O + (size_t)(row0 + ai * HALF + m * 16) * 1024 + col0;
#pragma unroll
                for (int bj = 0; bj < 2; ++bj) { const f32x4 v0 = acc[ai][bj][m][0] * scale, v1 = acc[ai][bj][m][1] * scale;
                    unsigned lo = 0u, hi = 0u;
                    lo = __builtin_amdgcn_cvt_pk_fp8_f32(v0[0], v0[1], lo, false); lo = __builtin_amdgcn_cvt_pk_fp8_f32(v0[2], v0[3], lo, true);
                    hi = __builtin_amdgcn_cvt_pk_fp8_f32(v1[0], v1[1], hi, false); hi = __builtin_amdgcn_cvt_pk_fp8_f32(v1[2], v1[3], hi, true);
                    *(unsigned long long*)(rowp + bj * HALF) = (unsigned long long)lo | ((unsigned long long)hi << 32); } }
    }
};
struct EpiStore {
    static constexpr bool PERM = true, AFTER_DRAIN = false;
    bf16_t* O; int ldc, colmask;
    __device__ __forceinline__ void operator()(const f32x4 (&acc)[2][2][4][2], const Unit& u, int wr, int wc, int fr, int fq) const {
        const int row0 = u.pm * BM + wr * 64 + fr, col0 = (u.pn & colmask) * BM + wc * 32 + 8 * fq;
#pragma unroll
        for (int ai = 0; ai < 2; ++ai)
#pragma unroll
            for (int m = 0; m < 4; ++m) { bf16_t* rowp = O + (size_t)(row0 + ai * HALF + m * 16) * ldc + col0;
#pragma unroll
                for (int bj = 0; bj < 2; ++bj) { const f32x4 v0 = acc[ai][bj][m][0], v1 = acc[ai][bj][m][1];
                    u32x4 w; w.x = cvt_pk_bf16(v0[0], v0[1]); w.y = cvt_pk_bf16(v0[2], v0[3]); w.z = cvt_pk_bf16(v1[0], v1[1]); w.w = cvt_pk_bf16(v1[2], v1[3]);
                    *(u32x4*)(rowp + bj * HALF) = w; } }
    }
};
template <class Epi, class Sched, int NK>
__device__ __forceinline__ void gemm_phase_f8s(PG8_LAS unsigned char* lds, const unsigned char* A, const unsigned char* Bt, const Sched& S, const Epi& E) {
    int tid_ = threadIdx.x; asm volatile("" : "+v"(tid_));
    const int tid = tid_, wid = __builtin_amdgcn_readfirstlane(tid >> 6), lane = tid & 63, wr = wid >> 2, wc = wid & 3, fr = lane & 15, fq = lane >> 4;
    constexpr int PITCH = NK * 128;
    unsigned voffA[2], voffB[2];
#pragma unroll
    for (int i = 0; i < 2; ++i) { int R, C; stage_rc(tid * 16 + i * 8192, R, C); const int Rb = Epi::PERM ? ((R & ~31) + perm32(R & 31)) : R; voffA[i] = (unsigned)(R * PITCH + 2 * C); voffB[i] = (unsigned)(Rb * PITCH + 2 * C); }
    constexpr size_t hstep = (size_t)HALF * PITCH, tstep = 2 * hstep;
    const unsigned ldsw = (unsigned)wid * 1024u;
    const int aoff = lds_byte(wr * 64 + fr, fq * 8), boff = lds_byte(wc * 32 + fr, fq * 8);
#define F8S_SA(b, h) (((b) * 2 + (h)) * HTB)
#define F8S_SB(b, h) ((4 + (b) * 2 + (h)) * HTB)
#define F8S_STAGE(bufoff, gbase, voff) do { _Pragma("unroll") for (int _i = 0; _i < 2; ++_i) \
        __builtin_amdgcn_global_load_lds((const unsigned*)((const char*)(gbase) + (voff)[_i]), (PG8_LAS unsigned*)(lds + (bufoff) + ldsw + _i * 8192), 16, 0, 0); } while (0)
#define F8S_STAGE4(b, pa, pb) do { F8S_STAGE(F8S_SB(b, 0), pb, voffB); F8S_STAGE(F8S_SB(b, 1), (pb) + hstep, voffB); F8S_STAGE(F8S_SA(b, 0), pa, voffA); F8S_STAGE(F8S_SA(b, 1), (pa) + hstep, voffA); } while (0)
#define F8S_LDA(dst, b, h) do { _Pragma("unroll") for (int m = 0; m < 4; ++m) _Pragma("unroll") for (int k = 0; k < 2; ++k) dst[m][k] = *(const PG8_LAS bf16x8*)(lds + F8S_SA(b, h) + aoff + m * 2048 + k * 1024); } while (0)
#define F8S_LDB(dst, b, h) do { _Pragma("unroll") for (int n = 0; n < 2; ++n) _Pragma("unroll") for (int k = 0; k < 2; ++k) dst[n][k] = *(const PG8_LAS bf16x8*)(lds + F8S_SB(b, h) + boff + n * 2048 + k * 1024); } while (0)
#define F8S_MMA(ai, bj, At, Bt_) do { _Pragma("unroll") for (int m = 0; m < 4; ++m) _Pragma("unroll") for (int n = 0; n < 2; ++n) mfma8(acc[ai][bj][m][n], cat8(Bt_[n][0], Bt_[n][1]), cat8(At[m][0], At[m][1])); } while (0)
    Unit cur, nxt; int ui = 0;
    if (!S.next(0, cur)) return;
    f32x4 acc[2][2][4][2];
#pragma unroll
    for (int a = 0; a < 2; ++a)
#pragma unroll
        for (int b = 0; b < 2; ++b)
#pragma unroll
            for (int m = 0; m < 4; ++m)
#pragma unroll
                for (int n = 0; n < 2; ++n) acc[a][b][m][n] = (f32x4){0.f, 0.f, 0.f, 0.f};
    const char* cA = (const char*)A + (size_t)cur.pm * tstep; const char* cB = (const char*)Bt + (size_t)cur.pn * tstep;
    bool has_next = S.next(1, nxt);
    int b = 0, kt = 0;
    F8S_STAGE4(0, cA, cB);
    asm volatile("s_waitcnt vmcnt(0)" ::: "memory");
#pragma nounroll
    for (;;) {
        __builtin_amdgcn_s_barrier();
        bf16x8 At0[4][2], At1[4][2], B0[2][2], B1[2][2];
        F8S_LDB(B0, b, 0); F8S_LDB(B1, b, 1); F8S_LDA(At0, b, 0); F8S_LDA(At1, b, 1);
        asm volatile("s_waitcnt lgkmcnt(0)" ::: "memory");
        __builtin_amdgcn_s_barrier();
        const bool last_kt = (kt == NK - 1), more = !last_kt || has_next;
        if (more) { const char* nA = last_kt ? (const char*)A + (size_t)nxt.pm * tstep : cA + (kt + 1) * 128; const char* nB = last_kt ? (const char*)Bt + (size_t)nxt.pn * tstep : cB + (kt + 1) * 128;
            if (b == 0) F8S_STAGE4(1, nA, nB); else F8S_STAGE4(0, nA, nB); }
        __builtin_amdgcn_s_setprio(1);
        F8S_MMA(0, 0, At0, B0); F8S_MMA(0, 1, At0, B1); F8S_MMA(1, 0, At1, B0); F8S_MMA(1, 1, At1, B1);
        __builtin_amdgcn_s_setprio(0);
        asm volatile("s_waitcnt vmcnt(0)" ::: "memory");
        if (last_kt) {
            mfma8_settle(acc);
            E(acc, cur, wr, wc, fr, fq);
            if (!has_next) break;
#pragma unroll
            for (int a = 0; a < 2; ++a)
#pragma unroll
                for (int bb = 0; bb < 2; ++bb)
#pragma unroll
                    for (int m = 0; m < 4; ++m)
#pragma unroll
                        for (int n = 0; n < 2; ++n) acc[a][bb][m][n] = (f32x4){0.f, 0.f, 0.f, 0.f};
            cur = nxt; cA = (const char*)A + (size_t)cur.pm * tstep; cB = (const char*)Bt + (size_t)cur.pn * tstep; ++ui; has_next = S.next(ui + 1, nxt); kt = 0;
        } else ++kt;
        b ^= 1;
    }
    __builtin_amdgcn_s_barrier();
#undef F8S_SA
#undef F8S_SB
#undef F8S_STAGE
#undef F8S_STAGE4
#undef F8S_LDA
#undef F8S_LDB
#undef F8S_MMA
}
}
__device__ __forceinline__ void p7_down(Frame& F, const Args& a) {
    unsigned char* ws = a.ws;
    LAS int* pre = (LAS int*)(F.lds + pg8::P6_PRE); LAS int* cnts = pre + 65;
    { pg8::SchedYr S; S.pre = pre; S.G = F.G; S.c = F.vcu; S.total = 4 * __builtin_amdgcn_readfirstlane(pre[64]);
      int kk = ED; asm volatile("" : "+s"(kk));
      LAS int* rml = (LAS int*)(F.lds + AUX_OFF + 2048); const unsigned long long* LIST = (const unsigned long long*)(ws + WS_LIST);
      __syncthreads();
      { int rvv[12];
#pragma unroll
        for (int i = 0; i < 12; ++i) { rvv[i] = M * 8;
          if (i * F.G + S.c < S.total) { const int t = (i * F.G + S.c) >> 2;
            int e = (int)__builtin_popcountll(__ballot(pre[1 + (threadIdx.x & 63)] <= t)); e = __builtin_amdgcn_readfirstlane(e);
            const int j = t - __builtin_amdgcn_readfirstlane(pre[e]), nv = __builtin_amdgcn_readfirstlane(cnts[e]) - 256 * j;
            if (F.tid < 256 && F.tid < nv) rvv[i] = (int)(unsigned)LIST[(size_t)e * LIST_CAP + 256 * j + F.tid]; } }
#pragma unroll
        for (int i = 0; i < 12; ++i) if (i * F.G + S.c < S.total && F.tid < 256) rml[i * 256 + F.tid] = rvv[i]; }
      __syncthreads();
      pg8::EpiStoreF8 E{ws + WS_YH, rml, F.G, S.c, pg8::YSCALE / (HM8SCALE * W8SCALE)};
      pg8::gemm_phase_f8s<pg8::EpiStoreF8, pg8::SchedYr, 1>(F.lds + RING_OFF, ws + WS_HM, ws + WS_WD, S, E); }
    { pg8::StaticOrder S; S.init(M, D, F.G, (int)blockIdx.x);
      int kk = SHD; asm volatile("" : "+s"(kk));
      pg8::EpiStoreF8Dense E{ws + WS_YSH, pg8::YSCALE / (SH8SCALE * W8SCALE)};
      pg8::gemm_phase_f8s<pg8::EpiStoreF8Dense, pg8::StaticOrder, 2>(F.lds + RING_OFF, ws + WS_SH, ws + WS_WSHD, S, E); }
}
__device__ __forceinline__ void p8_combine(Frame& F, const Args& a) {
    unsigned char* ws = a.ws; const unsigned char* Y8 = ws + WS_YH; const unsigned char* YSH = ws + WS_YSH;
    const float* mod = (const float*)(ws + WS_MOD); float* OUT = a.out; const int lane = F.lane;
    for (int tb = (F.vcu * NWAVES + F.wave) * 8; tb < M; tb += F.G * NWAVES * 8) {
        const int b = tb / SEQ; const float* gate = mod + (size_t)b * 6 * D + 5 * D + lane * 16;
        f32x4 gv[4];
#pragma unroll
        for (int i = 0; i < 4; ++i) gv[i] = *(const f32x4*)(gate + 4 * i);
#pragma nounroll
        for (int i = 0; i < 8; i += 2) {
            v4u y[2][9]; f32x4 x[2][4];
#pragma unroll
            for (int q = 0; q < 2; ++q) { const int t = tb + i + q;
#pragma unroll
                for (int k = 0; k < 8; ++k) y[q][k] = *(const GAS v4u*)(Y8 + ((size_t)t * 8 + k) * 1024 + lane * 16);
                y[q][8] = *(const GAS v4u*)(YSH + (size_t)t * D + lane * 16);
                const GAS v4u* o = (const GAS v4u*)(x1b_row(ws, t) + lane * 16); const v4u xa = o[0], xb = o[1];
                x[q][0] = f32x4{__builtin_bit_cast(float, xa.x << 16), __builtin_bit_cast(float, xa.x & 0xffff0000u), __builtin_bit_cast(float, xa.y << 16), __builtin_bit_cast(float, xa.y & 0xffff0000u)};
                x[q][1] = f32x4{__builtin_bit_cast(float, xa.z << 16), __builtin_bit_cast(float, xa.z & 0xffff0000u), __builtin_bit_cast(float, xa.w << 16), __builtin_bit_cast(float, xa.w & 0xffff0000u)};
                x[q][2] = f32x4{__builtin_bit_cast(float, xb.x << 16), __builtin_bit_cast(float, xb.x & 0xffff0000u), __builtin_bit_cast(float, xb.y << 16), __builtin_bit_cast(float, xb.y & 0xffff0000u)};
                x[q][3] = f32x4{__builtin_bit_cast(float, xb.z << 16), __builtin_bit_cast(float, xb.z & 0xffff0000u), __builtin_bit_cast(float, xb.w << 16), __builtin_bit_cast(float, xb.w & 0xffff0000u)}; }
#pragma unroll
            for (int q = 0; q < 2; ++q) { const int t = tb + i + q; float acc[16];
#pragma unroll
                for (int j = 0; j < 16; ++j) acc[j] = 0.f;
#pragma unroll
                for (int k = 0; k < 9; ++k) { const unsigned w4[4] = {y[q][k].x, y[q][k].y, y[q][k].z, y[q][k].w};
#pragma unroll
                    for (int j = 0; j < 4; ++j) { const pg8::f32x2_t lo = __builtin_amdgcn_cvt_pk_f32_fp8((int)w4[j], false), hi = __builtin_amdgcn_cvt_pk_f32_fp8((int)w4[j], true);
                        acc[4 * j] += lo.x; acc[4 * j + 1] += lo.y; acc[4 * j + 2] += hi.x; acc[4 * j + 3] += hi.y; } }
                GAS f32x4* o = (GAS f32x4*)(OUT + (size_t)t * D + lane * 16);
#pragma unroll
                for (int j = 0; j < 4; ++j) { const f32x4 rt = {acc[4 * j], acc[4 * j + 1], acc[4 * j + 2], acc[4 * j + 3]};
                    o[j] = x[q][j] + gv[j] * (rt * (1.f / pg8::YSCALE)); } }
        }
    }
}

__global__ void __launch_bounds__(NWAVES * 64, 2) mk_fwd(Args args) {
    extern __shared__ __attribute__((aligned(16))) unsigned char lds[];
    Frame F;
    F.lds = (LAS unsigned char*)lds; F.MISC = (volatile LAS unsigned*)(F.lds + MISC_OFF);
    F.tid = threadIdx.x; F.lane = F.tid & 63; F.wave = __builtin_amdgcn_readfirstlane(F.tid >> 6);
    F.G = gridDim.x; { const int bx = blockIdx.x; F.vcu = (F.G % 8 == 0) ? (bx % 8) * (F.G / 8) + bx / 8 : bx; }
    unsigned char* ws = args.ws; F.ctl = (gu32*)(ws + WS_CTL);
    for (int u = F.tid; u < (LDS_BYTES - LDSCTL_OFF) / 4; u += NWAVES * 64) ((LAS unsigned*)(F.lds + LDSCTL_OFF))[u] = 0u;
    __syncthreads();
    XcdBarrier bar; bar.bar = (unsigned*)(F.ctl + CW_BAR); bar.x = 0; bar.st = nullptr;
    if (args.use_bar) bar = xcd_barrier_post((unsigned*)(F.ctl + CW_BAR), F.MISC + 8);
    const int lo = args.ph_lo, hi = args.ph_hi;
#define IN(k) (lo <= (k) && (k) < hi)
#define SEAM(k) do { if (IN(k) && IN((k) + 1)) { if ((k) <= 5) { REFRESH(); xcd_barrier_work(bar, F, args, (k) == 0 ? 0 : (k) - 1); } else xcd_barrier(bar); } } while (0)
#define REFRESH() do { int t_ = threadIdx.x; asm volatile("" : "+v"(t_)); F.tid = t_; F.lane = t_ & 63; F.wave = __builtin_amdgcn_readfirstlane(t_ >> 6); } while (0)
#define PHASE(p, ...) do { if (IN(p)) { REFRESH(); const int reps_ = (DBL_PHASE == (p)) ? 2 : 1; for (int rep_ = 0; rep_ < reps_; ++rep_) { __VA_ARGS__; if (rep_ + 1 < reps_) xcd_barrier(bar); } } SEAM(p); } while (0)
    PHASE(0, { p0a(F, args); __syncthreads(); p0b(F, args); });
    PHASE(2, {
        pg8::StaticOrder S; S.init(M, INW / 2, F.G, (int)blockIdx.x);
        { pg8::Gemm g{(const bf16_t*)(ws + WS_XN), (const bf16_t*)(ws + WS_WIN), M, INW / 2, D};
          pg8::EpiProj E{(bf16_t*)(ws + WS_Q), (bf16_t*)(ws + WS_K), (bf16_t*)(ws + WS_V), (bf16_t*)(ws + WS_U), (bf16_t*)(ws + WS_GA), (bf16_t*)(ws + WS_GB), args.in[6], args.in[7], 0, 1.f};
          pg8::gemm_phase<pg8::EpiProj, pg8::StaticOrder, true, true>(F.lds + RING_OFF, g, S, E); }
        { pg8::Gemm g{(const bf16_t*)(ws + WS_XN8), (const bf16_t*)(ws + WS_WIN8), M, INW / 2, D / 2};
          pg8::EpiProj E{(bf16_t*)(ws + WS_Q), (bf16_t*)(ws + WS_K), (bf16_t*)(ws + WS_V), (bf16_t*)(ws + WS_U), (bf16_t*)(ws + WS_GA), (bf16_t*)(ws + WS_GB), args.in[6], args.in[7], 8, 1.f / (W8SCALE * H8SCALE)};
          pg8::gemm_phase<pg8::EpiProj, pg8::StaticOrder, true, true, true>(F.lds + RING_OFF, g, S, E); } });
    PHASE(3, {
        const bf16_t* Q = (const bf16_t*)(ws + WS_Q); const bf16_t* K = (const bf16_t*)(ws + WS_K); const bf16_t* V = (const bf16_t*)(ws + WS_V);
        constexpr int NU = BATCH * NH * (SEQ / 256); const int u0 = (F.G == 256) ? (F.vcu >> 5) * 64 + (F.vcu & 31) : F.vcu, u1 = (F.G == 256) ? u0 + 32 : u0 + F.G;
        sb::AttnPre pa, pb;
        if (u0 < NU) sb::attn_preload(pa, (u0 >> 4) >> 3, (u0 >> 4) & 7, u0 & 15, Q, K, F.wave, F.lane);
        p2_pool(F, (const bf16_t*)(ws + WS_U), (bf16_t*)(ws + WS_MIX));
        if (u0 < NU) sb::attn_unit((u0 >> 4) >> 3, (u0 >> 4) & 7, u0 & 15, pa, K, V, (bf16_t*)(ws + WS_OSB), F.lds + RING_OFF + F.wave * sb::WAVE_LDS, F.wave, F.lane);
        if (u1 < NU) { sb::attn_preload(pb, (u1 >> 4) >> 3, (u1 >> 4) & 7, u1 & 15, Q, K, F.wave, F.lane); sb::attn_unit((u1 >> 4) >> 3, (u1 >> 4) & 7, u1 & 15, pb, K, V, (bf16_t*)(ws + WS_OSB), F.lds + RING_OFF + F.wave * sb::WAVE_LDS, F.wave, F.lane); }
        for (int u = (F.G == 256) ? NU : u1 + F.G; u < NU; u += F.G) { sb::attn_preload(pa, (u >> 4) >> 3, (u >> 4) & 7, u & 15, Q, K, F.wave, F.lane);
            sb::attn_unit((u >> 4) >> 3, (u >> 4) & 7, u & 15, pa, K, V, (bf16_t*)(ws + WS_OSB), F.lds + RING_OFF + F.wave * sb::WAVE_LDS, F.wave, F.lane); } });
    PHASE(4, {
        static_assert(WS_MIX == WS_OSB + (size_t)M * SBW * 2 && WS_WEFF == WS_WSB + (size_t)D * SBW * 2 && SBW == PW, "P3 stacks o_sb | mix and W_sb_out^T | W_eff^T");
        pg8::SchedMerge S; S.so.init(M, D, F.G, (int)blockIdx.x);
        pg8::Gemm g{(const bf16_t*)(ws + WS_OSB), (const bf16_t*)(ws + WS_WSB), 2 * M, 2 * D, SBW}; pg8::EpiMerge2 E{ws + WS_GA, ws + WS_GB, ws + WS_MERGED8};
        pg8::gemm_phase<pg8::EpiMerge2, pg8::SchedMerge, true, true>(F.lds + RING_OFF, g, S, E); });
    PHASE(5, {
        pg8::Gemm g{(const bf16_t*)(ws + WS_MERGED8), (const bf16_t*)(ws + WS_WOUT), M, D, D / 2}; pg8::StaticOrder S; S.init(M, D, F.G, (int)blockIdx.x);
        pg8::EpiX1 E{args.in[0], (const float*)(ws + WS_MOD) + 2 * D, ws, (float*)(ws + WS_PE), 1.f / (32.f * W8SCALE)};
        pg8::gemm_phase<pg8::EpiX1, pg8::StaticOrder, true, true, true>(F.lds + RING_OFF, g, S, E); });
    PHASE(6, {
        if (rep_ > 0) { if (blockIdx.x == 0 && F.tid < 64) __hip_atomic_store(F.ctl + CW_CNT + 64 * F.tid, 0u, RLX_AGENT); xcd_barrier(bar); }
        p5_route(F, args); });
    PHASE(7, p6_gateup(F, args));
    PHASE(8, p7_down(F, args));
    if (IN(9)) { REFRESH(); p8_combine(F, args); }
#undef PHASE
#undef REFRESH
#undef IN
#undef SEAM
}
constexpr int N_PHASES = 10;
extern "C" void kernel_launch(void* const* d_in, const int* in_sizes, int n_in, void* d_out, int out_size, void* d_ws, size_t ws_size, hipStream_t stream) {
    static int grid = 0;
    if (grid == 0) {
        if (n_in != 22 || out_size != M * D || ws_size < WS_END) { fprintf(stderr, "kernel_launch: unexpected shapes n_in %d out %d ws %zu\n", n_in, out_size, ws_size); grid = -1; return; }
        int dev = 0, cus = 0, per_cu = 0;
        if (hipGetDevice(&dev) != hipSuccess || hipDeviceGetAttribute(&cus, hipDeviceAttributeMultiprocessorCount, dev) != hipSuccess) { grid = -1; return; }
        if (hipFuncSetAttribute((const void*)mk_fwd, hipFuncAttributeMaxDynamicSharedMemorySize, LDS_BYTES) != hipSuccess) { fprintf(stderr, "kernel_launch: hipFuncSetAttribute failed\n"); grid = -1; return; }
        if (hipOccupancyMaxActiveBlocksPerMultiprocessor(&per_cu, (const void*)mk_fwd, NWAVES * 64, LDS_BYTES) != hipSuccess || per_cu < 1) fprintf(stderr, "kernel_launch: occupancy query says %d per CU\n", per_cu);
        (void)hipGetLastError();
        grid = cus;
        if (grid * 64 < M) { fprintf(stderr, "kernel_launch: %d CUs cannot cover %d rows in the one-block-per-workgroup phases\n", cus, M); grid = -1; return; }
    }
    if (grid < 0) return;
    unsigned char* ws = (unsigned char*)d_ws;
    if (hipMemsetAsync(ws + WS_CTL, 0, CTL_ZERO_BYTES, stream) != hipSuccess) { fprintf(stderr, "kernel_launch: memset failed\n"); return; }
    Args a{};
    for (int i = 0; i < 22; ++i) a.in[i] = (const float*)d_in[i];
    a.out = (float*)d_out; a.ws = ws; a.ph_lo = 0; a.ph_hi = N_PHASES; a.use_bar = 1;
    hipLaunchKernelGGL(mk_fwd, dim3(grid), dim3(NWAVES * 64), LDS_BYTES, stream, a);
}
```
